# Optimizing an MI355X kernel written in HIP

```python
import jax, jax.numpy as jnp
from jax import lax
import numpy as np

D_MODEL = 1024
BATCH = 4
SEQ = 8192
DEPTH = 1
DEC_BATCH = 128
DEC_SEQ = 8
PAST_LEN = 16384
PAGE_SIZE = 128

HEAD_DIM = 64
D_ATTN = D_MODEL // 2
D_RWKV = D_MODEL - D_ATTN
N_HEADS = D_ATTN // HEAD_DIM
N_KV_HEADS = 2
GQA_GROUP = N_HEADS // N_KV_HEADS
D_KV = N_KV_HEADS * HEAD_DIM
WINDOW = 128
BLOCK = 128
ROPE_THETA = 10000.0
RWKV_HEADS = D_RWKV // HEAD_DIM
D_DECAY_LORA = 32
D_A_LORA = 32
D_GATE_LORA = 96
D_SHIFT = 3 * D_RWKV + D_DECAY_LORA + D_A_LORA + D_GATE_LORA
D_IN = D_ATTN + 2 * D_KV + D_SHIFT
D_FF = 2816
CONV_W = 3
RMS_EPS = 1e-6
GN_EPS = 64e-5
NEG_INF = -1e30

kernel_name = "hymba_swa_sink_rwkv7_convffn_step"


def _rms_norm(x, g):
    xf = x.astype(jnp.float32)
    y = xf * lax.rsqrt(jnp.mean(xf * xf, axis=-1, keepdims=True) + RMS_EPS)
    return (y * g.astype(jnp.float32)).astype(x.dtype)


def _rope(x, pos):
    half = HEAD_DIM // 2
    inv = ROPE_THETA ** (-jnp.arange(half, dtype=jnp.float32) / half)
    ang = pos.astype(jnp.float32)[:, None] * inv[None, :]
    cos = jnp.cos(ang)[None, :, None, :]
    sin = jnp.sin(ang)[None, :, None, :]
    xf = x.astype(jnp.float32)
    x1, x2 = xf[..., :half], xf[..., half:]
    return jnp.concatenate([x1 * cos - x2 * sin, x2 * cos + x1 * sin], axis=-1).astype(x.dtype)


def _attend_with_sinks(q, k, v, mask, sinks):
    s = jnp.einsum('...qkgd,...skd->...kgqs', q, k,
                   preferred_element_type=jnp.float32) * (HEAD_DIM ** -0.5)
    s = jnp.where(mask[..., None, None, :, :], s, NEG_INF)
    sink = sinks.astype(jnp.float32)[:, :, None, None]
    m = jnp.maximum(jnp.max(s, axis=-1, keepdims=True), sink)
    p = jnp.exp(s - m)
    p = (p / (jnp.sum(p, axis=-1, keepdims=True) + jnp.exp(sink - m))).astype(v.dtype)
    return jnp.einsum('...kgqs,...skd->...qkgd', p, v)


def _attn_prompt(q, k, v, sinks):
    B, T = q.shape[:2]
    nb = T // BLOCK
    qb = q.reshape(B, nb, BLOCK, N_KV_HEADS, GQA_GROUP, HEAD_DIM)
    kb = k.reshape(B, nb, BLOCK, N_KV_HEADS, HEAD_DIM)
    vb = v.reshape(B, nb, BLOCK, N_KV_HEADS, HEAD_DIM)
    pad = ((0, 0), (1, 0), (0, 0), (0, 0), (0, 0))
    kcat = jnp.concatenate([jnp.pad(kb, pad)[:, :-1], kb], axis=2)
    vcat = jnp.concatenate([jnp.pad(vb, pad)[:, :-1], vb], axis=2)
    qi = jnp.arange(BLOCK)[:, None]
    sj = jnp.arange(2 * BLOCK)[None, :]
    dist = qi + BLOCK - sj
    band = (dist >= 0) & (dist <= WINDOW)
    valid = (jnp.arange(nb)[:, None, None] > 0) | (sj >= BLOCK)[None]
    mask = band[None] & valid
    sk = sinks.reshape(N_KV_HEADS, GQA_GROUP)
    o = _attend_with_sinks(qb, kcat, vcat, mask, sk)
    return o.reshape(B, T, D_ATTN)


def _attn_sample(q, k, v, ck, cv, sinks):
    Bd, L = q.shape[:2]
    kcat = jnp.concatenate([ck, k], axis=1)
    vcat = jnp.concatenate([cv, v], axis=1)
    qi = jnp.arange(L)[:, None]
    sj = jnp.arange(WINDOW + L)[None, :]
    dist = qi + WINDOW - sj
    mask = (dist >= 0) & (dist <= WINDOW)
    sk = sinks.reshape(N_KV_HEADS, GQA_GROUP)
    o = _attend_with_sinks(q.reshape(Bd, L, N_KV_HEADS, GQA_GROUP, HEAD_DIM), kcat, vcat, mask, sk)
    return o.reshape(Bd, L, D_ATTN), kcat[:, -WINDOW:], vcat[:, -WINDOW:]


def _rwkv7(h, shift_prev, s0, mu, w0, w_decay_up, a0, w_a_up, w_g_up, k_k, k_a, r_k, gn_w, gn_b):
    B, T, _ = h.shape
    f32 = jnp.float32
    hprev = jnp.concatenate([shift_prev[:, None, :], h[:, :-1]], axis=1)
    hs = h + (hprev - h) * mu
    cuts = [D_RWKV, 2 * D_RWKV, 3 * D_RWKV, 3 * D_RWKV + D_DECAY_LORA,
            3 * D_RWKV + D_DECAY_LORA + D_A_LORA]
    r, k, v, wd, ad, gd = jnp.split(hs, cuts, axis=-1)
    w = -jax.nn.softplus(-(w0 + jnp.tanh(wd) @ w_decay_up)) - 0.5
    decay = jnp.exp(-jnp.exp(w.astype(f32)))
    a = jax.nn.sigmoid(a0 + ad @ w_a_up)
    g = jax.nn.sigmoid(gd) @ w_g_up
    heads = lambda t: t.astype(f32).reshape(B, T, RWKV_HEADS, HEAD_DIM)
    kk = heads(k * k_k)
    kk = kk * lax.rsqrt(jnp.maximum(jnp.sum(kk * kk, axis=-1, keepdims=True), 1e-24))
    k = k * (1.0 + (a - 1.0) * k_a)
    r_h, k_h, v_h, a_h, w_h = heads(r), heads(k), heads(v), heads(a), heads(decay)
    xs = tuple(jnp.moveaxis(t, 1, 0) for t in (r_h, w_h, k_h, v_h, kk, a_h))

    def step(S, inp):
        r_t, w_t, k_t, v_t, kk_t, a_t = inp
        sa = jnp.einsum('bhij,bhj->bhi', S, kk_t)
        S = (S * w_t[:, :, None, :] - sa[..., None] * (kk_t * a_t)[:, :, None, :]
             + v_t[..., None] * k_t[:, :, None, :])
        return S, jnp.einsum('bhij,bhj->bhi', S, r_t)

    S_T, ys = lax.scan(step, s0.astype(f32), xs)
    y = jnp.moveaxis(ys, 0, 1)
    mean = jnp.mean(y, axis=-1, keepdims=True)
    var = jnp.mean(jnp.square(y - mean), axis=-1, keepdims=True)
    y = ((y - mean) * lax.rsqrt(var + GN_EPS)).reshape(B, T, D_RWKV) * gn_w + gn_b
    bonus = jnp.sum(r_h * k_h * r_k.astype(f32), axis=-1, keepdims=True) * v_h
    y = (y + bonus.reshape(B, T, D_RWKV)) * g
    return y.astype(h.dtype), h[:, -1], S_T.astype(s0.dtype)


def _conv_ffn(x, conv_prev, w_ffn_in, conv_w, conv_b, w_ffn_out):
    T = x.shape[1]
    gu = x @ w_ffn_in
    z, u = gu[..., :D_FF], gu[..., D_FF:]
    zp = jnp.concatenate([conv_prev, z], axis=1)
    zc = conv_b + conv_w[0] * zp[:, 0:T]
    for j in range(1, CONV_W):
        zc = zc + conv_w[j] * zp[:, j:j + T]
    hid = jax.nn.silu(zc) * u
    return hid @ w_ffn_out, zp[:, -(CONV_W - 1):]


def _layer(x, pos, ck, cv, shift_prev, s0, conv_prev,
           g_pre_mix, w_in, attn_sinks, mu_shift, w0, w_decay_up, a0, w_a_up, w_g_up,
           k_k, k_a, r_k, gn_w, gn_b, w_out, g_post_mix, g_pre_ffn, w_ffn_in, conv_w,
           conv_b, w_ffn_out, g_post_ffn):
    B, T, _ = x.shape
    hn = _rms_norm(x, g_pre_mix)
    proj = hn @ w_in
    q = proj[..., :D_ATTN].reshape(B, T, N_HEADS, HEAD_DIM)
    k = proj[..., D_ATTN:D_ATTN + D_KV].reshape(B, T, N_KV_HEADS, HEAD_DIM)
    v = proj[..., D_ATTN + D_KV:D_ATTN + 2 * D_KV].reshape(B, T, N_KV_HEADS, HEAD_DIM)
    h_rw = proj[..., D_ATTN + 2 * D_KV:]
    q = _rope(q, pos)
    k = _rope(k, pos)
    if ck is None:
        o_attn = _attn_prompt(q, k, v, attn_sinks)
        new_k, new_v = k[:, -WINDOW:], v[:, -WINDOW:]
    else:
        o_attn, new_k, new_v = _attn_sample(q, k, v, ck, cv, attn_sinks)
    o_rw, new_shift, new_S = _rwkv7(h_rw, shift_prev, s0, mu_shift, w0, w_decay_up, a0,
                                    w_a_up, w_g_up, k_k, k_a, r_k, gn_w, gn_b)
    mix = jnp.concatenate([o_attn, o_rw], axis=-1) @ w_out
    x = x + _rms_norm(mix, g_post_mix)
    f, new_conv = _conv_ffn(_rms_norm(x, g_pre_ffn), conv_prev, w_ffn_in, conv_w, conv_b, w_ffn_out)
    x = x + _rms_norm(f, g_post_ffn)
    return x, (new_k, new_v, new_shift, new_S, new_conv)


def setup_inputs(seed: int = 0) -> dict:
    key = jax.random.key(seed)
    ks = jax.random.split(key, 32)
    nrm = lambda i, shape, s: jax.random.normal(ks[i], shape, jnp.float32) * s
    unif = lambda i, shape, lo, hi: jax.random.uniform(ks[i], shape, jnp.float32, lo, hi)
    L = DEPTH
    return {
        "x_prompt": nrm(0, (BATCH, SEQ, D_MODEL), 1.0),
        "x_sample": nrm(1, (DEC_BATCH, DEC_SEQ, D_MODEL), 1.0),
        "cache_k_win": nrm(2, (L, DEC_BATCH, WINDOW, N_KV_HEADS, HEAD_DIM), 1.0),
        "cache_v_win": nrm(3, (L, DEC_BATCH, WINDOW, N_KV_HEADS, HEAD_DIM), 1.0),
        "state_shift": nrm(4, (L, DEC_BATCH, D_SHIFT), 1.0),
        "state_wkv": nrm(5, (L, DEC_BATCH, RWKV_HEADS, HEAD_DIM, HEAD_DIM), 0.3),
        "state_conv": nrm(6, (L, DEC_BATCH, CONV_W - 1, D_FF), 1.0),
        "g_pre_mix": 1.0 + nrm(7, (L, D_MODEL), 0.05),
        "w_in": nrm(8, (L, D_MODEL, D_IN), D_MODEL ** -0.5),
        "attn_sinks": nrm(9, (L, N_HEADS), 0.5),
        "mu_shift": unif(10, (L, D_SHIFT), 0.0, 1.0),
        "w0": unif(11, (L, D_RWKV), -1.5, 1.5),
        "w_decay_up": nrm(12, (L, D_DECAY_LORA, D_RWKV), 0.1),
        "a0": nrm(13, (L, D_RWKV), 0.1),
        "w_a_up": nrm(14, (L, D_A_LORA, D_RWKV), 0.1),
        "w_g_up": nrm(15, (L, D_GATE_LORA, D_RWKV), D_GATE_LORA ** -0.5),
        "k_k": 0.85 + nrm(16, (L, D_RWKV), 0.05),
        "k_a": 1.0 + nrm(17, (L, D_RWKV), 0.05),
        "r_k": nrm(18, (L, RWKV_HEADS, HEAD_DIM), 0.1),
        "gn_w": 1.0 + nrm(19, (L, D_RWKV), 0.05),
        "gn_b": nrm(20, (L, D_RWKV), 0.01),
        "w_out": nrm(21, (L, D_MODEL, D_MODEL), D_MODEL ** -0.5),
        "g_post_mix": 1.0 + nrm(22, (L, D_MODEL), 0.05),
        "g_pre_ffn": 1.0 + nrm(23, (L, D_MODEL), 0.05),
        "w_ffn_in": nrm(24, (L, D_MODEL, 2 * D_FF), D_MODEL ** -0.5),
        "conv_w": nrm(25, (L, CONV_W, D_FF), CONV_W ** -0.5),
        "conv_b": nrm(26, (L, D_FF), 0.01),
        "w_ffn_out": nrm(27, (L, D_FF, D_MODEL), D_FF ** -0.5),
        "g_post_ffn": 1.0 + nrm(28, (L, D_MODEL), 0.05),
    }


def reference(x_prompt, x_sample, cache_k_win, cache_v_win, state_shift, state_wkv, state_conv,
              g_pre_mix, w_in, attn_sinks, mu_shift, w0, w_decay_up, a0, w_a_up, w_g_up,
              k_k, k_a, r_k, gn_w, gn_b, w_out, g_post_mix, g_pre_ffn, w_ffn_in, conv_w,
              conv_b, w_ffn_out, g_post_ffn):
    B, T = x_prompt.shape[:2]
    pos_p = jnp.arange(T, dtype=jnp.int32)
    pos_s = PAST_LEN + jnp.arange(x_sample.shape[1], dtype=jnp.int32)
    xp, xs = x_prompt, x_sample
    st_p, st_s = [], []
    for l in range(DEPTH):
        lw = (g_pre_mix[l], w_in[l], attn_sinks[l], mu_shift[l], w0[l], w_decay_up[l], a0[l],
              w_a_up[l], w_g_up[l], k_k[l], k_a[l], r_k[l], gn_w[l], gn_b[l], w_out[l],
              g_post_mix[l], g_pre_ffn[l], w_ffn_in[l], conv_w[l], conv_b[l], w_ffn_out[l],
              g_post_ffn[l])
        zero_shift = jnp.zeros((B, D_SHIFT), xp.dtype)
        zero_wkv = jnp.zeros((B, RWKV_HEADS, HEAD_DIM, HEAD_DIM), xp.dtype)
        zero_conv = jnp.zeros((B, CONV_W - 1, D_FF), xp.dtype)
        xp, sp = _layer(xp, pos_p, None, None, zero_shift, zero_wkv, zero_conv, *lw)
        xs, ss = _layer(xs, pos_s, cache_k_win[l], cache_v_win[l], state_shift[l],
                        state_wkv[l], state_conv[l], *lw)
        st_p.append(sp)
        st_s.append(ss)
    stk = lambda outs, i: jnp.stack([o[i] for o in outs], axis=0)
    return (xp, xs,
            stk(st_p, 0), stk(st_p, 1), stk(st_p, 2), stk(st_p, 3), stk(st_p, 4),
            stk(st_s, 0), stk(st_s, 1), stk(st_s, 2), stk(st_s, 3), stk(st_s, 4))
```

```cpp
#include <hip/hip_runtime.h>
#include <hip/hip_cooperative_groups.h>
#include <cstdio>
#include <cstdint>
#include <utility>
namespace cg = cooperative_groups;

#ifndef MK_PER_PHASE
#define MK_PER_PHASE 0
#endif

#define LAS __attribute__((address_space(3)))
typedef unsigned short bf16_t;
typedef short bf16x8 __attribute__((ext_vector_type(8)));
typedef float f32x4 __attribute__((ext_vector_type(4)));
typedef float f32x2 __attribute__((ext_vector_type(2)));
typedef unsigned u32x4 __attribute__((ext_vector_type(4)));
typedef unsigned u32x2 __attribute__((ext_vector_type(2)));

constexpr int DM = 1024, NB = 4, T = 8192, MP = NB * T, DB = 128, DT = 8, MS = DB * DT, M = MP + MS;
constexpr int WIN = 128, DSH = 1696, DINP = 2560, DFF = 2816, DFFH = 1408;
constexpr float RMS_EPS = 1e-6f, GN_EPS = 64e-5f;
constexpr float QSCALE = 0.125f * 1.4426950408889634f;
constexpr size_t O_Y = 0, O_KWP = 34603008, O_VWP = 34668544, O_SHP = 34734080, O_WKVP = 34740864, O_CVP = 34871936,
                 O_KWS = 34894464, O_VWS = 36991616, O_SHS = 39088768, O_WKVS = 39305856, O_CVS = 43500160;
constexpr size_t MiB = 1u << 20;
constexpr size_t WS_WIN = 1 * MiB, WS_WOUT = 6 * MiB, WS_WFI = 8 * MiB, WS_WFO = 19 * MiB, WS_ROPE = 25 * MiB;
constexpr size_t WS_XN = 32 * MiB;
constexpr size_t WS_SR = 32 * MiB, WS_SK = 65 * MiB;
constexpr size_t WS_Q = 98 * MiB, WS_K = 131 * MiB, WS_VT = 140 * MiB;
constexpr size_t WS_HRW = 150 * MiB;
constexpr size_t WS_OCAT = 260 * MiB;
constexpr size_t WS_SW = 326 * MiB;
constexpr size_t WS_SV = 392 * MiB, WS_SKK = 425 * MiB, WS_SB = 458 * MiB;
constexpr size_t WS_ZU = 100 * MiB;
constexpr size_t WS_HID = 282 * MiB;
constexpr size_t WS_F = 216 * MiB;
constexpr size_t WS_MIX = 150 * MiB;
constexpr size_t WS_END = 491 * MiB;

__device__ __forceinline__ unsigned f2bf(float f) { unsigned u = __float_as_uint(f); return (u + 0x7fffu + ((u >> 16) & 1u)) >> 16; }

__device__ __forceinline__ float bf2f(unsigned short h) { return __uint_as_float(((unsigned)h) << 16); }
__device__ __forceinline__ float bflo(unsigned w) { return __uint_as_float(w << 16); }
__device__ __forceinline__ float bfhi(unsigned w) { return __uint_as_float(w & 0xffff0000u); }
__device__ __forceinline__ unsigned cvt_pk_bf16(float lo, float hi) { unsigned r; asm volatile("v_cvt_pk_bf16_f32 %0, %1, %2" : "=v"(r) : "v"(lo), "v"(hi)); return r; }
__device__ __forceinline__ unsigned pk2(float lo, float hi) { return cvt_pk_bf16(lo, hi); }
template <int CTRL> __device__ __forceinline__ float dppf(float x) { return __int_as_float(__builtin_amdgcn_update_dpp(0, __float_as_int(x), CTRL, 0xF, 0xF, false)); }
__device__ __forceinline__ float allsum16(float x) {
    x += dppf<0xB1>(x); x += dppf<0x4E>(x); x += dppf<0x141>(x); x += dppf<0x140>(x); return x;
}
__device__ __forceinline__ void allsum16_2(float& a, float& b) {
    a += dppf<0xB1>(a); b += dppf<0xB1>(b); a += dppf<0x4E>(a); b += dppf<0x4E>(b); a += dppf<0x141>(a); b += dppf<0x141>(b); a += dppf<0x140>(a); b += dppf<0x140>(b);
}
__device__ __forceinline__ float wave_sum(float v) {
    v = allsum16(v);
    { auto r = __builtin_amdgcn_permlane16_swap(__float_as_uint(v), __float_as_uint(v), false, false); v = __uint_as_float(r[0]) + __uint_as_float(r[1]); }
    { auto r = __builtin_amdgcn_permlane32_swap(__float_as_uint(v), __float_as_uint(v), false, false); v = __uint_as_float(r[0]) + __uint_as_float(r[1]); }
    return v;
}
__device__ __forceinline__ float sigmoidf_(float x) { return __builtin_amdgcn_rcpf(1.0f + __expf(-x)); }

namespace pg8 {
constexpr int BM = 256, BK = 64, HALF = 128, HTB = HALF * BK * 2, STAGE_BYTES = 8 * HTB, NXCD = 8, WGM = 8;
__host__ __device__ __forceinline__ int lds_byte(int r, int c) { const int st = (r >> 4) * 2 + (c >> 5), rr = r & 15, cc = c & 31, ob = rr * 64 + cc * 2; return st * 1024 + (ob ^ (((ob >> 9) & 1) << 5)); }
__host__ __device__ __forceinline__ void stage_rc(int b, int& R, int& C) { const int st = b / 1024, sb = b % 1024, swz = sb ^ (((sb >> 9) & 1) << 5); R = (st >> 1) * 16 + swz / 64; C = (st & 1) * 32 + (swz % 64) / 2; }
__host__ __device__ __forceinline__ int perm32(int rho) { const int n = rho >> 4, i = rho & 15; return 8 * (i >> 2) + 4 * n + (i & 3); }
struct Unit { int pm, pn; };
struct Gemm { const bf16_t* A; const bf16_t* Bt; int M, N, K, lda, ldb, conv; };
__device__ __forceinline__ long arow(const Gemm& g, int pm) {
    if (!g.conv) return (long)pm * 256;
    if (pm < 132) { const int b = pm / 33; return (long)b * 8192 + 254 * (pm - 33 * b) - 2; }
    return 32768 + (long)(pm - 132) * 256;
}
struct StaticOrder {
    int nM, nN, nwg, G, c;
    __device__ void init(int M_, int N_, int G_, int c_) { nM = M_ / BM; nN = N_ / BM; nwg = nM * nN; G = G_; c = c_; }
    __device__ bool next(int i, Unit& u) const {
        const long L = (long)i * G + c; if (L >= nwg) return false;
        int wgid = (int)L; { const int q = nwg / NXCD, r = nwg % NXCD, xcd = wgid % NXCD, off = wgid / NXCD; wgid = (xcd < r ? xcd * (q + 1) : r * (q + 1) + (xcd - r) * q) + off; }
        const int nig = WGM * nN, gid = wgid / nig, fm = gid * WGM, gsz = (nM - fm) < WGM ? (nM - fm) : WGM;
        u.pm = fm + ((wgid % nig) % gsz); u.pn = (wgid % nig) / gsz; return true;
    }
};
template <class Epi, bool ALIGN_EPI>
__device__ __forceinline__ void gemm_phase(LAS unsigned char* lds, const Gemm g, const StaticOrder& S, const Epi& E) {
    const int tid = threadIdx.x, wid = __builtin_amdgcn_readfirstlane(tid >> 6), lane = tid & 63, wr = wid >> 2, wc = wid & 3, fr = lane & 15, fq = lane >> 4;
    const int nt = g.K / BK;
    unsigned voffA[2], voffB[2];
#pragma unroll
    for (int i = 0; i < 2; ++i) { int R, C; stage_rc(tid * 16 + i * 8192, R, C); const int Rb = (R & ~31) + perm32(R & 31);
        voffA[i] = (unsigned)(R * g.lda + C) * 2u; voffB[i] = (unsigned)(Rb * g.ldb + C) * 2u; }
    const size_t kstep = (size_t)(BK * 2);
    const size_t hstepA = (size_t)HALF * g.lda * 2, hstepB = (size_t)HALF * g.ldb * 2;
    const size_t rowA = (size_t)g.lda * 2, tstepB = 2 * hstepB;
    const unsigned ldsw = (unsigned)wid * 1024u;
    const int aoff = lds_byte(wr * 64 + fr, fq * 8), boff = lds_byte(wc * 32 + fr, fq * 8);
#define PG8_SA(b, h) (((b) * 2 + (h)) * HTB)
#define PG8_SB(b, h) ((4 + (b) * 2 + (h)) * HTB)
#define PG8_STAGE(bufoff, gbase, voff) do { _Pragma("unroll") for (int _i = 0; _i < 2; ++_i) \
        __builtin_amdgcn_global_load_lds((const unsigned*)((const char*)(gbase) + (voff)[_i]), (LAS unsigned*)(lds + (bufoff) + ldsw + _i * 8192), 16, 0, 0); } while (0)
#define PG8_LDA(dst, b, h) do { _Pragma("unroll") for (int m = 0; m < 4; ++m) _Pragma("unroll") for (int k = 0; k < 2; ++k) dst[m][k] = *(const LAS bf16x8*)(lds + PG8_SA(b, h) + aoff + m * 2048 + k * 1024); } while (0)
#define PG8_LDB(dst, b, h) do { _Pragma("unroll") for (int n = 0; n < 2; ++n) _Pragma("unroll") for (int k = 0; k < 2; ++k) dst[n][k] = *(const LAS bf16x8*)(lds + PG8_SB(b, h) + boff + n * 2048 + k * 1024); } while (0)
#define PG8_MMA(ai, bj, At, Bt) do { __builtin_amdgcn_s_setprio(1); _Pragma("unroll") for (int m = 0; m < 4; ++m) _Pragma("unroll") for (int n = 0; n < 2; ++n) _Pragma("unroll") for (int k = 0; k < 2; ++k) \
        acc[ai][bj][m][n] = __builtin_amdgcn_mfma_f32_16x16x32_bf16(Bt[n][k], At[m][k], acc[ai][bj][m][n], 0, 0, 0); __builtin_amdgcn_s_setprio(0); } while (0)
#define PG8_WAIT_V(n) asm volatile("s_waitcnt vmcnt(" #n ")" ::: "memory")
#define PG8_WAIT_L(n) asm volatile("s_waitcnt lgkmcnt(" #n ")" ::: "memory")
#define PG8_BAR __builtin_amdgcn_s_barrier()
#define PG8_SCHED __builtin_amdgcn_sched_barrier(0)
    Unit cur, nxt; int ui = 0;
    if (!S.next(0, cur)) return;
    f32x4 acc[2][2][4][2];
#pragma unroll
    for (int a = 0; a < 2; ++a)
#pragma unroll
        for (int b = 0; b < 2; ++b)
#pragma unroll
            for (int m = 0; m < 4; ++m)
#pragma unroll
                for (int n = 0; n < 2; ++n) acc[a][b][m][n] = (f32x4){0.f, 0.f, 0.f, 0.f};
    bf16x8 At[4][2], B0[2][2], B1[2][2];
    const char* cA = (const char*)g.A + arow(g, cur.pm) * (long)rowA; const char* cB = (const char*)g.Bt + (size_t)cur.pn * tstepB;
    PG8_STAGE(PG8_SB(0, 0), cB, voffB); PG8_STAGE(PG8_SB(0, 1), cB + hstepB, voffB); PG8_STAGE(PG8_SA(0, 0), cA, voffA); PG8_STAGE(PG8_SA(0, 1), cA + hstepA, voffA);
    if (wr == 1) PG8_BAR;
    PG8_WAIT_V(2); PG8_BAR;
    PG8_STAGE(PG8_SB(1, 0), cB + kstep, voffB); PG8_STAGE(PG8_SA(1, 0), cA + kstep, voffA); PG8_STAGE(PG8_SB(1, 1), cB + hstepB + kstep, voffB);
    PG8_WAIT_V(6); PG8_BAR;
    for (;;) {
        const bool has_next = S.next(ui + 1, nxt);
        const char* nA = has_next ? (const char*)g.A + arow(g, nxt.pm) * (long)rowA : cA; const char* nB = has_next ? (const char*)g.Bt + (size_t)nxt.pn * tstepB : cB;
        for (int t = 0; t < nt; t += 2) {
            const bool last = (t == nt - 2);
            const char* a1 = cA + (size_t)(t + 1) * kstep;
            const char* a2 = last ? nA : cA + (size_t)(t + 2) * kstep; const char* b2 = last ? nB : cB + (size_t)(t + 2) * kstep;
            const char* a3 = a2 + kstep; const char* b3 = b2 + kstep;
            PG8_LDB(B0, 0, 0); PG8_LDB(B1, 0, 1); PG8_SCHED; PG8_LDA(At, 0, 0); PG8_STAGE(PG8_SA(1, 1), a1 + hstepA, voffA);
            PG8_WAIT_V(8); PG8_WAIT_L(0); PG8_BAR; PG8_MMA(0, 0, At, B0); PG8_MMA(0, 1, At, B1); PG8_BAR; PG8_SCHED;
            PG8_LDA(At, 0, 1); PG8_STAGE(PG8_SB(0, 0), b2, voffB); PG8_STAGE(PG8_SB(0, 1), b2 + hstepB, voffB); PG8_STAGE(PG8_SA(0, 0), a2, voffA);
            PG8_WAIT_V(8); PG8_WAIT_L(0); PG8_BAR; PG8_MMA(1, 0, At, B0); PG8_MMA(1, 1, At, B1); PG8_BAR; PG8_SCHED;
            PG8_LDB(B0, 1, 0); PG8_LDB(B1, 1, 1); PG8_SCHED; PG8_LDA(At, 1, 0); PG8_STAGE(PG8_SA(0, 1), a2 + hstepA, voffA);
            PG8_WAIT_V(8); PG8_WAIT_L(0); PG8_BAR; PG8_MMA(0, 0, At, B0); PG8_MMA(0, 1, At, B1); PG8_BAR; PG8_SCHED;
            PG8_LDA(At, 1, 1); PG8_STAGE(PG8_SB(1, 0), b3, voffB); PG8_STAGE(PG8_SB(1, 1), b3 + hstepB, voffB); PG8_STAGE(PG8_SA(1, 0), a3, voffA);
            PG8_WAIT_V(8); PG8_WAIT_L(0); PG8_BAR; PG8_MMA(1, 0, At, B0); PG8_MMA(1, 1, At, B1); PG8_BAR; PG8_SCHED;
        }
        if constexpr (ALIGN_EPI) { if (wr == 0) PG8_BAR; }
        asm volatile("s_nop 7\n\ts_nop 7" ::: "memory");
        E(acc, cur, wr, wc, fr, fq);
        if (!has_next) break;
#pragma unroll
        for (int a = 0; a < 2; ++a)
#pragma unroll
            for (int b = 0; b < 2; ++b)
#pragma unroll
                for (int m = 0; m < 4; ++m)
#pragma unroll
                    for (int n = 0; n < 2; ++n) acc[a][b][m][n] = (f32x4){0.f, 0.f, 0.f, 0.f};
        cur = nxt; cA = nA; cB = nB; ++ui;
        if constexpr (ALIGN_EPI) { if (wr == 1) PG8_BAR; }
    }
    PG8_WAIT_V(0);
    if constexpr (!ALIGN_EPI) { if (wr == 0) PG8_BAR; }
    PG8_BAR;
#undef PG8_SA
#undef PG8_SB
#undef PG8_STAGE
#undef PG8_LDA
#undef PG8_LDB
#undef PG8_MMA
#undef PG8_WAIT_V
#undef PG8_WAIT_L
#undef PG8_BAR
#undef PG8_SCHED
}
}

struct RowInfo { int b, t, samp; };
__device__ __forceinline__ RowInfo row_info(int row) { RowInfo r; if (row < MP) { r.samp = 0; r.b = row >> 13; r.t = row & (T - 1); } else { const int rs = row - MP; r.samp = 1; r.b = rs >> 3; r.t = rs & 7; } return r; }

struct Epi1 {
    const float* rope; bf16_t* Q; bf16_t* Kb; bf16_t* VT; bf16_t* HRW; float* out;
    __device__ __forceinline__ void operator()(const f32x4 (&acc)[2][2][4][2], const pg8::Unit& u, int wr, int wc, int fr, int fq) const {
#pragma unroll
        for (int ai = 0; ai < 2; ++ai)
#pragma unroll
            for (int m = 0; m < 4; ++m) {
                const int row = u.pm * 256 + ai * 128 + wr * 64 + m * 16 + fr;
                const RowInfo ri = row_info(row);
                const int pidx = ri.samp ? (T + ri.t) : ri.t;
#pragma unroll
                for (int bj = 0; bj < 2; ++bj) {
                    const int cb = u.pn * 256 + bj * 128;
                    const int c0 = cb + wc * 32 + fq * 8;
                    const f32x4 v0 = acc[ai][bj][m][0], v1 = acc[ai][bj][m][1];
                    if (cb < 640) {
                        const int d0 = ((c0 & 63) >> 3) * 4;
                        const f32x4* rp = (const f32x4*)(rope + ((size_t)pidx * 32 + d0) * 2);
                        const f32x4 cs0 = rp[0], cs1 = rp[1];
                        f32x4 o1, o2;
                        o1[0] = v0[0] * cs0[0] - v1[0] * cs0[1]; o2[0] = v1[0] * cs0[0] + v0[0] * cs0[1];
                        o1[1] = v0[1] * cs0[2] - v1[1] * cs0[3]; o2[1] = v1[1] * cs0[2] + v0[1] * cs0[3];
                        o1[2] = v0[2] * cs1[0] - v1[2] * cs1[1]; o2[2] = v1[2] * cs1[0] + v0[2] * cs1[1];
                        o1[3] = v0[3] * cs1[2] - v1[3] * cs1[3]; o2[3] = v1[3] * cs1[2] + v0[3] * cs1[3];
                        if (cb < 512) {
                            o1 = o1 * QSCALE; o2 = o2 * QSCALE;
                            bf16_t* qp = Q + (size_t)row * 512 + (c0 & ~63) + d0;
                            u32x2 w1, w2; w1.x = cvt_pk_bf16(o1[0], o1[1]); w1.y = cvt_pk_bf16(o1[2], o1[3]); w2.x = cvt_pk_bf16(o2[0], o2[1]); w2.y = cvt_pk_bf16(o2[2], o2[3]);
                            *(u32x2*)qp = w1; *(u32x2*)(qp + 32) = w2;
                        } else {
                            const int kvh = (c0 - 512) >> 6;
                            bf16_t* kp = Kb + (size_t)row * 128 + kvh * 64 + d0;
                            u32x2 w1, w2; w1.x = cvt_pk_bf16(o1[0], o1[1]); w1.y = cvt_pk_bf16(o1[2], o1[3]); w2.x = cvt_pk_bf16(o2[0], o2[1]); w2.y = cvt_pk_bf16(o2[2], o2[3]);
                            *(u32x2*)kp = w1; *(u32x2*)(kp + 32) = w2;
                            if (!ri.samp) { if (ri.t >= T - WIN) { float* o = out + O_KWP + ((size_t)(ri.b * WIN + (ri.t - (T - WIN))) * 2 + kvh) * 64 + d0; *(f32x4*)o = o1; *(f32x4*)(o + 32) = o2; } }
                            else { float* o = out + O_KWS + ((size_t)(ri.b * WIN + (WIN - DT) + ri.t) * 2 + kvh) * 64 + d0; *(f32x4*)o = o1; *(f32x4*)(o + 32) = o2; }
                        }
                    } else if (cb < 768) {
                        const int kvh = (c0 - 640) >> 6, d0 = (c0 - 640) & 63;
                        if (!ri.samp) {
                            bf16_t* vp = VT + ((size_t)(ri.b * 2 + kvh) * 64 + d0) * T + ri.t;
                            vp[0] = (bf16_t)f2bf(v0[0]); vp[(size_t)T] = (bf16_t)f2bf(v0[1]); vp[(size_t)2 * T] = (bf16_t)f2bf(v0[2]); vp[(size_t)3 * T] = (bf16_t)f2bf(v0[3]);
                            vp[(size_t)4 * T] = (bf16_t)f2bf(v1[0]); vp[(size_t)5 * T] = (bf16_t)f2bf(v1[1]); vp[(size_t)6 * T] = (bf16_t)f2bf(v1[2]); vp[(size_t)7 * T] = (bf16_t)f2bf(v1[3]);
                            if (ri.t >= T - WIN) { float* o = out + O_VWP + ((size_t)(ri.b * WIN + (ri.t - (T - WIN))) * 2 + kvh) * 64 + d0; *(f32x4*)o = v0; *(f32x4*)(o + 4) = v1; }
                        } else { float* o = out + O_VWS + ((size_t)(ri.b * WIN + (WIN - DT) + ri.t) * 2 + kvh) * 64 + d0; *(f32x4*)o = v0; *(f32x4*)(o + 4) = v1; }
                    } else if (c0 < 2464) {
                        const int col = c0 - 768;
                        u32x4 w; w.x = cvt_pk_bf16(v0[0], v0[1]); w.y = cvt_pk_bf16(v0[2], v0[3]); w.z = cvt_pk_bf16(v1[0], v1[1]); w.w = cvt_pk_bf16(v1[2], v1[3]);
                        *(u32x4*)(HRW + (size_t)row * DSH + col) = w;
                        if (!ri.samp) { if (ri.t == T - 1) { float* o = out + O_SHP + (size_t)ri.b * DSH + col; *(f32x4*)o = v0; *(f32x4*)(o + 4) = v1; } }
                        else if (ri.t == DT - 1) { float* o = out + O_SHS + (size_t)ri.b * DSH + col; *(f32x4*)o = v0; *(f32x4*)(o + 4) = v1; }
                    }
                }
            }
    }
};
struct EpiF32 {
    float* O; int ldc;
    __device__ __forceinline__ void operator()(const f32x4 (&acc)[2][2][4][2], const pg8::Unit& u, int wr, int wc, int fr, int fq) const {
#pragma unroll
        for (int ai = 0; ai < 2; ++ai)
#pragma unroll
            for (int m = 0; m < 4; ++m) {
                float* rowp = O + (size_t)(u.pm * 256 + ai * 128 + wr * 64 + m * 16 + fr) * ldc + u.pn * 256 + wc * 32 + fq * 8;
#pragma unroll
                for (int bj = 0; bj < 2; ++bj) { *(f32x4*)(rowp + bj * 128) = acc[ai][bj][m][0]; *(f32x4*)(rowp + bj * 128 + 4) = acc[ai][bj][m][1]; }
            }
    }
};
struct EpiBf16 {
    bf16_t* O; int ldc;
    __device__ __forceinline__ void operator()(const f32x4 (&acc)[2][2][4][2], const pg8::Unit& u, int wr, int wc, int fr, int fq) const {
#pragma unroll
        for (int ai = 0; ai < 2; ++ai)
#pragma unroll
            for (int m = 0; m < 4; ++m) {
                bf16_t* rowp = O + (size_t)(u.pm * 256 + ai * 128 + wr * 64 + m * 16 + fr) * ldc + u.pn * 256 + wc * 32 + fq * 8;
#pragma unroll
                for (int bj = 0; bj < 2; ++bj) { const f32x4 v0 = acc[ai][bj][m][0], v1 = acc[ai][bj][m][1];
                    u32x4 w; w.x = cvt_pk_bf16(v0[0], v0[1]); w.y = cvt_pk_bf16(v0[2], v0[3]); w.z = cvt_pk_bf16(v1[0], v1[1]); w.w = cvt_pk_bf16(v1[2], v1[3]);
                    *(u32x4*)(rowp + bj * 128) = w; }
            }
    }
};
template <int CTRL> __device__ __forceinline__ float dpp_old(float old, float src) { return __int_as_float(__builtin_amdgcn_update_dpp(__float_as_int(old), __float_as_int(src), CTRL, 0xF, 0xF, false)); }
struct EpiConv {
    bf16_t* HID; float* out; const float* cw; const float* cb; const float* sc; LAS float* exch;
    __device__ __forceinline__ void operator()(const f32x4 (&acc)[2][2][4][2], const pg8::Unit& u, int wr, int wc, int fr, int fq) const {
        const int cw8 = wc * 32 + fq * 8, ch0 = u.pn * 128 + cw8;
        if (fr >= 14) {
#pragma unroll
            for (int ai = 0; ai < 2; ++ai)
#pragma unroll
                for (int n = 0; n < 2; ++n) *(LAS f32x4*)(exch + ((ai * 2 + wr) * 2 + (fr - 14)) * 128 + cw8 + 4 * n) = acc[ai][0][3][n];
        }
        asm volatile("s_waitcnt lgkmcnt(0)\n\ts_barrier" ::: "memory");
        int row0, b0 = 0, i0 = 0; const bool samp = u.pm >= 132;
        if (!samp) { b0 = u.pm / 33; i0 = u.pm - 33 * b0; row0 = b0 * T + 254 * i0 - 2; } else row0 = MP + (u.pm - 132) * 256;
        f32x4 w0[2], w1[2], w2[2], bb[2];
#pragma unroll
        for (int n = 0; n < 2; ++n) { w0[n] = *(const f32x4*)(cw + ch0 + 4 * n); w1[n] = *(const f32x4*)(cw + DFF + ch0 + 4 * n); w2[n] = *(const f32x4*)(cw + 2 * DFF + ch0 + 4 * n); bb[n] = *(const f32x4*)(cb + ch0 + 4 * n); }
#pragma unroll
        for (int ai = 0; ai < 2; ++ai) {
            const int strip = ai * 2 + wr;
            f32x4 h1[2], h2[2];
#pragma unroll
            for (int n = 0; n < 2; ++n) {
                if (strip > 0) { h1[n] = *(const LAS f32x4*)(exch + ((strip - 1) * 2 + 1) * 128 + cw8 + 4 * n); h2[n] = *(const LAS f32x4*)(exch + ((strip - 1) * 2) * 128 + cw8 + 4 * n); }
                else { h1[n] = (f32x4){0.f, 0.f, 0.f, 0.f}; h2[n] = (f32x4){0.f, 0.f, 0.f, 0.f}; }
            }
#pragma unroll
            for (int m = 0; m < 4; ++m) {
                const int lr = ai * 128 + wr * 64 + m * 16 + fr;
                int t, b; bool valid;
                if (!samp) { t = 254 * i0 + lr - 2; b = b0; valid = lr >= 2 && t < T; } else { const int rs = row0 - MP + lr; b = rs >> 3; t = rs & 7; valid = true; }
                const size_t R = (size_t)((long)row0 + lr);
                f32x4 hd[2];
#pragma unroll
                for (int n = 0; n < 2; ++n) {
                    const f32x4 z = acc[ai][0][m][n], uu = acc[ai][1][m][n];
                    f32x4 o1, o2, zm1, zm2;
                    if (m == 0) { o1 = h1[n]; o2 = (fr == 0) ? h2[n] : h1[n]; }
                    else {
#pragma unroll
                        for (int e = 0; e < 4; ++e) { o1[e] = dppf<0x121>(acc[ai][0][m > 0 ? m - 1 : 0][n][e]); o2[e] = dppf<0x122>(acc[ai][0][m > 0 ? m - 1 : 0][n][e]); }
                    }
#pragma unroll
                    for (int e = 0; e < 4; ++e) { zm1[e] = dpp_old<0x111>(o1[e], z[e]); zm2[e] = dpp_old<0x112>(o2[e], z[e]); }
                    if (t == 0) {
                        if (samp) { zm1 = *(const f32x4*)(sc + ((size_t)b * 2 + 1) * DFF + ch0 + 4 * n); zm2 = *(const f32x4*)(sc + ((size_t)b * 2) * DFF + ch0 + 4 * n); }
                        else { zm1 = (f32x4){0.f, 0.f, 0.f, 0.f}; zm2 = (f32x4){0.f, 0.f, 0.f, 0.f}; }
                    } else if (t == 1) {
                        if (samp) zm2 = *(const f32x4*)(sc + ((size_t)b * 2 + 1) * DFF + ch0 + 4 * n); else zm2 = (f32x4){0.f, 0.f, 0.f, 0.f};
                    }
                    const f32x4 zc = bb[n] + w0[n] * zm2 + w1[n] * zm1 + w2[n] * z;
#pragma unroll
                    for (int e = 0; e < 4; ++e) hd[n][e] = zc[e] * sigmoidf_(zc[e]) * uu[e];
                }
                if (valid) {
                    u32x4 w; w.x = cvt_pk_bf16(hd[0][0], hd[0][1]); w.y = cvt_pk_bf16(hd[0][2], hd[0][3]); w.z = cvt_pk_bf16(hd[1][0], hd[1][1]); w.w = cvt_pk_bf16(hd[1][2], hd[1][3]);
                    *(u32x4*)(HID + R * DFF + ch0) = w;
                    if (!samp) { if (t >= T - 2) { float* o = out + O_CVP + (size_t)(b * 2 + (t - (T - 2))) * DFF + ch0; *(f32x4*)o = acc[ai][0][m][0]; *(f32x4*)(o + 4) = acc[ai][0][m][1]; } }
                    else if (t >= DT - 2) { float* o = out + O_CVS + (size_t)(b * 2 + (t - (DT - 2))) * DFF + ch0; *(f32x4*)o = acc[ai][0][m][0]; *(f32x4*)(o + 4) = acc[ai][0][m][1]; }
                }
            }
        }
    }
};

#define XB_TMO      128
#define XB_XCNT(j)  (256  + 64 * (j))
#define XB_XSUB(j)  (1280 + 64 * (j))
#define XB_XGEN(j)  (2304 + 64 * (j))
#define XB_TOP      3328
#define XB_TOPGEN   3392
#define XCD_BAR_WORDS 3456
#define XB_SPIN_CAP (1u << 20)
__device__ __forceinline__ unsigned xb_ld(unsigned* p)              { return __hip_atomic_load(p, __ATOMIC_RELAXED, __HIP_MEMORY_SCOPE_AGENT); }
__device__ __forceinline__ unsigned xb_add(unsigned* p, unsigned v) { return __hip_atomic_fetch_add(p, v, __ATOMIC_RELAXED, __HIP_MEMORY_SCOPE_AGENT); }
__device__ __forceinline__ unsigned xb_xcc_id() { return (unsigned)__builtin_amdgcn_s_getreg((3 << 11) | 20) & 0xFu; }
#define XB_SPIN(cond, bar) do { unsigned _sp = 0; while (cond) { __builtin_amdgcn_s_sleep(1); \
    if ((++_sp & 255u) == 0u) { if (xb_ld(&(bar)[XB_TMO])) break; if (_sp > XB_SPIN_CAP) { atomicAdd(&(bar)[XB_TMO], 1u); break; } } } } while (0)
struct XcdBarrier { unsigned* bar; unsigned x; volatile LAS unsigned* st; };
__device__ __forceinline__ XcdBarrier xcd_barrier_post(unsigned* bar, volatile LAS unsigned* st) {
    XcdBarrier b; b.bar = bar; b.x = xb_xcc_id(); b.st = st;
    if (threadIdx.x == 0) (void)xb_add(&bar[XB_XCNT(b.x)], 1u);
    return b;
}
__device__ __forceinline__ void xcd_barrier_complete(unsigned* bar, unsigned x, unsigned& nloc, unsigned& nx) {
    const unsigned G = gridDim.x * gridDim.y * gridDim.z;
    unsigned sum, cnt, mine, sp = 0u;
    for (;;) {
        sum = 0u; cnt = 0u; mine = 0u;
#pragma unroll
        for (unsigned j = 0; j < 16; ++j) { const unsigned c = xb_ld(&bar[XB_XCNT(j)]); sum += c; cnt += (c > 0u) ? 1u : 0u; mine = (j == x) ? c : mine; }
        if (sum == G) break;
        __builtin_amdgcn_s_sleep(1);
        if ((++sp & 255u) == 0u) { if (xb_ld(&bar[XB_TMO])) break; if (sp > XB_SPIN_CAP) { atomicAdd(&bar[XB_TMO], 1u); break; } }
    }
    nloc = mine > 0u ? mine : 1u; nx = cnt > 0u ? cnt : 1u;
}
__device__ __forceinline__ void xcd_barrier(const XcdBarrier& b) {
    asm volatile("s_waitcnt vmcnt(0)" ::: "memory");
    __syncthreads();
    if (threadIdx.x == 0) {
        unsigned* bar = b.bar;
        __builtin_amdgcn_s_waitcnt(0);
        unsigned nloc = b.st[0], nx = b.st[1];
        if (nloc == 0u) { xcd_barrier_complete(bar, b.x, nloc, nx); b.st[0] = nloc; b.st[1] = nx; }
        const unsigned old = xb_add(&bar[XB_XSUB(b.x)], 1u);
        const unsigned gen = old / nloc;
        if (old + 1u == (gen + 1u) * nloc) {
            __builtin_amdgcn_fence(__ATOMIC_RELEASE, "agent");
            asm volatile("s_waitcnt vmcnt(0)" ::: "memory");
            const unsigned og = xb_add(&bar[XB_TOP], 1u);
            const unsigned tg = og / nx;
            if (og + 1u == (tg + 1u) * nx) xb_add(&bar[XB_TOPGEN], 1u);
            else XB_SPIN(xb_ld(&bar[XB_TOPGEN]) == tg, bar);
            __builtin_amdgcn_fence(__ATOMIC_ACQUIRE, "agent");
            xb_add(&bar[XB_XGEN(b.x)], 1u);
            asm volatile("s_waitcnt vmcnt(0)" ::: "memory");
        } else {
            XB_SPIN(xb_ld(&bar[XB_XGEN(b.x)]) == gen, bar);
            __builtin_amdgcn_fence(__ATOMIC_ACQUIRE, "agent");
            asm volatile("s_waitcnt vmcnt(0)" ::: "memory");
        }
    }
    __syncthreads();
}

constexpr int NWAVES = 8, NT = 512;
constexpr int LDS_BYTES = 163840;
constexpr int YP_OFF = 129536;
struct Args { const float* in[29]; float* out; unsigned char* ws; int ph_lo, ph_hi; };
struct Frame {
    LAS unsigned char* lds; unsigned char* ws; float* out; const float* const* in;
    int tid, lane, wave, G, bid;
};
__device__ __forceinline__ const float* xrow_ptr(const Frame& F, int m) { return m < MP ? F.in[0] + (size_t)m * DM : F.in[1] + (size_t)(m - MP) * DM; }

template <class MAP>
__device__ __forceinline__ void p0_transpose_item(const float* W, int K, int N, int Nout, bf16_t* WT, LAS float* scr, int item, int lane, MAP map) {
    const int nblk = Nout / 32, kb = item / nblk, nb = item % nblk, k0 = 64 * kb, n0 = 32 * nb;
    const int src = map(n0 + (lane & 31));
    float tv[32];
#pragma unroll
    for (int i = 0; i < 32; ++i) { const int kk = 2 * i + (lane >> 5); tv[i] = src >= 0 ? W[(size_t)(k0 + kk) * N + src] : 0.f; }
#pragma unroll
    for (int i = 0; i < 32; ++i) { const int kk = 2 * i + (lane >> 5); scr[kk * 33 + (lane & 31)] = tv[i]; }
    asm volatile("s_waitcnt lgkmcnt(0)" ::: "memory");
    const int c = lane & 7;
#pragma unroll
    for (int j = 0; j < 4; ++j) { const int n = (lane >> 3) + 8 * j; const LAS float* s = scr + (8 * c) * 33 + n;
        u32x4 o; o.x = pk2(s[0 * 33], s[1 * 33]); o.y = pk2(s[2 * 33], s[3 * 33]); o.z = pk2(s[4 * 33], s[5 * 33]); o.w = pk2(s[6 * 33], s[7 * 33]);
        *(u32x4*)(WT + (size_t)(n0 + n) * K + k0 + 8 * c) = o; }
    asm volatile("s_waitcnt lgkmcnt(0)" ::: "memory");
}
struct MapIn { __device__ int operator()(int n) const { if (n < 640) { const int w = n & 63; return (n & ~63) + (w >> 3) * 4 + (w & 3) + 32 * ((w >> 2) & 1); } return n < 2464 ? n : -1; } };
struct MapId { __device__ int operator()(int n) const { return n; } };
struct MapFfn { __device__ int operator()(int n) const { const int tile = n >> 8, sub = n & 255, ch = tile * 128 + (sub & 127); return sub < 128 ? ch : DFF + ch; } };

__device__ __forceinline__ void p0_prologue(Frame& F) {
    LAS float* scr = (LAS float*)(F.lds + F.wave * 16384);
    const int gw = F.bid * NWAVES + F.wave, NGW = F.G * NWAVES;
    constexpr int I_IN = 16 * (DINP / 32), I_OUT = 16 * 32, I_FI = 16 * (2 * DFF / 32), I_FO = (DFF / 64) * 32;
    constexpr int NITEMS = I_IN + I_OUT + I_FI + I_FO;
#pragma unroll 1
    for (int pass = 0; pass < 2; ++pass) {
    const bool rows_now = (pass == 0) == ((F.wave & 1) != 0);
    if (!rows_now)
    for (int it = gw; it < NITEMS; it += NGW) {
        int r = it;
        if (r < I_IN) { p0_transpose_item(F.in[8], DM, 2464, DINP, (bf16_t*)(F.ws + WS_WIN), scr, r, F.lane, MapIn()); continue; } r -= I_IN;
        if (r < I_OUT) { p0_transpose_item(F.in[21], DM, DM, DM, (bf16_t*)(F.ws + WS_WOUT), scr, r, F.lane, MapId()); continue; } r -= I_OUT;
        if (r < I_FI) { p0_transpose_item(F.in[24], DM, 2 * DFF, 2 * DFF, (bf16_t*)(F.ws + WS_WFI), scr, r, F.lane, MapFfn()); continue; } r -= I_FI;
        p0_transpose_item(F.in[27], DFF, DM, DM, (bf16_t*)(F.ws + WS_WFO), scr, r, F.lane, MapId());
    }
    float* rope = (float*)(F.ws + WS_ROPE);
    if (pass == 0)
    for (int e = F.bid * NT + F.tid; e < (T + DT) * 32; e += F.G * NT) {
        const int pidx = e >> 5, i = e & 31; const int pos = pidx < T ? pidx : 16384 + (pidx - T);
        const float inv = (float)exp2(-(double)i * (13.287712379549449 / 32.0));
        const float angf = (float)pos * inv;
        const double a = (double)angf;
        const double TWO_PI = 6.283185307179586476925286766559;
        const double n = rint(a / TWO_PI);
        const double r = a - n * TWO_PI;
        const double r2 = r * r;
        double c = 1.0, s = 1.0, tc = 1.0, ts = 1.0;
#pragma unroll
        for (int k = 1; k <= 14; ++k) { tc = -tc * r2 * (1.0 / (double)((2 * k - 1) * (2 * k))); ts = -ts * r2 * (1.0 / (double)((2 * k) * (2 * k + 1))); c += tc; s += ts; }
        s *= r;
        rope[(size_t)e * 2] = (float)c; rope[(size_t)e * 2 + 1] = (float)s;
    }
    const float* g = F.in[7];
    bf16_t* XN = (bf16_t*)(F.ws + WS_XN);
    if (rows_now)
    for (int m = gw; m < M; m += NGW) {
        const f32x4* xr = (const f32x4*)xrow_ptr(F, m) + F.lane;
        f32x4 v[4]; float s = 0.f;
#pragma unroll
        for (int j = 0; j < 4; ++j) { v[j] = __builtin_nontemporal_load(xr + 64 * j); s += (v[j].x * v[j].x + v[j].y * v[j].y) + (v[j].z * v[j].z + v[j].w * v[j].w); }
        const float rstd = 1.0f / sqrtf(wave_sum(s) * (1.f / DM) + RMS_EPS);
        u32x2* o8 = (u32x2*)(XN + (size_t)m * DM) + F.lane;
#pragma unroll
        for (int j = 0; j < 4; ++j) { const f32x4 gg = ((const f32x4*)g)[64 * j + F.lane]; u32x2 w; w.x = pk2(v[j].x * rstd * gg.x, v[j].y * rstd * gg.y); w.y = pk2(v[j].z * rstd * gg.z, v[j].w * rstd * gg.w); o8[64 * j] = w; }
    }
    }
}

__device__ __forceinline__ float hprev_val(const Frame& F, const bf16_t* HRW, int m, int col) {
    const RowInfo ri = row_info(m);
    if (ri.t == 0) return ri.samp ? F.in[4][(size_t)ri.b * DSH + col] : 0.f;
    return bf2f(HRW[(size_t)(m - 1) * DSH + col]);
}
__device__ __forceinline__ f32x4 ld_bf4(const bf16_t* p) { const u32x2 w = *(const u32x2*)p; return (f32x4){bflo(w.x), bfhi(w.x), bflo(w.y), bfhi(w.y)}; }
__device__ __forceinline__ f32x4 hs4(const Frame& F, const bf16_t* HRW, int m, const RowInfo& ri, int col) {
    const f32x4 h = ld_bf4(HRW + (size_t)m * DSH + col);
    f32x4 hp;
    if (ri.t == 0) hp = ri.samp ? *(const f32x4*)(F.in[4] + (size_t)ri.b * DSH + col) : (f32x4){0.f, 0.f, 0.f, 0.f};
    else hp = ld_bf4(HRW + (size_t)(m - 1) * DSH + col);
    const f32x4 mu = *(const f32x4*)(F.in[10] + col);
    return h + (hp - h) * mu;
}
__device__ __forceinline__ float xsum_fq(float v) {
    { auto r = __builtin_amdgcn_permlane16_swap(__float_as_uint(v), __float_as_uint(v), false, false); v = __uint_as_float(r[0]) + __uint_as_float(r[1]); }
    { auto r = __builtin_amdgcn_permlane32_swap(__float_as_uint(v), __float_as_uint(v), false, false); v = __uint_as_float(r[0]) + __uint_as_float(r[1]); }
    return v;
}
__device__ __forceinline__ u32x2 pk4(const f32x4 v) { u32x2 w; w.x = cvt_pk_bf16(v[0], v[1]); w.y = cvt_pk_bf16(v[2], v[3]); return w; }
__device__ __forceinline__ bf16x8 wfrag(const float* W, int k0, int fq, int ch) {
    u32x4 w; const float* p = W + (size_t)(k0 + 8 * fq) * 512 + ch;
    w.x = cvt_pk_bf16(p[0], p[512]); w.y = cvt_pk_bf16(p[1024], p[1536]); w.z = cvt_pk_bf16(p[2048], p[2560]); w.w = cvt_pk_bf16(p[3072], p[3584]);
    return __builtin_bit_cast(bf16x8, w);
}
#ifndef PREP_DUP
#define PREP_DUP 1
#endif
#ifndef POST_DUP
#define POST_DUP 1
#endif
__device__ __forceinline__ void prep_phase(Frame& F) {
    const bf16_t* HRW = (const bf16_t*)(F.ws + WS_HRW);
    bf16_t* SR = (bf16_t*)(F.ws + WS_SR); bf16_t* SK = (bf16_t*)(F.ws + WS_SK); bf16_t* SV = (bf16_t*)(F.ws + WS_SV);
    bf16_t* SKK = (bf16_t*)(F.ws + WS_SKK); bf16_t* SB = (bf16_t*)(F.ws + WS_SB); float* SW = (float*)(F.ws + WS_SW);
    const int fr = F.lane & 15, fq = F.lane >> 4, h = F.wave;
    bf16x8 Aw[4], Aa[4];
#pragma unroll
    for (int nt = 0; nt < 4; ++nt) { Aw[nt] = wfrag(F.in[12], 0, fq, h * 64 + nt * 16 + fr); Aa[nt] = wfrag(F.in[14], 0, fq, h * 64 + nt * 16 + fr); }
    constexpr int NTILE = M / 16;
    for (int tile_ = F.bid; tile_ < NTILE * PREP_DUP; tile_ += F.G) {
        const int m = (tile_ % NTILE) * 16 + fr;
        const RowInfo ri = row_info(m);
        bf16x8 xw, xa;
        { const f32x4 a0 = hs4(F, HRW, m, ri, 1536 + 8 * fq), a1 = hs4(F, HRW, m, ri, 1540 + 8 * fq);
          f32x4 t0, t1;
#pragma unroll
          for (int i = 0; i < 4; ++i) { t0[i] = 1.f - 2.f * __builtin_amdgcn_rcpf(__expf(2.f * a0[i]) + 1.f); t1[i] = 1.f - 2.f * __builtin_amdgcn_rcpf(__expf(2.f * a1[i]) + 1.f); }
          const u32x2 p0 = pk4(t0), p1 = pk4(t1); u32x4 w; w.x = p0.x; w.y = p0.y; w.z = p1.x; w.w = p1.y; xw = __builtin_bit_cast(bf16x8, w); }
        { const f32x4 a0 = hs4(F, HRW, m, ri, 1568 + 8 * fq), a1 = hs4(F, HRW, m, ri, 1572 + 8 * fq);
          const u32x2 p0 = pk4(a0), p1 = pk4(a1); u32x4 w; w.x = p0.x; w.y = p0.y; w.z = p1.x; w.w = p1.y; xa = __builtin_bit_cast(bf16x8, w); }
        f32x4 kkr[4], av[4]; float ss = 0.f;
#pragma unroll
        for (int nt = 0; nt < 4; ++nt) {
            const int c4 = h * 64 + nt * 16 + 4 * fq;
            const f32x4 z = {0.f, 0.f, 0.f, 0.f};
            const f32x4 accw = __builtin_amdgcn_mfma_f32_16x16x32_bf16(Aw[nt], xw, z, 0, 0, 0);
            const f32x4 acca = __builtin_amdgcn_mfma_f32_16x16x32_bf16(Aa[nt], xa, z, 0, 0, 0);
            const f32x4 r = hs4(F, HRW, m, ri, c4), k = hs4(F, HRW, m, ri, 512 + c4), v = hs4(F, HRW, m, ri, 1024 + c4);
            const f32x4 w0 = *(const f32x4*)(F.in[11] + c4), a0 = *(const f32x4*)(F.in[13] + c4), kkc = *(const f32x4*)(F.in[16] + c4), kac = *(const f32x4*)(F.in[17] + c4);
            f32x4 decay, a, k2;
#pragma unroll
            for (int j = 0; j < 4; ++j) {
                const float x = -(w0[j] + accw[j]);
                const float sp = fmaxf(x, 0.f) + __logf(1.f + __expf(-fabsf(x)));
                decay[j] = __expf(-__expf(-sp - 0.5f));
                a[j] = sigmoidf_(a0[j] + acca[j]);
                k2[j] = k[j] * (1.f + (a[j] - 1.f) * kac[j]);
            }
            const f32x4 kk = k * kkc;
            ss += (kk[0] * kk[0] + kk[1] * kk[1]) + (kk[2] * kk[2] + kk[3] * kk[3]);
            kkr[nt] = kk; av[nt] = a;
            const size_t o = (size_t)m * 512 + c4;
            *(f32x4*)(SW + o) = decay; *(u32x2*)(SR + o) = pk4(r); *(u32x2*)(SK + o) = pk4(k2); *(u32x2*)(SV + o) = pk4(v);
        }
        ss = xsum_fq(ss);
        const float rs = rsqrtf(fmaxf(ss, 1e-24f));
#pragma unroll
        for (int nt = 0; nt < 4; ++nt) {
            const size_t o = (size_t)m * 512 + h * 64 + nt * 16 + 4 * fq;
            const f32x4 kk = kkr[nt] * rs;
            *(u32x2*)(SKK + o) = pk4(kk); *(u32x2*)(SB + o) = pk4(kk * av[nt]);
        }
    }
}

__device__ __forceinline__ void sample_attn_phase(Frame& F) {
    constexpr int NK = WIN + DT, KS = 68;
    LAS float* Kl = (LAS float*)F.lds;
    LAS float* Vl = Kl + NK * KS;
    LAS float* Pl = Vl + NK * KS;
    const bf16_t* Q = (const bf16_t*)(F.ws + WS_Q);
    bf16_t* OC = (bf16_t*)(F.ws + WS_OCAT);
    for (int unit = F.bid; unit < DB * 2; unit += F.G) {
        const int b = unit >> 1, kvh = unit & 1;
        for (int e = F.tid; e < NK * 16; e += NT) {
            const int key = e >> 4, d4 = (e & 15) * 4;
            f32x4 kv, vv;
            if (key < WIN) { kv = *(const f32x4*)(F.in[2] + ((size_t)(b * WIN + key) * 2 + kvh) * 64 + d4); vv = *(const f32x4*)(F.in[3] + ((size_t)(b * WIN + key) * 2 + kvh) * 64 + d4); }
            else { kv = *(const f32x4*)(F.out + O_KWS + ((size_t)(b * WIN + key - DT) * 2 + kvh) * 64 + d4); vv = *(const f32x4*)(F.out + O_VWS + ((size_t)(b * WIN + key - DT) * 2 + kvh) * 64 + d4); }
            *(LAS f32x4*)(Kl + key * KS + d4) = kv; *(LAS f32x4*)(Vl + key * KS + d4) = vv;
            if (key >= DT && key < WIN) { *(f32x4*)(F.out + O_KWS + ((size_t)(b * WIN + key - DT) * 2 + kvh) * 64 + d4) = kv; *(f32x4*)(F.out + O_VWS + ((size_t)(b * WIN + key - DT) * 2 + kvh) * 64 + d4) = vv; }
        }
        __syncthreads();
        const int qi = F.tid >> 4, sub = F.tid & 15;
        const int t = qi >> 2, g = qi & 3, head = kvh * 4 + g;
        const int m = MP + b * DT + t;
        float mx = F.in[9][head] * 1.4426950408889634f;
        {
            const bf16_t* qp = Q + (size_t)m * 512 + head * 64;
            float q[64];
#pragma unroll
            for (int i = 0; i < 8; ++i) { const u32x4 w = *(const u32x4*)(qp + 8 * i); q[8 * i] = bflo(w.x); q[8 * i + 1] = bfhi(w.x); q[8 * i + 2] = bflo(w.y); q[8 * i + 3] = bfhi(w.y); q[8 * i + 4] = bflo(w.z); q[8 * i + 5] = bfhi(w.z); q[8 * i + 6] = bflo(w.w); q[8 * i + 7] = bfhi(w.w); }
#pragma unroll 1
            for (int key = sub; key < NK; key += 16) {
                float a = 0.f; const LAS f32x4* kr = (const LAS f32x4*)(Kl + key * KS);
#pragma unroll
                for (int i = 0; i < 16; ++i) { const f32x4 kx = kr[i]; a += q[4 * i] * kx[0] + q[4 * i + 1] * kx[1] + q[4 * i + 2] * kx[2] + q[4 * i + 3] * kx[3]; }
                const int dist = t + WIN - key;
                const float s = (dist >= 0 && dist <= WIN) ? a : -1e30f;
                Pl[qi * NK + key] = s; mx = fmaxf(mx, s);
            }
        }
        mx = fmaxf(mx, __shfl_xor(mx, 1)); mx = fmaxf(mx, __shfl_xor(mx, 2)); mx = fmaxf(mx, __shfl_xor(mx, 4)); mx = fmaxf(mx, __shfl_xor(mx, 8));
        float sum = 0.f;
#pragma unroll 1
        for (int key = sub; key < NK; key += 16) { const float sv = Pl[qi * NK + key]; const float p = sv > -1e29f ? __builtin_amdgcn_exp2f(sv - mx) : 0.f; sum += p; Pl[qi * NK + key] = p; }
        sum += __shfl_xor(sum, 1); sum += __shfl_xor(sum, 2); sum += __shfl_xor(sum, 4); sum += __shfl_xor(sum, 8);
        const float inv = __builtin_amdgcn_rcpf(sum + __builtin_amdgcn_exp2f(F.in[9][head] * 1.4426950408889634f - mx));
        __syncthreads();
        f32x4 o = {0.f, 0.f, 0.f, 0.f};
        for (int key = 0; key < NK; ++key) { const float p = Pl[qi * NK + key]; const f32x4 vv = *(const LAS f32x4*)(Vl + key * KS + sub * 4); o += vv * p; }
        o = o * inv;
        u32x2 w; w.x = pk2(o[0], o[1]); w.y = pk2(o[2], o[3]);
        *(u32x2*)(OC + (size_t)m * DM + head * 64 + sub * 4) = w;
        __syncthreads();
    }
}

__device__ __forceinline__ void prompt_attn_unit(Frame& F, int unit) {
    constexpr int KST = 144, VST = 528;
    LAS unsigned char* Kl = F.lds; LAS unsigned char* Vl = F.lds + 256 * KST;
    const bf16_t* Q = (const bf16_t*)(F.ws + WS_Q); const bf16_t* Kb = (const bf16_t*)(F.ws + WS_K); const bf16_t* VT = (const bf16_t*)(F.ws + WS_VT);
    bf16_t* OC = (bf16_t*)(F.ws + WS_OCAT);
    const int kvh = unit & 1, qb = (unit >> 1) & 63, b = unit >> 7;
    const int key0 = (qb - 1) * 128;
    for (int e = F.tid; e < 256 * 8; e += NT) {
        const int key = e >> 3, ch = e & 7; const int pos = key0 + key;
        u32x4 v = {0u, 0u, 0u, 0u};
        if (pos >= 0) v = *(const u32x4*)(Kb + (size_t)(b * T + pos) * 128 + kvh * 64 + ch * 8);
        *(LAS u32x4*)(Kl + key * KST + ch * 16) = v;
    }
    for (int e = F.tid; e < 64 * 32; e += NT) {
        const int d = e >> 5, ch = e & 31; const int pos = key0 + ch * 8;
        u32x4 v = {0u, 0u, 0u, 0u};
        if (pos >= 0) v = *(const u32x4*)(VT + ((size_t)(b * 2 + kvh) * 64 + d) * T + pos);
        *(LAS u32x4*)(Vl + d * VST + ch * 16) = v;
    }
    __syncthreads();
    const int fr = F.lane & 15, fq = F.lane >> 4;
    const int head = kvh * 4 + (F.wave >> 1);
    const float sink = F.in[9][head] * 1.4426950408889634f;
#pragma unroll 1
    for (int sb = 0; sb < 4; ++sb) {
        const int qi0 = (F.wave & 1) * 64 + sb * 16;
        const int qi = qi0 + fr;
        const size_t mrow = (size_t)b * T + qb * 128 + qi;
        const bf16x8 q0 = *(const bf16x8*)(Q + mrow * 512 + head * 64 + fq * 8);
        const bf16x8 q1 = *(const bf16x8*)(Q + mrow * 512 + head * 64 + 32 + fq * 8);
        const int ktlo = (F.wave & 1) * 4 + sb;
        f32x4 s[9];
#pragma unroll
        for (int kr = 0; kr < 9; ++kr) {
            const int kt = ktlo + kr;
            const bf16x8 k0 = *(const LAS bf16x8*)(Kl + (kt * 16 + fr) * KST + fq * 16);
            const bf16x8 k1 = *(const LAS bf16x8*)(Kl + (kt * 16 + fr) * KST + 64 + fq * 16);
            f32x4 a = {0.f, 0.f, 0.f, 0.f};
            a = __builtin_amdgcn_mfma_f32_16x16x32_bf16(k0, q0, a, 0, 0, 0);
            a = __builtin_amdgcn_mfma_f32_16x16x32_bf16(k1, q1, a, 0, 0, 0);
            s[kr] = a;
        }
        float mx = sink;
#pragma unroll
        for (int kr = 0; kr < 9; ++kr)
#pragma unroll
            for (int j = 0; j < 4; ++j) { const int sj = (ktlo + kr) * 16 + fq * 4 + j; const int dist = qi + 128 - sj; const bool ok = dist >= 0 && dist <= WIN && (key0 + sj) >= 0; const float v = ok ? s[kr][j] : -1e30f; s[kr][j] = v; mx = fmaxf(mx, v); }
        mx = fmaxf(mx, __shfl_xor(mx, 16)); mx = fmaxf(mx, __shfl_xor(mx, 32));
        float sum = 0.f;
        u32x2 pw[10];
#pragma unroll
        for (int kr = 0; kr < 9; ++kr) {
            f32x4 p;
#pragma unroll
            for (int j = 0; j < 4; ++j) { p[j] = s[kr][j] > -1e29f ? __builtin_amdgcn_exp2f(s[kr][j] - mx) : 0.f; sum += p[j]; }
            pw[kr].x = cvt_pk_bf16(p[0], p[1]); pw[kr].y = cvt_pk_bf16(p[2], p[3]);
        }
        pw[9].x = 0u; pw[9].y = 0u;
        sum += __shfl_xor(sum, 16); sum += __shfl_xor(sum, 32);
        const float inv = __builtin_amdgcn_rcpf(sum + __builtin_amdgcn_exp2f(sink - mx));
        f32x4 o[4];
#pragma unroll
        for (int dt = 0; dt < 4; ++dt) o[dt] = (f32x4){0.f, 0.f, 0.f, 0.f};
#pragma unroll
        for (int u = 0; u < 5; ++u) {
            u32x4 pb; pb.x = pw[2 * u].x; pb.y = pw[2 * u].y; pb.z = pw[2 * u + 1].x; pb.w = pw[2 * u + 1].y;
            const bf16x8 pf = __builtin_bit_cast(bf16x8, pb);
            const int kta = ktlo + 2 * u, ktb = u < 4 ? kta + 1 : kta;
#pragma unroll
            for (int dt = 0; dt < 4; ++dt) {
                const LAS unsigned char* vr = Vl + (dt * 16 + fr) * VST + (fq * 4) * 2;
                const u32x2 va = *(const LAS u32x2*)(vr + kta * 32), vb = *(const LAS u32x2*)(vr + ktb * 32);
                u32x4 vv; vv.x = va.x; vv.y = va.y; vv.z = vb.x; vv.w = vb.y;
                o[dt] = __builtin_amdgcn_mfma_f32_16x16x32_bf16(__builtin_bit_cast(bf16x8, vv), pf, o[dt], 0, 0, 0);
            }
        }
#pragma unroll
        for (int dt = 0; dt < 4; ++dt) { const f32x4 v = o[dt] * inv; u32x2 w; w.x = cvt_pk_bf16(v[0], v[1]); w.y = cvt_pk_bf16(v[2], v[3]); *(u32x2*)(OC + mrow * DM + head * 64 + dt * 16 + fq * 4) = w; }
    }
    __syncthreads();
}

struct StepOps { f32x4 w, nbe, kk, k, r; float v; };
template <int STRIDE_F> __device__ __forceinline__ StepOps load_ops(const LAS float* img, int s, int cgi, int vrow) {
    const LAS float* p = img + s * STRIDE_F + cgi * 4; StepOps o;
    o.w = *(const LAS f32x4*)(p); o.nbe = *(const LAS f32x4*)(p + 64); o.kk = *(const LAS f32x4*)(p + 128); o.k = *(const LAS f32x4*)(p + 192); o.r = *(const LAS f32x4*)(p + 256);
    o.v = img[s * STRIDE_F + 320 + vrow]; return o;
}
template <int J> __device__ __forceinline__ float sel_lane16(float oldv, float newv) {
    float r; const unsigned long long m = 0x0001000100010001ull << J;
    asm("v_cndmask_b32_e64 %0, %1, %2, %3" : "=v"(r) : "v"(oldv), "v"(newv), "s"(m));
    return r;
}
struct ScanState { f32x2 s01, s23; float ykeep, ypart; StepOps c0, c1; };
template <int STRIDE_F, int J>
__device__ __forceinline__ void scan_step(const LAS float* img, int s0, int vrow, int cgi, ScanState& Z) {
    const StepOps nx = load_ops<STRIDE_F>(img, s0 + J + 2, cgi, vrow);
    const StepOps& c = Z.c0;
    const f32x2 kk01 = {c.kk[0], c.kk[1]}, kk23 = {c.kk[2], c.kk[3]}, w01 = {c.w[0], c.w[1]}, w23 = {c.w[2], c.w[3]}, k01 = {c.k[0], c.k[1]}, k23 = {c.k[2], c.k[3]};
    const f32x2 b01 = {c.nbe[0], c.nbe[1]}, b23 = {c.nbe[2], c.nbe[3]}, r01 = {c.r[0], c.r[1]}, r23 = {c.r[2], c.r[3]};
    f32x2 t = Z.s01 * kk01; t = Z.s23 * kk23 + t;
    float sa = t.x + t.y;
    const f32x2 u01 = Z.s01 * w01 + k01 * c.v, u23 = Z.s23 * w23 + k23 * c.v;
    if (J > 0) { allsum16_2(sa, Z.ypart); Z.ykeep = sel_lane16<(J > 0 ? J - 1 : 0)>(Z.ykeep, Z.ypart); } else sa = allsum16(sa);
    Z.s01 = b01 * sa + u01; Z.s23 = b23 * sa + u23;
    f32x2 y2 = Z.s01 * r01; y2 = Z.s23 * r23 + y2;
    Z.ypart = y2.x + y2.y;
    Z.c0 = Z.c1; Z.c1 = nx;
}
template <int STRIDE_F, int GS, int... Js>
__device__ __forceinline__ void scan_group_impl(const LAS float* img, int s0, int vrow, int cgi, ScanState& Z, float* yout, std::integer_sequence<int, Js...>) {
    (scan_step<STRIDE_F, Js>(img, s0, vrow, cgi, Z), ...);
    Z.ypart = allsum16(Z.ypart); Z.ykeep = sel_lane16<GS - 1>(Z.ykeep, Z.ypart);
    if (cgi < GS) yout[(size_t)(s0 + cgi) * 512] = Z.ykeep;
}
template <int STRIDE_F, int J>
__device__ __forceinline__ void scan_step_yp(const LAS float* img, int s0, int vrow, int cgi, ScanState& Z, LAS float* ypb) {
    const StepOps nx = load_ops<STRIDE_F>(img, s0 + J + 2, cgi, vrow);
    const StepOps& c = Z.c0;
    const f32x2 kk01 = {c.kk[0], c.kk[1]}, kk23 = {c.kk[2], c.kk[3]}, w01 = {c.w[0], c.w[1]}, w23 = {c.w[2], c.w[3]}, k01 = {c.k[0], c.k[1]}, k23 = {c.k[2], c.k[3]};
    const f32x2 b01 = {c.nbe[0], c.nbe[1]}, b23 = {c.nbe[2], c.nbe[3]}, r01 = {c.r[0], c.r[1]}, r23 = {c.r[2], c.r[3]};
    f32x2 t = Z.s01 * kk01; t = Z.s23 * kk23 + t;
    float sa = t.x + t.y;
    const f32x2 u01 = Z.s01 * w01 + k01 * c.v, u23 = Z.s23 * w23 + k23 * c.v;
    sa = allsum16(sa);
    Z.s01 = b01 * sa + u01; Z.s23 = b23 * sa + u23;
    f32x2 y2 = Z.s01 * r01; y2 = Z.s23 * r23 + y2;
    ypb[(s0 + J) * 64] = y2.x + y2.y;
    Z.c0 = Z.c1; Z.c1 = nx;
}
struct StepOpsS { f32x4 nbe, kk, k, r; };
template <int STRIDE_F> __device__ __forceinline__ StepOpsS load_ops_s(const LAS float* img, int s, int cgi) {
    const LAS float* p = img + s * STRIDE_F + cgi * 4; StepOpsS o;
    o.nbe = *(const LAS f32x4*)(p + 64); o.kk = *(const LAS f32x4*)(p + 128); o.k = *(const LAS f32x4*)(p + 192); o.r = *(const LAS f32x4*)(p + 256);
    return o;
}
struct ScanT { f32x2 t01, t23; StepOpsS c0, c1; f32x4 v4[4]; };
template <int STRIDE_F, int J>
__device__ __forceinline__ void scan_step_s(const LAS float* img, int cgi, ScanT& Z, LAS float* ypb) {
    const StepOpsS nx = load_ops_s<STRIDE_F>(img, J + 2, cgi);
    const StepOpsS& c = Z.c0;
    const float v = Z.v4[J >> 2][J & 3];
    f32x2 t = Z.t01 * (f32x2){c.kk[0], c.kk[1]}; t = Z.t23 * (f32x2){c.kk[2], c.kk[3]} + t;
    float sa = t.x + t.y;
    const f32x2 a01 = (f32x2){c.k[0], c.k[1]} * v + Z.t01, a23 = (f32x2){c.k[2], c.k[3]} * v + Z.t23;
    sa = allsum16(sa);
    Z.t01 = (f32x2){c.nbe[0], c.nbe[1]} * sa + a01; Z.t23 = (f32x2){c.nbe[2], c.nbe[3]} * sa + a23;
    f32x2 y2 = Z.t01 * (f32x2){c.r[0], c.r[1]}; y2 = Z.t23 * (f32x2){c.r[2], c.r[3]} + y2;
    ypb[J * 64] = y2.x + y2.y;
    Z.c0 = Z.c1; Z.c1 = nx;
}
template <int STRIDE_F, int... Js>
__device__ __forceinline__ void scan_chunk_s_impl(const LAS float* img, int cgi, ScanT& Z, LAS float* ypb, std::integer_sequence<int, Js...>) {
    (scan_step_s<STRIDE_F, Js>(img, cgi, Z, ypb), ...);
}
template <int STRIDE_F, int NS>
__device__ __forceinline__ void scan_transform(LAS float* img, int lane) {
    LAS float* p = img + lane; float Wc = 1.f;
#pragma unroll
    for (int t = 0; t < NS; ++t, p += STRIDE_F) {
        const float w = p[0], nb = p[64], kk = p[128], k = p[192], r = p[256];
        p[128] = Wc * kk;
        Wc *= w; const float inv = __builtin_amdgcn_rcpf(Wc);
        p[64] = nb * inv; p[192] = k * inv; p[256] = Wc * r;
    }
    img[(NS - 1) * STRIDE_F + lane] = Wc;
}
template <int STRIDE_F, int... Js>
__device__ __forceinline__ void scan_group_yp_impl(const LAS float* img, int s0, int vrow, int cgi, ScanState& Z, LAS float* ypb, std::integer_sequence<int, Js...>) {
    (scan_step_yp<STRIDE_F, Js>(img, s0, vrow, cgi, Z, ypb), ...);
}
template <int... Js>
__device__ __forceinline__ void yp_reduce_impl(const LAS float* ypb, int cgi, float* yout, int s0, std::integer_sequence<int, Js...>) {
    float ykeep = 0.f;
    ((ykeep = sel_lane16<Js>(ykeep, allsum16(ypb[(s0 + Js) * 64]))), ...);
    yout[(size_t)(s0 + cgi) * 512] = ykeep;
}
template <int STRIDE_F, int GS>
__device__ __forceinline__ void scan_group(const LAS float* img, int s0, int vrow, int cgi, ScanState& Z, float* yout) {
    scan_group_impl<STRIDE_F, GS>(img, s0, vrow, cgi, Z, yout, std::make_integer_sequence<int, GS>());
}
constexpr int SC = 32;
constexpr int PSTR = 328;
constexpr int SSTR = 384;
struct ScanRegs { f32x4 w[2]; u32x4 b0[2], b1[2]; u32x4 v; };
__device__ __forceinline__ void scan_load(const Frame& F, ScanRegs& R, int m0, int h, int v0) {
    if (F.wave < 4) return;
    const int vt = F.tid - 256;
#pragma unroll
    for (int i = 0; i < 2; ++i) {
        const int tid = vt + 256 * i;
        { const int row = tid >> 4, c4 = (tid & 15) * 4; R.w[i] = *(const f32x4*)((const float*)(F.ws + WS_SW) + (size_t)(m0 + row) * 512 + h * 64 + c4); }
        { const int st = tid >> 7, row = (tid & 127) >> 2, seg = tid & 3;
          const size_t base = st == 0 ? WS_SB : st == 1 ? WS_SKK : st == 2 ? WS_SK : WS_SR;
          const bf16_t* p = (const bf16_t*)(F.ws + base) + (size_t)(m0 + row) * 512 + h * 64 + seg * 16;
          R.b0[i] = *(const u32x4*)p; R.b1[i] = *(const u32x4*)(p + 8); }
    }
    { R.v = *(const u32x4*)((const bf16_t*)(F.ws + WS_SV) + (size_t)(m0 + (vt & 31)) * 512 + h * 64 + v0); }
}
__device__ __forceinline__ void scan_store(const Frame& F, const ScanRegs& R, LAS float* img) {
    if (F.wave < 4) return;
    const int vt = F.tid - 256;
#pragma unroll
    for (int i = 0; i < 2; ++i) {
        const int tid = vt + 256 * i;
        { const int row = tid >> 4, c4 = (tid & 15) * 4; *(LAS f32x4*)(img + row * PSTR + c4) = R.w[i]; }
        { const int st = tid >> 7, row = (tid & 127) >> 2, seg = tid & 3;
          LAS float* d = img + row * PSTR + 64 + st * 64 + seg * 16;
          const float sg = st == 0 ? -1.f : 1.f; const u32x4 b0 = R.b0[i], b1 = R.b1[i];
          *(LAS f32x4*)(d) = (f32x4){bflo(b0.x), bfhi(b0.x), bflo(b0.y), bfhi(b0.y)} * sg; *(LAS f32x4*)(d + 4) = (f32x4){bflo(b0.z), bfhi(b0.z), bflo(b0.w), bfhi(b0.w)} * sg;
          *(LAS f32x4*)(d + 8) = (f32x4){bflo(b1.x), bfhi(b1.x), bflo(b1.y), bfhi(b1.y)} * sg; *(LAS f32x4*)(d + 12) = (f32x4){bflo(b1.z), bfhi(b1.z), bflo(b1.w), bfhi(b1.w)} * sg; }
    }
    if (vt < 32) { LAS float* d = img + SC * PSTR + vt;
      d[0 * SC] = bflo(R.v.x); d[1 * SC] = bfhi(R.v.x); d[2 * SC] = bflo(R.v.y); d[3 * SC] = bfhi(R.v.y); d[4 * SC] = bflo(R.v.z); d[5 * SC] = bfhi(R.v.z); d[6 * SC] = bflo(R.v.w); d[7 * SC] = bfhi(R.v.w); }
}
constexpr int NSW = 2;
__device__ __forceinline__ void prompt_scan(Frame& F, int sblk) {
    const int xcd = sblk & 7, k = sblk >> 3;
    const int chain = xcd * 4 + (k >> 3), rg = k & 7;
    const int b = chain >> 3, h = chain & 7, v0 = rg * 8;
    LAS float* img = (LAS float*)F.lds;
    constexpr int IMG = SC * PSTR + 8 * SC;
    const int rl = F.lane >> 4, cgi = F.lane & 15;
    const int vrow = F.wave * 4 + rl;
    float* Y = F.out;
    ScanState Z; Z.s01 = (f32x2){0.f, 0.f}; Z.s23 = (f32x2){0.f, 0.f}; Z.ykeep = 0.f; Z.ypart = 0.f;
    ScanRegs R0, R1, R2, R3;
    const int mbase = b * T;
    constexpr int NCH = T / SC;
#ifndef SCAN_DUP
#define SCAN_DUP 1
#endif
    constexpr int NTOT = NCH * SCAN_DUP;
    scan_load(F, R0, mbase, h, v0); scan_store(F, R0, img);
    scan_load(F, R1, mbase + SC, h, v0); scan_store(F, R1, img + IMG);
    scan_load(F, R2, mbase + 2 * SC, h, v0); scan_load(F, R3, mbase + 3 * SC, h, v0);
    __syncthreads();
    if (F.wave == 4 || F.wave == 5) scan_transform<PSTR, 16>(img + (F.wave - 4) * 16 * PSTR, F.lane);
    __syncthreads();
    LAS float* ypr = (LAS float*)(F.lds + YP_OFF);
#define SCAN_CHUNK(cc_) do { const int c_ = (cc_) % NCH; \
        if (SCAN_DUP > 1 && c_ == 0) { Z.s01 = (f32x2){0.f, 0.f}; Z.s23 = (f32x2){0.f, 0.f}; } \
        if (F.wave < NSW) { const LAS float* im = img + ((cc_) % 3) * IMG; LAS float* ypb = ypr + (((cc_) & 1) * NSW + F.wave) * (SC * 64) + F.lane; \
            const LAS float* vtp = im + SC * PSTR + vrow * SC; \
            ScanT Tz; Tz.t01 = Z.s01; Tz.t23 = Z.s23; Tz.c0 = load_ops_s<PSTR>(im, 0, cgi); Tz.c1 = load_ops_s<PSTR>(im, 1, cgi); \
            _Pragma("unroll") for (int q_ = 0; q_ < 4; ++q_) Tz.v4[q_] = *(const LAS f32x4*)(vtp + 4 * q_); \
            scan_chunk_s_impl<PSTR>(im, cgi, Tz, ypb, std::make_integer_sequence<int, 16>()); \
            { const f32x4 wce = *(const LAS f32x4*)(im + 15 * PSTR + cgi * 4); Tz.t01 = Tz.t01 * (f32x2){wce[0], wce[1]}; Tz.t23 = Tz.t23 * (f32x2){wce[2], wce[3]}; } \
            _Pragma("unroll") for (int q_ = 0; q_ < 4; ++q_) Tz.v4[q_] = *(const LAS f32x4*)(vtp + 16 + 4 * q_); \
            scan_chunk_s_impl<PSTR>(im + 16 * PSTR, cgi, Tz, ypb + 16 * 64, std::make_integer_sequence<int, 16>()); \
            { const f32x4 wce = *(const LAS f32x4*)(im + 31 * PSTR + cgi * 4); Z.s01 = Tz.t01 * (f32x2){wce[0], wce[1]}; Z.s23 = Tz.t23 * (f32x2){wce[2], wce[3]}; } } \
        else if (F.wave < 2 * NSW && (cc_) > 0) { const int sw_ = F.wave - NSW, cp_ = ((cc_) - 1) % NCH; \
            const LAS float* ypb = ypr + ((((cc_) - 1) & 1) * NSW + sw_) * (SC * 64) + F.lane; float* yo = Y + (size_t)(mbase + cp_ * SC) * 512 + h * 64 + v0 + sw_ * 4 + rl; \
            yp_reduce_impl(ypb, cgi, yo, 0, std::make_integer_sequence<int, 16>()); yp_reduce_impl(ypb, cgi, yo, 16, std::make_integer_sequence<int, 16>()); } \
        else if ((F.wave == 4 || F.wave == 5) && (cc_) + 1 < NTOT) scan_transform<PSTR, 16>(img + (((cc_) + 1) % 3) * IMG + (F.wave - 4) * 16 * PSTR, F.lane); } while (0)
#define SCAN_ITER(j_, RL_, RS_) do { const int c4_ = cc + (j_); \
        scan_load(F, RL_, mbase + ((c4_ + 4 < NTOT ? c4_ + 4 : NTOT - 1) % NCH) * SC, h, v0);        \
        SCAN_CHUNK(c4_); \
        if (c4_ + 2 < NTOT) scan_store(F, RS_, img + ((c4_ + 2) % 3) * IMG);                         \
        asm volatile("s_waitcnt lgkmcnt(0)\n\ts_barrier" ::: "memory"); } while (0)
#pragma unroll 1
    for (int cc = 0; cc < NTOT; cc += 4) {
        SCAN_ITER(0, R0, R2); SCAN_ITER(1, R1, R3); SCAN_ITER(2, R2, R0); SCAN_ITER(3, R3, R1);
    }
#undef SCAN_ITER
#undef SCAN_CHUNK
    if (F.wave >= NSW && F.wave < 2 * NSW) { const int sw_ = F.wave - NSW, cp_ = (NTOT - 1) % NCH;
        const LAS float* ypb = ypr + (((NTOT - 1) & 1) * NSW + sw_) * (SC * 64) + F.lane; float* yo = Y + (size_t)(mbase + cp_ * SC) * 512 + h * 64 + v0 + sw_ * 4 + rl;
        yp_reduce_impl(ypb, cgi, yo, 0, std::make_integer_sequence<int, 16>()); yp_reduce_impl(ypb, cgi, yo, 16, std::make_integer_sequence<int, 16>()); }
    __syncthreads();
    if (F.wave < NSW) *(f32x4*)(F.out + O_WKVP + ((size_t)(b * 8 + h) * 64 + v0 + vrow) * 64 + cgi * 4) = (f32x4){Z.s01.x, Z.s01.y, Z.s23.x, Z.s23.y};
}
__device__ __forceinline__ void sample_scan(Frame& F, int sblk, int nsblk) {
    LAS float* img = (LAS float*)F.lds;
    float* Y = F.out;
    const int rl = F.lane >> 4, cgi = F.lane & 15;
    for (int chain = sblk; chain < DB * 8; chain += nsblk) {
        const int b = chain >> 3, h = chain & 7; const int m0 = MP + b * DT;
        for (int e = F.tid; e < 6 * DT * 64; e += NT) {
            const int st = e >> 9, row = (e >> 6) & 7, ch = e & 63; const size_t o = (size_t)(m0 + row) * 512 + h * 64 + ch;
            float val;
            if (st == 0) val = ((const float*)(F.ws + WS_SW))[o];
            else { const size_t base = st == 1 ? WS_SB : st == 2 ? WS_SKK : st == 3 ? WS_SK : st == 4 ? WS_SR : WS_SV; val = bf2f(((const bf16_t*)(F.ws + base))[o]); if (st == 1) val = -val; }
            img[row * SSTR + st * 64 + ch] = val;
        }
        __syncthreads();
#pragma unroll 1
        for (int rnd = 0; rnd < 2; ++rnd) {
            const int vrow = (rnd * 8 + F.wave) * 4 + rl;
            const float* s0 = F.in[5] + ((size_t)chain * 64 + vrow) * 64 + cgi * 4;
            const f32x4 S = *(const f32x4*)s0;
            ScanState Z; Z.s01 = (f32x2){S[0], S[1]}; Z.s23 = (f32x2){S[2], S[3]}; Z.ykeep = 0.f; Z.ypart = 0.f;
            Z.c0 = load_ops<SSTR>(img, 0, cgi, vrow); Z.c1 = load_ops<SSTR>(img, 1, cgi, vrow);
            scan_group<SSTR, DT>(img, 0, vrow, cgi, Z, Y + (size_t)m0 * 512 + h * 64 + vrow);
            *(f32x4*)(F.out + O_WKVS + ((size_t)chain * 64 + vrow) * 64 + cgi * 4) = (f32x4){Z.s01.x, Z.s01.y, Z.s23.x, Z.s23.y};
        }
        __syncthreads();
    }
}

__device__ __forceinline__ void post_phase(Frame& F) {
    const bf16_t* HRW = (const bf16_t*)(F.ws + WS_HRW);
    const bf16_t* SR = (const bf16_t*)(F.ws + WS_SR); const bf16_t* SK = (const bf16_t*)(F.ws + WS_SK); const bf16_t* SV = (const bf16_t*)(F.ws + WS_SV);
    const float* Y = F.out; bf16_t* OC = (bf16_t*)(F.ws + WS_OCAT);
    const int fr = F.lane & 15, fq = F.lane >> 4, h = F.wave;
    bf16x8 Ag[4][3];
#pragma unroll
    for (int nt = 0; nt < 4; ++nt)
#pragma unroll
        for (int s3 = 0; s3 < 3; ++s3) Ag[nt][s3] = wfrag(F.in[15], 32 * s3, fq, h * 64 + nt * 16 + fr);
    constexpr int NTILE = M / 16;
    for (int tile_ = F.bid; tile_ < NTILE * POST_DUP; tile_ += F.G) {
        const int m = (tile_ % NTILE) * 16 + fr;
        const RowInfo ri = row_info(m);
        bf16x8 xg[3];
#pragma unroll
        for (int s3 = 0; s3 < 3; ++s3) {
            const f32x4 a0 = hs4(F, HRW, m, ri, 1600 + 32 * s3 + 8 * fq), a1 = hs4(F, HRW, m, ri, 1604 + 32 * s3 + 8 * fq);
            f32x4 t0, t1;
#pragma unroll
            for (int i = 0; i < 4; ++i) { t0[i] = sigmoidf_(a0[i]); t1[i] = sigmoidf_(a1[i]); }
            const u32x2 p0 = pk4(t0), p1 = pk4(t1); u32x4 w; w.x = p0.x; w.y = p0.y; w.z = p1.x; w.w = p1.y; xg[s3] = __builtin_bit_cast(bf16x8, w);
        }
        f32x4 y4[4], v4[4], g4[4]; float sy = 0.f, dot = 0.f;
#pragma unroll
        for (int nt = 0; nt < 4; ++nt) {
            const int c4 = h * 64 + nt * 16 + 4 * fq; const size_t o = (size_t)m * 512 + c4;
            f32x4 g = {0.f, 0.f, 0.f, 0.f};
#pragma unroll
            for (int s3 = 0; s3 < 3; ++s3) g = __builtin_amdgcn_mfma_f32_16x16x32_bf16(Ag[nt][s3], xg[s3], g, 0, 0, 0);
            g4[nt] = g;
            const f32x4 y = *(const f32x4*)(Y + o); const f32x4 r = ld_bf4(SR + o), k = ld_bf4(SK + o); v4[nt] = ld_bf4(SV + o);
            const f32x4 rk = *(const f32x4*)(F.in[18] + c4);
            y4[nt] = y; sy += (y[0] + y[1]) + (y[2] + y[3]);
            const f32x4 p = r * k * rk; dot += (p[0] + p[1]) + (p[2] + p[3]);
        }
        const float mean = xsum_fq(sy) * (1.f / 64.f); dot = xsum_fq(dot);
        float sq = 0.f;
#pragma unroll
        for (int nt = 0; nt < 4; ++nt) { y4[nt] = y4[nt] - mean; const f32x4 d = y4[nt]; sq += (d[0] * d[0] + d[1] * d[1]) + (d[2] * d[2] + d[3] * d[3]); }
        const float rstd = rsqrtf(xsum_fq(sq) * (1.f / 64.f) + GN_EPS);
#pragma unroll
        for (int nt = 0; nt < 4; ++nt) {
            const int c4 = h * 64 + nt * 16 + 4 * fq;
            const f32x4 gw = *(const f32x4*)(F.in[19] + c4), gb = *(const f32x4*)(F.in[20] + c4);
            const f32x4 o = (y4[nt] * rstd * gw + gb + v4[nt] * dot) * g4[nt];
            *(u32x2*)(OC + (size_t)m * DM + 512 + c4) = pk4(o);
        }
    }
}

__device__ __forceinline__ void rows_mid(Frame& F) {
    const int gw = F.bid * NWAVES + F.wave, NGW = F.G * NWAVES;
    const f32x4* g1 = (const f32x4*)F.in[22]; const f32x4* g2 = (const f32x4*)F.in[23];
    bf16_t* XN = (bf16_t*)(F.ws + WS_XN);
    for (int m = gw; m < M; m += NGW) {
        const f32x4* xr = (const f32x4*)xrow_ptr(F, m) + F.lane;
        const u32x2* mb = (const u32x2*)((const bf16_t*)(F.ws + WS_MIX) + (size_t)m * DM) + F.lane;
        f32x4 v[4]; float s = 0.f;
#pragma unroll
        for (int j = 0; j < 4; ++j) { const u32x2 w = mb[64 * j]; v[j] = (f32x4){bflo(w.x), bfhi(w.x), bflo(w.y), bfhi(w.y)}; s += (v[j].x * v[j].x + v[j].y * v[j].y) + (v[j].z * v[j].z + v[j].w * v[j].w); }
        const float rstd = 1.0f / sqrtf(wave_sum(s) * (1.f / DM) + RMS_EPS);
        float s2 = 0.f;
#pragma unroll
        for (int j = 0; j < 4; ++j) { v[j] = __builtin_nontemporal_load(xr + 64 * j) + v[j] * rstd * g1[64 * j + F.lane]; s2 += (v[j].x * v[j].x + v[j].y * v[j].y) + (v[j].z * v[j].z + v[j].w * v[j].w); }
        const float rstd2 = 1.0f / sqrtf(wave_sum(s2) * (1.f / DM) + RMS_EPS);
        u32x2* o8 = (u32x2*)(XN + (size_t)m * DM) + F.lane;
#pragma unroll
        for (int j = 0; j < 4; ++j) { const f32x4 gg = g2[64 * j + F.lane]; u32x2 w; w.x = pk2(v[j].x * rstd2 * gg.x, v[j].y * rstd2 * gg.y); w.y = pk2(v[j].z * rstd2 * gg.z, v[j].w * rstd2 * gg.w); o8[64 * j] = w; }
    }
}
__device__ __forceinline__ void rows_final(Frame& F) {
    const int gw = F.bid * NWAVES + F.wave, NGW = F.G * NWAVES;
    const f32x4* g0 = (const f32x4*)F.in[22]; const f32x4* g1 = (const f32x4*)F.in[28];
    const bf16_t* Fb = (const bf16_t*)(F.ws + WS_F);
    for (int m = gw; m < M; m += NGW) {
        f32x4* yr = (f32x4*)(F.out + (size_t)m * DM) + F.lane; const u32x2* fr = (const u32x2*)(Fb + (size_t)m * DM) + F.lane;
        const f32x4* xr = (const f32x4*)xrow_ptr(F, m) + F.lane; const u32x2* mb = (const u32x2*)((const bf16_t*)(F.ws + WS_MIX) + (size_t)m * DM) + F.lane;
        f32x4 v[4], x1[4]; float s = 0.f, sm = 0.f;
#pragma unroll
        for (int j = 0; j < 4; ++j) { const u32x2 w = __builtin_nontemporal_load(fr + 64 * j); v[j] = (f32x4){bflo(w.x), bfhi(w.x), bflo(w.y), bfhi(w.y)}; s += (v[j].x * v[j].x + v[j].y * v[j].y) + (v[j].z * v[j].z + v[j].w * v[j].w);
            const u32x2 q = __builtin_nontemporal_load(mb + 64 * j); x1[j] = (f32x4){bflo(q.x), bfhi(q.x), bflo(q.y), bfhi(q.y)}; sm += (x1[j].x * x1[j].x + x1[j].y * x1[j].y) + (x1[j].z * x1[j].z + x1[j].w * x1[j].w); }
        const float rstd = 1.0f / sqrtf(wave_sum(s) * (1.f / DM) + RMS_EPS), rstdm = 1.0f / sqrtf(wave_sum(sm) * (1.f / DM) + RMS_EPS);
#pragma unroll
        for (int j = 0; j < 4; ++j) __builtin_nontemporal_store((__builtin_nontemporal_load(xr + 64 * j) + x1[j] * rstdm * g0[64 * j + F.lane]) + v[j] * rstd * g1[64 * j + F.lane], yr + 64 * j);
    }
}
__device__ __forceinline__ void conv_phase(Frame& F, int half) {
    const bf16_t* ZU = (const bf16_t*)(F.ws + WS_ZU); bf16_t* HID = (bf16_t*)(F.ws + WS_HID);
    const float* cw = F.in[25]; const float* cb = F.in[26]; const float* sc = F.in[6];
    const long total = (long)M * 176;
    for (long e = (long)F.bid * NT + F.tid; e < total; e += (long)F.G * NT) {
        const int m = (int)(e / 176), r = (int)(e - (long)m * 176); const int tile = r >> 4, c8 = (r & 15) * 8;
        const int ch = (half * 11 + tile) * 128 + c8;
        const RowInfo ri = row_info(m);
        const bf16_t* zp = ZU + (size_t)m * DFF + tile * 256 + c8;
        const u32x4 z0 = *(const u32x4*)zp, uu = *(const u32x4*)(zp + 128);
        float z[8], z1[8], z2[8], u8[8];
        z[0] = bflo(z0.x); z[1] = bfhi(z0.x); z[2] = bflo(z0.y); z[3] = bfhi(z0.y); z[4] = bflo(z0.z); z[5] = bfhi(z0.z); z[6] = bflo(z0.w); z[7] = bfhi(z0.w);
        u8[0] = bflo(uu.x); u8[1] = bfhi(uu.x); u8[2] = bflo(uu.y); u8[3] = bfhi(uu.y); u8[4] = bflo(uu.z); u8[5] = bfhi(uu.z); u8[6] = bflo(uu.w); u8[7] = bfhi(uu.w);
        if (ri.t >= 1) { const u32x4 w = *(const u32x4*)(zp - DFF); z1[0] = bflo(w.x); z1[1] = bfhi(w.x); z1[2] = bflo(w.y); z1[3] = bfhi(w.y); z1[4] = bflo(w.z); z1[5] = bfhi(w.z); z1[6] = bflo(w.w); z1[7] = bfhi(w.w); }
        else {
#pragma unroll
            for (int j = 0; j < 8; ++j) z1[j] = ri.samp ? sc[((size_t)ri.b * 2 + 1) * DFF + ch + j] : 0.f; }
        if (ri.t >= 2) { const u32x4 w = *(const u32x4*)(zp - 2 * DFF); z2[0] = bflo(w.x); z2[1] = bfhi(w.x); z2[2] = bflo(w.y); z2[3] = bfhi(w.y); z2[4] = bflo(w.z); z2[5] = bfhi(w.z); z2[6] = bflo(w.w); z2[7] = bfhi(w.w); }
        else {
#pragma unroll
            for (int j = 0; j < 8; ++j) z2[j] = ri.samp ? sc[((size_t)ri.b * 2 + ri.t) * DFF + ch + j] : 0.f; }
        float hd[8];
#pragma unroll
        for (int j = 0; j < 8; ++j) { const float zc = cb[ch + j] + cw[ch + j] * z2[j] + cw[DFF + ch + j] * z1[j] + cw[2 * DFF + ch + j] * z[j]; hd[j] = zc * sigmoidf_(zc) * u8[j]; }
        u32x4 w; w.x = pk2(hd[0], hd[1]); w.y = pk2(hd[2], hd[3]); w.z = pk2(hd[4], hd[5]); w.w = pk2(hd[6], hd[7]);
        *(u32x4*)(HID + (size_t)m * DFF + ch) = w;
    }
}

constexpr int NPHASE = 10;
__global__ void __launch_bounds__(NT, 2) fwd_megakernel(Args args) {
    extern __shared__ __attribute__((aligned(16))) unsigned char lds_raw[];
    Frame F;
    F.lds = (LAS unsigned char*)lds_raw; F.ws = args.ws; F.out = args.out; F.in = args.in;
    F.tid = threadIdx.x; F.lane = F.tid & 63; F.wave = __builtin_amdgcn_readfirstlane(F.tid >> 6); F.G = gridDim.x; F.bid = blockIdx.x;
    const int lo = args.ph_lo, hi = args.ph_hi;
#ifndef PH_MASK
#define PH_MASK 0x3ff
#endif
#ifndef DUP_MASK
#define DUP_MASK 0
#endif
#define IN(k) (((PH_MASK >> (k)) & 1) && lo <= (k) && (k) < hi)
#define REP(k) for (int rep_ = 0; rep_ < 1 + ((DUP_MASK >> (k)) & 1); ++rep_)
    unsigned* barw = (unsigned*)F.ws;
    volatile LAS unsigned* bst = (volatile LAS unsigned*)(F.lds + LDS_BYTES - 64);
    if (F.tid < 2) bst[F.tid] = 0u;
    XcdBarrier xbar; xbar.bar = barw; xbar.x = 0; xbar.st = bst;
    bool posted = false;
    if (lo + 1 < hi && F.bid == 0) { for (int i = F.tid; i < XCD_BAR_WORDS; i += NT) barw[i] = 0u; }
#define SEAM(k) do { if (IN(k) && IN((k) + 1)) { if (!posted) { cg::this_grid().sync(); xbar = xcd_barrier_post(barw, bst); posted = true; } else xcd_barrier(xbar); } } while (0)
    bf16_t* XN = (bf16_t*)(F.ws + WS_XN);
    if (IN(0)) REP(0) { p0_prologue(F); } SEAM(0);
    if (IN(1)) REP(1) {
        pg8::Gemm g{XN, (const bf16_t*)(F.ws + WS_WIN), M, DINP, DM, DM, DM, 0}; pg8::StaticOrder S; S.init(M, DINP, F.G, F.bid);
        Epi1 E{(const float*)(F.ws + WS_ROPE), (bf16_t*)(F.ws + WS_Q), (bf16_t*)(F.ws + WS_K), (bf16_t*)(F.ws + WS_VT), (bf16_t*)(F.ws + WS_HRW), F.out};
        pg8::gemm_phase<Epi1, true>(F.lds, g, S, E);
    } SEAM(1);
    if (IN(2)) { if (F.bid & 1) sample_attn_phase(F); prep_phase(F); if (!(F.bid & 1)) sample_attn_phase(F); } SEAM(2);
    if (IN(3)) {
        for (int u = F.bid; u < NB * 64 * 2; u += F.G) prompt_attn_unit(F, u);
        sample_scan(F, F.bid, F.G);
        for (int sb = F.bid; sb < 256; sb += F.G) prompt_scan(F, sb);
    } SEAM(3);
    if (IN(4)) REP(4) { post_phase(F); } SEAM(4);
    if (IN(5)) REP(5) {
        pg8::Gemm g{(const bf16_t*)(F.ws + WS_OCAT), (const bf16_t*)(F.ws + WS_WOUT), M, DM, DM, DM, DM, 0}; pg8::StaticOrder S; S.init(M, DM, F.G, F.bid);
        EpiBf16 E{(bf16_t*)(F.ws + WS_MIX), DM};
        pg8::gemm_phase<EpiBf16, true>(F.lds, g, S, E);
    } SEAM(5);
    if (IN(6)) { rows_mid(F); } SEAM(6);
    if (IN(7)) REP(7) {
        pg8::Gemm g{XN, (const bf16_t*)(F.ws + WS_WFI), 136 * 256, 2 * DFF, DM, DM, DM, 1}; pg8::StaticOrder S; S.init(136 * 256, 2 * DFF, F.G, F.bid);
        EpiConv E{(bf16_t*)(F.ws + WS_HID), F.out, F.in[25], F.in[26], F.in[6], (LAS float*)(F.lds + 131072)};
        pg8::gemm_phase<EpiConv, true>(F.lds, g, S, E);
    } SEAM(7);
    if (IN(8)) REP(11) {
        pg8::Gemm g{(const bf16_t*)(F.ws + WS_HID), (const bf16_t*)(F.ws + WS_WFO), M, DM, DFF, DFF, DFF, 0}; pg8::StaticOrder S; S.init(M, DM, F.G, F.bid);
        EpiBf16 E{(bf16_t*)(F.ws + WS_F), DM};
        pg8::gemm_phase<EpiBf16, true>(F.lds, g, S, E);
    } SEAM(8);
    if (IN(9)) { rows_final(F); }
#undef IN
#undef SEAM
}

extern "C" void kernel_launch(void* const* d_in, const int* in_sizes, int n_in, void* d_out, int out_size, void* d_ws, size_t ws_size, hipStream_t stream) {
    static int grid = 0;
    if (grid == 0) {
        if (n_in != 29 || ws_size < WS_END) { fprintf(stderr, "kernel_launch: unexpected n_in %d / ws_size %zu\n", n_in, ws_size); grid = -1; return; }
        int dev = 0, cus = 0, per_cu = 0;
        hipGetDevice(&dev); hipDeviceGetAttribute(&cus, hipDeviceAttributeMultiprocessorCount, dev);
        if (hipFuncSetAttribute((const void*)fwd_megakernel, hipFuncAttributeMaxDynamicSharedMemorySize, LDS_BYTES) != hipSuccess) { fprintf(stderr, "kernel_launch: hipFuncSetAttribute failed\n"); grid = -1; return; }
        if (hipOccupancyMaxActiveBlocksPerMultiprocessor(&per_cu, (const void*)fwd_megakernel, NT, LDS_BYTES) != hipSuccess || per_cu < 1) { fprintf(stderr, "kernel_launch: occupancy query failed (%d)\n", per_cu); (void)hipGetLastError(); per_cu = 1; }
        grid = cus * (per_cu > 1 ? 1 : per_cu);
        fprintf(stderr, "kernel_launch: grid %d (cus %d, per_cu %d), ws %zu\n", grid, cus, per_cu, ws_size);
    }
    if (grid < 0) return;
    Args a{};
    for (int i = 0; i < 29; ++i) a.in[i] = (const float*)d_in[i];
    a.out = (float*)d_out; a.ws = (unsigned char*)d_ws;
#if MK_PER_PHASE
    for (int p = 0; p < NPHASE; ++p) { a.ph_lo = p; a.ph_hi = p + 1; hipLaunchKernelGGL(fwd_megakernel, dim3(grid), dim3(NT), LDS_BYTES, stream, a); }
#else
    a.ph_lo = 0; a.ph_hi = NPHASE;
    void* kargs[] = {&a};
    hipError_t e = hipLaunchCooperativeKernel((const void*)fwd_megakernel, dim3(grid), dim3(NT), kargs, LDS_BYTES, stream);
    if (e != hipSuccess) fprintf(stderr, "cooperative launch failed: %s (grid %d)\n", hipGetErrorString(e), grid);
#endif
}
```

```cpp
#include <hip/hip_runtime.h>
#include <hip/hip_cooperative_groups.h>
#include <cstdio>
#include <cstdint>
#include <utility>
namespace cg = cooperative_groups;

#ifndef MK_PER_PHASE
#define MK_PER_PHASE 0
#endif

#define LAS __attribute__((address_space(3)))
typedef unsigned short bf16_t;
typedef short bf16x8 __attribute__((ext_vector_type(8)));
typedef float f32x4 __attribute__((ext_vector_type(4)));
typedef float f32x2 __attribute__((ext_vector_type(2)));
typedef unsigned u32x4 __attribute__((ext_vector_type(4)));
typedef unsigned u32x2 __attribute__((ext_vector_type(2)));

constexpr int DM = 1024, NB = 4, T = 8192, MP = NB * T, DB = 128, DT = 8, MS = DB * DT, M = MP + MS;
constexpr int WIN = 128, DSH = 1696, DINP = 2560, DFF = 2816, DFFH = 1408;
constexpr float RMS_EPS = 1e-6f, GN_EPS = 64e-5f;
constexpr float QSCALE = 0.125f * 1.4426950408889634f;
constexpr size_t O_Y = 0, O_KWP = 34603008, O_VWP = 34668544, O_SHP = 34734080, O_WKVP = 34740864, O_CVP = 34871936,
                 O_KWS = 34894464, O_VWS = 36991616, O_SHS = 39088768, O_WKVS = 39305856, O_CVS = 43500160;
constexpr size_t MiB = 1u << 20;
constexpr size_t WS_WIN = 1 * MiB, WS_WOUT = 6 * MiB, WS_WFI = 8 * MiB, WS_WFO = 19 * MiB, WS_ROPE = 25 * MiB;
constexpr size_t WS_XN = 32 * MiB;
constexpr size_t WS_SR = 32 * MiB, WS_SK = 65 * MiB;
constexpr size_t WS_Q = 98 * MiB, WS_K = 131 * MiB, WS_VT = 140 * MiB;
constexpr size_t WS_HRW = 150 * MiB;
constexpr size_t WS_OCAT = 260 * MiB;
constexpr size_t WS_SW = 326 * MiB;
constexpr size_t WS_SV = 392 * MiB, WS_SKK = 425 * MiB, WS_SB = 458 * MiB;
constexpr size_t WS_ZU = 100 * MiB;
constexpr size_t WS_HID = 282 * MiB;
constexpr size_t WS_F = 216 * MiB;
constexpr size_t WS_MIX = 150 * MiB;
constexpr size_t WS_END = 491 * MiB;

__device__ __forceinline__ unsigned f2bf(float f) { unsigned u = __float_as_uint(f); return (u + 0x7fffu + ((u >> 16) & 1u)) >> 16; }

__device__ __forceinline__ float bf2f(unsigned short h) { return __uint_as_float(((unsigned)h) << 16); }
__device__ __forceinline__ float bflo(unsigned w) { return __uint_as_float(w << 16); }
__device__ __forceinline__ float bfhi(unsigned w) { return __uint_as_float(w & 0xffff0000u); }
__device__ __forceinline__ unsigned cvt_pk_bf16(float lo, float hi) { unsigned r; asm volatile("v_cvt_pk_bf16_f32 %0, %1, %2" : "=v"(r) : "v"(lo), "v"(hi)); return r; }
__device__ __forceinline__ unsigned pk2(float lo, float hi) { return cvt_pk_bf16(lo, hi); }
template <int CTRL> __device__ __forceinline__ float dppf(float x) { return __int_as_float(__builtin_amdgcn_update_dpp(0, __float_as_int(x), CTRL, 0xF, 0xF, false)); }
__device__ __forceinline__ float allsum16(float x) {
    x += dppf<0xB1>(x); x += dppf<0x4E>(x); x += dppf<0x141>(x); x += dppf<0x140>(x); return x;
}
__device__ __forceinline__ void allsum16_2(float& a, float& b) {
    a += dppf<0xB1>(a); b += dppf<0xB1>(b); a += dppf<0x4E>(a); b += dppf<0x4E>(b); a += dppf<0x141>(a); b += dppf<0x141>(b); a += dppf<0x140>(a); b += dppf<0x140>(b);
}
__device__ __forceinline__ float wave_sum(float v) {
    v = allsum16(v);
    { auto r = __builtin_amdgcn_permlane16_swap(__float_as_uint(v), __float_as_uint(v), false, false); v = __uint_as_float(r[0]) + __uint_as_float(r[1]); }
    { auto r = __builtin_amdgcn_permlane32_swap(__float_as_uint(v), __float_as_uint(v), false, false); v = __uint_as_float(r[0]) + __uint_as_float(r[1]); }
    return v;
}
__device__ __forceinline__ float sigmoidf_(float x) { return __builtin_amdgcn_rcpf(1.0f + __expf(-x)); }

namespace pg8 {
constexpr int BM = 256, BK = 64, HALF = 128, HTB = HALF * BK * 2, STAGE_BYTES = 8 * HTB, NXCD = 8, WGM = 8;
__host__ __device__ __forceinline__ int lds_byte(int r, int c) { const int st = (r >> 4) * 2 + (c >> 5), rr = r & 15, cc = c & 31, ob = rr * 64 + cc * 2; return st * 1024 + (ob ^ (((ob >> 9) & 1) << 5)); }
__host__ __device__ __forceinline__ void stage_rc(int b, int& R, int& C) { const int st = b / 1024, sb = b % 1024, swz = sb ^ (((sb >> 9) & 1) << 5); R = (st >> 1) * 16 + swz / 64; C = (st & 1) * 32 + (swz % 64) / 2; }
__host__ __device__ __forceinline__ int perm32(int rho) { const int n = rho >> 4, i = rho & 15; return 8 * (i >> 2) + 4 * n + (i & 3); }
struct Unit { int pm, pn; };
struct Gemm { const bf16_t* A; const bf16_t* Bt; int M, N, K, lda, ldb, conv; };
__device__ __forceinline__ long arow(const Gemm& g, int pm) {
    if (!g.conv) return (long)pm * 256;
    if (pm < 132) { const int b = pm / 33; return (long)b * 8192 + 254 * (pm - 33 * b) - 2; }
    return 32768 + (long)(pm - 132) * 256;
}
struct StaticOrder {
    int nM, nN, nwg, G, c;
    __device__ void init(int M_, int N_, int G_, int c_) { nM = M_ / BM; nN = N_ / BM; nwg = nM * nN; G = G_; c = c_; }
    __device__ bool next(int i, Unit& u) const {
        const long L = (long)i * G + c; if (L >= nwg) return false;
        int wgid = (int)L; { const int q = nwg / NXCD, r = nwg % NXCD, xcd = wgid % NXCD, off = wgid / NXCD; wgid = (xcd < r ? xcd * (q + 1) : r * (q + 1) + (xcd - r) * q) + off; }
        const int nig = WGM * nN, gid = wgid / nig, fm = gid * WGM, gsz = (nM - fm) < WGM ? (nM - fm) : WGM;
        u.pm = fm + ((wgid % nig) % gsz); u.pn = (wgid % nig) / gsz; return true;
    }
};
template <class Epi, bool ALIGN_EPI>
__device__ __forceinline__ void gemm_phase(LAS unsigned char* lds, const Gemm g, const StaticOrder& S, const Epi& E) {
    const int tid = threadIdx.x, wid = __builtin_amdgcn_readfirstlane(tid >> 6), lane = tid & 63, wr = wid >> 2, wc = wid & 3, fr = lane & 15, fq = lane >> 4;
    const int nt = g.K / BK;
    unsigned voffA[2], voffB[2];
#pragma unroll
    for (int i = 0; i < 2; ++i) { int R, C; stage_rc(tid * 16 + i * 8192, R, C); const int Rb = (R & ~31) + perm32(R & 31);
        voffA[i] = (unsigned)(R * g.lda + C) * 2u; voffB[i] = (unsigned)(Rb * g.ldb + C) * 2u; }
    const size_t kstep = (size_t)(BK * 2);
    const size_t hstepA = (size_t)HALF * g.lda * 2, hstepB = (size_t)HALF * g.ldb * 2;
    const size_t rowA = (size_t)g.lda * 2, tstepB = 2 * hstepB;
    const unsigned ldsw = (unsigned)wid * 1024u;
    const int aoff = lds_byte(wr * 64 + fr, fq * 8), boff = lds_byte(wc * 32 + fr, fq * 8);
#define PG8_SA(b, h) (((b) * 2 + (h)) * HTB)
#define PG8_SB(b, h) ((4 + (b) * 2 + (h)) * HTB)
#define PG8_STAGE(bufoff, gbase, voff) do { _Pragma("unroll") for (int _i = 0; _i < 2; ++_i) \
        __builtin_amdgcn_global_load_lds((const unsigned*)((const char*)(gbase) + (voff)[_i]), (LAS unsigned*)(lds + (bufoff) + ldsw + _i * 8192), 16, 0, 0); } while (0)
#define PG8_LDA(dst, b, h) do { _Pragma("unroll") for (int m = 0; m < 4; ++m) _Pragma("unroll") for (int k = 0; k < 2; ++k) dst[m][k] = *(const LAS bf16x8*)(lds + PG8_SA(b, h) + aoff + m * 2048 + k * 1024); } while (0)
#define PG8_LDB(dst, b, h) do { _Pragma("unroll") for (int n = 0; n < 2; ++n) _Pragma("unroll") for (int k = 0; k < 2; ++k) dst[n][k] = *(const LAS bf16x8*)(lds + PG8_SB(b, h) + boff + n * 2048 + k * 1024); } while (0)
#define PG8_MMA(ai, bj, At, Bt) do { __builtin_amdgcn_s_setprio(1); _Pragma("unroll") for (int m = 0; m < 4; ++m) _Pragma("unroll") for (int n = 0; n < 2; ++n) _Pragma("unroll") for (int k = 0; k < 2; ++k) \
        acc[ai][bj][m][n] = __builtin_amdgcn_mfma_f32_16x16x32_bf16(Bt[n][k], At[m][k], acc[ai][bj][m][n], 0, 0, 0); __builtin_amdgcn_s_setprio(0); } while (0)
#define PG8_WAIT_V(n) asm volatile("s_waitcnt vmcnt(" #n ")" ::: "memory")
#define PG8_WAIT_L(n) asm volatile("s_waitcnt lgkmcnt(" #n ")" ::: "memory")
#define PG8_BAR __builtin_amdgcn_s_barrier()
#define PG8_SCHED __builtin_amdgcn_sched_barrier(0)
    Unit cur, nxt; int ui = 0;
    if (!S.next(0, cur)) return;
    f32x4 acc[2][2][4][2];
#pragma unroll
    for (int a = 0; a < 2; ++a)
#pragma unroll
        for (int b = 0; b < 2; ++b)
#pragma unroll
            for (int m = 0; m < 4; ++m)
#pragma unroll
                for (int n = 0; n < 2; ++n) acc[a][b][m][n] = (f32x4){0.f, 0.f, 0.f, 0.f};
    bf16x8 At[4][2], B0[2][2], B1[2][2];
    const char* cA = (const char*)g.A + arow(g, cur.pm) * (long)rowA; const char* cB = (const char*)g.Bt + (size_t)cur.pn * tstepB;
    PG8_STAGE(PG8_SB(0, 0), cB, voffB); PG8_STAGE(PG8_SB(0, 1), cB + hstepB, voffB); PG8_STAGE(PG8_SA(0, 0), cA, voffA); PG8_STAGE(PG8_SA(0, 1), cA + hstepA, voffA);
    if (wr == 1) PG8_BAR;
    PG8_WAIT_V(2); PG8_BAR;
    PG8_STAGE(PG8_SB(1, 0), cB + kstep, voffB); PG8_STAGE(PG8_SA(1, 0), cA + kstep, voffA); PG8_STAGE(PG8_SB(1, 1), cB + hstepB + kstep, voffB);
    PG8_WAIT_V(6); PG8_BAR;
    for (;;) {
        const bool has_next = S.next(ui + 1, nxt);
        const char* nA = has_next ? (const char*)g.A + arow(g, nxt.pm) * (long)rowA : cA; const char* nB = has_next ? (const char*)g.Bt + (size_t)nxt.pn * tstepB : cB;
        for (int t = 0; t < nt; t += 2) {
            const bool last = (t == nt - 2);
            const char* a1 = cA + (size_t)(t + 1) * kstep;
            const char* a2 = last ? nA : cA + (size_t)(t + 2) * kstep; const char* b2 = last ? nB : cB + (size_t)(t + 2) * kstep;
            const char* a3 = a2 + kstep; const char* b3 = b2 + kstep;
            PG8_LDB(B0, 0, 0); PG8_LDB(B1, 0, 1); PG8_SCHED; PG8_LDA(At, 0, 0); PG8_STAGE(PG8_SA(1, 1), a1 + hstepA, voffA);
            PG8_WAIT_V(8); PG8_WAIT_L(0); PG8_BAR; PG8_MMA(0, 0, At, B0); PG8_MMA(0, 1, At, B1); PG8_BAR; PG8_SCHED;
            PG8_LDA(At, 0, 1); PG8_STAGE(PG8_SB(0, 0), b2, voffB); PG8_STAGE(PG8_SB(0, 1), b2 + hstepB, voffB); PG8_STAGE(PG8_SA(0, 0), a2, voffA);
            PG8_WAIT_V(8); PG8_WAIT_L(0); PG8_BAR; PG8_MMA(1, 0, At, B0); PG8_MMA(1, 1, At, B1); PG8_BAR; PG8_SCHED;
            PG8_LDB(B0, 1, 0); PG8_LDB(B1, 1, 1); PG8_SCHED; PG8_LDA(At, 1, 0); PG8_STAGE(PG8_SA(0, 1), a2 + hstepA, voffA);
            PG8_WAIT_V(8); PG8_WAIT_L(0); PG8_BAR; PG8_MMA(0, 0, At, B0); PG8_MMA(0, 1, At, B1); PG8_BAR; PG8_SCHED;
            PG8_LDA(At, 1, 1); PG8_STAGE(PG8_SB(1, 0), b3, voffB); PG8_STAGE(PG8_SB(1, 1), b3 + hstepB, voffB); PG8_STAGE(PG8_SA(1, 0), a3, voffA);
            PG8_WAIT_V(8); PG8_WAIT_L(0); PG8_BAR; PG8_MMA(1, 0, At, B0); PG8_MMA(1, 1, At, B1); PG8_BAR; PG8_SCHED;
        }
        if constexpr (ALIGN_EPI) { if (wr == 0) PG8_BAR; }
        asm volatile("s_nop 7\n\ts_nop 7" ::: "memory");
        E(acc, cur, wr, wc, fr, fq);
        if (!has_next) break;
#pragma unroll
        for (int a = 0; a < 2; ++a)
#pragma unroll
            for (int b = 0; b < 2; ++b)
#pragma unroll
                for (int m = 0; m < 4; ++m)
#pragma unroll
                    for (int n = 0; n < 2; ++n) acc[a][b][m][n] = (f32x4){0.f, 0.f, 0.f, 0.f};
        cur = nxt; cA = nA; cB = nB; ++ui;
        if constexpr (ALIGN_EPI) { if (wr == 1) PG8_BAR; }
    }
    PG8_WAIT_V(0);
    if constexpr (!ALIGN_EPI) { if (wr == 0) PG8_BAR; }
    PG8_BAR;
#undef PG8_SA
#undef PG8_SB
#undef PG8_STAGE
#undef PG8_LDA
#undef PG8_LDB
#undef PG8_MMA
#undef PG8_WAIT_V
#undef PG8_WAIT_L
#undef PG8_BAR
#undef PG8_SCHED
}
}

struct RowInfo { int b, t, samp; };
__device__ __forceinline__ RowInfo row_info(int row) { RowInfo r; if (row < MP) { r.samp = 0; r.b = row >> 13; r.t = row & (T - 1); } else { const int rs = row - MP; r.samp = 1; r.b = rs >> 3; r.t = rs & 7; } return r; }

struct Epi1 {
    const float* rope; bf16_t* Q; bf16_t* Kb; bf16_t* VT; bf16_t* HRW; float* out;
    __device__ __forceinline__ void operator()(const f32x4 (&acc)[2][2][4][2], const pg8::Unit& u, int wr, int wc, int fr, int fq) const {
#pragma unroll
        for (int ai = 0; ai < 2; ++ai)
#pragma unroll
            for (int m = 0; m < 4; ++m) {
                const int row = u.pm * 256 + ai * 128 + wr * 64 + m * 16 + fr;
                const RowInfo ri = row_info(row);
                const int pidx = ri.samp ? (T + ri.t) : ri.t;
#pragma unroll
                for (int bj = 0; bj < 2; ++bj) {
                    const int cb = u.pn * 256 + bj * 128;
                    const int c0 = cb + wc * 32 + fq * 8;
                    const f32x4 v0 = acc[ai][bj][m][0], v1 = acc[ai][bj][m][1];
                    if (cb < 640) {
                        const int d0 = ((c0 & 63) >> 3) * 4;
                        const f32x4* rp = (const f32x4*)(rope + ((size_t)pidx * 32 + d0) * 2);
                        const f32x4 cs0 = rp[0], cs1 = rp[1];
                        f32x4 o1, o2;
                        o1[0] = v0[0] * cs0[0] - v1[0] * cs0[1]; o2[0] = v1[0] * cs0[0] + v0[0] * cs0[1];
                        o1[1] = v0[1] * cs0[2] - v1[1] * cs0[3]; o2[1] = v1[1] * cs0[2] + v0[1] * cs0[3];
                        o1[2] = v0[2] * cs1[0] - v1[2] * cs1[1]; o2[2] = v1[2] * cs1[0] + v0[2] * cs1[1];
                        o1[3] = v0[3] * cs1[2] - v1[3] * cs1[3]; o2[3] = v1[3] * cs1[2] + v0[3] * cs1[3];
                        if (cb < 512) {
                            o1 = o1 * QSCALE; o2 = o2 * QSCALE;
                            bf16_t* qp = Q + (size_t)row * 512 + (c0 & ~63) + d0;
                            u32x2 w1, w2; w1.x = cvt_pk_bf16(o1[0], o1[1]); w1.y = cvt_pk_bf16(o1[2], o1[3]); w2.x = cvt_pk_bf16(o2[0], o2[1]); w2.y = cvt_pk_bf16(o2[2], o2[3]);
                            *(u32x2*)qp = w1; *(u32x2*)(qp + 32) = w2;
                        } else {
                            const int kvh = (c0 - 512) >> 6;
                            bf16_t* kp = Kb + (size_t)row * 128 + kvh * 64 + d0;
                            u32x2 w1, w2; w1.x = cvt_pk_bf16(o1[0], o1[1]); w1.y = cvt_pk_bf16(o1[2], o1[3]); w2.x = cvt_pk_bf16(o2[0], o2[1]); w2.y = cvt_pk_bf16(o2[2], o2[3]);
                            *(u32x2*)kp = w1; *(u32x2*)(kp + 32) = w2;
                            if (!ri.samp) { if (ri.t >= T - WIN) { float* o = out + O_KWP + ((size_t)(ri.b * WIN + (ri.t - (T - WIN))) * 2 + kvh) * 64 + d0; *(f32x4*)o = o1; *(f32x4*)(o + 32) = o2; } }
                            else { float* o = out + O_KWS + ((size_t)(ri.b * WIN + (WIN - DT) + ri.t) * 2 + kvh) * 64 + d0; *(f32x4*)o = o1; *(f32x4*)(o + 32) = o2; }
                        }
                    } else if (cb < 768) {
                        const int kvh = (c0 - 640) >> 6, d0 = (c0 - 640) & 63;
                        if (!ri.samp) {
                            bf16_t* vp = VT + ((size_t)(ri.b * 2 + kvh) * 64 + d0) * T + ri.t;
                            vp[0] = (bf16_t)f2bf(v0[0]); vp[(size_t)T] = (bf16_t)f2bf(v0[1]); vp[(size_t)2 * T] = (bf16_t)f2bf(v0[2]); vp[(size_t)3 * T] = (bf16_t)f2bf(v0[3]);
                            vp[(size_t)4 * T] = (bf16_t)f2bf(v1[0]); vp[(size_t)5 * T] = (bf16_t)f2bf(v1[1]); vp[(size_t)6 * T] = (bf16_t)f2bf(v1[2]); vp[(size_t)7 * T] = (bf16_t)f2bf(v1[3]);
                            if (ri.t >= T - WIN) { float* o = out + O_VWP + ((size_t)(ri.b * WIN + (ri.t - (T - WIN))) * 2 + kvh) * 64 + d0; *(f32x4*)o = v0; *(f32x4*)(o + 4) = v1; }
                        } else { float* o = out + O_VWS + ((size_t)(ri.b * WIN + (WIN - DT) + ri.t) * 2 + kvh) * 64 + d0; *(f32x4*)o = v0; *(f32x4*)(o + 4) = v1; }
                    } else if (c0 < 2464) {
                        const int col = c0 - 768;
                        u32x4 w; w.x = cvt_pk_bf16(v0[0], v0[1]); w.y = cvt_pk_bf16(v0[2], v0[3]); w.z = cvt_pk_bf16(v1[0], v1[1]); w.w = cvt_pk_bf16(v1[2], v1[3]);
                        *(u32x4*)(HRW + (size_t)row * DSH + col) = w;
                        if (!ri.samp) { if (ri.t == T - 1) { float* o = out + O_SHP + (size_t)ri.b * DSH + col; *(f32x4*)o = v0; *(f32x4*)(o + 4) = v1; } }
                        else if (ri.t == DT - 1) { float* o = out + O_SHS + (size_t)ri.b * DSH + col; *(f32x4*)o = v0; *(f32x4*)(o + 4) = v1; }
                    }
                }
            }
    }
};
struct EpiF32 {
    float* O; int ldc;
    __device__ __forceinline__ void operator()(const f32x4 (&acc)[2][2][4][2], const pg8::Unit& u, int wr, int wc, int fr, int fq) const {
#pragma unroll
        for (int ai = 0; ai < 2; ++ai)
#pragma unroll
            for (int m = 0; m < 4; ++m) {
                float* rowp = O + (size_t)(u.pm * 256 + ai * 128 + wr * 64 + m * 16 + fr) * ldc + u.pn * 256 + wc * 32 + fq * 8;
#pragma unroll
                for (int bj = 0; bj < 2; ++bj) { *(f32x4*)(rowp + bj * 128) = acc[ai][bj][m][0]; *(f32x4*)(rowp + bj * 128 + 4) = acc[ai][bj][m][1]; }
            }
    }
};
struct EpiBf16 {
    bf16_t* O; int ldc;
    __device__ __forceinline__ void operator()(const f32x4 (&acc)[2][2][4][2], const pg8::Unit& u, int wr, int wc, int fr, int fq) const {
#pragma unroll
        for (int ai = 0; ai < 2; ++ai)
#pragma unroll
            for (int m = 0; m < 4; ++m) {
                bf16_t* rowp = O + (size_t)(u.pm * 256 + ai * 128 + wr * 64 + m * 16 + fr) * ldc + u.pn * 256 + wc * 32 + fq * 8;
#pragma unroll
                for (int bj = 0; bj < 2; ++bj) { const f32x4 v0 = acc[ai][bj][m][0], v1 = acc[ai][bj][m][1];
                    u32x4 w; w.x = cvt_pk_bf16(v0[0], v0[1]); w.y = cvt_pk_bf16(v0[2], v0[3]); w.z = cvt_pk_bf16(v1[0], v1[1]); w.w = cvt_pk_bf16(v1[2], v1[3]);
                    *(u32x4*)(rowp + bj * 128) = w; }
            }
    }
};
template <int CTRL> __device__ __forceinline__ float dpp_old(float old, float src) { return __int_as_float(__builtin_amdgcn_update_dpp(__float_as_int(old), __float_as_int(src), CTRL, 0xF, 0xF, false)); }
struct EpiConv {
    bf16_t* HID; float* out; const float* cw; const float* cb; const float* sc; LAS float* exch;
    __device__ __forceinline__ void operator()(const f32x4 (&acc)[2][2][4][2], const pg8::Unit& u, int wr, int wc, int fr, int fq) const {
        const int cw8 = wc * 32 + fq * 8, ch0 = u.pn * 128 + cw8;
        if (fr >= 14) {
#pragma unroll
            for (int ai = 0; ai < 2; ++ai)
#pragma unroll
                for (int n = 0; n < 2; ++n) *(LAS f32x4*)(exch + ((ai * 2 + wr) * 2 + (fr - 14)) * 128 + cw8 + 4 * n) = acc[ai][0][3][n];
        }
        asm volatile("s_waitcnt lgkmcnt(0)\n\ts_barrier" ::: "memory");
        int row0, b0 = 0, i0 = 0; const bool samp = u.pm >= 132;
        if (!samp) { b0 = u.pm / 33; i0 = u.pm - 33 * b0; row0 = b0 * T + 254 * i0 - 2; } else row0 = MP + (u.pm - 132) * 256;
        f32x4 w0[2], w1[2], w2[2], bb[2];
#pragma unroll
        for (int n = 0; n < 2; ++n) { w0[n] = *(const f32x4*)(cw + ch0 + 4 * n); w1[n] = *(const f32x4*)(cw + DFF + ch0 + 4 * n); w2[n] = *(const f32x4*)(cw + 2 * DFF + ch0 + 4 * n); bb[n] = *(const f32x4*)(cb + ch0 + 4 * n); }
#pragma unroll
        for (int ai = 0; ai < 2; ++ai) {
            const int strip = ai * 2 + wr;
            f32x4 h1[2], h2[2];
#pragma unroll
            for (int n = 0; n < 2; ++n) {
                if (strip > 0) { h1[n] = *(const LAS f32x4*)(exch + ((strip - 1) * 2 + 1) * 128 + cw8 + 4 * n); h2[n] = *(const LAS f32x4*)(exch + ((strip - 1) * 2) * 128 + cw8 + 4 * n); }
                else { h1[n] = (f32x4){0.f, 0.f, 0.f, 0.f}; h2[n] = (f32x4){0.f, 0.f, 0.f, 0.f}; }
            }
#pragma unroll
            for (int m = 0; m < 4; ++m) {
                const int lr = ai * 128 + wr * 64 + m * 16 + fr;
                int t, b; bool valid;
                if (!samp) { t = 254 * i0 + lr - 2; b = b0; valid = lr >= 2 && t < T; } else { const int rs = row0 - MP + lr; b = rs >> 3; t = rs & 7; valid = true; }
                const size_t R = (size_t)((long)row0 + lr);
                f32x4 hd[2];
#pragma unroll
                for (int n = 0; n < 2; ++n) {
                    const f32x4 z = acc[ai][0][m][n], uu = acc[ai][1][m][n];
                    f32x4 o1, o2, zm1, zm2;
                    if (m == 0) { o1 = h1[n]; o2 = (fr == 0) ? h2[n] : h1[n]; }
                    else {
#pragma unroll
                        for (int e = 0; e < 4; ++e) { o1[e] = dppf<0x121>(acc[ai][0][m > 0 ? m - 1 : 0][n][e]); o2[e] = dppf<0x122>(acc[ai][0][m > 0 ? m - 1 : 0][n][e]); }
                    }
#pragma unroll
                    for (int e = 0; e < 4; ++e) { zm1[e] = dpp_old<0x111>(o1[e], z[e]); zm2[e] = dpp_old<0x112>(o2[e], z[e]); }
                    if (t == 0) {
                        if (samp) { zm1 = *(const f32x4*)(sc + ((size_t)b * 2 + 1) * DFF + ch0 + 4 * n); zm2 = *(const f32x4*)(sc + ((size_t)b * 2) * DFF + ch0 + 4 * n); }
                        else { zm1 = (f32x4){0.f, 0.f, 0.f, 0.f}; zm2 = (f32x4){0.f, 0.f, 0.f, 0.f}; }
                    } else if (t == 1) {
                        if (samp) zm2 = *(const f32x4*)(sc + ((size_t)b * 2 + 1) * DFF + ch0 + 4 * n); else zm2 = (f32x4){0.f, 0.f, 0.f, 0.f};
                    }
                    const f32x4 zc = bb[n] + w0[n] * zm2 + w1[n] * zm1 + w2[n] * z;
#pragma unroll
                    for (int e = 0; e < 4; ++e) hd[n][e] = zc[e] * sigmoidf_(zc[e]) * uu[e];
                }
                if (valid) {
                    u32x4 w; w.x = cvt_pk_bf16(hd[0][0], hd[0][1]); w.y = cvt_pk_bf16(hd[0][2], hd[0][3]); w.z = cvt_pk_bf16(hd[1][0], hd[1][1]); w.w = cvt_pk_bf16(hd[1][2], hd[1][3]);
                    *(u32x4*)(HID + R * DFF + ch0) = w;
                    if (!samp) { if (t >= T - 2) { float* o = out + O_CVP + (size_t)(b * 2 + (t - (T - 2))) * DFF + ch0; *(f32x4*)o = acc[ai][0][m][0]; *(f32x4*)(o + 4) = acc[ai][0][m][1]; } }
                    else if (t >= DT - 2) { float* o = out + O_CVS + (size_t)(b * 2 + (t - (DT - 2))) * DFF + ch0; *(f32x4*)o = acc[ai][0][m][0]; *(f32x4*)(o + 4) = acc[ai][0][m][1]; }
                }
            }
        }
    }
};

#define XB_TMO      128
#define XB_XCNT(j)  (256  + 64 * (j))
#define XB_XSUB(j)  (1280 + 64 * (j))
#define XB_XGEN(j)  (2304 + 64 * (j))
#define XB_TOP      3328
#define XB_TOPGEN   3392
#define XCD_BAR_WORDS 3456
#define XB_SPIN_CAP (1u << 20)
__device__ __forceinline__ unsigned xb_ld(unsigned* p)              { return __hip_atomic_load(p, __ATOMIC_RELAXED, __HIP_MEMORY_SCOPE_AGENT); }
__device__ __forceinline__ unsigned xb_add(unsigned* p, unsigned v) { return __hip_atomic_fetch_add(p, v, __ATOMIC_RELAXED, __HIP_MEMORY_SCOPE_AGENT); }
__device__ __forceinline__ unsigned xb_xcc_id() { return (unsigned)__builtin_amdgcn_s_getreg((3 << 11) | 20) & 0xFu; }
#define XB_SPIN(cond, bar) do { unsigned _sp = 0; while (cond) { __builtin_amdgcn_s_sleep(1); \
    if ((++_sp & 255u) == 0u) { if (xb_ld(&(bar)[XB_TMO])) break; if (_sp > XB_SPIN_CAP) { atomicAdd(&(bar)[XB_TMO], 1u); break; } } } } while (0)
struct XcdBarrier { unsigned* bar; unsigned x; volatile LAS unsigned* st; };
__device__ __forceinline__ XcdBarrier xcd_barrier_post(unsigned* bar, volatile LAS unsigned* st) {
    XcdBarrier b; b.bar = bar; b.x = xb_xcc_id(); b.st = st;
    if (threadIdx.x == 0) (void)xb_add(&bar[XB_XCNT(b.x)], 1u);
    return b;
}
__device__ __forceinline__ void xcd_barrier_complete(unsigned* bar, unsigned x, unsigned& nloc, unsigned& nx) {
    const unsigned G = gridDim.x * gridDim.y * gridDim.z;
    unsigned sum, cnt, mine, sp = 0u;
    for (;;) {
        sum = 0u; cnt = 0u; mine = 0u;
#pragma unroll
        for (unsigned j = 0; j < 16; ++j) { const unsigned c = xb_ld(&bar[XB_XCNT(j)]); sum += c; cnt += (c > 0u) ? 1u : 0u; mine = (j == x) ? c : mine; }
        if (sum == G) break;
        __builtin_amdgcn_s_sleep(1);
        if ((++sp & 255u) == 0u) { if (xb_ld(&bar[XB_TMO])) break; if (sp > XB_SPIN_CAP) { atomicAdd(&bar[XB_TMO], 1u); break; } }
    }
    nloc = mine > 0u ? mine : 1u; nx = cnt > 0u ? cnt : 1u;
}
__device__ __forceinline__ void xcd_barrier(const XcdBarrier& b) {
    asm volatile("s_waitcnt vmcnt(0)" ::: "memory");
    __syncthreads();
    if (threadIdx.x == 0) {
        unsigned* bar = b.bar;
        __builtin_amdgcn_s_waitcnt(0);
        unsigned nloc = b.st[0], nx = b.st[1];
        if (nloc == 0u) { xcd_barrier_complete(bar, b.x, nloc, nx); b.st[0] = nloc; b.st[1] = nx; }
        const unsigned old = xb_add(&bar[XB_XSUB(b.x)], 1u);
        const unsigned gen = old / nloc;
        if (old + 1u == (gen + 1u) * nloc) {
            __builtin_amdgcn_fence(__ATOMIC_RELEASE, "agent");
            asm volatile("s_waitcnt vmcnt(0)" ::: "memory");
            const unsigned og = xb_add(&bar[XB_TOP], 1u);
            const unsigned tg = og / nx;
            if (og + 1u == (tg + 1u) * nx) xb_add(&bar[XB_TOPGEN], 1u);
            else XB_SPIN(xb_ld(&bar[XB_TOPGEN]) == tg, bar);
            __builtin_amdgcn_fence(__ATOMIC_ACQUIRE, "agent");
            xb_add(&bar[XB_XGEN(b.x)], 1u);
            asm volatile("s_waitcnt vmcnt(0)" ::: "memory");
        } else {
            XB_SPIN(xb_ld(&bar[XB_XGEN(b.x)]) == gen, bar);
            __builtin_amdgcn_fence(__ATOMIC_ACQUIRE, "agent");
            asm volatile("s_waitcnt vmcnt(0)" ::: "memory");
        }
    }
    __syncthreads();
}

constexpr int NWAVES = 8, NT = 512;
constexpr int LDS_BYTES = 163840;
constexpr int YP_OFF = 129536;
struct Args { const float* in[29]; float* out; unsigned char* ws; int ph_lo, ph_hi; };
struct Frame {
    LAS unsigned char* lds; unsigned char* ws; float* out; const float* const* in;
    int tid, lane, wave, G, bid;
};
__device__ __forceinline__ const float* xrow_ptr(const Frame& F, int m) { return m < MP ? F.in[0] + (size_t)m * DM : F.in[1] + (size_t)(m - MP) * DM; }

template <class MAP>
__device__ __forceinline__ void p0_transpose_item(const float* W, int K, int N, int Nout, bf16_t* WT, LAS float* scr, int item, int lane, MAP map) {
    const int nblk = Nout / 32, kb = item / nblk, nb = item % nblk, k0 = 64 * kb, n0 = 32 * nb;
    const int src = map(n0 + (lane & 31));
    float tv[32];
#pragma unroll
    for (int i = 0; i < 32; ++i) { const int kk = 2 * i + (lane >> 5); tv[i] = src >= 0 ? W[(size_t)(k0 + kk) * N + src] : 0.f; }
#pragma unroll
    for (int i = 0; i < 32; ++i) { const int kk = 2 * i + (lane >> 5); scr[kk * 33 + (lane & 31)] = tv[i]; }
    asm volatile("s_waitcnt lgkmcnt(0)" ::: "memory");
    const int c = lane & 7;
#pragma unroll
    for (int j = 0; j < 4; ++j) { const int n = (lane >> 3) + 8 * j; const LAS float* s = scr + (8 * c) * 33 + n;
        u32x4 o; o.x = pk2(s[0 * 33], s[1 * 33]); o.y = pk2(s[2 * 33], s[3 * 33]); o.z = pk2(s[4 * 33], s[5 * 33]); o.w = pk2(s[6 * 33], s[7 * 33]);
        *(u32x4*)(WT + (size_t)(n0 + n) * K + k0 + 8 * c) = o; }
    asm volatile("s_waitcnt lgkmcnt(0)" ::: "memory");
}
struct MapIn { __device__ int operator()(int n) const { if (n < 640) { const int w = n & 63; return (n & ~63) + (w >> 3) * 4 + (w & 3) + 32 * ((w >> 2) & 1); } return n < 2464 ? n : -1; } };
struct MapId { __device__ int operator()(int n) const { return n; } };
struct MapFfn { __device__ int operator()(int n) const { const int tile = n >> 8, sub = n & 255, ch = tile * 128 + (sub & 127); return sub < 128 ? ch : DFF + ch; } };

__device__ __forceinline__ void p0_prologue(Frame& F) {
    LAS float* scr = (LAS float*)(F.lds + F.wave * 16384);
    const int gw = F.bid * NWAVES + F.wave, NGW = F.G * NWAVES;
    constexpr int I_IN = 16 * (DINP / 32), I_OUT = 16 * 32, I_FI = 16 * (2 * DFF / 32), I_FO = (DFF / 64) * 32;
    constexpr int NITEMS = I_IN + I_OUT + I_FI + I_FO;
    for (int it = gw; it < NITEMS; it += NGW) {
        int r = it;
        if (r < I_IN) { p0_transpose_item(F.in[8], DM, 2464, DINP, (bf16_t*)(F.ws + WS_WIN), scr, r, F.lane, MapIn()); continue; } r -= I_IN;
        if (r < I_OUT) { p0_transpose_item(F.in[21], DM, DM, DM, (bf16_t*)(F.ws + WS_WOUT), scr, r, F.lane, MapId()); continue; } r -= I_OUT;
        if (r < I_FI) { p0_transpose_item(F.in[24], DM, 2 * DFF, 2 * DFF, (bf16_t*)(F.ws + WS_WFI), scr, r, F.lane, MapFfn()); continue; } r -= I_FI;
        p0_transpose_item(F.in[27], DFF, DM, DM, (bf16_t*)(F.ws + WS_WFO), scr, r, F.lane, MapId());
    }
    float* rope = (float*)(F.ws + WS_ROPE);
    for (int e = F.bid * NT + F.tid; e < (T + DT) * 32; e += F.G * NT) {
        const int pidx = e >> 5, i = e & 31; const int pos = pidx < T ? pidx : 16384 + (pidx - T);
        const float inv = (float)exp2(-(double)i * (13.287712379549449 / 32.0));
        const float angf = (float)pos * inv;
        const double a = (double)angf;
        const double TWO_PI = 6.283185307179586476925286766559;
        const double n = rint(a / TWO_PI);
        const double r = a - n * TWO_PI;
        const double r2 = r * r;
        double c = 1.0, s = 1.0, tc = 1.0, ts = 1.0;
#pragma unroll
        for (int k = 1; k <= 14; ++k) { tc = -tc * r2 * (1.0 / (double)((2 * k - 1) * (2 * k))); ts = -ts * r2 * (1.0 / (double)((2 * k) * (2 * k + 1))); c += tc; s += ts; }
        s *= r;
        rope[(size_t)e * 2] = (float)c; rope[(size_t)e * 2 + 1] = (float)s;
    }
    const float* g = F.in[7];
    bf16_t* XN = (bf16_t*)(F.ws + WS_XN);
    for (int m = gw; m < M; m += NGW) {
        const f32x4* xr = (const f32x4*)xrow_ptr(F, m) + F.lane;
        f32x4 v[4]; float s = 0.f;
#pragma unroll
        for (int j = 0; j < 4; ++j) { v[j] = __builtin_nontemporal_load(xr + 64 * j); s += (v[j].x * v[j].x + v[j].y * v[j].y) + (v[j].z * v[j].z + v[j].w * v[j].w); }
        const float rstd = 1.0f / sqrtf(wave_sum(s) * (1.f / DM) + RMS_EPS);
        u32x2* o8 = (u32x2*)(XN + (size_t)m * DM) + F.lane;
#pragma unroll
        for (int j = 0; j < 4; ++j) { const f32x4 gg = ((const f32x4*)g)[64 * j + F.lane]; u32x2 w; w.x = pk2(v[j].x * rstd * gg.x, v[j].y * rstd * gg.y); w.y = pk2(v[j].z * rstd * gg.z, v[j].w * rstd * gg.w); o8[64 * j] = w; }
    }
}

__device__ __forceinline__ float hprev_val(const Frame& F, const bf16_t* HRW, int m, int col) {
    const RowInfo ri = row_info(m);
    if (ri.t == 0) return ri.samp ? F.in[4][(size_t)ri.b * DSH + col] : 0.f;
    return bf2f(HRW[(size_t)(m - 1) * DSH + col]);
}
__device__ __forceinline__ f32x4 ld_bf4(const bf16_t* p) { const u32x2 w = *(const u32x2*)p; return (f32x4){bflo(w.x), bfhi(w.x), bflo(w.y), bfhi(w.y)}; }
__device__ __forceinline__ f32x4 hs4(const Frame& F, const bf16_t* HRW, int m, const RowInfo& ri, int col) {
    const f32x4 h = ld_bf4(HRW + (size_t)m * DSH + col);
    f32x4 hp;
    if (ri.t == 0) hp = ri.samp ? *(const f32x4*)(F.in[4] + (size_t)ri.b * DSH + col) : (f32x4){0.f, 0.f, 0.f, 0.f};
    else hp = ld_bf4(HRW + (size_t)(m - 1) * DSH + col);
    const f32x4 mu = *(const f32x4*)(F.in[10] + col);
    return h + (hp - h) * mu;
}
struct F8 { f32x4 a, b; };
__device__ __forceinline__ F8 ld_bf8(const bf16_t* p) { const u32x4 w = *(const u32x4*)p; F8 r; r.a = (f32x4){bflo(w.x), bfhi(w.x), bflo(w.y), bfhi(w.y)}; r.b = (f32x4){bflo(w.z), bfhi(w.z), bflo(w.w), bfhi(w.w)}; return r; }
__device__ __forceinline__ u32x4 pk8(const f32x4 a, const f32x4 b) { u32x4 w; w.x = cvt_pk_bf16(a[0], a[1]); w.y = cvt_pk_bf16(a[2], a[3]); w.z = cvt_pk_bf16(b[0], b[1]); w.w = cvt_pk_bf16(b[2], b[3]); return w; }
__device__ __forceinline__ F8 hs8(const Frame& F, const bf16_t* HRW, int m, const RowInfo& ri, int col) {
    const F8 h = ld_bf8(HRW + (size_t)m * DSH + col);
    F8 hp;
    if (ri.t == 0) {
        if (ri.samp) { hp.a = *(const f32x4*)(F.in[4] + (size_t)ri.b * DSH + col); hp.b = *(const f32x4*)(F.in[4] + (size_t)ri.b * DSH + col + 4); }
        else { hp.a = (f32x4){0.f, 0.f, 0.f, 0.f}; hp.b = (f32x4){0.f, 0.f, 0.f, 0.f}; }
    } else hp = ld_bf8(HRW + (size_t)(m - 1) * DSH + col);
    const f32x4 mua = *(const f32x4*)(F.in[10] + col), mub = *(const f32x4*)(F.in[10] + col + 4);
    F8 r; r.a = h.a + (hp.a - h.a) * mua; r.b = h.b + (hp.b - h.b) * mub; return r;
}
__device__ __forceinline__ float xsum_fq(float v) {
    { auto r = __builtin_amdgcn_permlane16_swap(__float_as_uint(v), __float_as_uint(v), false, false); v = __uint_as_float(r[0]) + __uint_as_float(r[1]); }
    { auto r = __builtin_amdgcn_permlane32_swap(__float_as_uint(v), __float_as_uint(v), false, false); v = __uint_as_float(r[0]) + __uint_as_float(r[1]); }
    return v;
}
__device__ __forceinline__ u32x2 pk4(const f32x4 v) { u32x2 w; w.x = cvt_pk_bf16(v[0], v[1]); w.y = cvt_pk_bf16(v[2], v[3]); return w; }
__device__ __forceinline__ bf16x8 wfrag(const float* W, int k0, int fq, int ch) {
    u32x4 w; const float* p = W + (size_t)(k0 + 8 * fq) * 512 + ch;
    w.x = cvt_pk_bf16(p[0], p[512]); w.y = cvt_pk_bf16(p[1024], p[1536]); w.z = cvt_pk_bf16(p[2048], p[2560]); w.w = cvt_pk_bf16(p[3072], p[3584]);
    return __builtin_bit_cast(bf16x8, w);
}
#ifndef PREP_DUP
#define PREP_DUP 1
#endif
#ifndef POST_DUP
#define POST_DUP 1
#endif
__device__ __forceinline__ void prep_phase(Frame& F) {
    const bf16_t* HRW = (const bf16_t*)(F.ws + WS_HRW);
    bf16_t* SR = (bf16_t*)(F.ws + WS_SR); bf16_t* SK = (bf16_t*)(F.ws + WS_SK); bf16_t* SV = (bf16_t*)(F.ws + WS_SV);
    bf16_t* SKK = (bf16_t*)(F.ws + WS_SKK); bf16_t* SB = (bf16_t*)(F.ws + WS_SB); float* SW = (float*)(F.ws + WS_SW);
    const int fr = F.lane & 15, fq = F.lane >> 4, h = F.wave;
    bf16x8 Aw[4], Aa[4];
#pragma unroll
    for (int nt = 0; nt < 4; ++nt) { const int ch = h * 64 + 16 * (fr >> 2) + 4 * nt + (fr & 3); Aw[nt] = wfrag(F.in[12], 0, fq, ch); Aa[nt] = wfrag(F.in[14], 0, fq, ch); }
    constexpr int NTILE = M / 16;
    for (int tile_ = F.bid; tile_ < NTILE * PREP_DUP; tile_ += F.G) {
        const int m = (tile_ % NTILE) * 16 + fr;
        const RowInfo ri = row_info(m);
        bf16x8 xw, xa;
        { const F8 a = hs8(F, HRW, m, ri, 1536 + 8 * fq);
          f32x4 t0, t1;
#pragma unroll
          for (int i = 0; i < 4; ++i) { t0[i] = 1.f - 2.f * __builtin_amdgcn_rcpf(__expf(2.f * a.a[i]) + 1.f); t1[i] = 1.f - 2.f * __builtin_amdgcn_rcpf(__expf(2.f * a.b[i]) + 1.f); }
          xw = __builtin_bit_cast(bf16x8, pk8(t0, t1)); }
        { const F8 a = hs8(F, HRW, m, ri, 1568 + 8 * fq); xa = __builtin_bit_cast(bf16x8, pk8(a.a, a.b)); }
        f32x4 kkr[4], av[4]; float ss = 0.f;
#pragma unroll
        for (int np = 0; np < 2; ++np) {
            const int c8 = h * 64 + 16 * fq + 8 * np;
            const f32x4 z = {0.f, 0.f, 0.f, 0.f};
            f32x4 accw[2], acca[2];
#pragma unroll
            for (int q = 0; q < 2; ++q) { accw[q] = __builtin_amdgcn_mfma_f32_16x16x32_bf16(Aw[2 * np + q], xw, z, 0, 0, 0); acca[q] = __builtin_amdgcn_mfma_f32_16x16x32_bf16(Aa[2 * np + q], xa, z, 0, 0, 0); }
            const F8 r8 = hs8(F, HRW, m, ri, c8), k8 = hs8(F, HRW, m, ri, 512 + c8), v8 = hs8(F, HRW, m, ri, 1024 + c8);
            f32x4 dec[2], k2[2];
#pragma unroll
            for (int q = 0; q < 2; ++q) {
                const int c4 = c8 + 4 * q;
                const f32x4 k = q ? k8.b : k8.a;
                const f32x4 w0 = *(const f32x4*)(F.in[11] + c4), a0 = *(const f32x4*)(F.in[13] + c4), kkc = *(const f32x4*)(F.in[16] + c4), kac = *(const f32x4*)(F.in[17] + c4);
                f32x4 a;
#pragma unroll
                for (int j = 0; j < 4; ++j) {
                    const float x = -(w0[j] + accw[q][j]);
                    const float sp = fmaxf(x, 0.f) + __logf(1.f + __expf(-fabsf(x)));
                    dec[q][j] = __expf(-__expf(-sp - 0.5f));
                    a[j] = sigmoidf_(a0[j] + acca[q][j]);
                    k2[q][j] = k[j] * (1.f + (a[j] - 1.f) * kac[j]);
                }
                const f32x4 kk = k * kkc;
                ss += (kk[0] * kk[0] + kk[1] * kk[1]) + (kk[2] * kk[2] + kk[3] * kk[3]);
                kkr[2 * np + q] = kk; av[2 * np + q] = a;
            }
            const size_t o = (size_t)m * 512 + c8;
            *(f32x4*)(SW + o) = dec[0]; *(f32x4*)(SW + o + 4) = dec[1];
            *(u32x4*)(SR + o) = pk8(r8.a, r8.b); *(u32x4*)(SK + o) = pk8(k2[0], k2[1]); *(u32x4*)(SV + o) = pk8(v8.a, v8.b);
        }
        ss = xsum_fq(ss);
        const float rs = rsqrtf(fmaxf(ss, 1e-24f));
#pragma unroll
        for (int np = 0; np < 2; ++np) {
            const size_t o = (size_t)m * 512 + h * 64 + 16 * fq + 8 * np;
            const f32x4 ka = kkr[2 * np] * rs, kb = kkr[2 * np + 1] * rs;
            *(u32x4*)(SKK + o) = pk8(ka, kb); *(u32x4*)(SB + o) = pk8(ka * av[2 * np], kb * av[2 * np + 1]);
        }
    }
}

__device__ __forceinline__ void sample_attn_phase(Frame& F) {
    constexpr int NK = WIN + DT, KS = 68;
    LAS float* Kl = (LAS float*)F.lds;
    LAS float* Vl = Kl + NK * KS;
    LAS float* Pl = Vl + NK * KS;
    const bf16_t* Q = (const bf16_t*)(F.ws + WS_Q);
    bf16_t* OC = (bf16_t*)(F.ws + WS_OCAT);
    for (int unit = F.bid; unit < DB * 2; unit += F.G) {
        const int b = unit >> 1, kvh = unit & 1;
        for (int e = F.tid; e < NK * 16; e += NT) {
            const int key = e >> 4, d4 = (e & 15) * 4;
            f32x4 kv, vv;
            if (key < WIN) { kv = *(const f32x4*)(F.in[2] + ((size_t)(b * WIN + key) * 2 + kvh) * 64 + d4); vv = *(const f32x4*)(F.in[3] + ((size_t)(b * WIN + key) * 2 + kvh) * 64 + d4); }
            else { kv = *(const f32x4*)(F.out + O_KWS + ((size_t)(b * WIN + key - DT) * 2 + kvh) * 64 + d4); vv = *(const f32x4*)(F.out + O_VWS + ((size_t)(b * WIN + key - DT) * 2 + kvh) * 64 + d4); }
            *(LAS f32x4*)(Kl + key * KS + d4) = kv; *(LAS f32x4*)(Vl + key * KS + d4) = vv;
            if (key >= DT && key < WIN) { *(f32x4*)(F.out + O_KWS + ((size_t)(b * WIN + key - DT) * 2 + kvh) * 64 + d4) = kv; *(f32x4*)(F.out + O_VWS + ((size_t)(b * WIN + key - DT) * 2 + kvh) * 64 + d4) = vv; }
        }
        __syncthreads();
        const int qi = F.tid >> 4, sub = F.tid & 15;
        const int t = qi >> 2, g = qi & 3, head = kvh * 4 + g;
        const int m = MP + b * DT + t;
        float mx = F.in[9][head] * 1.4426950408889634f;
        {
            const bf16_t* qp = Q + (size_t)m * 512 + head * 64;
            float q[64];
#pragma unroll
            for (int i = 0; i < 8; ++i) { const u32x4 w = *(const u32x4*)(qp + 8 * i); q[8 * i] = bflo(w.x); q[8 * i + 1] = bfhi(w.x); q[8 * i + 2] = bflo(w.y); q[8 * i + 3] = bfhi(w.y); q[8 * i + 4] = bflo(w.z); q[8 * i + 5] = bfhi(w.z); q[8 * i + 6] = bflo(w.w); q[8 * i + 7] = bfhi(w.w); }
#pragma unroll 1
            for (int key = sub; key < NK; key += 16) {
                float a = 0.f; const LAS f32x4* kr = (const LAS f32x4*)(Kl + key * KS);
#pragma unroll
                for (int i = 0; i < 16; ++i) { const f32x4 kx = kr[i]; a += q[4 * i] * kx[0] + q[4 * i + 1] * kx[1] + q[4 * i + 2] * kx[2] + q[4 * i + 3] * kx[3]; }
                const int dist = t + WIN - key;
                const float s = (dist >= 0 && dist <= WIN) ? a : -1e30f;
                Pl[qi * NK + key] = s; mx = fmaxf(mx, s);
            }
        }
        mx = fmaxf(mx, __shfl_xor(mx, 1)); mx = fmaxf(mx, __shfl_xor(mx, 2)); mx = fmaxf(mx, __shfl_xor(mx, 4)); mx = fmaxf(mx, __shfl_xor(mx, 8));
        float sum = 0.f;
#pragma unroll 1
        for (int key = sub; key < NK; key += 16) { const float sv = Pl[qi * NK + key]; const float p = sv > -1e29f ? __builtin_amdgcn_exp2f(sv - mx) : 0.f; sum += p; Pl[qi * NK + key] = p; }
        sum += __shfl_xor(sum, 1); sum += __shfl_xor(sum, 2); sum += __shfl_xor(sum, 4); sum += __shfl_xor(sum, 8);
        const float inv = __builtin_amdgcn_rcpf(sum + __builtin_amdgcn_exp2f(F.in[9][head] * 1.4426950408889634f - mx));
        __syncthreads();
        f32x4 o = {0.f, 0.f, 0.f, 0.f};
        for (int key = 0; key < NK; ++key) { const float p = Pl[qi * NK + key]; const f32x4 vv = *(const LAS f32x4*)(Vl + key * KS + sub * 4); o += vv * p; }
        o = o * inv;
        u32x2 w; w.x = pk2(o[0], o[1]); w.y = pk2(o[2], o[3]);
        *(u32x2*)(OC + (size_t)m * DM + head * 64 + sub * 4) = w;
        __syncthreads();
    }
}

__device__ __forceinline__ void prompt_attn_unit(Frame& F, int unit) {
    constexpr int KST = 144, VST = 528;
    LAS unsigned char* Kl = F.lds; LAS unsigned char* Vl = F.lds + 256 * KST;
    const bf16_t* Q = (const bf16_t*)(F.ws + WS_Q); const bf16_t* Kb = (const bf16_t*)(F.ws + WS_K); const bf16_t* VT = (const bf16_t*)(F.ws + WS_VT);
    bf16_t* OC = (bf16_t*)(F.ws + WS_OCAT);
    const int kvh = unit & 1, qb = (unit >> 1) & 63, b = unit >> 7;
    const int key0 = (qb - 1) * 128;
    for (int e = F.tid; e < 256 * 8; e += NT) {
        const int key = e >> 3, ch = e & 7; const int pos = key0 + key;
        u32x4 v = {0u, 0u, 0u, 0u};
        if (pos >= 0) v = *(const u32x4*)(Kb + (size_t)(b * T + pos) * 128 + kvh * 64 + ch * 8);
        *(LAS u32x4*)(Kl + key * KST + ch * 16) = v;
    }
    for (int e = F.tid; e < 64 * 32; e += NT) {
        const int d = e >> 5, ch = e & 31; const int pos = key0 + ch * 8;
        u32x4 v = {0u, 0u, 0u, 0u};
        if (pos >= 0) v = *(const u32x4*)(VT + ((size_t)(b * 2 + kvh) * 64 + d) * T + pos);
        *(LAS u32x4*)(Vl + d * VST + ch * 16) = v;
    }
    __syncthreads();
    const int fr = F.lane & 15, fq = F.lane >> 4;
    const int head = kvh * 4 + (F.wave >> 1);
    const float sink = F.in[9][head] * 1.4426950408889634f;
#pragma unroll 1
    for (int sb = 0; sb < 4; ++sb) {
        const int qi0 = (F.wave & 1) * 64 + sb * 16;
        const int qi = qi0 + fr;
        const size_t mrow = (size_t)b * T + qb * 128 + qi;
        const bf16x8 q0 = *(const bf16x8*)(Q + mrow * 512 + head * 64 + fq * 8);
        const bf16x8 q1 = *(const bf16x8*)(Q + mrow * 512 + head * 64 + 32 + fq * 8);
        const int ktlo = (F.wave & 1) * 4 + sb;
        f32x4 s[9];
#pragma unroll
        for (int kr = 0; kr < 9; ++kr) {
            const int kt = ktlo + kr;
            const bf16x8 k0 = *(const LAS bf16x8*)(Kl + (kt * 16 + fr) * KST + fq * 16);
            const bf16x8 k1 = *(const LAS bf16x8*)(Kl + (kt * 16 + fr) * KST + 64 + fq * 16);
            f32x4 a = {0.f, 0.f, 0.f, 0.f};
            a = __builtin_amdgcn_mfma_f32_16x16x32_bf16(k0, q0, a, 0, 0, 0);
            a = __builtin_amdgcn_mfma_f32_16x16x32_bf16(k1, q1, a, 0, 0, 0);
            s[kr] = a;
        }
        float mx = sink;
#pragma unroll
        for (int kr = 0; kr < 9; ++kr)
#pragma unroll
            for (int j = 0; j < 4; ++j) { const int sj = (ktlo + kr) * 16 + fq * 4 + j; const int dist = qi + 128 - sj; const bool ok = dist >= 0 && dist <= WIN && (key0 + sj) >= 0; const float v = ok ? s[kr][j] : -1e30f; s[kr][j] = v; mx = fmaxf(mx, v); }
        mx = fmaxf(mx, __shfl_xor(mx, 16)); mx = fmaxf(mx, __shfl_xor(mx, 32));
        float sum = 0.f;
        u32x2 pw[10];
#pragma unroll
        for (int kr = 0; kr < 9; ++kr) {
            f32x4 p;
#pragma unroll
            for (int j = 0; j < 4; ++j) { p[j] = s[kr][j] > -1e29f ? __builtin_amdgcn_exp2f(s[kr][j] - mx) : 0.f; sum += p[j]; }
            pw[kr].x = cvt_pk_bf16(p[0], p[1]); pw[kr].y = cvt_pk_bf16(p[2], p[3]);
        }
        pw[9].x = 0u; pw[9].y = 0u;
        sum += __shfl_xor(sum, 16); sum += __shfl_xor(sum, 32);
        const float inv = __builtin_amdgcn_rcpf(sum + __builtin_amdgcn_exp2f(sink - mx));
        f32x4 o[4];
#pragma unroll
        for (int dt = 0; dt < 4; ++dt) o[dt] = (f32x4){0.f, 0.f, 0.f, 0.f};
#pragma unroll
        for (int u = 0; u < 5; ++u) {
            u32x4 pb; pb.x = pw[2 * u].x; pb.y = pw[2 * u].y; pb.z = pw[2 * u + 1].x; pb.w = pw[2 * u + 1].y;
            const bf16x8 pf = __builtin_bit_cast(bf16x8, pb);
            const int kta = ktlo + 2 * u, ktb = u < 4 ? kta + 1 : kta;
#pragma unroll
            for (int dt = 0; dt < 4; ++dt) {
                const LAS unsigned char* vr = Vl + (dt * 16 + fr) * VST + (fq * 4) * 2;
                const u32x2 va = *(const LAS u32x2*)(vr + kta * 32), vb = *(const LAS u32x2*)(vr + ktb * 32);
                u32x4 vv; vv.x = va.x; vv.y = va.y; vv.z = vb.x; vv.w = vb.y;
                o[dt] = __builtin_amdgcn_mfma_f32_16x16x32_bf16(__builtin_bit_cast(bf16x8, vv), pf, o[dt], 0, 0, 0);
            }
        }
#pragma unroll
        for (int dt = 0; dt < 4; ++dt) { const f32x4 v = o[dt] * inv; u32x2 w; w.x = cvt_pk_bf16(v[0], v[1]); w.y = cvt_pk_bf16(v[2], v[3]); *(u32x2*)(OC + mrow * DM + head * 64 + dt * 16 + fq * 4) = w; }
    }
    __syncthreads();
}

struct StepOps { f32x4 w, nbe, kk, k, r; float v; };
template <int STRIDE_F> __device__ __forceinline__ StepOps load_ops(const LAS float* img, int s, int cgi, int vrow) {
    const LAS float* p = img + s * STRIDE_F + cgi * 4; StepOps o;
    o.w = *(const LAS f32x4*)(p); o.nbe = *(const LAS f32x4*)(p + 64); o.kk = *(const LAS f32x4*)(p + 128); o.k = *(const LAS f32x4*)(p + 192); o.r = *(const LAS f32x4*)(p + 256);
    o.v = img[s * STRIDE_F + 320 + vrow]; return o;
}
template <int J> __device__ __forceinline__ float sel_lane16(float oldv, float newv) {
    float r; const unsigned long long m = 0x0001000100010001ull << J;
    asm("v_cndmask_b32_e64 %0, %1, %2, %3" : "=v"(r) : "v"(oldv), "v"(newv), "s"(m));
    return r;
}
struct ScanState { f32x2 s01, s23; float ykeep, ypart; StepOps c0, c1; };
template <int STRIDE_F, int J>
__device__ __forceinline__ void scan_step(const LAS float* img, int s0, int vrow, int cgi, ScanState& Z) {
    const StepOps nx = load_ops<STRIDE_F>(img, s0 + J + 2, cgi, vrow);
    const StepOps& c = Z.c0;
    const f32x2 kk01 = {c.kk[0], c.kk[1]}, kk23 = {c.kk[2], c.kk[3]}, w01 = {c.w[0], c.w[1]}, w23 = {c.w[2], c.w[3]}, k01 = {c.k[0], c.k[1]}, k23 = {c.k[2], c.k[3]};
    const f32x2 b01 = {c.nbe[0], c.nbe[1]}, b23 = {c.nbe[2], c.nbe[3]}, r01 = {c.r[0], c.r[1]}, r23 = {c.r[2], c.r[3]};
    f32x2 t = Z.s01 * kk01; t = Z.s23 * kk23 + t;
    float sa = t.x + t.y;
    const f32x2 u01 = Z.s01 * w01 + k01 * c.v, u23 = Z.s23 * w23 + k23 * c.v;
    if (J > 0) { allsum16_2(sa, Z.ypart); Z.ykeep = sel_lane16<(J > 0 ? J - 1 : 0)>(Z.ykeep, Z.ypart); } else sa = allsum16(sa);
    Z.s01 = b01 * sa + u01; Z.s23 = b23 * sa + u23;
    f32x2 y2 = Z.s01 * r01; y2 = Z.s23 * r23 + y2;
    Z.ypart = y2.x + y2.y;
    Z.c0 = Z.c1; Z.c1 = nx;
}
template <int STRIDE_F, int GS, int... Js>
__device__ __forceinline__ void scan_group_impl(const LAS float* img, int s0, int vrow, int cgi, ScanState& Z, float* yout, std::integer_sequence<int, Js...>) {
    (scan_step<STRIDE_F, Js>(img, s0, vrow, cgi, Z), ...);
    Z.ypart = allsum16(Z.ypart); Z.ykeep = sel_lane16<GS - 1>(Z.ykeep, Z.ypart);
    if (cgi < GS) yout[(size_t)(s0 + cgi) * 512] = Z.ykeep;
}
template <int STRIDE_F, int J>
__device__ __forceinline__ void scan_step_yp(const LAS float* img, int s0, int vrow, int cgi, ScanState& Z, LAS float* ypb) {
    const StepOps nx = load_ops<STRIDE_F>(img, s0 + J + 2, cgi, vrow);
    const StepOps& c = Z.c0;
    const f32x2 kk01 = {c.kk[0], c.kk[1]}, kk23 = {c.kk[2], c.kk[3]}, w01 = {c.w[0], c.w[1]}, w23 = {c.w[2], c.w[3]}, k01 = {c.k[0], c.k[1]}, k23 = {c.k[2], c.k[3]};
    const f32x2 b01 = {c.nbe[0], c.nbe[1]}, b23 = {c.nbe[2], c.nbe[3]}, r01 = {c.r[0], c.r[1]}, r23 = {c.r[2], c.r[3]};
    f32x2 t = Z.s01 * kk01; t = Z.s23 * kk23 + t;
    float sa = t.x + t.y;
    const f32x2 u01 = Z.s01 * w01 + k01 * c.v, u23 = Z.s23 * w23 + k23 * c.v;
    sa = allsum16(sa);
    Z.s01 = b01 * sa + u01; Z.s23 = b23 * sa + u23;
    f32x2 y2 = Z.s01 * r01; y2 = Z.s23 * r23 + y2;
    ypb[(s0 + J) * 64] = y2.x + y2.y;
    Z.c0 = Z.c1; Z.c1 = nx;
}
struct StepOpsS { f32x4 nbe, kk, k, r; };
template <int STRIDE_F> __device__ __forceinline__ StepOpsS load_ops_s(const LAS float* img, int s, int cgi) {
    const LAS float* p = img + s * STRIDE_F + cgi * 4; StepOpsS o;
    o.nbe = *(const LAS f32x4*)(p + 64); o.kk = *(const LAS f32x4*)(p + 128); o.k = *(const LAS f32x4*)(p + 192); o.r = *(const LAS f32x4*)(p + 256);
    return o;
}
struct ScanT { f32x2 t01, t23; StepOpsS c0, c1; f32x4 v4[4]; };
template <int STRIDE_F, int J>
__device__ __forceinline__ void scan_step_s(const LAS float* img, int cgi, ScanT& Z, LAS float* ypb) {
    const StepOpsS nx = load_ops_s<STRIDE_F>(img, J + 2, cgi);
    const StepOpsS& c = Z.c0;
    const float v = Z.v4[J >> 2][J & 3];
    f32x2 t = Z.t01 * (f32x2){c.kk[0], c.kk[1]}; t = Z.t23 * (f32x2){c.kk[2], c.kk[3]} + t;
    float sa = t.x + t.y;
    const f32x2 a01 = (f32x2){c.k[0], c.k[1]} * v + Z.t01, a23 = (f32x2){c.k[2], c.k[3]} * v + Z.t23;
    sa = allsum16(sa);
    Z.t01 = (f32x2){c.nbe[0], c.nbe[1]} * sa + a01; Z.t23 = (f32x2){c.nbe[2], c.nbe[3]} * sa + a23;
    f32x2 y2 = Z.t01 * (f32x2){c.r[0], c.r[1]}; y2 = Z.t23 * (f32x2){c.r[2], c.r[3]} + y2;
    ypb[J * 64] = y2.x + y2.y;
    Z.c0 = Z.c1; Z.c1 = nx;
}
template <int STRIDE_F, int... Js>
__device__ __forceinline__ void scan_chunk_s_impl(const LAS float* img, int cgi, ScanT& Z, LAS float* ypb, std::integer_sequence<int, Js...>) {
    (scan_step_s<STRIDE_F, Js>(img, cgi, Z, ypb), ...);
}
template <int STRIDE_F, int NS>
__device__ __forceinline__ void scan_transform(LAS float* img, int lane) {
    LAS float* p = img + lane; float Wc = 1.f;
#pragma unroll
    for (int t = 0; t < NS; ++t, p += STRIDE_F) {
        const float w = p[0], nb = p[64], kk = p[128], k = p[192], r = p[256];
        p[128] = Wc * kk;
        Wc *= w; const float inv = __builtin_amdgcn_rcpf(Wc);
        p[64] = nb * inv; p[192] = k * inv; p[256] = Wc * r;
    }
    img[(NS - 1) * STRIDE_F + lane] = Wc;
}
template <int STRIDE_F, int... Js>
__device__ __forceinline__ void scan_group_yp_impl(const LAS float* img, int s0, int vrow, int cgi, ScanState& Z, LAS float* ypb, std::integer_sequence<int, Js...>) {
    (scan_step_yp<STRIDE_F, Js>(img, s0, vrow, cgi, Z, ypb), ...);
}
template <int... Js>
__device__ __forceinline__ void yp_reduce_impl(const LAS float* ypb, int cgi, float* yout, int s0, std::integer_sequence<int, Js...>) {
    float ykeep = 0.f;
    ((ykeep = sel_lane16<Js>(ykeep, allsum16(ypb[(s0 + Js) * 64]))), ...);
    yout[(size_t)(s0 + cgi) * 512] = ykeep;
}
template <int STRIDE_F, int GS>
__device__ __forceinline__ void scan_group(const LAS float* img, int s0, int vrow, int cgi, ScanState& Z, float* yout) {
    scan_group_impl<STRIDE_F, GS>(img, s0, vrow, cgi, Z, yout, std::make_integer_sequence<int, GS>());
}
constexpr int SC = 32;
constexpr int PSTR = 328;
constexpr int SSTR = 384;
struct ScanRegs { f32x4 w[2]; u32x4 b0[2], b1[2]; u32x4 v; };
__device__ __forceinline__ void scan_load(const Frame& F, ScanRegs& R, int m0, int h, int v0) {
    if (F.wave < 4) return;
    const int vt = F.tid - 256;
#pragma unroll
    for (int i = 0; i < 2; ++i) {
        const int tid = vt + 256 * i;
        { const int row = tid >> 4, c4 = (tid & 15) * 4; R.w[i] = *(const f32x4*)((const float*)(F.ws + WS_SW) + (size_t)(m0 + row) * 512 + h * 64 + c4); }
        { const int st = tid >> 7, row = (tid & 127) >> 2, seg = tid & 3;
          const size_t base = st == 0 ? WS_SB : st == 1 ? WS_SKK : st == 2 ? WS_SK : WS_SR;
          const bf16_t* p = (const bf16_t*)(F.ws + base) + (size_t)(m0 + row) * 512 + h * 64 + seg * 16;
          R.b0[i] = *(const u32x4*)p; R.b1[i] = *(const u32x4*)(p + 8); }
    }
    { R.v = *(const u32x4*)((const bf16_t*)(F.ws + WS_SV) + (size_t)(m0 + (vt & 31)) * 512 + h * 64 + v0); }
}
__device__ __forceinline__ void scan_store(const Frame& F, const ScanRegs& R, LAS float* img) {
    if (F.wave < 4) return;
    const int vt = F.tid - 256;
#pragma unroll
    for (int i = 0; i < 2; ++i) {
        const int tid = vt + 256 * i;
        { const int row = tid >> 4, c4 = (tid & 15) * 4; *(LAS f32x4*)(img + row * PSTR + c4) = R.w[i]; }
        { const int st = tid >> 7, row = (tid & 127) >> 2, seg = tid & 3;
          LAS float* d = img + row * PSTR + 64 + st * 64 + seg * 16;
          const float sg = st == 0 ? -1.f : 1.f; const u32x4 b0 = R.b0[i], b1 = R.b1[i];
          *(LAS f32x4*)(d) = (f32x4){bflo(b0.x), bfhi(b0.x), bflo(b0.y), bfhi(b0.y)} * sg; *(LAS f32x4*)(d + 4) = (f32x4){bflo(b0.z), bfhi(b0.z), bflo(b0.w), bfhi(b0.w)} * sg;
          *(LAS f32x4*)(d + 8) = (f32x4){bflo(b1.x), bfhi(b1.x), bflo(b1.y), bfhi(b1.y)} * sg; *(LAS f32x4*)(d + 12) = (f32x4){bflo(b1.z), bfhi(b1.z), bflo(b1.w), bfhi(b1.w)} * sg; }
    }
    if (vt < 32) { LAS float* d = img + SC * PSTR + vt;
      d[0 * SC] = bflo(R.v.x); d[1 * SC] = bfhi(R.v.x); d[2 * SC] = bflo(R.v.y); d[3 * SC] = bfhi(R.v.y); d[4 * SC] = bflo(R.v.z); d[5 * SC] = bfhi(R.v.z); d[6 * SC] = bflo(R.v.w); d[7 * SC] = bfhi(R.v.w); }
}
constexpr int NSW = 2;
__device__ __forceinline__ void prompt_scan(Frame& F, int sblk) {
    const int xcd = sblk & 7, k = sblk >> 3;
    const int chain = xcd * 4 + (k >> 3), rg = k & 7;
    const int b = chain >> 3, h = chain & 7, v0 = rg * 8;
    LAS float* img = (LAS float*)F.lds;
    constexpr int IMG = SC * PSTR + 8 * SC;
    const int rl = F.lane >> 4, cgi = F.lane & 15;
    const int vrow = F.wave * 4 + rl;
    float* Y = F.out;
    ScanState Z; Z.s01 = (f32x2){0.f, 0.f}; Z.s23 = (f32x2){0.f, 0.f}; Z.ykeep = 0.f; Z.ypart = 0.f;
    ScanRegs R0, R1, R2, R3;
    const int mbase = b * T;
    constexpr int NCH = T / SC;
#ifndef SCAN_DUP
#define SCAN_DUP 1
#endif
    constexpr int NTOT = NCH * SCAN_DUP;
    scan_load(F, R0, mbase, h, v0); scan_store(F, R0, img);
    scan_load(F, R1, mbase + SC, h, v0); scan_store(F, R1, img + IMG);
    scan_load(F, R2, mbase + 2 * SC, h, v0); scan_load(F, R3, mbase + 3 * SC, h, v0);
    __syncthreads();
    if (F.wave == 4 || F.wave == 5) scan_transform<PSTR, 16>(img + (F.wave - 4) * 16 * PSTR, F.lane);
    __syncthreads();
    LAS float* ypr = (LAS float*)(F.lds + YP_OFF);
#define SCAN_CHUNK(cc_) do { const int c_ = (cc_) % NCH; \
        if (SCAN_DUP > 1 && c_ == 0) { Z.s01 = (f32x2){0.f, 0.f}; Z.s23 = (f32x2){0.f, 0.f}; } \
        if (F.wave < NSW) { const LAS float* im = img + ((cc_) % 3) * IMG; LAS float* ypb = ypr + (((cc_) & 1) * NSW + F.wave) * (SC * 64) + F.lane; \
            const LAS float* vtp = im + SC * PSTR + vrow * SC; \
            ScanT Tz; Tz.t01 = Z.s01; Tz.t23 = Z.s23; Tz.c0 = load_ops_s<PSTR>(im, 0, cgi); Tz.c1 = load_ops_s<PSTR>(im, 1, cgi); \
            _Pragma("unroll") for (int q_ = 0; q_ < 4; ++q_) Tz.v4[q_] = *(const LAS f32x4*)(vtp + 4 * q_); \
            scan_chunk_s_impl<PSTR>(im, cgi, Tz, ypb, std::make_integer_sequence<int, 16>()); \
            { const f32x4 wce = *(const LAS f32x4*)(im + 15 * PSTR + cgi * 4); Tz.t01 = Tz.t01 * (f32x2){wce[0], wce[1]}; Tz.t23 = Tz.t23 * (f32x2){wce[2], wce[3]}; } \
            _Pragma("unroll") for (int q_ = 0; q_ < 4; ++q_) Tz.v4[q_] = *(const LAS f32x4*)(vtp + 16 + 4 * q_); \
            scan_chunk_s_impl<PSTR>(im + 16 * PSTR, cgi, Tz, ypb + 16 * 64, std::make_integer_sequence<int, 16>()); \
            { const f32x4 wce = *(const LAS f32x4*)(im + 31 * PSTR + cgi * 4); Z.s01 = Tz.t01 * (f32x2){wce[0], wce[1]}; Z.s23 = Tz.t23 * (f32x2){wce[2], wce[3]}; } } \
        else if (F.wave < 2 * NSW && (cc_) > 0) { const int sw_ = F.wave - NSW, cp_ = ((cc_) - 1) % NCH; \
            const LAS float* ypb = ypr + ((((cc_) - 1) & 1) * NSW + sw_) * (SC * 64) + F.lane; float* yo = Y + (size_t)(mbase + cp_ * SC) * 512 + h * 64 + v0 + sw_ * 4 + rl; \
            yp_reduce_impl(ypb, cgi, yo, 0, std::make_integer_sequence<int, 16>()); yp_reduce_impl(ypb, cgi, yo, 16, std::make_integer_sequence<int, 16>()); } \
        else if ((F.wave == 4 || F.wave == 5) && (cc_) + 1 < NTOT) scan_transform<PSTR, 16>(img + (((cc_) + 1) % 3) * IMG + (F.wave - 4) * 16 * PSTR, F.lane); } while (0)
#define SCAN_ITER(j_, RL_, RS_) do { const int c4_ = cc + (j_); \
        scan_load(F, RL_, mbase + ((c4_ + 4 < NTOT ? c4_ + 4 : NTOT - 1) % NCH) * SC, h, v0);        \
        SCAN_CHUNK(c4_); \
        if (c4_ + 2 < NTOT) scan_store(F, RS_, img + ((c4_ + 2) % 3) * IMG);                         \
        asm volatile("s_waitcnt lgkmcnt(0)\n\ts_barrier" ::: "memory"); } while (0)
#pragma unroll 1
    for (int cc = 0; cc < NTOT; cc += 4) {
        SCAN_ITER(0, R0, R2); SCAN_ITER(1, R1, R3); SCAN_ITER(2, R2, R0); SCAN_ITER(3, R3, R1);
    }
#undef SCAN_ITER
#undef SCAN_CHUNK
    if (F.wave >= NSW && F.wave < 2 * NSW) { const int sw_ = F.wave - NSW, cp_ = (NTOT - 1) % NCH;
        const LAS float* ypb = ypr + (((NTOT - 1) & 1) * NSW + sw_) * (SC * 64) + F.lane; float* yo = Y + (size_t)(mbase + cp_ * SC) * 512 + h * 64 + v0 + sw_ * 4 + rl;
        yp_reduce_impl(ypb, cgi, yo, 0, std::make_integer_sequence<int, 16>()); yp_reduce_impl(ypb, cgi, yo, 16, std::make_integer_sequence<int, 16>()); }
    __syncthreads();
    if (F.wave < NSW) *(f32x4*)(F.out + O_WKVP + ((size_t)(b * 8 + h) * 64 + v0 + vrow) * 64 + cgi * 4) = (f32x4){Z.s01.x, Z.s01.y, Z.s23.x, Z.s23.y};
}
__device__ __forceinline__ void sample_scan(Frame& F, int sblk, int nsblk) {
    LAS float* img = (LAS float*)F.lds;
    float* Y = F.out;
    const int rl = F.lane >> 4, cgi = F.lane & 15;
    for (int chain = sblk; chain < DB * 8; chain += nsblk) {
        const int b = chain >> 3, h = chain & 7; const int m0 = MP + b * DT;
        for (int e = F.tid; e < 6 * DT * 64; e += NT) {
            const int st = e >> 9, row = (e >> 6) & 7, ch = e & 63; const size_t o = (size_t)(m0 + row) * 512 + h * 64 + ch;
            float val;
            if (st == 0) val = ((const float*)(F.ws + WS_SW))[o];
            else { const size_t base = st == 1 ? WS_SB : st == 2 ? WS_SKK : st == 3 ? WS_SK : st == 4 ? WS_SR : WS_SV; val = bf2f(((const bf16_t*)(F.ws + base))[o]); if (st == 1) val = -val; }
            img[row * SSTR + st * 64 + ch] = val;
        }
        __syncthreads();
#pragma unroll 1
        for (int rnd = 0; rnd < 2; ++rnd) {
            const int vrow = (rnd * 8 + F.wave) * 4 + rl;
            const float* s0 = F.in[5] + ((size_t)chain * 64 + vrow) * 64 + cgi * 4;
            const f32x4 S = *(const f32x4*)s0;
            ScanState Z; Z.s01 = (f32x2){S[0], S[1]}; Z.s23 = (f32x2){S[2], S[3]}; Z.ykeep = 0.f; Z.ypart = 0.f;
            Z.c0 = load_ops<SSTR>(img, 0, cgi, vrow); Z.c1 = load_ops<SSTR>(img, 1, cgi, vrow);
            scan_group<SSTR, DT>(img, 0, vrow, cgi, Z, Y + (size_t)m0 * 512 + h * 64 + vrow);
            *(f32x4*)(F.out + O_WKVS + ((size_t)chain * 64 + vrow) * 64 + cgi * 4) = (f32x4){Z.s01.x, Z.s01.y, Z.s23.x, Z.s23.y};
        }
        __syncthreads();
    }
}

__device__ __forceinline__ void post_phase(Frame& F) {
    const bf16_t* HRW = (const bf16_t*)(F.ws + WS_HRW);
    const bf16_t* SR = (const bf16_t*)(F.ws + WS_SR); const bf16_t* SK = (const bf16_t*)(F.ws + WS_SK); const bf16_t* SV = (const bf16_t*)(F.ws + WS_SV);
    const float* Y = F.out; bf16_t* OC = (bf16_t*)(F.ws + WS_OCAT);
    const int fr = F.lane & 15, fq = F.lane >> 4, h = F.wave;
    bf16x8 Ag[4][3];
#pragma unroll
    for (int nt = 0; nt < 4; ++nt)
#pragma unroll
        for (int s3 = 0; s3 < 3; ++s3) Ag[nt][s3] = wfrag(F.in[15], 32 * s3, fq, h * 64 + 16 * (fr >> 2) + 4 * nt + (fr & 3));
    constexpr int NTILE = M / 16;
    for (int tile_ = F.bid; tile_ < NTILE * POST_DUP; tile_ += F.G) {
        const int m = (tile_ % NTILE) * 16 + fr;
        const RowInfo ri = row_info(m);
        bf16x8 xg[3];
#pragma unroll
        for (int s3 = 0; s3 < 3; ++s3) {
            const F8 a = hs8(F, HRW, m, ri, 1600 + 32 * s3 + 8 * fq);
            f32x4 t0, t1;
#pragma unroll
            for (int i = 0; i < 4; ++i) { t0[i] = sigmoidf_(a.a[i]); t1[i] = sigmoidf_(a.b[i]); }
            xg[s3] = __builtin_bit_cast(bf16x8, pk8(t0, t1));
        }
        f32x4 y4[4], v4[4], g4[4]; float sy = 0.f, dot = 0.f;
#pragma unroll
        for (int np = 0; np < 2; ++np) {
            const int c8 = h * 64 + 16 * fq + 8 * np; const size_t o = (size_t)m * 512 + c8;
#pragma unroll
            for (int q = 0; q < 2; ++q) { f32x4 g = {0.f, 0.f, 0.f, 0.f};
#pragma unroll
                for (int s3 = 0; s3 < 3; ++s3) g = __builtin_amdgcn_mfma_f32_16x16x32_bf16(Ag[2 * np + q][s3], xg[s3], g, 0, 0, 0);
                g4[2 * np + q] = g; }
            const f32x4 ya = *(const f32x4*)(Y + o), yb = *(const f32x4*)(Y + o + 4);
            const F8 r8 = ld_bf8(SR + o), k8 = ld_bf8(SK + o), v8 = ld_bf8(SV + o);
            const f32x4 rka = *(const f32x4*)(F.in[18] + c8), rkb = *(const f32x4*)(F.in[18] + c8 + 4);
            y4[2 * np] = ya; y4[2 * np + 1] = yb; v4[2 * np] = v8.a; v4[2 * np + 1] = v8.b;
            sy += ((ya[0] + ya[1]) + (ya[2] + ya[3])) + ((yb[0] + yb[1]) + (yb[2] + yb[3]));
            const f32x4 pa = r8.a * k8.a * rka, pb = r8.b * k8.b * rkb; dot += ((pa[0] + pa[1]) + (pa[2] + pa[3])) + ((pb[0] + pb[1]) + (pb[2] + pb[3]));
        }
        const float mean = xsum_fq(sy) * (1.f / 64.f); dot = xsum_fq(dot);
        float sq = 0.f;
#pragma unroll
        for (int nt = 0; nt < 4; ++nt) { y4[nt] = y4[nt] - mean; const f32x4 d = y4[nt]; sq += (d[0] * d[0] + d[1] * d[1]) + (d[2] * d[2] + d[3] * d[3]); }
        const float rstd = rsqrtf(xsum_fq(sq) * (1.f / 64.f) + GN_EPS);
#pragma unroll
        for (int np = 0; np < 2; ++np) {
            const int c8 = h * 64 + 16 * fq + 8 * np;
            f32x4 oo[2];
#pragma unroll
            for (int q = 0; q < 2; ++q) { const int c4 = c8 + 4 * q; const f32x4 gw = *(const f32x4*)(F.in[19] + c4), gb = *(const f32x4*)(F.in[20] + c4);
                oo[q] = (y4[2 * np + q] * rstd * gw + gb + v4[2 * np + q] * dot) * g4[2 * np + q]; }
            *(u32x4*)(OC + (size_t)m * DM + 512 + c8) = pk8(oo[0], oo[1]);
        }
    }
}

__device__ __forceinline__ void rows_mid(Frame& F) {
    const int gw = F.bid * NWAVES + F.wave, NGW = F.G * NWAVES;
    const f32x4* g1 = (const f32x4*)F.in[22]; const f32x4* g2 = (const f32x4*)F.in[23];
    bf16_t* XN = (bf16_t*)(F.ws + WS_XN);
    for (int m = gw; m < M; m += NGW) {
        const f32x4* xr = (const f32x4*)xrow_ptr(F, m) + F.lane;
        const u32x2* mb = (const u32x2*)((const bf16_t*)(F.ws + WS_MIX) + (size_t)m * DM) + F.lane;
        f32x4 v[4]; float s = 0.f;
#pragma unroll
        for (int j = 0; j < 4; ++j) { const u32x2 w = mb[64 * j]; v[j] = (f32x4){bflo(w.x), bfhi(w.x), bflo(w.y), bfhi(w.y)}; s += (v[j].x * v[j].x + v[j].y * v[j].y) + (v[j].z * v[j].z + v[j].w * v[j].w); }
        const float rstd = 1.0f / sqrtf(wave_sum(s) * (1.f / DM) + RMS_EPS);
        float s2 = 0.f;
#pragma unroll
        for (int j = 0; j < 4; ++j) { v[j] = __builtin_nontemporal_load(xr + 64 * j) + v[j] * rstd * g1[64 * j + F.lane]; s2 += (v[j].x * v[j].x + v[j].y * v[j].y) + (v[j].z * v[j].z + v[j].w * v[j].w); }
        const float rstd2 = 1.0f / sqrtf(wave_sum(s2) * (1.f / DM) + RMS_EPS);
        u32x2* o8 = (u32x2*)(XN + (size_t)m * DM) + F.lane;
#pragma unroll
        for (int j = 0; j < 4; ++j) { const f32x4 gg = g2[64 * j + F.lane]; u32x2 w; w.x = pk2(v[j].x * rstd2 * gg.x, v[j].y * rstd2 * gg.y); w.y = pk2(v[j].z * rstd2 * gg.z, v[j].w * rstd2 * gg.w); o8[64 * j] = w; }
    }
}
__device__ __forceinline__ void rows_final(Frame& F) {
    const int gw = F.bid * NWAVES + F.wave, NGW = F.G * NWAVES;
    const f32x4* g0 = (const f32x4*)F.in[22]; const f32x4* g1 = (const f32x4*)F.in[28];
    const bf16_t* Fb = (const bf16_t*)(F.ws + WS_F);
    for (int m = gw; m < M; m += NGW) {
        f32x4* yr = (f32x4*)(F.out + (size_t)m * DM) + F.lane; const u32x2* fr = (const u32x2*)(Fb + (size_t)m * DM) + F.lane;
        const f32x4* xr = (const f32x4*)xrow_ptr(F, m) + F.lane; const u32x2* mb = (const u32x2*)((const bf16_t*)(F.ws + WS_MIX) + (size_t)m * DM) + F.lane;
        f32x4 v[4], x1[4]; float s = 0.f, sm = 0.f;
#pragma unroll
        for (int j = 0; j < 4; ++j) { const u32x2 w = __builtin_nontemporal_load(fr + 64 * j); v[j] = (f32x4){bflo(w.x), bfhi(w.x), bflo(w.y), bfhi(w.y)}; s += (v[j].x * v[j].x + v[j].y * v[j].y) + (v[j].z * v[j].z + v[j].w * v[j].w);
            const u32x2 q = __builtin_nontemporal_load(mb + 64 * j); x1[j] = (f32x4){bflo(q.x), bfhi(q.x), bflo(q.y), bfhi(q.y)}; sm += (x1[j].x * x1[j].x + x1[j].y * x1[j].y) + (x1[j].z * x1[j].z + x1[j].w * x1[j].w); }
        const float rstd = 1.0f / sqrtf(wave_sum(s) * (1.f / DM) + RMS_EPS), rstdm = 1.0f / sqrtf(wave_sum(sm) * (1.f / DM) + RMS_EPS);
#pragma unroll
        for (int j = 0; j < 4; ++j) __builtin_nontemporal_store((__builtin_nontemporal_load(xr + 64 * j) + x1[j] * rstdm * g0[64 * j + F.lane]) + v[j] * rstd * g1[64 * j + F.lane], yr + 64 * j);
    }
}
__device__ __forceinline__ void conv_phase(Frame& F, int half) {
    const bf16_t* ZU = (const bf16_t*)(F.ws + WS_ZU); bf16_t* HID = (bf16_t*)(F.ws + WS_HID);
    const float* cw = F.in[25]; const float* cb = F.in[26]; const float* sc = F.in[6];
    const long total = (long)M * 176;
    for (long e = (long)F.bid * NT + F.tid; e < total; e += (long)F.G * NT) {
        const int m = (int)(e / 176), r = (int)(e - (long)m * 176); const int tile = r >> 4, c8 = (r & 15) * 8;
        const int ch = (half * 11 + tile) * 128 + c8;
        const RowInfo ri = row_info(m);
        const bf16_t* zp = ZU + (size_t)m * DFF + tile * 256 + c8;
        const u32x4 z0 = *(const u32x4*)zp, uu = *(const u32x4*)(zp + 128);
        float z[8], z1[8], z2[8], u8[8];
        z[0] = bflo(z0.x); z[1] = bfhi(z0.x); z[2] = bflo(z0.y); z[3] = bfhi(z0.y); z[4] = bflo(z0.z); z[5] = bfhi(z0.z); z[6] = bflo(z0.w); z[7] = bfhi(z0.w);
        u8[0] = bflo(uu.x); u8[1] = bfhi(uu.x); u8[2] = bflo(uu.y); u8[3] = bfhi(uu.y); u8[4] = bflo(uu.z); u8[5] = bfhi(uu.z); u8[6] = bflo(uu.w); u8[7] = bfhi(uu.w);
        if (ri.t >= 1) { const u32x4 w = *(const u32x4*)(zp - DFF); z1[0] = bflo(w.x); z1[1] = bfhi(w.x); z1[2] = bflo(w.y); z1[3] = bfhi(w.y); z1[4] = bflo(w.z); z1[5] = bfhi(w.z); z1[6] = bflo(w.w); z1[7] = bfhi(w.w); }
        else {
#pragma unroll
            for (int j = 0; j < 8; ++j) z1[j] = ri.samp ? sc[((size_t)ri.b * 2 + 1) * DFF + ch + j] : 0.f; }
        if (ri.t >= 2) { const u32x4 w = *(const u32x4*)(zp - 2 * DFF); z2[0] = bflo(w.x); z2[1] = bfhi(w.x); z2[2] = bflo(w.y); z2[3] = bfhi(w.y); z2[4] = bflo(w.z); z2[5] = bfhi(w.z); z2[6] = bflo(w.w); z2[7] = bfhi(w.w); }
        else {
#pragma unroll
            for (int j = 0; j < 8; ++j) z2[j] = ri.samp ? sc[((size_t)ri.b * 2 + ri.t) * DFF + ch + j] : 0.f; }
        float hd[8];
#pragma unroll
        for (int j = 0; j < 8; ++j) { const float zc = cb[ch + j] + cw[ch + j] * z2[j] + cw[DFF + ch + j] * z1[j] + cw[2 * DFF + ch + j] * z[j]; hd[j] = zc * sigmoidf_(zc) * u8[j]; }
        u32x4 w; w.x = pk2(hd[0], hd[1]); w.y = pk2(hd[2], hd[3]); w.z = pk2(hd[4], hd[5]); w.w = pk2(hd[6], hd[7]);
        *(u32x4*)(HID + (size_t)m * DFF + ch) = w;
    }
}

constexpr int NPHASE = 10;
__global__ void __launch_bounds__(NT, 2) fwd_megakernel(Args args) {
    extern __shared__ __attribute__((aligned(16))) unsigned char lds_raw[];
    Frame F;
    F.lds = (LAS unsigned char*)lds_raw; F.ws = args.ws; F.out = args.out; F.in = args.in;
    F.tid = threadIdx.x; F.lane = F.tid & 63; F.wave = __builtin_amdgcn_readfirstlane(F.tid >> 6); F.G = gridDim.x; F.bid = blockIdx.x;
    const int lo = args.ph_lo, hi = args.ph_hi;
#ifndef PH_MASK
#define PH_MASK 0x3ff
#endif
#ifndef DUP_MASK
#define DUP_MASK 0
#endif
#define IN(k) (((PH_MASK >> (k)) & 1) && lo <= (k) && (k) < hi)
#define REP(k) for (int rep_ = 0; rep_ < 1 + ((DUP_MASK >> (k)) & 1); ++rep_)
    unsigned* barw = (unsigned*)F.ws;
    volatile LAS unsigned* bst = (volatile LAS unsigned*)(F.lds + LDS_BYTES - 64);
    if (F.tid < 2) bst[F.tid] = 0u;
    XcdBarrier xbar; xbar.bar = barw; xbar.x = 0; xbar.st = bst;
    bool posted = false;
    if (lo + 1 < hi && F.bid == 0) { for (int i = F.tid; i < XCD_BAR_WORDS; i += NT) barw[i] = 0u; }
#define SEAM(k) do { if (IN(k) && IN((k) + 1)) { if (!posted) { cg::this_grid().sync(); xbar = xcd_barrier_post(barw, bst); posted = true; } else xcd_barrier(xbar); } } while (0)
    bf16_t* XN = (bf16_t*)(F.ws + WS_XN);
    if (IN(0)) REP(0) { p0_prologue(F); } SEAM(0);
    if (IN(1)) REP(1) {
        pg8::Gemm g{XN, (const bf16_t*)(F.ws + WS_WIN), M, DINP, DM, DM, DM, 0}; pg8::StaticOrder S; S.init(M, DINP, F.G, F.bid);
        Epi1 E{(const float*)(F.ws + WS_ROPE), (bf16_t*)(F.ws + WS_Q), (bf16_t*)(F.ws + WS_K), (bf16_t*)(F.ws + WS_VT), (bf16_t*)(F.ws + WS_HRW), F.out};
        pg8::gemm_phase<Epi1, true>(F.lds, g, S, E);
    } SEAM(1);
    if (IN(2)) REP(2) { prep_phase(F); sample_attn_phase(F); } SEAM(2);
    if (IN(3)) {
        for (int u = F.bid; u < NB * 64 * 2; u += F.G) prompt_attn_unit(F, u);
        sample_scan(F, F.bid, F.G);
        for (int sb = F.bid; sb < 256; sb += F.G) prompt_scan(F, sb);
    } SEAM(3);
    if (IN(4)) REP(4) { post_phase(F); } SEAM(4);
    if (IN(5)) REP(5) {
        pg8::Gemm g{(const bf16_t*)(F.ws + WS_OCAT), (const bf16_t*)(F.ws + WS_WOUT), M, DM, DM, DM, DM, 0}; pg8::StaticOrder S; S.init(M, DM, F.G, F.bid);
        EpiBf16 E{(bf16_t*)(F.ws + WS_MIX), DM};
        pg8::gemm_phase<EpiBf16, true>(F.lds, g, S, E);
    } SEAM(5);
    if (IN(6)) { rows_mid(F); } SEAM(6);
    if (IN(7)) REP(7) {
        pg8::Gemm g{XN, (const bf16_t*)(F.ws + WS_WFI), 136 * 256, 2 * DFF, DM, DM, DM, 1}; pg8::StaticOrder S; S.init(136 * 256, 2 * DFF, F.G, F.bid);
        EpiConv E{(bf16_t*)(F.ws + WS_HID), F.out, F.in[25], F.in[26], F.in[6], (LAS float*)(F.lds + 131072)};
        pg8::gemm_phase<EpiConv, true>(F.lds, g, S, E);
    } SEAM(7);
    if (IN(8)) REP(11) {
        pg8::Gemm g{(const bf16_t*)(F.ws + WS_HID), (const bf16_t*)(F.ws + WS_WFO), M, DM, DFF, DFF, DFF, 0}; pg8::StaticOrder S; S.init(M, DM, F.G, F.bid);
        EpiBf16 E{(bf16_t*)(F.ws + WS_F), DM};
        pg8::gemm_phase<EpiBf16, true>(F.lds, g, S, E);
    } SEAM(8);
    if (IN(9)) { rows_final(F); }
#undef IN
#undef SEAM
}

extern "C" void kernel_launch(void* const* d_in, const int* in_sizes, int n_in, void* d_out, int out_size, void* d_ws, size_t ws_size, hipStream_t stream) {
    static int grid = 0;
    if (grid == 0) {
        if (n_in != 29 || ws_size < WS_END) { fprintf(stderr, "kernel_launch: unexpected n_in %d / ws_size %zu\n", n_in, ws_size); grid = -1; return; }
        int dev = 0, cus = 0, per_cu = 0;
        hipGetDevice(&dev); hipDeviceGetAttribute(&cus, hipDeviceAttributeMultiprocessorCount, dev);
        if (hipFuncSetAttribute((const void*)fwd_megakernel, hipFuncAttributeMaxDynamicSharedMemorySize, LDS_BYTES) != hipSuccess) { fprintf(stderr, "kernel_launch: hipFuncSetAttribute failed\n"); grid = -1; return; }
        if (hipOccupancyMaxActiveBlocksPerMultiprocessor(&per_cu, (const void*)fwd_megakernel, NT, LDS_BYTES) != hipSuccess || per_cu < 1) { fprintf(stderr, "kernel_launch: occupancy query failed (%d)\n", per_cu); (void)hipGetLastError(); per_cu = 1; }
        grid = cus * (per_cu > 1 ? 1 : per_cu);
        fprintf(stderr, "kernel_launch: grid %d (cus %d, per_cu %d), ws %zu\n", grid, cus, per_cu, ws_size);
    }
    if (grid < 0) return;
    Args a{};
    for (int i = 0; i < 29; ++i) a.in[i] = (const float*)d_in[i];
    a.out = (float*)d_out; a.ws = (unsigned char*)d_ws;
#if MK_PER_PHASE
    for (int p = 0; p < NPHASE; ++p) { a.ph_lo = p; a.ph_hi = p + 1; hipLaunchKernelGGL(fwd_megakernel, dim3(grid), dim3(NT), LDS_BYTES, stream, a); }
#else
    a.ph_lo = 0; a.ph_hi = NPHASE;
    void* kargs[] = {&a};
    hipError_t e = hipLaunchCooperativeKernel((const void*)fwd_megakernel, dim3(grid), dim3(NT), kargs, LDS_BYTES, stream);
    if (e != hipSuccess) fprintf(stderr, "cooperative launch failed: %s (grid %d)\n", hipGetErrorString(e), grid);
#endif
}
```

```cpp
#include <hip/hip_runtime.h>
#include <hip/hip_cooperative_groups.h>
#include <cstdio>
#include <cstdint>
#include <utility>
namespace cg = cooperative_groups;

#ifndef MK_PER_PHASE
#define MK_PER_PHASE 0
#endif

#define LAS __attribute__((address_space(3)))
typedef unsigned short bf16_t;
typedef short bf16x8 __attribute__((ext_vector_type(8)));
typedef float f32x4 __attribute__((ext_vector_type(4)));
typedef float f32x2 __attribute__((ext_vector_type(2)));
typedef unsigned u32x4 __attribute__((ext_vector_type(4)));
typedef unsigned u32x2 __attribute__((ext_vector_type(2)));

constexpr int DM = 1024, NB = 4, T = 8192, MP = NB * T, DB = 128, DT = 8, MS = DB * DT, M = MP + MS;
constexpr int WIN = 128, DSH = 1696, DINP = 2560, DFF = 2816, DFFH = 1408;
constexpr float RMS_EPS = 1e-6f, GN_EPS = 64e-5f;
constexpr float QSCALE = 0.125f * 1.4426950408889634f;
constexpr size_t O_Y = 0, O_KWP = 34603008, O_VWP = 34668544, O_SHP = 34734080, O_WKVP = 34740864, O_CVP = 34871936,
                 O_KWS = 34894464, O_VWS = 36991616, O_SHS = 39088768, O_WKVS = 39305856, O_CVS = 43500160;
constexpr size_t MiB = 1u << 20;
constexpr size_t WS_WIN = 1 * MiB, WS_WOUT = 6 * MiB, WS_WFI = 8 * MiB, WS_WFO = 19 * MiB, WS_ROPE = 25 * MiB;
constexpr size_t WS_XN = 32 * MiB;
constexpr size_t WS_SR = 32 * MiB, WS_SK = 65 * MiB;
constexpr size_t WS_Q = 98 * MiB, WS_K = 131 * MiB, WS_VT = 140 * MiB;
constexpr size_t WS_HRW = 150 * MiB;
constexpr size_t WS_OCAT = 260 * MiB;
constexpr size_t WS_SW = 326 * MiB;
constexpr size_t WS_SV = 392 * MiB, WS_SKK = 425 * MiB, WS_SB = 458 * MiB;
constexpr size_t WS_ZU = 100 * MiB;
constexpr size_t WS_HID = 282 * MiB;
constexpr size_t WS_F = 216 * MiB;
constexpr size_t WS_MIX = 150 * MiB;
constexpr size_t WS_END = 491 * MiB;

__device__ __forceinline__ unsigned f2bf(float f) { unsigned u = __float_as_uint(f); return (u + 0x7fffu + ((u >> 16) & 1u)) >> 16; }

__device__ __forceinline__ float bf2f(unsigned short h) { return __uint_as_float(((unsigned)h) << 16); }
__device__ __forceinline__ float bflo(unsigned w) { return __uint_as_float(w << 16); }
__device__ __forceinline__ float bfhi(unsigned w) { return __uint_as_float(w & 0xffff0000u); }
__device__ __forceinline__ unsigned cvt_pk_bf16(float lo, float hi) { unsigned r; asm volatile("v_cvt_pk_bf16_f32 %0, %1, %2" : "=v"(r) : "v"(lo), "v"(hi)); return r; }
__device__ __forceinline__ unsigned pk2(float lo, float hi) { return cvt_pk_bf16(lo, hi); }
template <int CTRL> __device__ __forceinline__ float dppf(float x) { return __int_as_float(__builtin_amdgcn_update_dpp(0, __float_as_int(x), CTRL, 0xF, 0xF, false)); }
__device__ __forceinline__ float allsum16(float x) {
    x += dppf<0xB1>(x); x += dppf<0x4E>(x); x += dppf<0x141>(x); x += dppf<0x140>(x); return x;
}
__device__ __forceinline__ void allsum16_2(float& a, float& b) {
    a += dppf<0xB1>(a); b += dppf<0xB1>(b); a += dppf<0x4E>(a); b += dppf<0x4E>(b); a += dppf<0x141>(a); b += dppf<0x141>(b); a += dppf<0x140>(a); b += dppf<0x140>(b);
}
__device__ __forceinline__ float wave_sum(float v) {
    v = allsum16(v);
    { auto r = __builtin_amdgcn_permlane16_swap(__float_as_uint(v), __float_as_uint(v), false, false); v = __uint_as_float(r[0]) + __uint_as_float(r[1]); }
    { auto r = __builtin_amdgcn_permlane32_swap(__float_as_uint(v), __float_as_uint(v), false, false); v = __uint_as_float(r[0]) + __uint_as_float(r[1]); }
    return v;
}
__device__ __forceinline__ float sigmoidf_(float x) { return __builtin_amdgcn_rcpf(1.0f + __expf(-x)); }

namespace pg8 {
constexpr int BM = 256, BK = 64, HALF = 128, HTB = HALF * BK * 2, STAGE_BYTES = 8 * HTB, NXCD = 8, WGM = 8;
__host__ __device__ __forceinline__ int lds_byte(int r, int c) { const int st = (r >> 4) * 2 + (c >> 5), rr = r & 15, cc = c & 31, ob = rr * 64 + cc * 2; return st * 1024 + (ob ^ (((ob >> 9) & 1) << 5)); }
__host__ __device__ __forceinline__ void stage_rc(int b, int& R, int& C) { const int st = b / 1024, sb = b % 1024, swz = sb ^ (((sb >> 9) & 1) << 5); R = (st >> 1) * 16 + swz / 64; C = (st & 1) * 32 + (swz % 64) / 2; }
__host__ __device__ __forceinline__ int perm32(int rho) { const int n = rho >> 4, i = rho & 15; return 8 * (i >> 2) + 4 * n + (i & 3); }
struct Unit { int pm, pn; };
struct Gemm { const bf16_t* A; const bf16_t* Bt; int M, N, K, lda, ldb, conv; };
__device__ __forceinline__ long arow(const Gemm& g, int pm) {
    if (!g.conv) return (long)pm * 256;
    if (pm < 132) { const int b = pm / 33; return (long)b * 8192 + 254 * (pm - 33 * b) - 2; }
    return 32768 + (long)(pm - 132) * 256;
}
struct StaticOrder {
    int nM, nN, nwg, G, c;
    __device__ void init(int M_, int N_, int G_, int c_) { nM = M_ / BM; nN = N_ / BM; nwg = nM * nN; G = G_; c = c_; }
    __device__ bool next(int i, Unit& u) const {
        const long L = (long)i * G + c; if (L >= nwg) return false;
        int wgid = (int)L; { const int q = nwg / NXCD, r = nwg % NXCD, xcd = wgid % NXCD, off = wgid / NXCD; wgid = (xcd < r ? xcd * (q + 1) : r * (q + 1) + (xcd - r) * q) + off; }
        const int nig = WGM * nN, gid = wgid / nig, fm = gid * WGM, gsz = (nM - fm) < WGM ? (nM - fm) : WGM;
        u.pm = fm + ((wgid % nig) % gsz); u.pn = (wgid % nig) / gsz; return true;
    }
};
template <class Epi, bool ALIGN_EPI>
__device__ __forceinline__ void gemm_phase(LAS unsigned char* lds, const Gemm g, const StaticOrder& S, const Epi& E) {
    const int tid = threadIdx.x, wid = __builtin_amdgcn_readfirstlane(tid >> 6), lane = tid & 63, wr = wid >> 2, wc = wid & 3, fr = lane & 15, fq = lane >> 4;
    const int nt = g.K / BK;
    unsigned voffA[2], voffB[2];
#pragma unroll
    for (int i = 0; i < 2; ++i) { int R, C; stage_rc(tid * 16 + i * 8192, R, C); const int Rb = (R & ~31) + perm32(R & 31);
        voffA[i] = (unsigned)(R * g.lda + C) * 2u; voffB[i] = (unsigned)(Rb * g.ldb + C) * 2u; }
    const size_t kstep = (size_t)(BK * 2);
    const size_t hstepA = (size_t)HALF * g.lda * 2, hstepB = (size_t)HALF * g.ldb * 2;
    const size_t rowA = (size_t)g.lda * 2, tstepB = 2 * hstepB;
    const unsigned ldsw = (unsigned)wid * 1024u;
    const int aoff = lds_byte(wr * 64 + fr, fq * 8), boff = lds_byte(wc * 32 + fr, fq * 8);
#define PG8_SA(b, h) (((b) * 2 + (h)) * HTB)
#define PG8_SB(b, h) ((4 + (b) * 2 + (h)) * HTB)
#define PG8_STAGE(bufoff, gbase, voff) do { _Pragma("unroll") for (int _i = 0; _i < 2; ++_i) \
        __builtin_amdgcn_global_load_lds((const unsigned*)((const char*)(gbase) + (voff)[_i]), (LAS unsigned*)(lds + (bufoff) + ldsw + _i * 8192), 16, 0, 0); } while (0)
#define PG8_LDA(dst, b, h) do { _Pragma("unroll") for (int m = 0; m < 4; ++m) _Pragma("unroll") for (int k = 0; k < 2; ++k) dst[m][k] = *(const LAS bf16x8*)(lds + PG8_SA(b, h) + aoff + m * 2048 + k * 1024); } while (0)
#define PG8_LDB(dst, b, h) do { _Pragma("unroll") for (int n = 0; n < 2; ++n) _Pragma("unroll") for (int k = 0; k < 2; ++k) dst[n][k] = *(const LAS bf16x8*)(lds + PG8_SB(b, h) + boff + n * 2048 + k * 1024); } while (0)
#define PG8_MMA(ai, bj, At, Bt) do { __builtin_amdgcn_s_setprio(1); _Pragma("unroll") for (int m = 0; m < 4; ++m) _Pragma("unroll") for (int n = 0; n < 2; ++n) _Pragma("unroll") for (int k = 0; k < 2; ++k) \
        acc[ai][bj][m][n] = __builtin_amdgcn_mfma_f32_16x16x32_bf16(Bt[n][k], At[m][k], acc[ai][bj][m][n], 0, 0, 0); __builtin_amdgcn_s_setprio(0); } while (0)
#define PG8_WAIT_V(n) asm volatile("s_waitcnt vmcnt(" #n ")" ::: "memory")
#define PG8_WAIT_L(n) asm volatile("s_waitcnt lgkmcnt(" #n ")" ::: "memory")
#define PG8_BAR __builtin_amdgcn_s_barrier()
#define PG8_SCHED __builtin_amdgcn_sched_barrier(0)
    Unit cur, nxt; int ui = 0;
    if (!S.next(0, cur)) return;
    f32x4 acc[2][2][4][2];
#pragma unroll
    for (int a = 0; a < 2; ++a)
#pragma unroll
        for (int b = 0; b < 2; ++b)
#pragma unroll
            for (int m = 0; m < 4; ++m)
#pragma unroll
                for (int n = 0; n < 2; ++n) acc[a][b][m][n] = (f32x4){0.f, 0.f, 0.f, 0.f};
    bf16x8 At[4][2], B0[2][2], B1[2][2];
    const char* cA = (const char*)g.A + arow(g, cur.pm) * (long)rowA; const char* cB = (const char*)g.Bt + (size_t)cur.pn * tstepB;
    PG8_STAGE(PG8_SB(0, 0), cB, voffB); PG8_STAGE(PG8_SB(0, 1), cB + hstepB, voffB); PG8_STAGE(PG8_SA(0, 0), cA, voffA); PG8_STAGE(PG8_SA(0, 1), cA + hstepA, voffA);
    if (wr == 1) PG8_BAR;
    PG8_WAIT_V(2); PG8_BAR;
    PG8_STAGE(PG8_SB(1, 0), cB + kstep, voffB); PG8_STAGE(PG8_SA(1, 0), cA + kstep, voffA); PG8_STAGE(PG8_SB(1, 1), cB + hstepB + kstep, voffB);
    PG8_WAIT_V(6); PG8_BAR;
    for (;;) {
        const bool has_next = S.next(ui + 1, nxt);
        const char* nA = has_next ? (const char*)g.A + arow(g, nxt.pm) * (long)rowA : cA; const char* nB = has_next ? (const char*)g.Bt + (size_t)nxt.pn * tstepB : cB;
        for (int t = 0; t < nt; t += 2) {
            const bool last = (t == nt - 2);
            const char* a1 = cA + (size_t)(t + 1) * kstep;
            const char* a2 = last ? nA : cA + (size_t)(t + 2) * kstep; const char* b2 = last ? nB : cB + (size_t)(t + 2) * kstep;
            const char* a3 = a2 + kstep; const char* b3 = b2 + kstep;
            PG8_LDB(B0, 0, 0); PG8_LDB(B1, 0, 1); PG8_SCHED; PG8_LDA(At, 0, 0); PG8_STAGE(PG8_SA(1, 1), a1 + hstepA, voffA);
            PG8_WAIT_V(8); PG8_WAIT_L(0); PG8_BAR; PG8_MMA(0, 0, At, B0); PG8_MMA(0, 1, At, B1); PG8_BAR; PG8_SCHED;
            PG8_LDA(At, 0, 1); PG8_STAGE(PG8_SB(0, 0), b2, voffB); PG8_STAGE(PG8_SB(0, 1), b2 + hstepB, voffB); PG8_STAGE(PG8_SA(0, 0), a2, voffA);
            PG8_WAIT_V(8); PG8_WAIT_L(0); PG8_BAR; PG8_MMA(1, 0, At, B0); PG8_MMA(1, 1, At, B1); PG8_BAR; PG8_SCHED;
            PG8_LDB(B0, 1, 0); PG8_LDB(B1, 1, 1); PG8_SCHED; PG8_LDA(At, 1, 0); PG8_STAGE(PG8_SA(0, 1), a2 + hstepA, voffA);
            PG8_WAIT_V(8); PG8_WAIT_L(0); PG8_BAR; PG8_MMA(0, 0, At, B0); PG8_MMA(0, 1, At, B1); PG8_BAR; PG8_SCHED;
            PG8_LDA(At, 1, 1); PG8_STAGE(PG8_SB(1, 0), b3, voffB); PG8_STAGE(PG8_SB(1, 1), b3 + hstepB, voffB); PG8_STAGE(PG8_SA(1, 0), a3, voffA);
            PG8_WAIT_V(8); PG8_WAIT_L(0); PG8_BAR; PG8_MMA(1, 0, At, B0); PG8_MMA(1, 1, At, B1); PG8_BAR; PG8_SCHED;
        }
        if constexpr (ALIGN_EPI) { if (wr == 0) PG8_BAR; }
        asm volatile("s_nop 7\n\ts_nop 7" ::: "memory");
        E(acc, cur, wr, wc, fr, fq);
        if (!has_next) break;
#pragma unroll
        for (int a = 0; a < 2; ++a)
#pragma unroll
            for (int b = 0; b < 2; ++b)
#pragma unroll
                for (int m = 0; m < 4; ++m)
#pragma unroll
                    for (int n = 0; n < 2; ++n) acc[a][b][m][n] = (f32x4){0.f, 0.f, 0.f, 0.f};
        cur = nxt; cA = nA; cB = nB; ++ui;
        if constexpr (ALIGN_EPI) { if (wr == 1) PG8_BAR; }
    }
    PG8_WAIT_V(0);
    if constexpr (!ALIGN_EPI) { if (wr == 0) PG8_BAR; }
    PG8_BAR;
#undef PG8_SA
#undef PG8_SB
#undef PG8_STAGE
#undef PG8_LDA
#undef PG8_LDB
#undef PG8_MMA
#undef PG8_WAIT_V
#undef PG8_WAIT_L
#undef PG8_BAR
#undef PG8_SCHED
}
}

struct RowInfo { int b, t, samp; };
__device__ __forceinline__ RowInfo row_info(int row) { RowInfo r; if (row < MP) { r.samp = 0; r.b = row >> 13; r.t = row & (T - 1); } else { const int rs = row - MP; r.samp = 1; r.b = rs >> 3; r.t = rs & 7; } return r; }

struct Epi1 {
    const float* rope; bf16_t* Q; bf16_t* Kb; bf16_t* VT; bf16_t* HRW; float* out;
    __device__ __forceinline__ void operator()(const f32x4 (&acc)[2][2][4][2], const pg8::Unit& u, int wr, int wc, int fr, int fq) const {
#pragma unroll
        for (int ai = 0; ai < 2; ++ai)
#pragma unroll
            for (int m = 0; m < 4; ++m) {
                const int row = u.pm * 256 + ai * 128 + wr * 64 + m * 16 + fr;
                const RowInfo ri = row_info(row);
                const int pidx = ri.samp ? (T + ri.t) : ri.t;
#pragma unroll
                for (int bj = 0; bj < 2; ++bj) {
                    const int cb = u.pn * 256 + bj * 128;
                    const int c0 = cb + wc * 32 + fq * 8;
                    const f32x4 v0 = acc[ai][bj][m][0], v1 = acc[ai][bj][m][1];
                    if (cb < 640) {
                        const int d0 = ((c0 & 63) >> 3) * 4;
                        const f32x4* rp = (const f32x4*)(rope + ((size_t)pidx * 32 + d0) * 2);
                        const f32x4 cs0 = rp[0], cs1 = rp[1];
                        f32x4 o1, o2;
                        o1[0] = v0[0] * cs0[0] - v1[0] * cs0[1]; o2[0] = v1[0] * cs0[0] + v0[0] * cs0[1];
                        o1[1] = v0[1] * cs0[2] - v1[1] * cs0[3]; o2[1] = v1[1] * cs0[2] + v0[1] * cs0[3];
                        o1[2] = v0[2] * cs1[0] - v1[2] * cs1[1]; o2[2] = v1[2] * cs1[0] + v0[2] * cs1[1];
                        o1[3] = v0[3] * cs1[2] - v1[3] * cs1[3]; o2[3] = v1[3] * cs1[2] + v0[3] * cs1[3];
                        if (cb < 512) {
                            o1 = o1 * QSCALE; o2 = o2 * QSCALE;
                            bf16_t* qp = Q + (size_t)row * 512 + (c0 & ~63) + d0;
                            u32x2 w1, w2; w1.x = cvt_pk_bf16(o1[0], o1[1]); w1.y = cvt_pk_bf16(o1[2], o1[3]); w2.x = cvt_pk_bf16(o2[0], o2[1]); w2.y = cvt_pk_bf16(o2[2], o2[3]);
                            *(u32x2*)qp = w1; *(u32x2*)(qp + 32) = w2;
                        } else {
                            const int kvh = (c0 - 512) >> 6;
                            bf16_t* kp = Kb + (size_t)row * 128 + kvh * 64 + d0;
                            u32x2 w1, w2; w1.x = cvt_pk_bf16(o1[0], o1[1]); w1.y = cvt_pk_bf16(o1[2], o1[3]); w2.x = cvt_pk_bf16(o2[0], o2[1]); w2.y = cvt_pk_bf16(o2[2], o2[3]);
                            *(u32x2*)kp = w1; *(u32x2*)(kp + 32) = w2;
                            if (!ri.samp) { if (ri.t >= T - WIN) { float* o = out + O_KWP + ((size_t)(ri.b * WIN + (ri.t - (T - WIN))) * 2 + kvh) * 64 + d0; *(f32x4*)o = o1; *(f32x4*)(o + 32) = o2; } }
                            else { float* o = out + O_KWS + ((size_t)(ri.b * WIN + (WIN - DT) + ri.t) * 2 + kvh) * 64 + d0; *(f32x4*)o = o1; *(f32x4*)(o + 32) = o2; }
                        }
                    } else if (cb < 768) {
                        const int kvh = (c0 - 640) >> 6, d0 = (c0 - 640) & 63;
                        if (!ri.samp) {
                            bf16_t* vp = VT + ((size_t)(ri.b * 2 + kvh) * 64 + d0) * T + ri.t;
                            vp[0] = (bf16_t)f2bf(v0[0]); vp[(size_t)T] = (bf16_t)f2bf(v0[1]); vp[(size_t)2 * T] = (bf16_t)f2bf(v0[2]); vp[(size_t)3 * T] = (bf16_t)f2bf(v0[3]);
                            vp[(size_t)4 * T] = (bf16_t)f2bf(v1[0]); vp[(size_t)5 * T] = (bf16_t)f2bf(v1[1]); vp[(size_t)6 * T] = (bf16_t)f2bf(v1[2]); vp[(size_t)7 * T] = (bf16_t)f2bf(v1[3]);
                            if (ri.t >= T - WIN) { float* o = out + O_VWP + ((size_t)(ri.b * WIN + (ri.t - (T - WIN))) * 2 + kvh) * 64 + d0; *(f32x4*)o = v0; *(f32x4*)(o + 4) = v1; }
                        } else { float* o = out + O_VWS + ((size_t)(ri.b * WIN + (WIN - DT) + ri.t) * 2 + kvh) * 64 + d0; *(f32x4*)o = v0; *(f32x4*)(o + 4) = v1; }
                    } else if (c0 < 2464) {
                        const int col = c0 - 768;
                        u32x4 w; w.x = cvt_pk_bf16(v0[0], v0[1]); w.y = cvt_pk_bf16(v0[2], v0[3]); w.z = cvt_pk_bf16(v1[0], v1[1]); w.w = cvt_pk_bf16(v1[2], v1[3]);
                        *(u32x4*)(HRW + (size_t)row * DSH + col) = w;
                        if (!ri.samp) { if (ri.t == T - 1) { float* o = out + O_SHP + (size_t)ri.b * DSH + col; *(f32x4*)o = v0; *(f32x4*)(o + 4) = v1; } }
                        else if (ri.t == DT - 1) { float* o = out + O_SHS + (size_t)ri.b * DSH + col; *(f32x4*)o = v0; *(f32x4*)(o + 4) = v1; }
                    }
                }
            }
    }
};
struct EpiF32 {
    float* O; int ldc;
    __device__ __forceinline__ void operator()(const f32x4 (&acc)[2][2][4][2], const pg8::Unit& u, int wr, int wc, int fr, int fq) const {
#pragma unroll
        for (int ai = 0; ai < 2; ++ai)
#pragma unroll
            for (int m = 0; m < 4; ++m) {
                float* rowp = O + (size_t)(u.pm * 256 + ai * 128 + wr * 64 + m * 16 + fr) * ldc + u.pn * 256 + wc * 32 + fq * 8;
#pragma unroll
                for (int bj = 0; bj < 2; ++bj) { *(f32x4*)(rowp + bj * 128) = acc[ai][bj][m][0]; *(f32x4*)(rowp + bj * 128 + 4) = acc[ai][bj][m][1]; }
            }
    }
};
struct EpiBf16 {
    bf16_t* O; int ldc;
    __device__ __forceinline__ void operator()(const f32x4 (&acc)[2][2][4][2], const pg8::Unit& u, int wr, int wc, int fr, int fq) const {
#pragma unroll
        for (int ai = 0; ai < 2; ++ai)
#pragma unroll
            for (int m = 0; m < 4; ++m) {
                bf16_t* rowp = O + (size_t)(u.pm * 256 + ai * 128 + wr * 64 + m * 16 + fr) * ldc + u.pn * 256 + wc * 32 + fq * 8;
#pragma unroll
                for (int bj = 0; bj < 2; ++bj) { const f32x4 v0 = acc[ai][bj][m][0], v1 = acc[ai][bj][m][1];
                    u32x4 w; w.x = cvt_pk_bf16(v0[0], v0[1]); w.y = cvt_pk_bf16(v0[2], v0[3]); w.z = cvt_pk_bf16(v1[0], v1[1]); w.w = cvt_pk_bf16(v1[2], v1[3]);
                    *(u32x4*)(rowp + bj * 128) = w; }
            }
    }
};
template <int CTRL> __device__ __forceinline__ float dpp_old(float old, float src) { return __int_as_float(__builtin_amdgcn_update_dpp(__float_as_int(old), __float_as_int(src), CTRL, 0xF, 0xF, false)); }
struct EpiConv {
    bf16_t* HID; float* out; const float* cw; const float* cb; const float* sc; LAS float* exch;
    __device__ __forceinline__ void operator()(const f32x4 (&acc)[2][2][4][2], const pg8::Unit& u, int wr, int wc, int fr, int fq) const {
        const int cw8 = wc * 32 + fq * 8, ch0 = u.pn * 128 + cw8;
        if (fr >= 14) {
#pragma unroll
            for (int ai = 0; ai < 2; ++ai)
#pragma unroll
                for (int n = 0; n < 2; ++n) *(LAS f32x4*)(exch + ((ai * 2 + wr) * 2 + (fr - 14)) * 128 + cw8 + 4 * n) = acc[ai][0][3][n];
        }
        asm volatile("s_waitcnt lgkmcnt(0)\n\ts_barrier" ::: "memory");
        int row0, b0 = 0, i0 = 0; const bool samp = u.pm >= 132;
        if (!samp) { b0 = u.pm / 33; i0 = u.pm - 33 * b0; row0 = b0 * T + 254 * i0 - 2; } else row0 = MP + (u.pm - 132) * 256;
        f32x4 w0[2], w1[2], w2[2], bb[2];
#pragma unroll
        for (int n = 0; n < 2; ++n) { w0[n] = *(const f32x4*)(cw + ch0 + 4 * n); w1[n] = *(const f32x4*)(cw + DFF + ch0 + 4 * n); w2[n] = *(const f32x4*)(cw + 2 * DFF + ch0 + 4 * n); bb[n] = *(const f32x4*)(cb + ch0 + 4 * n); }
#pragma unroll
        for (int ai = 0; ai < 2; ++ai) {
            const int strip = ai * 2 + wr;
            f32x4 h1[2], h2[2];
#pragma unroll
            for (int n = 0; n < 2; ++n) {
                if (strip > 0) { h1[n] = *(const LAS f32x4*)(exch + ((strip - 1) * 2 + 1) * 128 + cw8 + 4 * n); h2[n] = *(const LAS f32x4*)(exch + ((strip - 1) * 2) * 128 + cw8 + 4 * n); }
                else { h1[n] = (f32x4){0.f, 0.f, 0.f, 0.f}; h2[n] = (f32x4){0.f, 0.f, 0.f, 0.f}; }
            }
#pragma unroll
            for (int m = 0; m < 4; ++m) {
                const int lr = ai * 128 + wr * 64 + m * 16 + fr;
                int t, b; bool valid;
                if (!samp) { t = 254 * i0 + lr - 2; b = b0; valid = lr >= 2 && t < T; } else { const int rs = row0 - MP + lr; b = rs >> 3; t = rs & 7; valid = true; }
                const size_t R = (size_t)((long)row0 + lr);
                f32x4 hd[2];
#pragma unroll
                for (int n = 0; n < 2; ++n) {
                    const f32x4 z = acc[ai][0][m][n], uu = acc[ai][1][m][n];
                    f32x4 o1, o2, zm1, zm2;
                    if (m == 0) { o1 = h1[n]; o2 = (fr == 0) ? h2[n] : h1[n]; }
                    else {
#pragma unroll
                        for (int e = 0; e < 4; ++e) { o1[e] = dppf<0x121>(acc[ai][0][m > 0 ? m - 1 : 0][n][e]); o2[e] = dppf<0x122>(acc[ai][0][m > 0 ? m - 1 : 0][n][e]); }
                    }
#pragma unroll
                    for (int e = 0; e < 4; ++e) { zm1[e] = dpp_old<0x111>(o1[e], z[e]); zm2[e] = dpp_old<0x112>(o2[e], z[e]); }
                    if (t == 0) {
                        if (samp) { zm1 = *(const f32x4*)(sc + ((size_t)b * 2 + 1) * DFF + ch0 + 4 * n); zm2 = *(const f32x4*)(sc + ((size_t)b * 2) * DFF + ch0 + 4 * n); }
                        else { zm1 = (f32x4){0.f, 0.f, 0.f, 0.f}; zm2 = (f32x4){0.f, 0.f, 0.f, 0.f}; }
                    } else if (t == 1) {
                        if (samp) zm2 = *(const f32x4*)(sc + ((size_t)b * 2 + 1) * DFF + ch0 + 4 * n); else zm2 = (f32x4){0.f, 0.f, 0.f, 0.f};
                    }
                    const f32x4 zc = bb[n] + w0[n] * zm2 + w1[n] * zm1 + w2[n] * z;
#pragma unroll
                    for (int e = 0; e < 4; ++e) hd[n][e] = zc[e] * sigmoidf_(zc[e]) * uu[e];
                }
                if (valid) {
                    u32x4 w; w.x = cvt_pk_bf16(hd[0][0], hd[0][1]); w.y = cvt_pk_bf16(hd[0][2], hd[0][3]); w.z = cvt_pk_bf16(hd[1][0], hd[1][1]); w.w = cvt_pk_bf16(hd[1][2], hd[1][3]);
                    *(u32x4*)(HID + R * DFF + ch0) = w;
                    if (!samp) { if (t >= T - 2) { float* o = out + O_CVP + (size_t)(b * 2 + (t - (T - 2))) * DFF + ch0; *(f32x4*)o = acc[ai][0][m][0]; *(f32x4*)(o + 4) = acc[ai][0][m][1]; } }
                    else if (t >= DT - 2) { float* o = out + O_CVS + (size_t)(b * 2 + (t - (DT - 2))) * DFF + ch0; *(f32x4*)o = acc[ai][0][m][0]; *(f32x4*)(o + 4) = acc[ai][0][m][1]; }
                }
            }
        }
    }
};

#define XB_TMO      128
#define XB_XCNT(j)  (256  + 64 * (j))
#define XB_XSUB(j)  (1280 + 64 * (j))
#define XB_XGEN(j)  (2304 + 64 * (j))
#define XB_TOP      3328
#define XB_TOPGEN   3392
#define XCD_BAR_WORDS 3456
#define XB_SPIN_CAP (1u << 20)
__device__ __forceinline__ unsigned xb_ld(unsigned* p)              { return __hip_atomic_load(p, __ATOMIC_RELAXED, __HIP_MEMORY_SCOPE_AGENT); }
__device__ __forceinline__ unsigned xb_add(unsigned* p, unsigned v) { return __hip_atomic_fetch_add(p, v, __ATOMIC_RELAXED, __HIP_MEMORY_SCOPE_AGENT); }
__device__ __forceinline__ unsigned xb_xcc_id() { return (unsigned)__builtin_amdgcn_s_getreg((3 << 11) | 20) & 0xFu; }
#define XB_SPIN(cond, bar) do { unsigned _sp = 0; while (cond) { __builtin_amdgcn_s_sleep(1); \
    if ((++_sp & 255u) == 0u) { if (xb_ld(&(bar)[XB_TMO])) break; if (_sp > XB_SPIN_CAP) { atomicAdd(&(bar)[XB_TMO], 1u); break; } } } } while (0)
struct XcdBarrier { unsigned* bar; unsigned x; volatile LAS unsigned* st; };
__device__ __forceinline__ XcdBarrier xcd_barrier_post(unsigned* bar, volatile LAS unsigned* st) {
    XcdBarrier b; b.bar = bar; b.x = xb_xcc_id(); b.st = st;
    if (threadIdx.x == 0) (void)xb_add(&bar[XB_XCNT(b.x)], 1u);
    return b;
}
__device__ __forceinline__ void xcd_barrier_complete(unsigned* bar, unsigned x, unsigned& nloc, unsigned& nx) {
    const unsigned G = gridDim.x * gridDim.y * gridDim.z;
    unsigned sum, cnt, mine, sp = 0u;
    for (;;) {
        sum = 0u; cnt = 0u; mine = 0u;
#pragma unroll
        for (unsigned j = 0; j < 16; ++j) { const unsigned c = xb_ld(&bar[XB_XCNT(j)]); sum += c; cnt += (c > 0u) ? 1u : 0u; mine = (j == x) ? c : mine; }
        if (sum == G) break;
        __builtin_amdgcn_s_sleep(1);
        if ((++sp & 255u) == 0u) { if (xb_ld(&bar[XB_TMO])) break; if (sp > XB_SPIN_CAP) { atomicAdd(&bar[XB_TMO], 1u); break; } }
    }
    nloc = mine > 0u ? mine : 1u; nx = cnt > 0u ? cnt : 1u;
}
__device__ __forceinline__ void xcd_barrier(const XcdBarrier& b) {
    asm volatile("s_waitcnt vmcnt(0)" ::: "memory");
    __syncthreads();
    if (threadIdx.x == 0) {
        unsigned* bar = b.bar;
        __builtin_amdgcn_s_waitcnt(0);
        unsigned nloc = b.st[0], nx = b.st[1];
        if (nloc == 0u) { xcd_barrier_complete(bar, b.x, nloc, nx); b.st[0] = nloc; b.st[1] = nx; }
        const unsigned old = xb_add(&bar[XB_XSUB(b.x)], 1u);
        const unsigned gen = old / nloc;
        if (old + 1u == (gen + 1u) * nloc) {
            __builtin_amdgcn_fence(__ATOMIC_RELEASE, "agent");
            asm volatile("s_waitcnt vmcnt(0)" ::: "memory");
            const unsigned og = xb_add(&bar[XB_TOP], 1u);
            const unsigned tg = og / nx;
            if (og + 1u == (tg + 1u) * nx) xb_add(&bar[XB_TOPGEN], 1u);
            else XB_SPIN(xb_ld(&bar[XB_TOPGEN]) == tg, bar);
            __builtin_amdgcn_fence(__ATOMIC_ACQUIRE, "agent");
            xb_add(&bar[XB_XGEN(b.x)], 1u);
            asm volatile("s_waitcnt vmcnt(0)" ::: "memory");
        } else {
            XB_SPIN(xb_ld(&bar[XB_XGEN(b.x)]) == gen, bar);
            __builtin_amdgcn_fence(__ATOMIC_ACQUIRE, "agent");
            asm volatile("s_waitcnt vmcnt(0)" ::: "memory");
        }
    }
    __syncthreads();
}

constexpr int NWAVES = 8, NT = 512;
constexpr int LDS_BYTES = 163840;
constexpr int YP_OFF = 129536;
struct Args { const float* in[29]; float* out; unsigned char* ws; int ph_lo, ph_hi; };
struct Frame {
    LAS unsigned char* lds; unsigned char* ws; float* out; const float* const* in;
    int tid, lane, wave, G, bid;
};
__device__ __forceinline__ const float* xrow_ptr(const Frame& F, int m) { return m < MP ? F.in[0] + (size_t)m * DM : F.in[1] + (size_t)(m - MP) * DM; }

template <class MAP>
__device__ __forceinline__ void p0_transpose_item(const float* W, int K, int N, int Nout, bf16_t* WT, LAS float* scr, int item, int lane, MAP map) {
    const int nblk = Nout / 32, kb = item / nblk, nb = item % nblk, k0 = 64 * kb, n0 = 32 * nb;
    const int src = map(n0 + (lane & 31));
    float tv[32];
#pragma unroll
    for (int i = 0; i < 32; ++i) { const int kk = 2 * i + (lane >> 5); tv[i] = src >= 0 ? W[(size_t)(k0 + kk) * N + src] : 0.f; }
#pragma unroll
    for (int i = 0; i < 32; ++i) { const int kk = 2 * i + (lane >> 5); scr[kk * 33 + (lane & 31)] = tv[i]; }
    asm volatile("s_waitcnt lgkmcnt(0)" ::: "memory");
    const int c = lane & 7;
#pragma unroll
    for (int j = 0; j < 4; ++j) { const int n = (lane >> 3) + 8 * j; const LAS float* s = scr + (8 * c) * 33 + n;
        u32x4 o; o.x = pk2(s[0 * 33], s[1 * 33]); o.y = pk2(s[2 * 33], s[3 * 33]); o.z = pk2(s[4 * 33], s[5 * 33]); o.w = pk2(s[6 * 33], s[7 * 33]);
        *(u32x4*)(WT + (size_t)(n0 + n) * K + k0 + 8 * c) = o; }
    asm volatile("s_waitcnt lgkmcnt(0)" ::: "memory");
}
struct MapIn { __device__ int operator()(int n) const { if (n < 640) { const int w = n & 63; return (n & ~63) + (w >> 3) * 4 + (w & 3) + 32 * ((w >> 2) & 1); } return n < 2464 ? n : -1; } };
struct MapId { __device__ int operator()(int n) const { return n; } };
struct MapFfn { __device__ int operator()(int n) const { const int tile = n >> 8, sub = n & 255, ch = tile * 128 + (sub & 127); return sub < 128 ? ch : DFF + ch; } };

__device__ __forceinline__ void p0_prologue(Frame& F) {
    LAS float* scr = (LAS float*)(F.lds + F.wave * 16384);
    const int gw = F.bid * NWAVES + F.wave, NGW = F.G * NWAVES;
    constexpr int I_IN = 16 * (DINP / 32), I_OUT = 16 * 32, I_FI = 16 * (2 * DFF / 32), I_FO = (DFF / 64) * 32;
    constexpr int NITEMS = I_IN + I_OUT + I_FI + I_FO;
#ifndef TR_DUP
#define TR_DUP 1
#endif
    for (int it_ = gw; it_ < NITEMS * TR_DUP; it_ += NGW) {
        const int it = it_ % NITEMS;
        int r = it;
        if (r < I_IN) { p0_transpose_item(F.in[8], DM, 2464, DINP, (bf16_t*)(F.ws + WS_WIN), scr, r, F.lane, MapIn()); continue; } r -= I_IN;
        if (r < I_OUT) { p0_transpose_item(F.in[21], DM, DM, DM, (bf16_t*)(F.ws + WS_WOUT), scr, r, F.lane, MapId()); continue; } r -= I_OUT;
        if (r < I_FI) { p0_transpose_item(F.in[24], DM, 2 * DFF, 2 * DFF, (bf16_t*)(F.ws + WS_WFI), scr, r, F.lane, MapFfn()); continue; } r -= I_FI;
        p0_transpose_item(F.in[27], DFF, DM, DM, (bf16_t*)(F.ws + WS_WFO), scr, r, F.lane, MapId());
    }
    float* rope = (float*)(F.ws + WS_ROPE);
    for (int e = F.bid * NT + F.tid; e < (T + DT) * 32; e += F.G * NT) {
        const int pidx = e >> 5, i = e & 31; const int pos = pidx < T ? pidx : 16384 + (pidx - T);
        const float inv = (float)exp2(-(double)i * (13.287712379549449 / 32.0));
        const float angf = (float)pos * inv;
        const double a = (double)angf;
        const double TWO_PI = 6.283185307179586476925286766559;
        const double n = rint(a / TWO_PI);
        const double r = a - n * TWO_PI;
        const double r2 = r * r;
        double c = 1.0, s = 1.0, tc = 1.0, ts = 1.0;
#pragma unroll
        for (int k = 1; k <= 14; ++k) { tc = -tc * r2 * (1.0 / (double)((2 * k - 1) * (2 * k))); ts = -ts * r2 * (1.0 / (double)((2 * k) * (2 * k + 1))); c += tc; s += ts; }
        s *= r;
        rope[(size_t)e * 2] = (float)c; rope[(size_t)e * 2 + 1] = (float)s;
    }
    const float* g = F.in[7];
    bf16_t* XN = (bf16_t*)(F.ws + WS_XN);
    for (int m = gw; m < M; m += 2 * NGW) {
        const int m1 = m + NGW; const bool has1 = m1 < M;
        const f32x4* xr0 = (const f32x4*)xrow_ptr(F, m) + F.lane; const f32x4* xr1 = (const f32x4*)xrow_ptr(F, has1 ? m1 : m) + F.lane;
        f32x4 v0[4], v1[4];
#pragma unroll
        for (int j = 0; j < 4; ++j) v0[j] = __builtin_nontemporal_load(xr0 + 64 * j);
#pragma unroll
        for (int j = 0; j < 4; ++j) v1[j] = __builtin_nontemporal_load(xr1 + 64 * j);
        float s0 = 0.f, s1 = 0.f;
#pragma unroll
        for (int j = 0; j < 4; ++j) { s0 += (v0[j].x * v0[j].x + v0[j].y * v0[j].y) + (v0[j].z * v0[j].z + v0[j].w * v0[j].w); s1 += (v1[j].x * v1[j].x + v1[j].y * v1[j].y) + (v1[j].z * v1[j].z + v1[j].w * v1[j].w); }
        const float r0 = 1.0f / sqrtf(wave_sum(s0) * (1.f / DM) + RMS_EPS), r1 = 1.0f / sqrtf(wave_sum(s1) * (1.f / DM) + RMS_EPS);
        u32x2* o0 = (u32x2*)(XN + (size_t)m * DM) + F.lane; u32x2* o1 = (u32x2*)(XN + (size_t)m1 * DM) + F.lane;
#pragma unroll
        for (int j = 0; j < 4; ++j) { const f32x4 gg = ((const f32x4*)g)[64 * j + F.lane];
            u32x2 w; w.x = pk2(v0[j].x * r0 * gg.x, v0[j].y * r0 * gg.y); w.y = pk2(v0[j].z * r0 * gg.z, v0[j].w * r0 * gg.w); o0[64 * j] = w;
            if (has1) { u32x2 q; q.x = pk2(v1[j].x * r1 * gg.x, v1[j].y * r1 * gg.y); q.y = pk2(v1[j].z * r1 * gg.z, v1[j].w * r1 * gg.w); o1[64 * j] = q; } }
    }
}

__device__ __forceinline__ float hprev_val(const Frame& F, const bf16_t* HRW, int m, int col) {
    const RowInfo ri = row_info(m);
    if (ri.t == 0) return ri.samp ? F.in[4][(size_t)ri.b * DSH + col] : 0.f;
    return bf2f(HRW[(size_t)(m - 1) * DSH + col]);
}
__device__ __forceinline__ f32x4 ld_bf4(const bf16_t* p) { const u32x2 w = *(const u32x2*)p; return (f32x4){bflo(w.x), bfhi(w.x), bflo(w.y), bfhi(w.y)}; }
__device__ __forceinline__ f32x4 hs4(const Frame& F, const bf16_t* HRW, int m, const RowInfo& ri, int col) {
    const f32x4 h = ld_bf4(HRW + (size_t)m * DSH + col);
    f32x4 hp;
    if (ri.t == 0) hp = ri.samp ? *(const f32x4*)(F.in[4] + (size_t)ri.b * DSH + col) : (f32x4){0.f, 0.f, 0.f, 0.f};
    else hp = ld_bf4(HRW + (size_t)(m - 1) * DSH + col);
    const f32x4 mu = *(const f32x4*)(F.in[10] + col);
    return h + (hp - h) * mu;
}
struct F8 { f32x4 a, b; };
__device__ __forceinline__ F8 ld_bf8(const bf16_t* p) { const u32x4 w = *(const u32x4*)p; F8 r; r.a = (f32x4){bflo(w.x), bfhi(w.x), bflo(w.y), bfhi(w.y)}; r.b = (f32x4){bflo(w.z), bfhi(w.z), bflo(w.w), bfhi(w.w)}; return r; }
__device__ __forceinline__ u32x4 pk8(const f32x4 a, const f32x4 b) { u32x4 w; w.x = cvt_pk_bf16(a[0], a[1]); w.y = cvt_pk_bf16(a[2], a[3]); w.z = cvt_pk_bf16(b[0], b[1]); w.w = cvt_pk_bf16(b[2], b[3]); return w; }
__device__ __forceinline__ F8 hs8(const Frame& F, const bf16_t* HRW, int m, const RowInfo& ri, int col) {
    const F8 h = ld_bf8(HRW + (size_t)m * DSH + col);
    F8 hp;
    if (ri.t == 0) {
        if (ri.samp) { hp.a = *(const f32x4*)(F.in[4] + (size_t)ri.b * DSH + col); hp.b = *(const f32x4*)(F.in[4] + (size_t)ri.b * DSH + col + 4); }
        else { hp.a = (f32x4){0.f, 0.f, 0.f, 0.f}; hp.b = (f32x4){0.f, 0.f, 0.f, 0.f}; }
    } else hp = ld_bf8(HRW + (size_t)(m - 1) * DSH + col);
    const f32x4 mua = *(const f32x4*)(F.in[10] + col), mub = *(const f32x4*)(F.in[10] + col + 4);
    F8 r; r.a = h.a + (hp.a - h.a) * mua; r.b = h.b + (hp.b - h.b) * mub; return r;
}
__device__ __forceinline__ float xsum_fq(float v) {
    { auto r = __builtin_amdgcn_permlane16_swap(__float_as_uint(v), __float_as_uint(v), false, false); v = __uint_as_float(r[0]) + __uint_as_float(r[1]); }
    { auto r = __builtin_amdgcn_permlane32_swap(__float_as_uint(v), __float_as_uint(v), false, false); v = __uint_as_float(r[0]) + __uint_as_float(r[1]); }
    return v;
}
__device__ __forceinline__ u32x2 pk4(const f32x4 v) { u32x2 w; w.x = cvt_pk_bf16(v[0], v[1]); w.y = cvt_pk_bf16(v[2], v[3]); return w; }
__device__ __forceinline__ bf16x8 wfrag(const float* W, int k0, int fq, int ch) {
    u32x4 w; const float* p = W + (size_t)(k0 + 8 * fq) * 512 + ch;
    w.x = cvt_pk_bf16(p[0], p[512]); w.y = cvt_pk_bf16(p[1024], p[1536]); w.z = cvt_pk_bf16(p[2048], p[2560]); w.w = cvt_pk_bf16(p[3072], p[3584]);
    return __builtin_bit_cast(bf16x8, w);
}
#ifndef PREP_DUP
#define PREP_DUP 1
#endif
#ifndef POST_DUP
#define POST_DUP 1
#endif
__device__ __forceinline__ void prep_phase(Frame& F) {
    const bf16_t* HRW = (const bf16_t*)(F.ws + WS_HRW);
    bf16_t* SR = (bf16_t*)(F.ws + WS_SR); bf16_t* SK = (bf16_t*)(F.ws + WS_SK); bf16_t* SV = (bf16_t*)(F.ws + WS_SV);
    bf16_t* SKK = (bf16_t*)(F.ws + WS_SKK); bf16_t* SB = (bf16_t*)(F.ws + WS_SB); float* SW = (float*)(F.ws + WS_SW);
    const int fr = F.lane & 15, fq = F.lane >> 4, h = F.wave;
    bf16x8 Aw[4], Aa[4];
#pragma unroll
    for (int nt = 0; nt < 4; ++nt) { const int ch = h * 64 + 16 * (fr >> 2) + 4 * nt + (fr & 3); Aw[nt] = wfrag(F.in[12], 0, fq, ch); Aa[nt] = wfrag(F.in[14], 0, fq, ch); }
    constexpr int NTILE = M / 16;
    for (int tile_ = F.bid; tile_ < NTILE * PREP_DUP; tile_ += F.G) {
        const int m = (tile_ % NTILE) * 16 + fr;
        const RowInfo ri = row_info(m);
        bf16x8 xw, xa;
        { const F8 a = hs8(F, HRW, m, ri, 1536 + 8 * fq);
          f32x4 t0, t1;
#pragma unroll
          for (int i = 0; i < 4; ++i) { t0[i] = 1.f - 2.f * __builtin_amdgcn_rcpf(__expf(2.f * a.a[i]) + 1.f); t1[i] = 1.f - 2.f * __builtin_amdgcn_rcpf(__expf(2.f * a.b[i]) + 1.f); }
          xw = __builtin_bit_cast(bf16x8, pk8(t0, t1)); }
        { const F8 a = hs8(F, HRW, m, ri, 1568 + 8 * fq); xa = __builtin_bit_cast(bf16x8, pk8(a.a, a.b)); }
        f32x4 kkr[4], av[4]; float ss = 0.f;
#pragma unroll
        for (int np = 0; np < 2; ++np) {
            const int c8 = h * 64 + 16 * fq + 8 * np;
            const f32x4 z = {0.f, 0.f, 0.f, 0.f};
            f32x4 accw[2], acca[2];
#pragma unroll
            for (int q = 0; q < 2; ++q) { accw[q] = __builtin_amdgcn_mfma_f32_16x16x32_bf16(Aw[2 * np + q], xw, z, 0, 0, 0); acca[q] = __builtin_amdgcn_mfma_f32_16x16x32_bf16(Aa[2 * np + q], xa, z, 0, 0, 0); }
            const F8 r8 = hs8(F, HRW, m, ri, c8), k8 = hs8(F, HRW, m, ri, 512 + c8), v8 = hs8(F, HRW, m, ri, 1024 + c8);
            f32x4 dec[2], k2[2];
#pragma unroll
            for (int q = 0; q < 2; ++q) {
                const int c4 = c8 + 4 * q;
                const f32x4 k = q ? k8.b : k8.a;
                const f32x4 w0 = *(const f32x4*)(F.in[11] + c4), a0 = *(const f32x4*)(F.in[13] + c4), kkc = *(const f32x4*)(F.in[16] + c4), kac = *(const f32x4*)(F.in[17] + c4);
                f32x4 a;
#pragma unroll
                for (int j = 0; j < 4; ++j) {
                    const float x = -(w0[j] + accw[q][j]);
                    const float sp = fmaxf(x, 0.f) + __logf(1.f + __expf(-fabsf(x)));
                    dec[q][j] = __expf(-__expf(-sp - 0.5f));
                    a[j] = sigmoidf_(a0[j] + acca[q][j]);
                    k2[q][j] = k[j] * (1.f + (a[j] - 1.f) * kac[j]);
                }
                const f32x4 kk = k * kkc;
                ss += (kk[0] * kk[0] + kk[1] * kk[1]) + (kk[2] * kk[2] + kk[3] * kk[3]);
                kkr[2 * np + q] = kk; av[2 * np + q] = a;
            }
            const size_t o = (size_t)m * 512 + c8;
            *(f32x4*)(SW + o) = dec[0]; *(f32x4*)(SW + o + 4) = dec[1];
            *(u32x4*)(SR + o) = pk8(r8.a, r8.b); *(u32x4*)(SK + o) = pk8(k2[0], k2[1]); *(u32x4*)(SV + o) = pk8(v8.a, v8.b);
        }
        ss = xsum_fq(ss);
        const float rs = rsqrtf(fmaxf(ss, 1e-24f));
#pragma unroll
        for (int np = 0; np < 2; ++np) {
            const size_t o = (size_t)m * 512 + h * 64 + 16 * fq + 8 * np;
            const f32x4 ka = kkr[2 * np] * rs, kb = kkr[2 * np + 1] * rs;
            *(u32x4*)(SKK + o) = pk8(ka, kb); *(u32x4*)(SB + o) = pk8(ka * av[2 * np], kb * av[2 * np + 1]);
        }
    }
}

__device__ __forceinline__ void sample_attn_phase(Frame& F) {
    constexpr int NK = WIN + DT, KS = 68;
    LAS float* Kl = (LAS float*)F.lds;
    LAS float* Vl = Kl + NK * KS;
    LAS float* Pl = Vl + NK * KS;
    const bf16_t* Q = (const bf16_t*)(F.ws + WS_Q);
    bf16_t* OC = (bf16_t*)(F.ws + WS_OCAT);
    for (int unit = F.bid; unit < DB * 2; unit += F.G) {
        const int b = unit >> 1, kvh = unit & 1;
        for (int e = F.tid; e < NK * 16; e += NT) {
            const int key = e >> 4, d4 = (e & 15) * 4;
            f32x4 kv, vv;
            if (key < WIN) { kv = *(const f32x4*)(F.in[2] + ((size_t)(b * WIN + key) * 2 + kvh) * 64 + d4); vv = *(const f32x4*)(F.in[3] + ((size_t)(b * WIN + key) * 2 + kvh) * 64 + d4); }
            else { kv = *(const f32x4*)(F.out + O_KWS + ((size_t)(b * WIN + key - DT) * 2 + kvh) * 64 + d4); vv = *(const f32x4*)(F.out + O_VWS + ((size_t)(b * WIN + key - DT) * 2 + kvh) * 64 + d4); }
            *(LAS f32x4*)(Kl + key * KS + d4) = kv; *(LAS f32x4*)(Vl + key * KS + d4) = vv;
            if (key >= DT && key < WIN) { *(f32x4*)(F.out + O_KWS + ((size_t)(b * WIN + key - DT) * 2 + kvh) * 64 + d4) = kv; *(f32x4*)(F.out + O_VWS + ((size_t)(b * WIN + key - DT) * 2 + kvh) * 64 + d4) = vv; }
        }
        __syncthreads();
        const int qi = F.tid >> 4, sub = F.tid & 15;
        const int t = qi >> 2, g = qi & 3, head = kvh * 4 + g;
        const int m = MP + b * DT + t;
        float mx = F.in[9][head] * 1.4426950408889634f;
        {
            const bf16_t* qp = Q + (size_t)m * 512 + head * 64;
            float q[64];
#pragma unroll
            for (int i = 0; i < 8; ++i) { const u32x4 w = *(const u32x4*)(qp + 8 * i); q[8 * i] = bflo(w.x); q[8 * i + 1] = bfhi(w.x); q[8 * i + 2] = bflo(w.y); q[8 * i + 3] = bfhi(w.y); q[8 * i + 4] = bflo(w.z); q[8 * i + 5] = bfhi(w.z); q[8 * i + 6] = bflo(w.w); q[8 * i + 7] = bfhi(w.w); }
#pragma unroll 1
            for (int key = sub; key < NK; key += 16) {
                float a = 0.f; const LAS f32x4* kr = (const LAS f32x4*)(Kl + key * KS);
#pragma unroll
                for (int i = 0; i < 16; ++i) { const f32x4 kx = kr[i]; a += q[4 * i] * kx[0] + q[4 * i + 1] * kx[1] + q[4 * i + 2] * kx[2] + q[4 * i + 3] * kx[3]; }
                const int dist = t + WIN - key;
                const float s = (dist >= 0 && dist <= WIN) ? a : -1e30f;
                Pl[qi * NK + key] = s; mx = fmaxf(mx, s);
            }
        }
        mx = fmaxf(mx, __shfl_xor(mx, 1)); mx = fmaxf(mx, __shfl_xor(mx, 2)); mx = fmaxf(mx, __shfl_xor(mx, 4)); mx = fmaxf(mx, __shfl_xor(mx, 8));
        float sum = 0.f;
#pragma unroll 1
        for (int key = sub; key < NK; key += 16) { const float sv = Pl[qi * NK + key]; const float p = sv > -1e29f ? __builtin_amdgcn_exp2f(sv - mx) : 0.f; sum += p; Pl[qi * NK + key] = p; }
        sum += __shfl_xor(sum, 1); sum += __shfl_xor(sum, 2); sum += __shfl_xor(sum, 4); sum += __shfl_xor(sum, 8);
        const float inv = __builtin_amdgcn_rcpf(sum + __builtin_amdgcn_exp2f(F.in[9][head] * 1.4426950408889634f - mx));
        __syncthreads();
        f32x4 o = {0.f, 0.f, 0.f, 0.f};
        for (int key = 0; key < NK; ++key) { const float p = Pl[qi * NK + key]; const f32x4 vv = *(const LAS f32x4*)(Vl + key * KS + sub * 4); o += vv * p; }
        o = o * inv;
        u32x2 w; w.x = pk2(o[0], o[1]); w.y = pk2(o[2], o[3]);
        *(u32x2*)(OC + (size_t)m * DM + head * 64 + sub * 4) = w;
        __syncthreads();
    }
}

__device__ __forceinline__ void prompt_attn_unit(Frame& F, int unit) {
    constexpr int KST = 144, VST = 528;
    LAS unsigned char* Kl = F.lds; LAS unsigned char* Vl = F.lds + 256 * KST;
    const bf16_t* Q = (const bf16_t*)(F.ws + WS_Q); const bf16_t* Kb = (const bf16_t*)(F.ws + WS_K); const bf16_t* VT = (const bf16_t*)(F.ws + WS_VT);
    bf16_t* OC = (bf16_t*)(F.ws + WS_OCAT);
    const int kvh = unit & 1, qb = (unit >> 1) & 63, b = unit >> 7;
    const int key0 = (qb - 1) * 128;
    for (int e = F.tid; e < 256 * 8; e += NT) {
        const int key = e >> 3, ch = e & 7; const int pos = key0 + key;
        u32x4 v = {0u, 0u, 0u, 0u};
        if (pos >= 0) v = *(const u32x4*)(Kb + (size_t)(b * T + pos) * 128 + kvh * 64 + ch * 8);
        *(LAS u32x4*)(Kl + key * KST + ch * 16) = v;
    }
    for (int e = F.tid; e < 64 * 32; e += NT) {
        const int d = e >> 5, ch = e & 31; const int pos = key0 + ch * 8;
        u32x4 v = {0u, 0u, 0u, 0u};
        if (pos >= 0) v = *(const u32x4*)(VT + ((size_t)(b * 2 + kvh) * 64 + d) * T + pos);
        *(LAS u32x4*)(Vl + d * VST + ch * 16) = v;
    }
    __syncthreads();
    const int fr = F.lane & 15, fq = F.lane >> 4;
    const int head = kvh * 4 + (F.wave >> 1);
    const float sink = F.in[9][head] * 1.4426950408889634f;
#pragma unroll 1
    for (int sb = 0; sb < 4; ++sb) {
        const int qi0 = (F.wave & 1) * 64 + sb * 16;
        const int qi = qi0 + fr;
        const size_t mrow = (size_t)b * T + qb * 128 + qi;
        const bf16x8 q0 = *(const bf16x8*)(Q + mrow * 512 + head * 64 + fq * 8);
        const bf16x8 q1 = *(const bf16x8*)(Q + mrow * 512 + head * 64 + 32 + fq * 8);
        const int ktlo = (F.wave & 1) * 4 + sb;
        f32x4 s[9];
#pragma unroll
        for (int kr = 0; kr < 9; ++kr) {
            const int kt = ktlo + kr;
            const bf16x8 k0 = *(const LAS bf16x8*)(Kl + (kt * 16 + fr) * KST + fq * 16);
            const bf16x8 k1 = *(const LAS bf16x8*)(Kl + (kt * 16 + fr) * KST + 64 + fq * 16);
            f32x4 a = {0.f, 0.f, 0.f, 0.f};
            a = __builtin_amdgcn_mfma_f32_16x16x32_bf16(k0, q0, a, 0, 0, 0);
            a = __builtin_amdgcn_mfma_f32_16x16x32_bf16(k1, q1, a, 0, 0, 0);
            s[kr] = a;
        }
        float mx = sink;
#pragma unroll
        for (int kr = 0; kr < 9; ++kr)
#pragma unroll
            for (int j = 0; j < 4; ++j) { const int sj = (ktlo + kr) * 16 + fq * 4 + j; const int dist = qi + 128 - sj; const bool ok = dist >= 0 && dist <= WIN && (key0 + sj) >= 0; const float v = ok ? s[kr][j] : -1e30f; s[kr][j] = v; mx = fmaxf(mx, v); }
        mx = fmaxf(mx, __shfl_xor(mx, 16)); mx = fmaxf(mx, __shfl_xor(mx, 32));
        float sum = 0.f;
        u32x2 pw[10];
#pragma unroll
        for (int kr = 0; kr < 9; ++kr) {
            f32x4 p;
#pragma unroll
            for (int j = 0; j < 4; ++j) { p[j] = s[kr][j] > -1e29f ? __builtin_amdgcn_exp2f(s[kr][j] - mx) : 0.f; sum += p[j]; }
            pw[kr].x = cvt_pk_bf16(p[0], p[1]); pw[kr].y = cvt_pk_bf16(p[2], p[3]);
        }
        pw[9].x = 0u; pw[9].y = 0u;
        sum += __shfl_xor(sum, 16); sum += __shfl_xor(sum, 32);
        const float inv = __builtin_amdgcn_rcpf(sum + __builtin_amdgcn_exp2f(sink - mx));
        f32x4 o[4];
#pragma unroll
        for (int dt = 0; dt < 4; ++dt) o[dt] = (f32x4){0.f, 0.f, 0.f, 0.f};
#pragma unroll
        for (int u = 0; u < 5; ++u) {
            u32x4 pb; pb.x = pw[2 * u].x; pb.y = pw[2 * u].y; pb.z = pw[2 * u + 1].x; pb.w = pw[2 * u + 1].y;
            const bf16x8 pf = __builtin_bit_cast(bf16x8, pb);
            const int kta = ktlo + 2 * u, ktb = u < 4 ? kta + 1 : kta;
#pragma unroll
            for (int dt = 0; dt < 4; ++dt) {
                const LAS unsigned char* vr = Vl + (dt * 16 + fr) * VST + (fq * 4) * 2;
                const u32x2 va = *(const LAS u32x2*)(vr + kta * 32), vb = *(const LAS u32x2*)(vr + ktb * 32);
                u32x4 vv; vv.x = va.x; vv.y = va.y; vv.z = vb.x; vv.w = vb.y;
                o[dt] = __builtin_amdgcn_mfma_f32_16x16x32_bf16(__builtin_bit_cast(bf16x8, vv), pf, o[dt], 0, 0, 0);
            }
        }
#pragma unroll
        for (int dt = 0; dt < 4; ++dt) { const f32x4 v = o[dt] * inv; u32x2 w; w.x = cvt_pk_bf16(v[0], v[1]); w.y = cvt_pk_bf16(v[2], v[3]); *(u32x2*)(OC + mrow * DM + head * 64 + dt * 16 + fq * 4) = w; }
    }
    __syncthreads();
}

struct StepOps { f32x4 w, nbe, kk, k, r; float v; };
template <int STRIDE_F> __device__ __forceinline__ StepOps load_ops(const LAS float* img, int s, int cgi, int vrow) {
    const LAS float* p = img + s * STRIDE_F + cgi * 4; StepOps o;
    o.w = *(const LAS f32x4*)(p); o.nbe = *(const LAS f32x4*)(p + 64); o.kk = *(const LAS f32x4*)(p + 128); o.k = *(const LAS f32x4*)(p + 192); o.r = *(const LAS f32x4*)(p + 256);
    o.v = img[s * STRIDE_F + 320 + vrow]; return o;
}
template <int J> __device__ __forceinline__ float sel_lane16(float oldv, float newv) {
    float r; const unsigned long long m = 0x0001000100010001ull << J;
    asm("v_cndmask_b32_e64 %0, %1, %2, %3" : "=v"(r) : "v"(oldv), "v"(newv), "s"(m));
    return r;
}
struct ScanState { f32x2 s01, s23; float ykeep, ypart; StepOps c0, c1; };
template <int STRIDE_F, int J>
__device__ __forceinline__ void scan_step(const LAS float* img, int s0, int vrow, int cgi, ScanState& Z) {
    const StepOps nx = load_ops<STRIDE_F>(img, s0 + J + 2, cgi, vrow);
    const StepOps& c = Z.c0;
    const f32x2 kk01 = {c.kk[0], c.kk[1]}, kk23 = {c.kk[2], c.kk[3]}, w01 = {c.w[0], c.w[1]}, w23 = {c.w[2], c.w[3]}, k01 = {c.k[0], c.k[1]}, k23 = {c.k[2], c.k[3]};
    const f32x2 b01 = {c.nbe[0], c.nbe[1]}, b23 = {c.nbe[2], c.nbe[3]}, r01 = {c.r[0], c.r[1]}, r23 = {c.r[2], c.r[3]};
    f32x2 t = Z.s01 * kk01; t = Z.s23 * kk23 + t;
    float sa = t.x + t.y;
    const f32x2 u01 = Z.s01 * w01 + k01 * c.v, u23 = Z.s23 * w23 + k23 * c.v;
    if (J > 0) { allsum16_2(sa, Z.ypart); Z.ykeep = sel_lane16<(J > 0 ? J - 1 : 0)>(Z.ykeep, Z.ypart); } else sa = allsum16(sa);
    Z.s01 = b01 * sa + u01; Z.s23 = b23 * sa + u23;
    f32x2 y2 = Z.s01 * r01; y2 = Z.s23 * r23 + y2;
    Z.ypart = y2.x + y2.y;
    Z.c0 = Z.c1; Z.c1 = nx;
}
template <int STRIDE_F, int GS, int... Js>
__device__ __forceinline__ void scan_group_impl(const LAS float* img, int s0, int vrow, int cgi, ScanState& Z, float* yout, std::integer_sequence<int, Js...>) {
    (scan_step<STRIDE_F, Js>(img, s0, vrow, cgi, Z), ...);
    Z.ypart = allsum16(Z.ypart); Z.ykeep = sel_lane16<GS - 1>(Z.ykeep, Z.ypart);
    if (cgi < GS) yout[(size_t)(s0 + cgi) * 512] = Z.ykeep;
}
template <int STRIDE_F, int J>
__device__ __forceinline__ void scan_step_yp(const LAS float* img, int s0, int vrow, int cgi, ScanState& Z, LAS float* ypb) {
    const StepOps nx = load_ops<STRIDE_F>(img, s0 + J + 2, cgi, vrow);
    const StepOps& c = Z.c0;
    const f32x2 kk01 = {c.kk[0], c.kk[1]}, kk23 = {c.kk[2], c.kk[3]}, w01 = {c.w[0], c.w[1]}, w23 = {c.w[2], c.w[3]}, k01 = {c.k[0], c.k[1]}, k23 = {c.k[2], c.k[3]};
    const f32x2 b01 = {c.nbe[0], c.nbe[1]}, b23 = {c.nbe[2], c.nbe[3]}, r01 = {c.r[0], c.r[1]}, r23 = {c.r[2], c.r[3]};
    f32x2 t = Z.s01 * kk01; t = Z.s23 * kk23 + t;
    float sa = t.x + t.y;
    const f32x2 u01 = Z.s01 * w01 + k01 * c.v, u23 = Z.s23 * w23 + k23 * c.v;
    sa = allsum16(sa);
    Z.s01 = b01 * sa + u01; Z.s23 = b23 * sa + u23;
    f32x2 y2 = Z.s01 * r01; y2 = Z.s23 * r23 + y2;
    ypb[(s0 + J) * 64] = y2.x + y2.y;
    Z.c0 = Z.c1; Z.c1 = nx;
}
struct StepOpsS { f32x4 nbe, kk, k, r; };
template <int STRIDE_F> __device__ __forceinline__ StepOpsS load_ops_s(const LAS float* img, int s, int cgi) {
    const LAS float* p = img + s * STRIDE_F + cgi * 4; StepOpsS o;
    o.nbe = *(const LAS f32x4*)(p + 64); o.kk = *(const LAS f32x4*)(p + 128); o.k = *(const LAS f32x4*)(p + 192); o.r = *(const LAS f32x4*)(p + 256);
    return o;
}
struct ScanT { f32x2 t01, t23; StepOpsS c0, c1; f32x4 v4[4]; };
template <int STRIDE_F, int J>
__device__ __forceinline__ void scan_step_s(const LAS float* img, int cgi, ScanT& Z, LAS float* ypb) {
    const StepOpsS nx = load_ops_s<STRIDE_F>(img, J + 2, cgi);
    const StepOpsS& c = Z.c0;
    const float v = Z.v4[J >> 2][J & 3];
    f32x2 t = Z.t01 * (f32x2){c.kk[0], c.kk[1]}; t = Z.t23 * (f32x2){c.kk[2], c.kk[3]} + t;
    float sa = t.x + t.y;
    const f32x2 a01 = (f32x2){c.k[0], c.k[1]} * v + Z.t01, a23 = (f32x2){c.k[2], c.k[3]} * v + Z.t23;
    sa = allsum16(sa);
    Z.t01 = (f32x2){c.nbe[0], c.nbe[1]} * sa + a01; Z.t23 = (f32x2){c.nbe[2], c.nbe[3]} * sa + a23;
    f32x2 y2 = Z.t01 * (f32x2){c.r[0], c.r[1]}; y2 = Z.t23 * (f32x2){c.r[2], c.r[3]} + y2;
    ypb[J * 64] = y2.x + y2.y;
    Z.c0 = Z.c1; Z.c1 = nx;
}
template <int STRIDE_F, int... Js>
__device__ __forceinline__ void scan_chunk_s_impl(const LAS float* img, int cgi, ScanT& Z, LAS float* ypb, std::integer_sequence<int, Js...>) {
    (scan_step_s<STRIDE_F, Js>(img, cgi, Z, ypb), ...);
}
template <int STRIDE_F, int NS>
__device__ __forceinline__ void scan_transform(LAS float* img, int lane) {
    LAS float* p = img + lane; float Wc = 1.f;
#pragma unroll
    for (int t = 0; t < NS; ++t, p += STRIDE_F) {
        const float w = p[0], nb = p[64], kk = p[128], k = p[192], r = p[256];
        p[128] = Wc * kk;
        Wc *= w; const float inv = __builtin_amdgcn_rcpf(Wc);
        p[64] = nb * inv; p[192] = k * inv; p[256] = Wc * r;
    }
    img[(NS - 1) * STRIDE_F + lane] = Wc;
}
template <int STRIDE_F, int... Js>
__device__ __forceinline__ void scan_group_yp_impl(const LAS float* img, int s0, int vrow, int cgi, ScanState& Z, LAS float* ypb, std::integer_sequence<int, Js...>) {
    (scan_step_yp<STRIDE_F, Js>(img, s0, vrow, cgi, Z, ypb), ...);
}
template <int... Js>
__device__ __forceinline__ void yp_reduce_impl(const LAS float* ypb, int cgi, float* yout, int s0, std::integer_sequence<int, Js...>) {
    float ykeep = 0.f;
    ((ykeep = sel_lane16<Js>(ykeep, allsum16(ypb[(s0 + Js) * 64]))), ...);
    yout[(size_t)(s0 + cgi) * 512] = ykeep;
}
template <int STRIDE_F, int GS>
__device__ __forceinline__ void scan_group(const LAS float* img, int s0, int vrow, int cgi, ScanState& Z, float* yout) {
    scan_group_impl<STRIDE_F, GS>(img, s0, vrow, cgi, Z, yout, std::make_integer_sequence<int, GS>());
}
constexpr int SC = 32;
constexpr int PSTR = 328;
constexpr int SSTR = 384;
struct ScanRegs { f32x4 w[2]; u32x4 b0[2], b1[2]; u32x4 v; };
__device__ __forceinline__ void scan_load(const Frame& F, ScanRegs& R, int m0, int h, int v0) {
    if (F.wave < 4) return;
    const int vt = F.tid - 256;
#pragma unroll
    for (int i = 0; i < 2; ++i) {
        const int tid = vt + 256 * i;
        { const int row = tid >> 4, c4 = (tid & 15) * 4; R.w[i] = *(const f32x4*)((const float*)(F.ws + WS_SW) + (size_t)(m0 + row) * 512 + h * 64 + c4); }
        { const int st = tid >> 7, row = (tid & 127) >> 2, seg = tid & 3;
          const size_t base = st == 0 ? WS_SB : st == 1 ? WS_SKK : st == 2 ? WS_SK : WS_SR;
          const bf16_t* p = (const bf16_t*)(F.ws + base) + (size_t)(m0 + row) * 512 + h * 64 + seg * 16;
          R.b0[i] = *(const u32x4*)p; R.b1[i] = *(const u32x4*)(p + 8); }
    }
    { R.v = *(const u32x4*)((const bf16_t*)(F.ws + WS_SV) + (size_t)(m0 + (vt & 31)) * 512 + h * 64 + v0); }
}
__device__ __forceinline__ void scan_store(const Frame& F, const ScanRegs& R, LAS float* img) {
    if (F.wave < 4) return;
    const int vt = F.tid - 256;
#pragma unroll
    for (int i = 0; i < 2; ++i) {
        const int tid = vt + 256 * i;
        { const int row = tid >> 4, c4 = (tid & 15) * 4; *(LAS f32x4*)(img + row * PSTR + c4) = R.w[i]; }
        { const int st = tid >> 7, row = (tid & 127) >> 2, seg = tid & 3;
          LAS float* d = img + row * PSTR + 64 + st * 64 + seg * 16;
          const float sg = st == 0 ? -1.f : 1.f; const u32x4 b0 = R.b0[i], b1 = R.b1[i];
          *(LAS f32x4*)(d) = (f32x4){bflo(b0.x), bfhi(b0.x), bflo(b0.y), bfhi(b0.y)} * sg; *(LAS f32x4*)(d + 4) = (f32x4){bflo(b0.z), bfhi(b0.z), bflo(b0.w), bfhi(b0.w)} * sg;
          *(LAS f32x4*)(d + 8) = (f32x4){bflo(b1.x), bfhi(b1.x), bflo(b1.y), bfhi(b1.y)} * sg; *(LAS f32x4*)(d + 12) = (f32x4){bflo(b1.z), bfhi(b1.z), bflo(b1.w), bfhi(b1.w)} * sg; }
    }
    if (vt < 32) { LAS float* d = img + SC * PSTR + vt;
      d[0 * SC] = bflo(R.v.x); d[1 * SC] = bfhi(R.v.x); d[2 * SC] = bflo(R.v.y); d[3 * SC] = bfhi(R.v.y); d[4 * SC] = bflo(R.v.z); d[5 * SC] = bfhi(R.v.z); d[6 * SC] = bflo(R.v.w); d[7 * SC] = bfhi(R.v.w); }
}
constexpr int NSW = 2;
__device__ __forceinline__ void prompt_scan(Frame& F, int sblk) {
    const int xcd = sblk & 7, k = sblk >> 3;
    const int chain = xcd * 4 + (k >> 3), rg = k & 7;
    const int b = chain >> 3, h = chain & 7, v0 = rg * 8;
    LAS float* img = (LAS float*)F.lds;
    constexpr int IMG = SC * PSTR + 8 * SC;
    const int rl = F.lane >> 4, cgi = F.lane & 15;
    const int vrow = F.wave * 4 + rl;
    float* Y = F.out;
    ScanState Z; Z.s01 = (f32x2){0.f, 0.f}; Z.s23 = (f32x2){0.f, 0.f}; Z.ykeep = 0.f; Z.ypart = 0.f;
    ScanRegs R0, R1, R2, R3;
    const int mbase = b * T;
    constexpr int NCH = T / SC;
#ifndef SCAN_DUP
#define SCAN_DUP 1
#endif
    constexpr int NTOT = NCH * SCAN_DUP;
    scan_load(F, R0, mbase, h, v0); scan_store(F, R0, img);
    scan_load(F, R1, mbase + SC, h, v0); scan_store(F, R1, img + IMG);
    scan_load(F, R2, mbase + 2 * SC, h, v0); scan_load(F, R3, mbase + 3 * SC, h, v0);
    __syncthreads();
    if (F.wave == 4 || F.wave == 5) scan_transform<PSTR, 16>(img + (F.wave - 4) * 16 * PSTR, F.lane);
    __syncthreads();
    LAS float* ypr = (LAS float*)(F.lds + YP_OFF);
#define SCAN_CHUNK(cc_) do { const int c_ = (cc_) % NCH; \
        if (SCAN_DUP > 1 && c_ == 0) { Z.s01 = (f32x2){0.f, 0.f}; Z.s23 = (f32x2){0.f, 0.f}; } \
        if (F.wave < NSW) { const LAS float* im = img + ((cc_) % 3) * IMG; LAS float* ypb = ypr + (((cc_) & 1) * NSW + F.wave) * (SC * 64) + F.lane; \
            const LAS float* vtp = im + SC * PSTR + vrow * SC; \
            ScanT Tz; Tz.t01 = Z.s01; Tz.t23 = Z.s23; Tz.c0 = load_ops_s<PSTR>(im, 0, cgi); Tz.c1 = load_ops_s<PSTR>(im, 1, cgi); \
            _Pragma("unroll") for (int q_ = 0; q_ < 4; ++q_) Tz.v4[q_] = *(const LAS f32x4*)(vtp + 4 * q_); \
            scan_chunk_s_impl<PSTR>(im, cgi, Tz, ypb, std::make_integer_sequence<int, 16>()); \
            { const f32x4 wce = *(const LAS f32x4*)(im + 15 * PSTR + cgi * 4); Tz.t01 = Tz.t01 * (f32x2){wce[0], wce[1]}; Tz.t23 = Tz.t23 * (f32x2){wce[2], wce[3]}; } \
            _Pragma("unroll") for (int q_ = 0; q_ < 4; ++q_) Tz.v4[q_] = *(const LAS f32x4*)(vtp + 16 + 4 * q_); \
            scan_chunk_s_impl<PSTR>(im + 16 * PSTR, cgi, Tz, ypb + 16 * 64, std::make_integer_sequence<int, 16>()); \
            { const f32x4 wce = *(const LAS f32x4*)(im + 31 * PSTR + cgi * 4); Z.s01 = Tz.t01 * (f32x2){wce[0], wce[1]}; Z.s23 = Tz.t23 * (f32x2){wce[2], wce[3]}; } } \
        else if (F.wave < 2 * NSW && (cc_) > 0) { const int sw_ = F.wave - NSW, cp_ = ((cc_) - 1) % NCH; \
            const LAS float* ypb = ypr + ((((cc_) - 1) & 1) * NSW + sw_) * (SC * 64) + F.lane; float* yo = Y + (size_t)(mbase + cp_ * SC) * 512 + h * 64 + v0 + sw_ * 4 + rl; \
            yp_reduce_impl(ypb, cgi, yo, 0, std::make_integer_sequence<int, 16>()); yp_reduce_impl(ypb, cgi, yo, 16, std::make_integer_sequence<int, 16>()); } \
        else if ((F.wave == 4 || F.wave == 5) && (cc_) + 1 < NTOT) scan_transform<PSTR, 16>(img + (((cc_) + 1) % 3) * IMG + (F.wave - 4) * 16 * PSTR, F.lane); } while (0)
#define SCAN_ITER(j_, RL_, RS_) do { const int c4_ = cc + (j_); \
        scan_load(F, RL_, mbase + ((c4_ + 4 < NTOT ? c4_ + 4 : NTOT - 1) % NCH) * SC, h, v0);        \
        SCAN_CHUNK(c4_); \
        if (c4_ + 2 < NTOT) scan_store(F, RS_, img + ((c4_ + 2) % 3) * IMG);                         \
        asm volatile("s_waitcnt lgkmcnt(0)\n\ts_barrier" ::: "memory"); } while (0)
#pragma unroll 1
    for (int cc = 0; cc < NTOT; cc += 4) {
        SCAN_ITER(0, R0, R2); SCAN_ITER(1, R1, R3); SCAN_ITER(2, R2, R0); SCAN_ITER(3, R3, R1);
    }
#undef SCAN_ITER
#undef SCAN_CHUNK
    if (F.wave >= NSW && F.wave < 2 * NSW) { const int sw_ = F.wave - NSW, cp_ = (NTOT - 1) % NCH;
        const LAS float* ypb = ypr + (((NTOT - 1) & 1) * NSW + sw_) * (SC * 64) + F.lane; float* yo = Y + (size_t)(mbase + cp_ * SC) * 512 + h * 64 + v0 + sw_ * 4 + rl;
        yp_reduce_impl(ypb, cgi, yo, 0, std::make_integer_sequence<int, 16>()); yp_reduce_impl(ypb, cgi, yo, 16, std::make_integer_sequence<int, 16>()); }
    __syncthreads();
    if (F.wave < NSW) *(f32x4*)(F.out + O_WKVP + ((size_t)(b * 8 + h) * 64 + v0 + vrow) * 64 + cgi * 4) = (f32x4){Z.s01.x, Z.s01.y, Z.s23.x, Z.s23.y};
}
__device__ __forceinline__ void sample_scan(Frame& F, int sblk, int nsblk) {
    LAS float* img = (LAS float*)F.lds;
    float* Y = F.out;
    const int rl = F.lane >> 4, cgi = F.lane & 15;
    for (int chain = sblk; chain < DB * 8; chain += nsblk) {
        const int b = chain >> 3, h = chain & 7; const int m0 = MP + b * DT;
        for (int e = F.tid; e < 6 * DT * 64; e += NT) {
            const int st = e >> 9, row = (e >> 6) & 7, ch = e & 63; const size_t o = (size_t)(m0 + row) * 512 + h * 64 + ch;
            float val;
            if (st == 0) val = ((const float*)(F.ws + WS_SW))[o];
            else { const size_t base = st == 1 ? WS_SB : st == 2 ? WS_SKK : st == 3 ? WS_SK : st == 4 ? WS_SR : WS_SV; val = bf2f(((const bf16_t*)(F.ws + base))[o]); if (st == 1) val = -val; }
            img[row * SSTR + st * 64 + ch] = val;
        }
        __syncthreads();
#pragma unroll 1
        for (int rnd = 0; rnd < 2; ++rnd) {
            const int vrow = (rnd * 8 + F.wave) * 4 + rl;
            const float* s0 = F.in[5] + ((size_t)chain * 64 + vrow) * 64 + cgi * 4;
            const f32x4 S = *(const f32x4*)s0;
            ScanState Z; Z.s01 = (f32x2){S[0], S[1]}; Z.s23 = (f32x2){S[2], S[3]}; Z.ykeep = 0.f; Z.ypart = 0.f;
            Z.c0 = load_ops<SSTR>(img, 0, cgi, vrow); Z.c1 = load_ops<SSTR>(img, 1, cgi, vrow);
            scan_group<SSTR, DT>(img, 0, vrow, cgi, Z, Y + (size_t)m0 * 512 + h * 64 + vrow);
            *(f32x4*)(F.out + O_WKVS + ((size_t)chain * 64 + vrow) * 64 + cgi * 4) = (f32x4){Z.s01.x, Z.s01.y, Z.s23.x, Z.s23.y};
        }
        __syncthreads();
    }
}

__device__ __forceinline__ void post_phase(Frame& F) {
    const bf16_t* HRW = (const bf16_t*)(F.ws + WS_HRW);
    const bf16_t* SR = (const bf16_t*)(F.ws + WS_SR); const bf16_t* SK = (const bf16_t*)(F.ws + WS_SK); const bf16_t* SV = (const bf16_t*)(F.ws + WS_SV);
    const float* Y = F.out; bf16_t* OC = (bf16_t*)(F.ws + WS_OCAT);
    const int fr = F.lane & 15, fq = F.lane >> 4, h = F.wave;
    bf16x8 Ag[4][3];
#pragma unroll
    for (int nt = 0; nt < 4; ++nt)
#pragma unroll
        for (int s3 = 0; s3 < 3; ++s3) Ag[nt][s3] = wfrag(F.in[15], 32 * s3, fq, h * 64 + 16 * (fr >> 2) + 4 * nt + (fr & 3));
    constexpr int NTILE = M / 16;
    for (int tile_ = F.bid; tile_ < NTILE * POST_DUP; tile_ += F.G) {
        const int m = (tile_ % NTILE) * 16 + fr;
        const RowInfo ri = row_info(m);
        bf16x8 xg[3];
#pragma unroll
        for (int s3 = 0; s3 < 3; ++s3) {
            const F8 a = hs8(F, HRW, m, ri, 1600 + 32 * s3 + 8 * fq);
            f32x4 t0, t1;
#pragma unroll
            for (int i = 0; i < 4; ++i) { t0[i] = sigmoidf_(a.a[i]); t1[i] = sigmoidf_(a.b[i]); }
            xg[s3] = __builtin_bit_cast(bf16x8, pk8(t0, t1));
        }
        f32x4 y4[4], v4[4], g4[4]; float sy = 0.f, dot = 0.f;
#pragma unroll
        for (int np = 0; np < 2; ++np) {
            const int c8 = h * 64 + 16 * fq + 8 * np; const size_t o = (size_t)m * 512 + c8;
#pragma unroll
            for (int q = 0; q < 2; ++q) { f32x4 g = {0.f, 0.f, 0.f, 0.f};
#pragma unroll
                for (int s3 = 0; s3 < 3; ++s3) g = __builtin_amdgcn_mfma_f32_16x16x32_bf16(Ag[2 * np + q][s3], xg[s3], g, 0, 0, 0);
                g4[2 * np + q] = g; }
            const f32x4 ya = *(const f32x4*)(Y + o), yb = *(const f32x4*)(Y + o + 4);
            const F8 r8 = ld_bf8(SR + o), k8 = ld_bf8(SK + o), v8 = ld_bf8(SV + o);
            const f32x4 rka = *(const f32x4*)(F.in[18] + c8), rkb = *(const f32x4*)(F.in[18] + c8 + 4);
            y4[2 * np] = ya; y4[2 * np + 1] = yb; v4[2 * np] = v8.a; v4[2 * np + 1] = v8.b;
            sy += ((ya[0] + ya[1]) + (ya[2] + ya[3])) + ((yb[0] + yb[1]) + (yb[2] + yb[3]));
            const f32x4 pa = r8.a * k8.a * rka, pb = r8.b * k8.b * rkb; dot += ((pa[0] + pa[1]) + (pa[2] + pa[3])) + ((pb[0] + pb[1]) + (pb[2] + pb[3]));
        }
        const float mean = xsum_fq(sy) * (1.f / 64.f); dot = xsum_fq(dot);
        float sq = 0.f;
#pragma unroll
        for (int nt = 0; nt < 4; ++nt) { y4[nt] = y4[nt] - mean; const f32x4 d = y4[nt]; sq += (d[0] * d[0] + d[1] * d[1]) + (d[2] * d[2] + d[3] * d[3]); }
        const float rstd = rsqrtf(xsum_fq(sq) * (1.f / 64.f) + GN_EPS);
#pragma unroll
        for (int np = 0; np < 2; ++np) {
            const int c8 = h * 64 + 16 * fq + 8 * np;
            f32x4 oo[2];
#pragma unroll
            for (int q = 0; q < 2; ++q) { const int c4 = c8 + 4 * q; const f32x4 gw = *(const f32x4*)(F.in[19] + c4), gb = *(const f32x4*)(F.in[20] + c4);
                oo[q] = (y4[2 * np + q] * rstd * gw + gb + v4[2 * np + q] * dot) * g4[2 * np + q]; }
            *(u32x4*)(OC + (size_t)m * DM + 512 + c8) = pk8(oo[0], oo[1]);
        }
    }
}

__device__ __forceinline__ f32x4 bf4_to_f(const u32x2 w) { return (f32x4){bflo(w.x), bfhi(w.x), bflo(w.y), bfhi(w.y)}; }
__device__ __forceinline__ float sumsq4(const f32x4 (&v)[4]) { float s = 0.f;
#pragma unroll
    for (int j = 0; j < 4; ++j) s += (v[j].x * v[j].x + v[j].y * v[j].y) + (v[j].z * v[j].z + v[j].w * v[j].w);
    return s; }
__device__ __forceinline__ void rows_mid(Frame& F) {
    const int gw = F.bid * NWAVES + F.wave, NGW = F.G * NWAVES;
    const f32x4* g1 = (const f32x4*)F.in[22]; const f32x4* g2 = (const f32x4*)F.in[23];
    bf16_t* XN = (bf16_t*)(F.ws + WS_XN); const bf16_t* MIXb = (const bf16_t*)(F.ws + WS_MIX);
    for (int m = gw; m < M; m += 2 * NGW) {
        const int m1 = m + NGW; const bool has1 = m1 < M; const int mm1 = has1 ? m1 : m;
        const f32x4* xr0 = (const f32x4*)xrow_ptr(F, m) + F.lane; const f32x4* xr1 = (const f32x4*)xrow_ptr(F, mm1) + F.lane;
        const u32x2* mb0 = (const u32x2*)(MIXb + (size_t)m * DM) + F.lane; const u32x2* mb1 = (const u32x2*)(MIXb + (size_t)mm1 * DM) + F.lane;
        f32x4 v0[4], v1[4], x0[4], x1[4];
#pragma unroll
        for (int j = 0; j < 4; ++j) { v0[j] = bf4_to_f(__builtin_nontemporal_load(mb0 + 64 * j)); x0[j] = __builtin_nontemporal_load(xr0 + 64 * j); }
#pragma unroll
        for (int j = 0; j < 4; ++j) { v1[j] = bf4_to_f(__builtin_nontemporal_load(mb1 + 64 * j)); x1[j] = __builtin_nontemporal_load(xr1 + 64 * j); }
        const float ra = 1.0f / sqrtf(wave_sum(sumsq4(v0)) * (1.f / DM) + RMS_EPS), rb = 1.0f / sqrtf(wave_sum(sumsq4(v1)) * (1.f / DM) + RMS_EPS);
#pragma unroll
        for (int j = 0; j < 4; ++j) { const f32x4 gg = g1[64 * j + F.lane]; v0[j] = x0[j] + v0[j] * ra * gg; v1[j] = x1[j] + v1[j] * rb * gg; }
        const float qa = 1.0f / sqrtf(wave_sum(sumsq4(v0)) * (1.f / DM) + RMS_EPS), qb = 1.0f / sqrtf(wave_sum(sumsq4(v1)) * (1.f / DM) + RMS_EPS);
        u32x2* o0 = (u32x2*)(XN + (size_t)m * DM) + F.lane; u32x2* o1 = (u32x2*)(XN + (size_t)mm1 * DM) + F.lane;
#pragma unroll
        for (int j = 0; j < 4; ++j) { const f32x4 gg = g2[64 * j + F.lane];
            u32x2 w; w.x = pk2(v0[j].x * qa * gg.x, v0[j].y * qa * gg.y); w.y = pk2(v0[j].z * qa * gg.z, v0[j].w * qa * gg.w); o0[64 * j] = w;
            if (has1) { u32x2 q; q.x = pk2(v1[j].x * qb * gg.x, v1[j].y * qb * gg.y); q.y = pk2(v1[j].z * qb * gg.z, v1[j].w * qb * gg.w); o1[64 * j] = q; } }
    }
}
__device__ __forceinline__ void rows_final(Frame& F) {
    const int gw = F.bid * NWAVES + F.wave, NGW = F.G * NWAVES;
    const f32x4* g0 = (const f32x4*)F.in[22]; const f32x4* g1 = (const f32x4*)F.in[28];
    const bf16_t* Fb = (const bf16_t*)(F.ws + WS_F); const bf16_t* MIXb = (const bf16_t*)(F.ws + WS_MIX);
    for (int m = gw; m < M; m += 2 * NGW) {
        const int m1 = m + NGW; const bool has1 = m1 < M; const int mm1 = has1 ? m1 : m;
        f32x4 f0[4], f1[4], a0[4], a1[4], x0[4], x1[4];
        { const u32x2* fr = (const u32x2*)(Fb + (size_t)m * DM) + F.lane; const u32x2* mb = (const u32x2*)(MIXb + (size_t)m * DM) + F.lane; const f32x4* xr = (const f32x4*)xrow_ptr(F, m) + F.lane;
#pragma unroll
          for (int j = 0; j < 4; ++j) { f0[j] = bf4_to_f(__builtin_nontemporal_load(fr + 64 * j)); a0[j] = bf4_to_f(__builtin_nontemporal_load(mb + 64 * j)); x0[j] = __builtin_nontemporal_load(xr + 64 * j); } }
        { const u32x2* fr = (const u32x2*)(Fb + (size_t)mm1 * DM) + F.lane; const u32x2* mb = (const u32x2*)(MIXb + (size_t)mm1 * DM) + F.lane; const f32x4* xr = (const f32x4*)xrow_ptr(F, mm1) + F.lane;
#pragma unroll
          for (int j = 0; j < 4; ++j) { f1[j] = bf4_to_f(__builtin_nontemporal_load(fr + 64 * j)); a1[j] = bf4_to_f(__builtin_nontemporal_load(mb + 64 * j)); x1[j] = __builtin_nontemporal_load(xr + 64 * j); } }
        const float rf0 = 1.0f / sqrtf(wave_sum(sumsq4(f0)) * (1.f / DM) + RMS_EPS), rm0 = 1.0f / sqrtf(wave_sum(sumsq4(a0)) * (1.f / DM) + RMS_EPS);
        const float rf1 = 1.0f / sqrtf(wave_sum(sumsq4(f1)) * (1.f / DM) + RMS_EPS), rm1 = 1.0f / sqrtf(wave_sum(sumsq4(a1)) * (1.f / DM) + RMS_EPS);
        f32x4* y0 = (f32x4*)(F.out + (size_t)m * DM) + F.lane; f32x4* y1 = (f32x4*)(F.out + (size_t)mm1 * DM) + F.lane;
#pragma unroll
        for (int j = 0; j < 4; ++j) { const f32x4 ga = g0[64 * j + F.lane], gb = g1[64 * j + F.lane];
            __builtin_nontemporal_store((x0[j] + a0[j] * rm0 * ga) + f0[j] * rf0 * gb, y0 + 64 * j);
            if (has1) __builtin_nontemporal_store((x1[j] + a1[j] * rm1 * ga) + f1[j] * rf1 * gb, y1 + 64 * j); }
    }
}
__device__ __forceinline__ void conv_phase(Frame& F, int half) {
    const bf16_t* ZU = (const bf16_t*)(F.ws + WS_ZU); bf16_t* HID = (bf16_t*)(F.ws + WS_HID);
    const float* cw = F.in[25]; const float* cb = F.in[26]; const float* sc = F.in[6];
    const long total = (long)M * 176;
    for (long e = (long)F.bid * NT + F.tid; e < total; e += (long)F.G * NT) {
        const int m = (int)(e / 176), r = (int)(e - (long)m * 176); const int tile = r >> 4, c8 = (r & 15) * 8;
        const int ch = (half * 11 + tile) * 128 + c8;
        const RowInfo ri = row_info(m);
        const bf16_t* zp = ZU + (size_t)m * DFF + tile * 256 + c8;
        const u32x4 z0 = *(const u32x4*)zp, uu = *(const u32x4*)(zp + 128);
        float z[8], z1[8], z2[8], u8[8];
        z[0] = bflo(z0.x); z[1] = bfhi(z0.x); z[2] = bflo(z0.y); z[3] = bfhi(z0.y); z[4] = bflo(z0.z); z[5] = bfhi(z0.z); z[6] = bflo(z0.w); z[7] = bfhi(z0.w);
        u8[0] = bflo(uu.x); u8[1] = bfhi(uu.x); u8[2] = bflo(uu.y); u8[3] = bfhi(uu.y); u8[4] = bflo(uu.z); u8[5] = bfhi(uu.z); u8[6] = bflo(uu.w); u8[7] = bfhi(uu.w);
        if (ri.t >= 1) { const u32x4 w = *(const u32x4*)(zp - DFF); z1[0] = bflo(w.x); z1[1] = bfhi(w.x); z1[2] = bflo(w.y); z1[3] = bfhi(w.y); z1[4] = bflo(w.z); z1[5] = bfhi(w.z); z1[6] = bflo(w.w); z1[7] = bfhi(w.w); }
        else {
#pragma unroll
            for (int j = 0; j < 8; ++j) z1[j] = ri.samp ? sc[((size_t)ri.b * 2 + 1) * DFF + ch + j] : 0.f; }
        if (ri.t >= 2) { const u32x4 w = *(const u32x4*)(zp - 2 * DFF); z2[0] = bflo(w.x); z2[1] = bfhi(w.x); z2[2] = bflo(w.y); z2[3] = bfhi(w.y); z2[4] = bflo(w.z); z2[5] = bfhi(w.z); z2[6] = bflo(w.w); z2[7] = bfhi(w.w); }
        else {
#pragma unroll
            for (int j = 0; j < 8; ++j) z2[j] = ri.samp ? sc[((size_t)ri.b * 2 + ri.t) * DFF + ch + j] : 0.f; }
        float hd[8];
#pragma unroll
        for (int j = 0; j < 8; ++j) { const float zc = cb[ch + j] + cw[ch + j] * z2[j] + cw[DFF + ch + j] * z1[j] + cw[2 * DFF + ch + j] * z[j]; hd[j] = zc * sigmoidf_(zc) * u8[j]; }
        u32x4 w; w.x = pk2(hd[0], hd[1]); w.y = pk2(hd[2], hd[3]); w.z = pk2(hd[4], hd[5]); w.w = pk2(hd[6], hd[7]);
        *(u32x4*)(HID + (size_t)m * DFF + ch) = w;
    }
}

constexpr int NPHASE = 10;
__global__ void __launch_bounds__(NT, 2) fwd_megakernel(Args args) {
    extern __shared__ __attribute__((aligned(16))) unsigned char lds_raw[];
    Frame F;
    F.lds = (LAS unsigned char*)lds_raw; F.ws = args.ws; F.out = args.out; F.in = args.in;
    F.tid = threadIdx.x; F.lane = F.tid & 63; F.wave = __builtin_amdgcn_readfirstlane(F.tid >> 6); F.G = gridDim.x; F.bid = blockIdx.x;
    const int lo = args.ph_lo, hi = args.ph_hi;
#ifndef PH_MASK
#define PH_MASK 0x3ff
#endif
#ifndef DUP_MASK
#define DUP_MASK 0
#endif
#define IN(k) (((PH_MASK >> (k)) & 1) && lo <= (k) && (k) < hi)
#define REP(k) for (int rep_ = 0; rep_ < 1 + ((DUP_MASK >> (k)) & 1); ++rep_)
    unsigned* barw = (unsigned*)F.ws;
    volatile LAS unsigned* bst = (volatile LAS unsigned*)(F.lds + LDS_BYTES - 64);
    if (F.tid < 2) bst[F.tid] = 0u;
    XcdBarrier xbar; xbar.bar = barw; xbar.x = 0; xbar.st = bst;
    bool posted = false;
    if (lo + 1 < hi && F.bid == 0) { for (int i = F.tid; i < XCD_BAR_WORDS; i += NT) barw[i] = 0u; }
#define SEAM(k) do { if (IN(k) && IN((k) + 1)) { if (!posted) { cg::this_grid().sync(); xbar = xcd_barrier_post(barw, bst); posted = true; } else xcd_barrier(xbar); } } while (0)
    bf16_t* XN = (bf16_t*)(F.ws + WS_XN);
    if (IN(0)) REP(0) { p0_prologue(F); } SEAM(0);
    if (IN(1)) REP(1) {
        pg8::Gemm g{XN, (const bf16_t*)(F.ws + WS_WIN), M, DINP, DM, DM, DM, 0}; pg8::StaticOrder S; S.init(M, DINP, F.G, F.bid);
        Epi1 E{(const float*)(F.ws + WS_ROPE), (bf16_t*)(F.ws + WS_Q), (bf16_t*)(F.ws + WS_K), (bf16_t*)(F.ws + WS_VT), (bf16_t*)(F.ws + WS_HRW), F.out};
        pg8::gemm_phase<Epi1, true>(F.lds, g, S, E);
    } SEAM(1);
    if (IN(2)) REP(2) { prep_phase(F); sample_attn_phase(F); } SEAM(2);
    if (IN(3)) {
        for (int u = F.bid; u < NB * 64 * 2; u += F.G) prompt_attn_unit(F, u);
        sample_scan(F, F.bid, F.G);
        for (int sb = F.bid; sb < 256; sb += F.G) prompt_scan(F, sb);
    } SEAM(3);
    if (IN(4)) REP(4) { post_phase(F); } SEAM(4);
    if (IN(5)) REP(5) {
        pg8::Gemm g{(const bf16_t*)(F.ws + WS_OCAT), (const bf16_t*)(F.ws + WS_WOUT), M, DM, DM, DM, DM, 0}; pg8::StaticOrder S; S.init(M, DM, F.G, F.bid);
        EpiBf16 E{(bf16_t*)(F.ws + WS_MIX), DM};
        pg8::gemm_phase<EpiBf16, true>(F.lds, g, S, E);
    } SEAM(5);
    if (IN(6)) { rows_mid(F); } SEAM(6);
    if (IN(7)) REP(7) {
        pg8::Gemm g{XN, (const bf16_t*)(F.ws + WS_WFI), 136 * 256, 2 * DFF, DM, DM, DM, 1}; pg8::StaticOrder S; S.init(136 * 256, 2 * DFF, F.G, F.bid);
        EpiConv E{(bf16_t*)(F.ws + WS_HID), F.out, F.in[25], F.in[26], F.in[6], (LAS float*)(F.lds + 131072)};
        pg8::gemm_phase<EpiConv, true>(F.lds, g, S, E);
    } SEAM(7);
    if (IN(8)) REP(11) {
        pg8::Gemm g{(const bf16_t*)(F.ws + WS_HID), (const bf16_t*)(F.ws + WS_WFO), M, DM, DFF, DFF, DFF, 0}; pg8::StaticOrder S; S.init(M, DM, F.G, F.bid);
        EpiBf16 E{(bf16_t*)(F.ws + WS_F), DM};
        pg8::gemm_phase<EpiBf16, true>(F.lds, g, S, E);
    } SEAM(8);
    if (IN(9)) { rows_final(F); }
#undef IN
#undef SEAM
}

extern "C" void kernel_launch(void* const* d_in, const int* in_sizes, int n_in, void* d_out, int out_size, void* d_ws, size_t ws_size, hipStream_t stream) {
    static int grid = 0;
    if (grid == 0) {
        if (n_in != 29 || ws_size < WS_END) { fprintf(stderr, "kernel_launch: unexpected n_in %d / ws_size %zu\n", n_in, ws_size); grid = -1; return; }
        int dev = 0, cus = 0, per_cu = 0;
        hipGetDevice(&dev); hipDeviceGetAttribute(&cus, hipDeviceAttributeMultiprocessorCount, dev);
        if (hipFuncSetAttribute((const void*)fwd_megakernel, hipFuncAttributeMaxDynamicSharedMemorySize, LDS_BYTES) != hipSuccess) { fprintf(stderr, "kernel_launch: hipFuncSetAttribute failed\n"); grid = -1; return; }
        if (hipOccupancyMaxActiveBlocksPerMultiprocessor(&per_cu, (const void*)fwd_megakernel, NT, LDS_BYTES) != hipSuccess || per_cu < 1) { fprintf(stderr, "kernel_launch: occupancy query failed (%d)\n", per_cu); (void)hipGetLastError(); per_cu = 1; }
        grid = cus * (per_cu > 1 ? 1 : per_cu);
        fprintf(stderr, "kernel_launch: grid %d (cus %d, per_cu %d), ws %zu\n", grid, cus, per_cu, ws_size);
    }
    if (grid < 0) return;
    Args a{};
    for (int i = 0; i < 29; ++i) a.in[i] = (const float*)d_in[i];
    a.out = (float*)d_out; a.ws = (unsigned char*)d_ws;
#if MK_PER_PHASE
    for (int p = 0; p < NPHASE; ++p) { a.ph_lo = p; a.ph_hi = p + 1; hipLaunchKernelGGL(fwd_megakernel, dim3(grid), dim3(NT), LDS_BYTES, stream, a); }
#else
    a.ph_lo = 0; a.ph_hi = NPHASE;
    void* kargs[] = {&a};
    hipError_t e = hipLaunchCooperativeKernel((const void*)fwd_megakernel, dim3(grid), dim3(NT), kargs, LDS_BYTES, stream);
    if (e != hipSuccess) fprintf(stderr, "cooperative launch failed: %s (grid %d)\n", hipGetErrorString(e), grid);
#endif
}
```

```cpp
#include <hip/hip_runtime.h>
#include <hip/hip_cooperative_groups.h>
#include <cstdio>
#include <cstdint>
#include <utility>
namespace cg = cooperative_groups;

#ifndef MK_PER_PHASE
#define MK_PER_PHASE 0
#endif

#define LAS __attribute__((address_space(3)))
typedef unsigned short bf16_t;
typedef short bf16x8 __attribute__((ext_vector_type(8)));
typedef float f32x4 __attribute__((ext_vector_type(4)));
typedef float f32x2 __attribute__((ext_vector_type(2)));
typedef unsigned u32x4 __attribute__((ext_vector_type(4)));
typedef unsigned u32x2 __attribute__((ext_vector_type(2)));

constexpr int DM = 1024, NB = 4, T = 8192, MP = NB * T, DB = 128, DT = 8, MS = DB * DT, M = MP + MS;
constexpr int WIN = 128, DSH = 1696, DINP = 2560, DFF = 2816, DFFH = 1408;
constexpr float RMS_EPS = 1e-6f, GN_EPS = 64e-5f;
constexpr float QSCALE = 0.125f * 1.4426950408889634f;
constexpr size_t O_Y = 0, O_KWP = 34603008, O_VWP = 34668544, O_SHP = 34734080, O_WKVP = 34740864, O_CVP = 34871936,
                 O_KWS = 34894464, O_VWS = 36991616, O_SHS = 39088768, O_WKVS = 39305856, O_CVS = 43500160;
constexpr size_t MiB = 1u << 20;
constexpr size_t WS_WIN = 1 * MiB, WS_WOUT = 6 * MiB, WS_WFI = 8 * MiB, WS_WFO = 19 * MiB, WS_ROPE = 25 * MiB;
constexpr size_t WS_XN = 32 * MiB;
constexpr size_t WS_SR = 32 * MiB, WS_SK = 65 * MiB;
constexpr size_t WS_Q = 98 * MiB, WS_K = 131 * MiB, WS_VT = 140 * MiB;
constexpr size_t WS_HRW = 150 * MiB;
constexpr size_t WS_OCAT = 260 * MiB;
constexpr size_t WS_SW = 326 * MiB;
constexpr size_t WS_SV = 392 * MiB, WS_SKK = 425 * MiB, WS_SB = 458 * MiB;
constexpr size_t WS_ZU = 100 * MiB;
constexpr size_t WS_HID = 282 * MiB;
constexpr size_t WS_F = 216 * MiB;
constexpr size_t WS_MIX = 150 * MiB;
constexpr size_t WS_END = 491 * MiB;

__device__ __forceinline__ unsigned f2bf(float f) { unsigned u = __float_as_uint(f); return (u + 0x7fffu + ((u >> 16) & 1u)) >> 16; }

__device__ __forceinline__ float bf2f(unsigned short h) { return __uint_as_float(((unsigned)h) << 16); }
__device__ __forceinline__ float bflo(unsigned w) { return __uint_as_float(w << 16); }
__device__ __forceinline__ float bfhi(unsigned w) { return __uint_as_float(w & 0xffff0000u); }
__device__ __forceinline__ unsigned cvt_pk_bf16(float lo, float hi) { unsigned r; asm volatile("v_cvt_pk_bf16_f32 %0, %1, %2" : "=v"(r) : "v"(lo), "v"(hi)); return r; }
__device__ __forceinline__ unsigned pk2(float lo, float hi) { return cvt_pk_bf16(lo, hi); }
template <int CTRL> __device__ __forceinline__ float dppf(float x) { return __int_as_float(__builtin_amdgcn_update_dpp(0, __float_as_int(x), CTRL, 0xF, 0xF, false)); }
__device__ __forceinline__ float allsum16(float x) {
    x += dppf<0xB1>(x); x += dppf<0x4E>(x); x += dppf<0x141>(x); x += dppf<0x140>(x); return x;
}
__device__ __forceinline__ void allsum16_2(float& a, float& b) {
    a += dppf<0xB1>(a); b += dppf<0xB1>(b); a += dppf<0x4E>(a); b += dppf<0x4E>(b); a += dppf<0x141>(a); b += dppf<0x141>(b); a += dppf<0x140>(a); b += dppf<0x140>(b);
}
__device__ __forceinline__ float wave_sum(float v) {
    v = allsum16(v);
    { auto r = __builtin_amdgcn_permlane16_swap(__float_as_uint(v), __float_as_uint(v), false, false); v = __uint_as_float(r[0]) + __uint_as_float(r[1]); }
    { auto r = __builtin_amdgcn_permlane32_swap(__float_as_uint(v), __float_as_uint(v), false, false); v = __uint_as_float(r[0]) + __uint_as_float(r[1]); }
    return v;
}
__device__ __forceinline__ float sigmoidf_(float x) { return __builtin_amdgcn_rcpf(1.0f + __expf(-x)); }

namespace pg8 {
constexpr int BM = 256, BK = 64, HALF = 128, HTB = HALF * BK * 2, STAGE_BYTES = 8 * HTB, NXCD = 8, WGM = 8;
__host__ __device__ __forceinline__ int lds_byte(int r, int c) { const int st = (r >> 4) * 2 + (c >> 5), rr = r & 15, cc = c & 31, ob = rr * 64 + cc * 2; return st * 1024 + (ob ^ (((ob >> 9) & 1) << 5)); }
__host__ __device__ __forceinline__ void stage_rc(int b, int& R, int& C) { const int st = b / 1024, sb = b % 1024, swz = sb ^ (((sb >> 9) & 1) << 5); R = (st >> 1) * 16 + swz / 64; C = (st & 1) * 32 + (swz % 64) / 2; }
__host__ __device__ __forceinline__ int perm32(int rho) { const int n = rho >> 4, i = rho & 15; return 8 * (i >> 2) + 4 * n + (i & 3); }
struct Unit { int pm, pn; };
struct Gemm { const bf16_t* A; const bf16_t* Bt; int M, N, K, lda, ldb, conv; };
__device__ __forceinline__ long arow(const Gemm& g, int pm) {
    if (!g.conv) return (long)pm * 256;
    if (pm < 132) { const int b = pm / 33; return (long)b * 8192 + 254 * (pm - 33 * b) - 2; }
    return 32768 + (long)(pm - 132) * 256;
}
struct StaticOrder {
    int nM, nN, nwg, G, c;
    __device__ void init(int M_, int N_, int G_, int c_) { nM = M_ / BM; nN = N_ / BM; nwg = nM * nN; G = G_; c = c_; }
    __device__ bool next(int i, Unit& u) const {
        const long L = (long)i * G + c; if (L >= nwg) return false;
        int wgid = (int)L; { const int q = nwg / NXCD, r = nwg % NXCD, xcd = wgid % NXCD, off = wgid / NXCD; wgid = (xcd < r ? xcd * (q + 1) : r * (q + 1) + (xcd - r) * q) + off; }
        const int nig = WGM * nN, gid = wgid / nig, fm = gid * WGM, gsz = (nM - fm) < WGM ? (nM - fm) : WGM;
        u.pm = fm + ((wgid % nig) % gsz); u.pn = (wgid % nig) / gsz; return true;
    }
};
template <class Epi, bool ALIGN_EPI>
__device__ __forceinline__ void gemm_phase(LAS unsigned char* lds, const Gemm g, const StaticOrder& S, const Epi& E) {
    const int tid = threadIdx.x, wid = __builtin_amdgcn_readfirstlane(tid >> 6), lane = tid & 63, wr = wid >> 2, wc = wid & 3, fr = lane & 15, fq = lane >> 4;
    const int nt = g.K / BK;
    unsigned voffA[2], voffB[2];
#pragma unroll
    for (int i = 0; i < 2; ++i) { int R, C; stage_rc(tid * 16 + i * 8192, R, C); const int Rb = (R & ~31) + perm32(R & 31);
        voffA[i] = (unsigned)(R * g.lda + C) * 2u; voffB[i] = (unsigned)(Rb * g.ldb + C) * 2u; }
    const size_t kstep = (size_t)(BK * 2);
    const size_t hstepA = (size_t)HALF * g.lda * 2, hstepB = (size_t)HALF * g.ldb * 2;
    const size_t rowA = (size_t)g.lda * 2, tstepB = 2 * hstepB;
    const unsigned ldsw = (unsigned)wid * 1024u;
    const int aoff = lds_byte(wr * 64 + fr, fq * 8), boff = lds_byte(wc * 32 + fr, fq * 8);
#define PG8_SA(b, h) (((b) * 2 + (h)) * HTB)
#define PG8_SB(b, h) ((4 + (b) * 2 + (h)) * HTB)
#define PG8_STAGE(bufoff, gbase, voff) do { _Pragma("unroll") for (int _i = 0; _i < 2; ++_i) \
        __builtin_amdgcn_global_load_lds((const unsigned*)((const char*)(gbase) + (voff)[_i]), (LAS unsigned*)(lds + (bufoff) + ldsw + _i * 8192), 16, 0, 0); } while (0)
#define PG8_LDA(dst, b, h) do { _Pragma("unroll") for (int m = 0; m < 4; ++m) _Pragma("unroll") for (int k = 0; k < 2; ++k) dst[m][k] = *(const LAS bf16x8*)(lds + PG8_SA(b, h) + aoff + m * 2048 + k * 1024); } while (0)
#define PG8_LDB(dst, b, h) do { _Pragma("unroll") for (int n = 0; n < 2; ++n) _Pragma("unroll") for (int k = 0; k < 2; ++k) dst[n][k] = *(const LAS bf16x8*)(lds + PG8_SB(b, h) + boff + n * 2048 + k * 1024); } while (0)
#define PG8_MMA(ai, bj, At, Bt) do { __builtin_amdgcn_s_setprio(1); _Pragma("unroll") for (int m = 0; m < 4; ++m) _Pragma("unroll") for (int n = 0; n < 2; ++n) _Pragma("unroll") for (int k = 0; k < 2; ++k) \
        acc[ai][bj][m][n] = __builtin_amdgcn_mfma_f32_16x16x32_bf16(Bt[n][k], At[m][k], acc[ai][bj][m][n], 0, 0, 0); __builtin_amdgcn_s_setprio(0); } while (0)
#define PG8_WAIT_V(n) asm volatile("s_waitcnt vmcnt(" #n ")" ::: "memory")
#define PG8_WAIT_L(n) asm volatile("s_waitcnt lgkmcnt(" #n ")" ::: "memory")
#define PG8_BAR __builtin_amdgcn_s_barrier()
#define PG8_SCHED __builtin_amdgcn_sched_barrier(0)
    Unit cur, nxt; int ui = 0;
    if (!S.next(0, cur)) return;
    f32x4 acc[2][2][4][2];
#pragma unroll
    for (int a = 0; a < 2; ++a)
#pragma unroll
        for (int b = 0; b < 2; ++b)
#pragma unroll
            for (int m = 0; m < 4; ++m)
#pragma unroll
                for (int n = 0; n < 2; ++n) acc[a][b][m][n] = (f32x4){0.f, 0.f, 0.f, 0.f};
    bf16x8 At[4][2], B0[2][2], B1[2][2];
    const char* cA = (const char*)g.A + arow(g, cur.pm) * (long)rowA; const char* cB = (const char*)g.Bt + (size_t)cur.pn * tstepB;
    PG8_STAGE(PG8_SB(0, 0), cB, voffB); PG8_STAGE(PG8_SB(0, 1), cB + hstepB, voffB); PG8_STAGE(PG8_SA(0, 0), cA, voffA); PG8_STAGE(PG8_SA(0, 1), cA + hstepA, voffA);
    if (wr == 1) PG8_BAR;
    PG8_WAIT_V(2); PG8_BAR;
    PG8_STAGE(PG8_SB(1, 0), cB + kstep, voffB); PG8_STAGE(PG8_SA(1, 0), cA + kstep, voffA); PG8_STAGE(PG8_SB(1, 1), cB + hstepB + kstep, voffB);
    PG8_WAIT_V(6); PG8_BAR;
    for (;;) {
        const bool has_next = S.next(ui + 1, nxt);
        const char* nA = has_next ? (const char*)g.A + arow(g, nxt.pm) * (long)rowA : cA; const char* nB = has_next ? (const char*)g.Bt + (size_t)nxt.pn * tstepB : cB;
        for (int t = 0; t < nt; t += 2) {
            const bool last = (t == nt - 2);
            const char* a1 = cA + (size_t)(t + 1) * kstep;
            const char* a2 = last ? nA : cA + (size_t)(t + 2) * kstep; const char* b2 = last ? nB : cB + (size_t)(t + 2) * kstep;
            const char* a3 = a2 + kstep; const char* b3 = b2 + kstep;
            PG8_LDB(B0, 0, 0); PG8_LDB(B1, 0, 1); PG8_SCHED; PG8_LDA(At, 0, 0); PG8_STAGE(PG8_SA(1, 1), a1 + hstepA, voffA);
            PG8_WAIT_V(8); PG8_WAIT_L(0); PG8_BAR; PG8_MMA(0, 0, At, B0); PG8_MMA(0, 1, At, B1); PG8_BAR; PG8_SCHED;
            PG8_LDA(At, 0, 1); PG8_STAGE(PG8_SB(0, 0), b2, voffB); PG8_STAGE(PG8_SB(0, 1), b2 + hstepB, voffB); PG8_STAGE(PG8_SA(0, 0), a2, voffA);
            PG8_WAIT_V(8); PG8_WAIT_L(0); PG8_BAR; PG8_MMA(1, 0, At, B0); PG8_MMA(1, 1, At, B1); PG8_BAR; PG8_SCHED;
            PG8_LDB(B0, 1, 0); PG8_LDB(B1, 1, 1); PG8_SCHED; PG8_LDA(At, 1, 0); PG8_STAGE(PG8_SA(0, 1), a2 + hstepA, voffA);
            PG8_WAIT_V(8); PG8_WAIT_L(0); PG8_BAR; PG8_MMA(0, 0, At, B0); PG8_MMA(0, 1, At, B1); PG8_BAR; PG8_SCHED;
            PG8_LDA(At, 1, 1); PG8_STAGE(PG8_SB(1, 0), b3, voffB); PG8_STAGE(PG8_SB(1, 1), b3 + hstepB, voffB); PG8_STAGE(PG8_SA(1, 0), a3, voffA);
            PG8_WAIT_V(8); PG8_WAIT_L(0); PG8_BAR; PG8_MMA(1, 0, At, B0); PG8_MMA(1, 1, At, B1); PG8_BAR; PG8_SCHED;
        }
        if constexpr (ALIGN_EPI) { if (wr == 0) PG8_BAR; }
        asm volatile("s_nop 7\n\ts_nop 7" ::: "memory");
        E(acc, cur, wr, wc, fr, fq);
        if (!has_next) break;
#pragma unroll
        for (int a = 0; a < 2; ++a)
#pragma unroll
            for (int b = 0; b < 2; ++b)
#pragma unroll
                for (int m = 0; m < 4; ++m)
#pragma unroll
                    for (int n = 0; n < 2; ++n) acc[a][b][m][n] = (f32x4){0.f, 0.f, 0.f, 0.f};
        cur = nxt; cA = nA; cB = nB; ++ui;
        if constexpr (ALIGN_EPI) { if (wr == 1) PG8_BAR; }
    }
    PG8_WAIT_V(0);
    if constexpr (!ALIGN_EPI) { if (wr == 0) PG8_BAR; }
    PG8_BAR;
#undef PG8_SA
#undef PG8_SB
#undef PG8_STAGE
#undef PG8_LDA
#undef PG8_LDB
#undef PG8_MMA
#undef PG8_WAIT_V
#undef PG8_WAIT_L
#undef PG8_BAR
#undef PG8_SCHED
}
}

struct RowInfo { int b, t, samp; };
__device__ __forceinline__ RowInfo row_info(int row) { RowInfo r; if (row < MP) { r.samp = 0; r.b = row >> 13; r.t = row & (T - 1); } else { const int rs = row - MP; r.samp = 1; r.b = rs >> 3; r.t = rs & 7; } return r; }

struct Epi1 {
    const float* rope; bf16_t* Q; bf16_t* Kb; bf16_t* VT; bf16_t* HRW; float* out;
    __device__ __forceinline__ void operator()(const f32x4 (&acc)[2][2][4][2], const pg8::Unit& u, int wr, int wc, int fr, int fq) const {
#pragma unroll
        for (int ai = 0; ai < 2; ++ai)
#pragma unroll
            for (int m = 0; m < 4; ++m) {
                const int row = u.pm * 256 + ai * 128 + wr * 64 + m * 16 + fr;
                const RowInfo ri = row_info(row);
                const int pidx = ri.samp ? (T + ri.t) : ri.t;
#pragma unroll
                for (int bj = 0; bj < 2; ++bj) {
                    const int cb = u.pn * 256 + bj * 128;
                    const int c0 = cb + wc * 32 + fq * 8;
                    const f32x4 v0 = acc[ai][bj][m][0], v1 = acc[ai][bj][m][1];
                    if (cb < 640) {
                        const int d0 = ((c0 & 63) >> 3) * 4;
                        const f32x4* rp = (const f32x4*)(rope + ((size_t)pidx * 32 + d0) * 2);
                        const f32x4 cs0 = rp[0], cs1 = rp[1];
                        f32x4 o1, o2;
                        o1[0] = v0[0] * cs0[0] - v1[0] * cs0[1]; o2[0] = v1[0] * cs0[0] + v0[0] * cs0[1];
                        o1[1] = v0[1] * cs0[2] - v1[1] * cs0[3]; o2[1] = v1[1] * cs0[2] + v0[1] * cs0[3];
                        o1[2] = v0[2] * cs1[0] - v1[2] * cs1[1]; o2[2] = v1[2] * cs1[0] + v0[2] * cs1[1];
                        o1[3] = v0[3] * cs1[2] - v1[3] * cs1[3]; o2[3] = v1[3] * cs1[2] + v0[3] * cs1[3];
                        if (cb < 512) {
                            o1 = o1 * QSCALE; o2 = o2 * QSCALE;
                            bf16_t* qp = Q + (size_t)row * 512 + (c0 & ~63) + d0;
                            u32x2 w1, w2; w1.x = cvt_pk_bf16(o1[0], o1[1]); w1.y = cvt_pk_bf16(o1[2], o1[3]); w2.x = cvt_pk_bf16(o2[0], o2[1]); w2.y = cvt_pk_bf16(o2[2], o2[3]);
                            *(u32x2*)qp = w1; *(u32x2*)(qp + 32) = w2;
                        } else {
                            const int kvh = (c0 - 512) >> 6;
                            bf16_t* kp = Kb + (size_t)row * 128 + kvh * 64 + d0;
                            u32x2 w1, w2; w1.x = cvt_pk_bf16(o1[0], o1[1]); w1.y = cvt_pk_bf16(o1[2], o1[3]); w2.x = cvt_pk_bf16(o2[0], o2[1]); w2.y = cvt_pk_bf16(o2[2], o2[3]);
                            *(u32x2*)kp = w1; *(u32x2*)(kp + 32) = w2;
                            if (!ri.samp) { if (ri.t >= T - WIN) { float* o = out + O_KWP + ((size_t)(ri.b * WIN + (ri.t - (T - WIN))) * 2 + kvh) * 64 + d0; *(f32x4*)o = o1; *(f32x4*)(o + 32) = o2; } }
                            else { float* o = out + O_KWS + ((size_t)(ri.b * WIN + (WIN - DT) + ri.t) * 2 + kvh) * 64 + d0; *(f32x4*)o = o1; *(f32x4*)(o + 32) = o2; }
                        }
                    } else if (cb < 768) {
                        const int kvh = (c0 - 640) >> 6, d0 = (c0 - 640) & 63;
                        if (!ri.samp) {
                            bf16_t* vp = VT + ((size_t)(ri.b * 2 + kvh) * 64 + d0) * T + ri.t;
                            vp[0] = (bf16_t)f2bf(v0[0]); vp[(size_t)T] = (bf16_t)f2bf(v0[1]); vp[(size_t)2 * T] = (bf16_t)f2bf(v0[2]); vp[(size_t)3 * T] = (bf16_t)f2bf(v0[3]);
                            vp[(size_t)4 * T] = (bf16_t)f2bf(v1[0]); vp[(size_t)5 * T] = (bf16_t)f2bf(v1[1]); vp[(size_t)6 * T] = (bf16_t)f2bf(v1[2]); vp[(size_t)7 * T] = (bf16_t)f2bf(v1[3]);
                            if (ri.t >= T - WIN) { float* o = out + O_VWP + ((size_t)(ri.b * WIN + (ri.t - (T - WIN))) * 2 + kvh) * 64 + d0; *(f32x4*)o = v0; *(f32x4*)(o + 4) = v1; }
                        } else { float* o = out + O_VWS + ((size_t)(ri.b * WIN + (WIN - DT) + ri.t) * 2 + kvh) * 64 + d0; *(f32x4*)o = v0; *(f32x4*)(o + 4) = v1; }
                    } else if (c0 < 2464) {
                        const int col = c0 - 768;
                        u32x4 w; w.x = cvt_pk_bf16(v0[0], v0[1]); w.y = cvt_pk_bf16(v0[2], v0[3]); w.z = cvt_pk_bf16(v1[0], v1[1]); w.w = cvt_pk_bf16(v1[2], v1[3]);
                        *(u32x4*)(HRW + (size_t)row * DSH + col) = w;
                        if (!ri.samp) { if (ri.t == T - 1) { float* o = out + O_SHP + (size_t)ri.b * DSH + col; *(f32x4*)o = v0; *(f32x4*)(o + 4) = v1; } }
                        else if (ri.t == DT - 1) { float* o = out + O_SHS + (size_t)ri.b * DSH + col; *(f32x4*)o = v0; *(f32x4*)(o + 4) = v1; }
                    }
                }
            }
    }
};
struct EpiF32 {
    float* O; int ldc;
    __device__ __forceinline__ void operator()(const f32x4 (&acc)[2][2][4][2], const pg8::Unit& u, int wr, int wc, int fr, int fq) const {
#pragma unroll
        for (int ai = 0; ai < 2; ++ai)
#pragma unroll
            for (int m = 0; m < 4; ++m) {
                float* rowp = O + (size_t)(u.pm * 256 + ai * 128 + wr * 64 + m * 16 + fr) * ldc + u.pn * 256 + wc * 32 + fq * 8;
#pragma unroll
                for (int bj = 0; bj < 2; ++bj) { *(f32x4*)(rowp + bj * 128) = acc[ai][bj][m][0]; *(f32x4*)(rowp + bj * 128 + 4) = acc[ai][bj][m][1]; }
            }
    }
};
struct EpiBf16 {
    bf16_t* O; int ldc;
    __device__ __forceinline__ void operator()(const f32x4 (&acc)[2][2][4][2], const pg8::Unit& u, int wr, int wc, int fr, int fq) const {
#pragma unroll
        for (int ai = 0; ai < 2; ++ai)
#pragma unroll
            for (int m = 0; m < 4; ++m) {
                bf16_t* rowp = O + (size_t)(u.pm * 256 + ai * 128 + wr * 64 + m * 16 + fr) * ldc + u.pn * 256 + wc * 32 + fq * 8;
#pragma unroll
                for (int bj = 0; bj < 2; ++bj) { const f32x4 v0 = acc[ai][bj][m][0], v1 = acc[ai][bj][m][1];
                    u32x4 w; w.x = cvt_pk_bf16(v0[0], v0[1]); w.y = cvt_pk_bf16(v0[2], v0[3]); w.z = cvt_pk_bf16(v1[0], v1[1]); w.w = cvt_pk_bf16(v1[2], v1[3]);
                    *(u32x4*)(rowp + bj * 128) = w; }
            }
    }
};
template <int CTRL> __device__ __forceinline__ float dpp_old(float old, float src) { return __int_as_float(__builtin_amdgcn_update_dpp(__float_as_int(old), __float_as_int(src), CTRL, 0xF, 0xF, false)); }
struct EpiConv {
    bf16_t* HID; float* out; const float* cw; const float* cb; const float* sc; LAS float* exch;
    __device__ __forceinline__ void operator()(const f32x4 (&acc)[2][2][4][2], const pg8::Unit& u, int wr, int wc, int fr, int fq) const {
        const int cw8 = wc * 32 + fq * 8, ch0 = u.pn * 128 + cw8;
        if (fr >= 14) {
#pragma unroll
            for (int ai = 0; ai < 2; ++ai)
#pragma unroll
                for (int n = 0; n < 2; ++n) *(LAS f32x4*)(exch + ((ai * 2 + wr) * 2 + (fr - 14)) * 128 + cw8 + 4 * n) = acc[ai][0][3][n];
        }
        asm volatile("s_waitcnt lgkmcnt(0)\n\ts_barrier" ::: "memory");
        int row0, b0 = 0, i0 = 0; const bool samp = u.pm >= 132;
        if (!samp) { b0 = u.pm / 33; i0 = u.pm - 33 * b0; row0 = b0 * T + 254 * i0 - 2; } else row0 = MP + (u.pm - 132) * 256;
        f32x4 w0[2], w1[2], w2[2], bb[2];
#pragma unroll
        for (int n = 0; n < 2; ++n) { w0[n] = *(const f32x4*)(cw + ch0 + 4 * n); w1[n] = *(const f32x4*)(cw + DFF + ch0 + 4 * n); w2[n] = *(const f32x4*)(cw + 2 * DFF + ch0 + 4 * n); bb[n] = *(const f32x4*)(cb + ch0 + 4 * n); }
#pragma unroll
        for (int ai = 0; ai < 2; ++ai) {
            const int strip = ai * 2 + wr;
            f32x4 h1[2], h2[2];
#pragma unroll
            for (int n = 0; n < 2; ++n) {
                if (strip > 0) { h1[n] = *(const LAS f32x4*)(exch + ((strip - 1) * 2 + 1) * 128 + cw8 + 4 * n); h2[n] = *(const LAS f32x4*)(exch + ((strip - 1) * 2) * 128 + cw8 + 4 * n); }
                else { h1[n] = (f32x4){0.f, 0.f, 0.f, 0.f}; h2[n] = (f32x4){0.f, 0.f, 0.f, 0.f}; }
            }
#pragma unroll
            for (int m = 0; m < 4; ++m) {
                const int lr = ai * 128 + wr * 64 + m * 16 + fr;
                int t, b; bool valid;
                if (!samp) { t = 254 * i0 + lr - 2; b = b0; valid = lr >= 2 && t < T; } else { const int rs = row0 - MP + lr; b = rs >> 3; t = rs & 7; valid = true; }
                const size_t R = (size_t)((long)row0 + lr);
                f32x4 hd[2];
#pragma unroll
                for (int n = 0; n < 2; ++n) {
                    const f32x4 z = acc[ai][0][m][n], uu = acc[ai][1][m][n];
                    f32x4 o1, o2, zm1, zm2;
                    if (m == 0) { o1 = h1[n]; o2 = (fr == 0) ? h2[n] : h1[n]; }
                    else {
#pragma unroll
                        for (int e = 0; e < 4; ++e) { o1[e] = dppf<0x121>(acc[ai][0][m > 0 ? m - 1 : 0][n][e]); o2[e] = dppf<0x122>(acc[ai][0][m > 0 ? m - 1 : 0][n][e]); }
                    }
#pragma unroll
                    for (int e = 0; e < 4; ++e) { zm1[e] = dpp_old<0x111>(o1[e], z[e]); zm2[e] = dpp_old<0x112>(o2[e], z[e]); }
                    if (t == 0) {
                        if (samp) { zm1 = *(const f32x4*)(sc + ((size_t)b * 2 + 1) * DFF + ch0 + 4 * n); zm2 = *(const f32x4*)(sc + ((size_t)b * 2) * DFF + ch0 + 4 * n); }
                        else { zm1 = (f32x4){0.f, 0.f, 0.f, 0.f}; zm2 = (f32x4){0.f, 0.f, 0.f, 0.f}; }
                    } else if (t == 1) {
                        if (samp) zm2 = *(const f32x4*)(sc + ((size_t)b * 2 + 1) * DFF + ch0 + 4 * n); else zm2 = (f32x4){0.f, 0.f, 0.f, 0.f};
                    }
                    const f32x4 zc = bb[n] + w0[n] * zm2 + w1[n] * zm1 + w2[n] * z;
#pragma unroll
                    for (int e = 0; e < 4; ++e) hd[n][e] = zc[e] * sigmoidf_(zc[e]) * uu[e];
                }
                if (valid) {
                    u32x4 w; w.x = cvt_pk_bf16(hd[0][0], hd[0][1]); w.y = cvt_pk_bf16(hd[0][2], hd[0][3]); w.z = cvt_pk_bf16(hd[1][0], hd[1][1]); w.w = cvt_pk_bf16(hd[1][2], hd[1][3]);
                    *(u32x4*)(HID + R * DFF + ch0) = w;
                    if (!samp) { if (t >= T - 2) { float* o = out + O_CVP + (size_t)(b * 2 + (t - (T - 2))) * DFF + ch0; *(f32x4*)o = acc[ai][0][m][0]; *(f32x4*)(o + 4) = acc[ai][0][m][1]; } }
                    else if (t >= DT - 2) { float* o = out + O_CVS + (size_t)(b * 2 + (t - (DT - 2))) * DFF + ch0; *(f32x4*)o = acc[ai][0][m][0]; *(f32x4*)(o + 4) = acc[ai][0][m][1]; }
                }
            }
        }
    }
};

#define XB_TMO      128
#define XB_XCNT(j)  (256  + 64 * (j))
#define XB_XSUB(j)  (1280 + 64 * (j))
#define XB_XGEN(j)  (2304 + 64 * (j))
#define XB_TOP      3328
#define XB_TOPGEN   3392
#define XCD_BAR_WORDS 3456
#define XB_SPIN_CAP (1u << 20)
__device__ __forceinline__ unsigned xb_ld(unsigned* p)              { return __hip_atomic_load(p, __ATOMIC_RELAXED, __HIP_MEMORY_SCOPE_AGENT); }
__device__ __forceinline__ unsigned xb_add(unsigned* p, unsigned v) { return __hip_atomic_fetch_add(p, v, __ATOMIC_RELAXED, __HIP_MEMORY_SCOPE_AGENT); }
__device__ __forceinline__ unsigned xb_xcc_id() { return (unsigned)__builtin_amdgcn_s_getreg((3 << 11) | 20) & 0xFu; }
#define XB_SPIN(cond, bar) do { unsigned _sp = 0; while (cond) { __builtin_amdgcn_s_sleep(1); \
    if ((++_sp & 255u) == 0u) { if (xb_ld(&(bar)[XB_TMO])) break; if (_sp > XB_SPIN_CAP) { atomicAdd(&(bar)[XB_TMO], 1u); break; } } } } while (0)
struct XcdBarrier { unsigned* bar; unsigned x; volatile LAS unsigned* st; };
__device__ __forceinline__ XcdBarrier xcd_barrier_post(unsigned* bar, volatile LAS unsigned* st) {
    XcdBarrier b; b.bar = bar; b.x = xb_xcc_id(); b.st = st;
    if (threadIdx.x == 0) (void)xb_add(&bar[XB_XCNT(b.x)], 1u);
    return b;
}
__device__ __forceinline__ void xcd_barrier_complete(unsigned* bar, unsigned x, unsigned& nloc, unsigned& nx) {
    const unsigned G = gridDim.x * gridDim.y * gridDim.z;
    unsigned sum, cnt, mine, sp = 0u;
    for (;;) {
        sum = 0u; cnt = 0u; mine = 0u;
#pragma unroll
        for (unsigned j = 0; j < 16; ++j) { const unsigned c = xb_ld(&bar[XB_XCNT(j)]); sum += c; cnt += (c > 0u) ? 1u : 0u; mine = (j == x) ? c : mine; }
        if (sum == G) break;
        __builtin_amdgcn_s_sleep(1);
        if ((++sp & 255u) == 0u) { if (xb_ld(&bar[XB_TMO])) break; if (sp > XB_SPIN_CAP) { atomicAdd(&bar[XB_TMO], 1u); break; } }
    }
    nloc = mine > 0u ? mine : 1u; nx = cnt > 0u ? cnt : 1u;
}
__device__ __forceinline__ void xcd_barrier(const XcdBarrier& b) {
    asm volatile("s_waitcnt vmcnt(0)" ::: "memory");
    __syncthreads();
    if (threadIdx.x == 0) {
        unsigned* bar = b.bar;
        __builtin_amdgcn_s_waitcnt(0);
        unsigned nloc = b.st[0], nx = b.st[1];
        if (nloc == 0u) { xcd_barrier_complete(bar, b.x, nloc, nx); b.st[0] = nloc; b.st[1] = nx; }
        const unsigned old = xb_add(&bar[XB_XSUB(b.x)], 1u);
        const unsigned gen = old / nloc;
        if (old + 1u == (gen + 1u) * nloc) {
            __builtin_amdgcn_fence(__ATOMIC_RELEASE, "agent");
            asm volatile("s_waitcnt vmcnt(0)" ::: "memory");
            const unsigned og = xb_add(&bar[XB_TOP], 1u);
            const unsigned tg = og / nx;
            if (og + 1u == (tg + 1u) * nx) xb_add(&bar[XB_TOPGEN], 1u);
            else XB_SPIN(xb_ld(&bar[XB_TOPGEN]) == tg, bar);
            __builtin_amdgcn_fence(__ATOMIC_ACQUIRE, "agent");
            xb_add(&bar[XB_XGEN(b.x)], 1u);
            asm volatile("s_waitcnt vmcnt(0)" ::: "memory");
        } else {
            XB_SPIN(xb_ld(&bar[XB_XGEN(b.x)]) == gen, bar);
            __builtin_amdgcn_fence(__ATOMIC_ACQUIRE, "agent");
            asm volatile("s_waitcnt vmcnt(0)" ::: "memory");
        }
    }
    __syncthreads();
}

constexpr int NWAVES = 8, NT = 512;
constexpr int LDS_BYTES = 163840;
constexpr int YP_OFF = 129536;
struct Args { const float* in[29]; float* out; unsigned char* ws; int ph_lo, ph_hi; };
struct Frame {
    LAS unsigned char* lds; unsigned char* ws; float* out; const float* const* in;
    int tid, lane, wave, G, bid;
};
__device__ __forceinline__ const float* xrow_ptr(const Frame& F, int m) { return m < MP ? F.in[0] + (size_t)m * DM : F.in[1] + (size_t)(m - MP) * DM; }

template <class MAP>
__device__ __forceinline__ void p0_transpose_item(const float* W, int K, int N, int Nout, bf16_t* WT, LAS float* scr, int item, int lane, MAP map) {
    const int nblk = Nout / 32, kb = item / nblk, nb = item % nblk, k0 = 64 * kb, n0 = 32 * nb;
    const int src = map(n0 + (lane & 31));
    float tv[32];
#pragma unroll
    for (int i = 0; i < 32; ++i) { const int kk = 2 * i + (lane >> 5); tv[i] = src >= 0 ? W[(size_t)(k0 + kk) * N + src] : 0.f; }
#pragma unroll
    for (int i = 0; i < 32; ++i) { const int kk = 2 * i + (lane >> 5); scr[kk * 33 + (lane & 31)] = tv[i]; }
    asm volatile("s_waitcnt lgkmcnt(0)" ::: "memory");
    const int c = lane & 7;
#pragma unroll
    for (int j = 0; j < 4; ++j) { const int n = (lane >> 3) + 8 * j; const LAS float* s = scr + (8 * c) * 33 + n;
        u32x4 o; o.x = pk2(s[0 * 33], s[1 * 33]); o.y = pk2(s[2 * 33], s[3 * 33]); o.z = pk2(s[4 * 33], s[5 * 33]); o.w = pk2(s[6 * 33], s[7 * 33]);
        *(u32x4*)(WT + (size_t)(n0 + n) * K + k0 + 8 * c) = o; }
    asm volatile("s_waitcnt lgkmcnt(0)" ::: "memory");
}
struct MapIn { __device__ int operator()(int n) const { if (n < 640) { const int w = n & 63; return (n & ~63) + (w >> 3) * 4 + (w & 3) + 32 * ((w >> 2) & 1); } return n < 2464 ? n : -1; } };
struct MapId { __device__ int operator()(int n) const { return n; } };
struct MapFfn { __device__ int operator()(int n) const { const int tile = n >> 8, sub = n & 255, ch = tile * 128 + (sub & 127); return sub < 128 ? ch : DFF + ch; } };

__device__ __forceinline__ void p0_prologue(Frame& F) {
    LAS float* scr = (LAS float*)(F.lds + F.wave * 16384);
    const int gw = F.bid * NWAVES + F.wave, NGW = F.G * NWAVES;
    constexpr int I_IN = 16 * (DINP / 32), I_OUT = 16 * 32, I_FI = 16 * (2 * DFF / 32), I_FO = (DFF / 64) * 32;
    constexpr int NITEMS = I_IN + I_OUT + I_FI + I_FO;
#ifndef TR_DUP
#define TR_DUP 1
#endif
    for (int it_ = gw; it_ < NITEMS * TR_DUP; it_ += NGW) {
        const int it = it_ % NITEMS;
        int r = it;
        if (r < I_IN) { p0_transpose_item(F.in[8], DM, 2464, DINP, (bf16_t*)(F.ws + WS_WIN), scr, r, F.lane, MapIn()); continue; } r -= I_IN;
        if (r < I_OUT) { p0_transpose_item(F.in[21], DM, DM, DM, (bf16_t*)(F.ws + WS_WOUT), scr, r, F.lane, MapId()); continue; } r -= I_OUT;
        if (r < I_FI) { p0_transpose_item(F.in[24], DM, 2 * DFF, 2 * DFF, (bf16_t*)(F.ws + WS_WFI), scr, r, F.lane, MapFfn()); continue; } r -= I_FI;
        p0_transpose_item(F.in[27], DFF, DM, DM, (bf16_t*)(F.ws + WS_WFO), scr, r, F.lane, MapId());
    }
    float* rope = (float*)(F.ws + WS_ROPE);
    for (int e = F.bid * NT + F.tid; e < (T + DT) * 32; e += F.G * NT) {
        const int pidx = e >> 5, i = e & 31; const int pos = pidx < T ? pidx : 16384 + (pidx - T);
        const float inv = (float)exp2(-(double)i * (13.287712379549449 / 32.0));
        const float angf = (float)pos * inv;
        const double a = (double)angf;
        const double TWO_PI = 6.283185307179586476925286766559;
        const double n = rint(a / TWO_PI);
        const double r = a - n * TWO_PI;
        const double r2 = r * r;
        double c = 1.0, s = 1.0, tc = 1.0, ts = 1.0;
#pragma unroll
        for (int k = 1; k <= 14; ++k) { tc = -tc * r2 * (1.0 / (double)((2 * k - 1) * (2 * k))); ts = -ts * r2 * (1.0 / (double)((2 * k) * (2 * k + 1))); c += tc; s += ts; }
        s *= r;
        rope[(size_t)e * 2] = (float)c; rope[(size_t)e * 2 + 1] = (float)s;
    }
    const float* g = F.in[7];
    bf16_t* XN = (bf16_t*)(F.ws + WS_XN);
    for (int m = gw; m < M; m += 2 * NGW) {
        const int m1 = m + NGW; const bool has1 = m1 < M;
        const f32x4* xr0 = (const f32x4*)xrow_ptr(F, m) + F.lane; const f32x4* xr1 = (const f32x4*)xrow_ptr(F, has1 ? m1 : m) + F.lane;
        f32x4 v0[4], v1[4];
#pragma unroll
        for (int j = 0; j < 4; ++j) v0[j] = __builtin_nontemporal_load(xr0 + 64 * j);
#pragma unroll
        for (int j = 0; j < 4; ++j) v1[j] = __builtin_nontemporal_load(xr1 + 64 * j);
        float s0 = 0.f, s1 = 0.f;
#pragma unroll
        for (int j = 0; j < 4; ++j) { s0 += (v0[j].x * v0[j].x + v0[j].y * v0[j].y) + (v0[j].z * v0[j].z + v0[j].w * v0[j].w); s1 += (v1[j].x * v1[j].x + v1[j].y * v1[j].y) + (v1[j].z * v1[j].z + v1[j].w * v1[j].w); }
        const float r0 = 1.0f / sqrtf(wave_sum(s0) * (1.f / DM) + RMS_EPS), r1 = 1.0f / sqrtf(wave_sum(s1) * (1.f / DM) + RMS_EPS);
        u32x2* o0 = (u32x2*)(XN + (size_t)m * DM) + F.lane; u32x2* o1 = (u32x2*)(XN + (size_t)m1 * DM) + F.lane;
#pragma unroll
        for (int j = 0; j < 4; ++j) { const f32x4 gg = ((const f32x4*)g)[64 * j + F.lane];
            u32x2 w; w.x = pk2(v0[j].x * r0 * gg.x, v0[j].y * r0 * gg.y); w.y = pk2(v0[j].z * r0 * gg.z, v0[j].w * r0 * gg.w); o0[64 * j] = w;
            if (has1) { u32x2 q; q.x = pk2(v1[j].x * r1 * gg.x, v1[j].y * r1 * gg.y); q.y = pk2(v1[j].z * r1 * gg.z, v1[j].w * r1 * gg.w); o1[64 * j] = q; } }
    }
}

__device__ __forceinline__ float hprev_val(const Frame& F, const bf16_t* HRW, int m, int col) {
    const RowInfo ri = row_info(m);
    if (ri.t == 0) return ri.samp ? F.in[4][(size_t)ri.b * DSH + col] : 0.f;
    return bf2f(HRW[(size_t)(m - 1) * DSH + col]);
}
__device__ __forceinline__ f32x4 ld_bf4(const bf16_t* p) { const u32x2 w = *(const u32x2*)p; return (f32x4){bflo(w.x), bfhi(w.x), bflo(w.y), bfhi(w.y)}; }
__device__ __forceinline__ f32x4 hs4(const Frame& F, const bf16_t* HRW, int m, const RowInfo& ri, int col) {
    const f32x4 h = ld_bf4(HRW + (size_t)m * DSH + col);
    f32x4 hp;
    if (ri.t == 0) hp = ri.samp ? *(const f32x4*)(F.in[4] + (size_t)ri.b * DSH + col) : (f32x4){0.f, 0.f, 0.f, 0.f};
    else hp = ld_bf4(HRW + (size_t)(m - 1) * DSH + col);
    const f32x4 mu = *(const f32x4*)(F.in[10] + col);
    return h + (hp - h) * mu;
}
struct F8 { f32x4 a, b; };
__device__ __forceinline__ F8 ld_bf8(const bf16_t* p) { const u32x4 w = *(const u32x4*)p; F8 r; r.a = (f32x4){bflo(w.x), bfhi(w.x), bflo(w.y), bfhi(w.y)}; r.b = (f32x4){bflo(w.z), bfhi(w.z), bflo(w.w), bfhi(w.w)}; return r; }
__device__ __forceinline__ u32x4 pk8(const f32x4 a, const f32x4 b) { u32x4 w; w.x = cvt_pk_bf16(a[0], a[1]); w.y = cvt_pk_bf16(a[2], a[3]); w.z = cvt_pk_bf16(b[0], b[1]); w.w = cvt_pk_bf16(b[2], b[3]); return w; }
__device__ __forceinline__ F8 hs8(const Frame& F, const bf16_t* HRW, int m, const RowInfo& ri, int col) {
    const F8 h = ld_bf8(HRW + (size_t)m * DSH + col);
    F8 hp;
    if (ri.t == 0) {
        if (ri.samp) { hp.a = *(const f32x4*)(F.in[4] + (size_t)ri.b * DSH + col); hp.b = *(const f32x4*)(F.in[4] + (size_t)ri.b * DSH + col + 4); }
        else { hp.a = (f32x4){0.f, 0.f, 0.f, 0.f}; hp.b = (f32x4){0.f, 0.f, 0.f, 0.f}; }
    } else hp = ld_bf8(HRW + (size_t)(m - 1) * DSH + col);
    const f32x4 mua = *(const f32x4*)(F.in[10] + col), mub = *(const f32x4*)(F.in[10] + col + 4);
    F8 r; r.a = h.a + (hp.a - h.a) * mua; r.b = h.b + (hp.b - h.b) * mub; return r;
}
__device__ __forceinline__ float xsum_fq(float v) {
    { auto r = __builtin_amdgcn_permlane16_swap(__float_as_uint(v), __float_as_uint(v), false, false); v = __uint_as_float(r[0]) + __uint_as_float(r[1]); }
    { auto r = __builtin_amdgcn_permlane32_swap(__float_as_uint(v), __float_as_uint(v), false, false); v = __uint_as_float(r[0]) + __uint_as_float(r[1]); }
    return v;
}
__device__ __forceinline__ u32x2 pk4(const f32x4 v) { u32x2 w; w.x = cvt_pk_bf16(v[0], v[1]); w.y = cvt_pk_bf16(v[2], v[3]); return w; }
__device__ __forceinline__ bf16x8 wfrag(const float* W, int k0, int fq, int ch) {
    u32x4 w; const float* p = W + (size_t)(k0 + 8 * fq) * 512 + ch;
    w.x = cvt_pk_bf16(p[0], p[512]); w.y = cvt_pk_bf16(p[1024], p[1536]); w.z = cvt_pk_bf16(p[2048], p[2560]); w.w = cvt_pk_bf16(p[3072], p[3584]);
    return __builtin_bit_cast(bf16x8, w);
}
#ifndef PREP_DUP
#define PREP_DUP 1
#endif
#ifndef POST_DUP
#define POST_DUP 1
#endif
__device__ __forceinline__ void prep_phase(Frame& F) {
    const bf16_t* HRW = (const bf16_t*)(F.ws + WS_HRW);
    bf16_t* SR = (bf16_t*)(F.ws + WS_SR); bf16_t* SK = (bf16_t*)(F.ws + WS_SK); bf16_t* SV = (bf16_t*)(F.ws + WS_SV);
    bf16_t* SKK = (bf16_t*)(F.ws + WS_SKK); bf16_t* SB = (bf16_t*)(F.ws + WS_SB); float* SW = (float*)(F.ws + WS_SW);
    const int fr = F.lane & 15, fq = F.lane >> 4, h = F.wave;
    bf16x8 Aw[4], Aa[4];
#pragma unroll
    for (int nt = 0; nt < 4; ++nt) { const int ch = h * 64 + 16 * (fr >> 2) + 4 * nt + (fr & 3); Aw[nt] = wfrag(F.in[12], 0, fq, ch); Aa[nt] = wfrag(F.in[14], 0, fq, ch); }
    constexpr int NTILE = M / 16;
    for (int tile_ = F.bid; tile_ < NTILE * PREP_DUP; tile_ += F.G) {
        const int m = (tile_ % NTILE) * 16 + fr;
        const RowInfo ri = row_info(m);
        bf16x8 xw, xa;
        { const F8 a = hs8(F, HRW, m, ri, 1536 + 8 * fq);
          f32x4 t0, t1;
#pragma unroll
          for (int i = 0; i < 4; ++i) { t0[i] = 1.f - 2.f * __builtin_amdgcn_rcpf(__expf(2.f * a.a[i]) + 1.f); t1[i] = 1.f - 2.f * __builtin_amdgcn_rcpf(__expf(2.f * a.b[i]) + 1.f); }
          xw = __builtin_bit_cast(bf16x8, pk8(t0, t1)); }
        { const F8 a = hs8(F, HRW, m, ri, 1568 + 8 * fq); xa = __builtin_bit_cast(bf16x8, pk8(a.a, a.b)); }
        f32x4 kkr[4], av[4]; float ss = 0.f;
#pragma unroll
        for (int np = 0; np < 2; ++np) {
            const int c8 = h * 64 + 16 * fq + 8 * np;
            const f32x4 z = {0.f, 0.f, 0.f, 0.f};
            f32x4 accw[2], acca[2];
#pragma unroll
            for (int q = 0; q < 2; ++q) { accw[q] = __builtin_amdgcn_mfma_f32_16x16x32_bf16(Aw[2 * np + q], xw, z, 0, 0, 0); acca[q] = __builtin_amdgcn_mfma_f32_16x16x32_bf16(Aa[2 * np + q], xa, z, 0, 0, 0); }
            const F8 r8 = hs8(F, HRW, m, ri, c8), k8 = hs8(F, HRW, m, ri, 512 + c8), v8 = hs8(F, HRW, m, ri, 1024 + c8);
            f32x4 dec[2], k2[2];
#pragma unroll
            for (int q = 0; q < 2; ++q) {
                const int c4 = c8 + 4 * q;
                const f32x4 k = q ? k8.b : k8.a;
                const f32x4 w0 = *(const f32x4*)(F.in[11] + c4), a0 = *(const f32x4*)(F.in[13] + c4), kkc = *(const f32x4*)(F.in[16] + c4), kac = *(const f32x4*)(F.in[17] + c4);
                f32x4 a;
#pragma unroll
                for (int j = 0; j < 4; ++j) {
                    const float x = -(w0[j] + accw[q][j]);
                    const float sp = fmaxf(x, 0.f) + __logf(1.f + __expf(-fabsf(x)));
                    dec[q][j] = __expf(-__expf(-sp - 0.5f));
                    a[j] = sigmoidf_(a0[j] + acca[q][j]);
                    k2[q][j] = k[j] * (1.f + (a[j] - 1.f) * kac[j]);
                }
                const f32x4 kk = k * kkc;
                ss += (kk[0] * kk[0] + kk[1] * kk[1]) + (kk[2] * kk[2] + kk[3] * kk[3]);
                kkr[2 * np + q] = kk; av[2 * np + q] = a;
            }
            const size_t o = (size_t)m * 512 + c8;
            *(f32x4*)(SW + o) = dec[0]; *(f32x4*)(SW + o + 4) = dec[1];
            *(u32x4*)(SR + o) = pk8(r8.a, r8.b); *(u32x4*)(SK + o) = pk8(k2[0], k2[1]); *(u32x4*)(SV + o) = pk8(v8.a, v8.b);
        }
        ss = xsum_fq(ss);
        const float rs = rsqrtf(fmaxf(ss, 1e-24f));
#pragma unroll
        for (int np = 0; np < 2; ++np) {
            const size_t o = (size_t)m * 512 + h * 64 + 16 * fq + 8 * np;
            const f32x4 ka = kkr[2 * np] * rs, kb = kkr[2 * np + 1] * rs;
            *(u32x4*)(SKK + o) = pk8(ka, kb); *(u32x4*)(SB + o) = pk8(ka * av[2 * np], kb * av[2 * np + 1]);
        }
    }
}

__device__ __forceinline__ void sample_attn_phase(Frame& F) {
    constexpr int NK = WIN + DT, KS = 68;
    LAS float* Kl = (LAS float*)F.lds;
    LAS float* Vl = Kl + NK * KS;
    LAS float* Pl = Vl + NK * KS;
    const bf16_t* Q = (const bf16_t*)(F.ws + WS_Q);
    bf16_t* OC = (bf16_t*)(F.ws + WS_OCAT);
    for (int unit = F.bid; unit < DB * 2; unit += F.G) {
        const int b = unit >> 1, kvh = unit & 1;
        for (int e = F.tid; e < NK * 16; e += NT) {
            const int key = e >> 4, d4 = (e & 15) * 4;
            f32x4 kv, vv;
            if (key < WIN) { kv = *(const f32x4*)(F.in[2] + ((size_t)(b * WIN + key) * 2 + kvh) * 64 + d4); vv = *(const f32x4*)(F.in[3] + ((size_t)(b * WIN + key) * 2 + kvh) * 64 + d4); }
            else { kv = *(const f32x4*)(F.out + O_KWS + ((size_t)(b * WIN + key - DT) * 2 + kvh) * 64 + d4); vv = *(const f32x4*)(F.out + O_VWS + ((size_t)(b * WIN + key - DT) * 2 + kvh) * 64 + d4); }
            *(LAS f32x4*)(Kl + key * KS + d4) = kv; *(LAS f32x4*)(Vl + key * KS + d4) = vv;
            if (key >= DT && key < WIN) { *(f32x4*)(F.out + O_KWS + ((size_t)(b * WIN + key - DT) * 2 + kvh) * 64 + d4) = kv; *(f32x4*)(F.out + O_VWS + ((size_t)(b * WIN + key - DT) * 2 + kvh) * 64 + d4) = vv; }
        }
        __syncthreads();
        const int qi = F.tid >> 4, sub = F.tid & 15;
        const int t = qi >> 2, g = qi & 3, head = kvh * 4 + g;
        const int m = MP + b * DT + t;
        float mx = F.in[9][head] * 1.4426950408889634f;
        {
            const bf16_t* qp = Q + (size_t)m * 512 + head * 64;
            float q[64];
#pragma unroll
            for (int i = 0; i < 8; ++i) { const u32x4 w = *(const u32x4*)(qp + 8 * i); q[8 * i] = bflo(w.x); q[8 * i + 1] = bfhi(w.x); q[8 * i + 2] = bflo(w.y); q[8 * i + 3] = bfhi(w.y); q[8 * i + 4] = bflo(w.z); q[8 * i + 5] = bfhi(w.z); q[8 * i + 6] = bflo(w.w); q[8 * i + 7] = bfhi(w.w); }
#pragma unroll 1
            for (int key = sub; key < NK; key += 16) {
                float a = 0.f; const LAS f32x4* kr = (const LAS f32x4*)(Kl + key * KS);
#pragma unroll
                for (int i = 0; i < 16; ++i) { const f32x4 kx = kr[i]; a += q[4 * i] * kx[0] + q[4 * i + 1] * kx[1] + q[4 * i + 2] * kx[2] + q[4 * i + 3] * kx[3]; }
                const int dist = t + WIN - key;
                const float s = (dist >= 0 && dist <= WIN) ? a : -1e30f;
                Pl[qi * NK + key] = s; mx = fmaxf(mx, s);
            }
        }
        mx = fmaxf(mx, __shfl_xor(mx, 1)); mx = fmaxf(mx, __shfl_xor(mx, 2)); mx = fmaxf(mx, __shfl_xor(mx, 4)); mx = fmaxf(mx, __shfl_xor(mx, 8));
        float sum = 0.f;
#pragma unroll 1
        for (int key = sub; key < NK; key += 16) { const float sv = Pl[qi * NK + key]; const float p = sv > -1e29f ? __builtin_amdgcn_exp2f(sv - mx) : 0.f; sum += p; Pl[qi * NK + key] = p; }
        sum += __shfl_xor(sum, 1); sum += __shfl_xor(sum, 2); sum += __shfl_xor(sum, 4); sum += __shfl_xor(sum, 8);
        const float inv = __builtin_amdgcn_rcpf(sum + __builtin_amdgcn_exp2f(F.in[9][head] * 1.4426950408889634f - mx));
        __syncthreads();
        f32x4 o = {0.f, 0.f, 0.f, 0.f};
        for (int key = 0; key < NK; ++key) { const float p = Pl[qi * NK + key]; const f32x4 vv = *(const LAS f32x4*)(Vl + key * KS + sub * 4); o += vv * p; }
        o = o * inv;
        u32x2 w; w.x = pk2(o[0], o[1]); w.y = pk2(o[2], o[3]);
        *(u32x2*)(OC + (size_t)m * DM + head * 64 + sub * 4) = w;
        __syncthreads();
    }
}

__device__ __forceinline__ void prompt_attn_unit(Frame& F, int unit) {
    constexpr int KST = 144, VST = 528;
    LAS unsigned char* Kl = F.lds; LAS unsigned char* Vl = F.lds + 256 * KST;
    const bf16_t* Q = (const bf16_t*)(F.ws + WS_Q); const bf16_t* Kb = (const bf16_t*)(F.ws + WS_K); const bf16_t* VT = (const bf16_t*)(F.ws + WS_VT);
    bf16_t* OC = (bf16_t*)(F.ws + WS_OCAT);
    const int kvh = unit & 1, qb = (unit >> 1) & 63, b = unit >> 7;
    const int key0 = (qb - 1) * 128;
    for (int e = F.tid; e < 256 * 8; e += NT) {
        const int key = e >> 3, ch = e & 7; const int pos = key0 + key;
        u32x4 v = {0u, 0u, 0u, 0u};
        if (pos >= 0) v = *(const u32x4*)(Kb + (size_t)(b * T + pos) * 128 + kvh * 64 + ch * 8);
        *(LAS u32x4*)(Kl + key * KST + ch * 16) = v;
    }
    for (int e = F.tid; e < 64 * 32; e += NT) {
        const int d = e >> 5, ch = e & 31; const int pos = key0 + ch * 8;
        u32x4 v = {0u, 0u, 0u, 0u};
        if (pos >= 0) v = *(const u32x4*)(VT + ((size_t)(b * 2 + kvh) * 64 + d) * T + pos);
        *(LAS u32x4*)(Vl + d * VST + ch * 16) = v;
    }
    __syncthreads();
    const int fr = F.lane & 15, fq = F.lane >> 4;
    const int head = kvh * 4 + (F.wave >> 1);
    const float sink = F.in[9][head] * 1.4426950408889634f;
#pragma unroll 1
    for (int sb = 0; sb < 4; ++sb) {
        const int qi0 = (F.wave & 1) * 64 + sb * 16;
        const int qi = qi0 + fr;
        const size_t mrow = (size_t)b * T + qb * 128 + qi;
        const bf16x8 q0 = *(const bf16x8*)(Q + mrow * 512 + head * 64 + fq * 8);
        const bf16x8 q1 = *(const bf16x8*)(Q + mrow * 512 + head * 64 + 32 + fq * 8);
        const int ktlo = (F.wave & 1) * 4 + sb;
        f32x4 s[9];
#pragma unroll
        for (int kr = 0; kr < 9; ++kr) {
            const int kt = ktlo + kr;
            const bf16x8 k0 = *(const LAS bf16x8*)(Kl + (kt * 16 + fr) * KST + fq * 16);
            const bf16x8 k1 = *(const LAS bf16x8*)(Kl + (kt * 16 + fr) * KST + 64 + fq * 16);
            f32x4 a = {0.f, 0.f, 0.f, 0.f};
            a = __builtin_amdgcn_mfma_f32_16x16x32_bf16(k0, q0, a, 0, 0, 0);
            a = __builtin_amdgcn_mfma_f32_16x16x32_bf16(k1, q1, a, 0, 0, 0);
            s[kr] = a;
        }
        float mx = sink;
#pragma unroll
        for (int kr = 0; kr < 9; ++kr)
#pragma unroll
            for (int j = 0; j < 4; ++j) { const int sj = (ktlo + kr) * 16 + fq * 4 + j; const int dist = qi + 128 - sj; const bool ok = dist >= 0 && dist <= WIN && (key0 + sj) >= 0; const float v = ok ? s[kr][j] : -1e30f; s[kr][j] = v; mx = fmaxf(mx, v); }
        mx = fmaxf(mx, __shfl_xor(mx, 16)); mx = fmaxf(mx, __shfl_xor(mx, 32));
        float sum = 0.f;
        u32x2 pw[10];
#pragma unroll
        for (int kr = 0; kr < 9; ++kr) {
            f32x4 p;
#pragma unroll
            for (int j = 0; j < 4; ++j) { p[j] = s[kr][j] > -1e29f ? __builtin_amdgcn_exp2f(s[kr][j] - mx) : 0.f; sum += p[j]; }
            pw[kr].x = cvt_pk_bf16(p[0], p[1]); pw[kr].y = cvt_pk_bf16(p[2], p[3]);
        }
        pw[9].x = 0u; pw[9].y = 0u;
        sum += __shfl_xor(sum, 16); sum += __shfl_xor(sum, 32);
        const float inv = __builtin_amdgcn_rcpf(sum + __builtin_amdgcn_exp2f(sink - mx));
        f32x4 o[4];
#pragma unroll
        for (int dt = 0; dt < 4; ++dt) o[dt] = (f32x4){0.f, 0.f, 0.f, 0.f};
#pragma unroll
        for (int u = 0; u < 5; ++u) {
            u32x4 pb; pb.x = pw[2 * u].x; pb.y = pw[2 * u].y; pb.z = pw[2 * u + 1].x; pb.w = pw[2 * u + 1].y;
            const bf16x8 pf = __builtin_bit_cast(bf16x8, pb);
            const int kta = ktlo + 2 * u, ktb = u < 4 ? kta + 1 : kta;
#pragma unroll
            for (int dt = 0; dt < 4; ++dt) {
                const LAS unsigned char* vr = Vl + (dt * 16 + fr) * VST + (fq * 4) * 2;
                const u32x2 va = *(const LAS u32x2*)(vr + kta * 32), vb = *(const LAS u32x2*)(vr + ktb * 32);
                u32x4 vv; vv.x = va.x; vv.y = va.y; vv.z = vb.x; vv.w = vb.y;
                o[dt] = __builtin_amdgcn_mfma_f32_16x16x32_bf16(__builtin_bit_cast(bf16x8, vv), pf, o[dt], 0, 0, 0);
            }
        }
#pragma unroll
        for (int dt = 0; dt < 4; ++dt) { const f32x4 v = o[dt] * inv; u32x2 w; w.x = cvt_pk_bf16(v[0], v[1]); w.y = cvt_pk_bf16(v[2], v[3]); *(u32x2*)(OC + mrow * DM + head * 64 + dt * 16 + fq * 4) = w; }
    }
    __syncthreads();
}

struct StepOps { f32x4 w, nbe, kk, k, r; float v; };
template <int STRIDE_F> __device__ __forceinline__ StepOps load_ops(const LAS float* img, int s, int cgi, int vrow) {
    const LAS float* p = img + s * STRIDE_F + cgi * 4; StepOps o;
    o.w = *(const LAS f32x4*)(p); o.nbe = *(const LAS f32x4*)(p + 64); o.kk = *(const LAS f32x4*)(p + 128); o.k = *(const LAS f32x4*)(p + 192); o.r = *(const LAS f32x4*)(p + 256);
    o.v = img[s * STRIDE_F + 320 + vrow]; return o;
}
template <int J> __device__ __forceinline__ float sel_lane16(float oldv, float newv) {
    float r; const unsigned long long m = 0x0001000100010001ull << J;
    asm("v_cndmask_b32_e64 %0, %1, %2, %3" : "=v"(r) : "v"(oldv), "v"(newv), "s"(m));
    return r;
}
struct ScanState { f32x2 s01, s23; float ykeep, ypart; StepOps c0, c1; };
template <int STRIDE_F, int J>
__device__ __forceinline__ void scan_step(const LAS float* img, int s0, int vrow, int cgi, ScanState& Z) {
    const StepOps nx = load_ops<STRIDE_F>(img, s0 + J + 2, cgi, vrow);
    const StepOps& c = Z.c0;
    const f32x2 kk01 = {c.kk[0], c.kk[1]}, kk23 = {c.kk[2], c.kk[3]}, w01 = {c.w[0], c.w[1]}, w23 = {c.w[2], c.w[3]}, k01 = {c.k[0], c.k[1]}, k23 = {c.k[2], c.k[3]};
    const f32x2 b01 = {c.nbe[0], c.nbe[1]}, b23 = {c.nbe[2], c.nbe[3]}, r01 = {c.r[0], c.r[1]}, r23 = {c.r[2], c.r[3]};
    f32x2 t = Z.s01 * kk01; t = Z.s23 * kk23 + t;
    float sa = t.x + t.y;
    const f32x2 u01 = Z.s01 * w01 + k01 * c.v, u23 = Z.s23 * w23 + k23 * c.v;
    if (J > 0) { allsum16_2(sa, Z.ypart); Z.ykeep = sel_lane16<(J > 0 ? J - 1 : 0)>(Z.ykeep, Z.ypart); } else sa = allsum16(sa);
    Z.s01 = b01 * sa + u01; Z.s23 = b23 * sa + u23;
    f32x2 y2 = Z.s01 * r01; y2 = Z.s23 * r23 + y2;
    Z.ypart = y2.x + y2.y;
    Z.c0 = Z.c1; Z.c1 = nx;
}
template <int STRIDE_F, int GS, int... Js>
__device__ __forceinline__ void scan_group_impl(const LAS float* img, int s0, int vrow, int cgi, ScanState& Z, float* yout, std::integer_sequence<int, Js...>) {
    (scan_step<STRIDE_F, Js>(img, s0, vrow, cgi, Z), ...);
    Z.ypart = allsum16(Z.ypart); Z.ykeep = sel_lane16<GS - 1>(Z.ykeep, Z.ypart);
    if (cgi < GS) yout[(size_t)(s0 + cgi) * 512] = Z.ykeep;
}
template <int STRIDE_F, int J>
__device__ __forceinline__ void scan_step_yp(const LAS float* img, int s0, int vrow, int cgi, ScanState& Z, LAS float* ypb) {
    const StepOps nx = load_ops<STRIDE_F>(img, s0 + J + 2, cgi, vrow);
    const StepOps& c = Z.c0;
    const f32x2 kk01 = {c.kk[0], c.kk[1]}, kk23 = {c.kk[2], c.kk[3]}, w01 = {c.w[0], c.w[1]}, w23 = {c.w[2], c.w[3]}, k01 = {c.k[0], c.k[1]}, k23 = {c.k[2], c.k[3]};
    const f32x2 b01 = {c.nbe[0], c.nbe[1]}, b23 = {c.nbe[2], c.nbe[3]}, r01 = {c.r[0], c.r[1]}, r23 = {c.r[2], c.r[3]};
    f32x2 t = Z.s01 * kk01; t = Z.s23 * kk23 + t;
    float sa = t.x + t.y;
    const f32x2 u01 = Z.s01 * w01 + k01 * c.v, u23 = Z.s23 * w23 + k23 * c.v;
    sa = allsum16(sa);
    Z.s01 = b01 * sa + u01; Z.s23 = b23 * sa + u23;
    f32x2 y2 = Z.s01 * r01; y2 = Z.s23 * r23 + y2;
    ypb[(s0 + J) * 64] = y2.x + y2.y;
    Z.c0 = Z.c1; Z.c1 = nx;
}
struct StepOpsS { f32x4 nbe, kk, k, r; };
template <int STRIDE_F> __device__ __forceinline__ StepOpsS load_ops_s(const LAS float* img, int s, int cgi) {
    const LAS float* p = img + s * STRIDE_F + cgi * 4; StepOpsS o;
    o.nbe = *(const LAS f32x4*)(p + 64); o.kk = *(const LAS f32x4*)(p + 128); o.k = *(const LAS f32x4*)(p + 192); o.r = *(const LAS f32x4*)(p + 256);
    return o;
}
struct ScanT { f32x2 t01, t23; StepOpsS c0, c1; f32x4 v4[4]; };
template <int STRIDE_F, int J>
__device__ __forceinline__ void scan_step_s(const LAS float* img, int cgi, ScanT& Z, LAS float* ypb) {
    const StepOpsS nx = load_ops_s<STRIDE_F>(img, J + 2, cgi);
    const StepOpsS& c = Z.c0;
    const float v = Z.v4[J >> 2][J & 3];
    f32x2 t = Z.t01 * (f32x2){c.kk[0], c.kk[1]}; t = Z.t23 * (f32x2){c.kk[2], c.kk[3]} + t;
    float sa = t.x + t.y;
    const f32x2 a01 = (f32x2){c.k[0], c.k[1]} * v + Z.t01, a23 = (f32x2){c.k[2], c.k[3]} * v + Z.t23;
    sa = allsum16(sa);
    Z.t01 = (f32x2){c.nbe[0], c.nbe[1]} * sa + a01; Z.t23 = (f32x2){c.nbe[2], c.nbe[3]} * sa + a23;
    f32x2 y2 = Z.t01 * (f32x2){c.r[0], c.r[1]}; y2 = Z.t23 * (f32x2){c.r[2], c.r[3]} + y2;
    ypb[J * 64] = y2.x + y2.y;
    Z.c0 = Z.c1; Z.c1 = nx;
}
template <int STRIDE_F, int... Js>
__device__ __forceinline__ void scan_chunk_s_impl(const LAS float* img, int cgi, ScanT& Z, LAS float* ypb, std::integer_sequence<int, Js...>) {
    (scan_step_s<STRIDE_F, Js>(img, cgi, Z, ypb), ...);
}
template <int STRIDE_F, int NS>
__device__ __forceinline__ void scan_transform(LAS float* img, int lane) {
    LAS float* p = img + lane; float Wc = 1.f;
#pragma unroll
    for (int t = 0; t < NS; ++t, p += STRIDE_F) {
        const float w = p[0], nb = p[64], kk = p[128], k = p[192], r = p[256];
        p[128] = Wc * kk;
        Wc *= w; const float inv = __builtin_amdgcn_rcpf(Wc);
        p[64] = nb * inv; p[192] = k * inv; p[256] = Wc * r;
    }
    img[(NS - 1) * STRIDE_F + lane] = Wc;
}
template <int STRIDE_F, int... Js>
__device__ __forceinline__ void scan_group_yp_impl(const LAS float* img, int s0, int vrow, int cgi, ScanState& Z, LAS float* ypb, std::integer_sequence<int, Js...>) {
    (scan_step_yp<STRIDE_F, Js>(img, s0, vrow, cgi, Z, ypb), ...);
}
template <int... Js>
__device__ __forceinline__ void yp_reduce_impl(const LAS float* ypb, int cgi, float* yout, int s0, std::integer_sequence<int, Js...>) {
    float ykeep = 0.f;
    ((ykeep = sel_lane16<Js>(ykeep, allsum16(ypb[(s0 + Js) * 64]))), ...);
    yout[(size_t)(s0 + cgi) * 512] = ykeep;
}
template <int STRIDE_F, int GS>
__device__ __forceinline__ void scan_group(const LAS float* img, int s0, int vrow, int cgi, ScanState& Z, float* yout) {
    scan_group_impl<STRIDE_F, GS>(img, s0, vrow, cgi, Z, yout, std::make_integer_sequence<int, GS>());
}
constexpr int SC = 32;
constexpr int PSTR = 328;
constexpr int SSTR = 384;
struct ScanRegs { f32x4 w[2]; u32x4 b0[2], b1[2]; u32x4 v; };
__device__ __forceinline__ void scan_load(const Frame& F, ScanRegs& R, int m0, int h, int v0) {
    if (F.wave < 4) return;
    const int vt = F.tid - 256;
#pragma unroll
    for (int i = 0; i < 2; ++i) {
        const int tid = vt + 256 * i;
        { const int row = tid >> 4, c4 = (tid & 15) * 4; R.w[i] = *(const f32x4*)((const float*)(F.ws + WS_SW) + (size_t)(m0 + row) * 512 + h * 64 + c4); }
        { const int st = tid >> 7, row = (tid & 127) >> 2, seg = tid & 3;
          const size_t base = st == 0 ? WS_SB : st == 1 ? WS_SKK : st == 2 ? WS_SK : WS_SR;
          const bf16_t* p = (const bf16_t*)(F.ws + base) + (size_t)(m0 + row) * 512 + h * 64 + seg * 16;
          R.b0[i] = *(const u32x4*)p; R.b1[i] = *(const u32x4*)(p + 8); }
    }
    { R.v = *(const u32x4*)((const bf16_t*)(F.ws + WS_SV) + (size_t)(m0 + (vt & 31)) * 512 + h * 64 + v0); }
}
__device__ __forceinline__ void scan_store(const Frame& F, const ScanRegs& R, LAS float* img) {
    if (F.wave < 4) return;
    const int vt = F.tid - 256;
#pragma unroll
    for (int i = 0; i < 2; ++i) {
        const int tid = vt + 256 * i;
        { const int row = tid >> 4, c4 = (tid & 15) * 4; *(LAS f32x4*)(img + row * PSTR + c4) = R.w[i]; }
        { const int st = tid >> 7, row = (tid & 127) >> 2, seg = tid & 3;
          LAS float* d = img + row * PSTR + 64 + st * 64 + seg * 16;
          const float sg = st == 0 ? -1.f : 1.f; const u32x4 b0 = R.b0[i], b1 = R.b1[i];
          *(LAS f32x4*)(d) = (f32x4){bflo(b0.x), bfhi(b0.x), bflo(b0.y), bfhi(b0.y)} * sg; *(LAS f32x4*)(d + 4) = (f32x4){bflo(b0.z), bfhi(b0.z), bflo(b0.w), bfhi(b0.w)} * sg;
          *(LAS f32x4*)(d + 8) = (f32x4){bflo(b1.x), bfhi(b1.x), bflo(b1.y), bfhi(b1.y)} * sg; *(LAS f32x4*)(d + 12) = (f32x4){bflo(b1.z), bfhi(b1.z), bflo(b1.w), bfhi(b1.w)} * sg; }
    }
    if (vt < 32) { LAS float* d = img + SC * PSTR + vt;
      d[0 * SC] = bflo(R.v.x); d[1 * SC] = bfhi(R.v.x); d[2 * SC] = bflo(R.v.y); d[3 * SC] = bfhi(R.v.y); d[4 * SC] = bflo(R.v.z); d[5 * SC] = bfhi(R.v.z); d[6 * SC] = bflo(R.v.w); d[7 * SC] = bfhi(R.v.w); }
}
constexpr int NSW = 2;
__device__ __forceinline__ void prompt_scan(Frame& F, int sblk) {
    const int xcd = sblk & 7, k = sblk >> 3;
    const int chain = xcd * 4 + (k >> 3), rg = k & 7;
    const int b = chain >> 3, h = chain & 7, v0 = rg * 8;
    LAS float* img = (LAS float*)F.lds;
    constexpr int IMG = SC * PSTR + 8 * SC;
    const int rl = F.lane >> 4, cgi = F.lane & 15;
    const int vrow = F.wave * 4 + rl;
    float* Y = F.out;
    ScanState Z; Z.s01 = (f32x2){0.f, 0.f}; Z.s23 = (f32x2){0.f, 0.f}; Z.ykeep = 0.f; Z.ypart = 0.f;
    ScanRegs R0, R1, R2, R3;
    const int mbase = b * T;
    constexpr int NCH = T / SC;
#ifndef SCAN_DUP
#define SCAN_DUP 1
#endif
    constexpr int NTOT = NCH * SCAN_DUP;
    scan_load(F, R0, mbase, h, v0); scan_store(F, R0, img);
    scan_load(F, R1, mbase + SC, h, v0); scan_store(F, R1, img + IMG);
    scan_load(F, R2, mbase + 2 * SC, h, v0); scan_load(F, R3, mbase + 3 * SC, h, v0);
    __syncthreads();
    if (F.wave == 4 || F.wave == 5) scan_transform<PSTR, 16>(img + (F.wave - 4) * 16 * PSTR, F.lane);
    __syncthreads();
    LAS float* ypr = (LAS float*)(F.lds + YP_OFF);
#define SCAN_CHUNK(cc_) do { const int c_ = (cc_) % NCH; \
        if (SCAN_DUP > 1 && c_ == 0) { Z.s01 = (f32x2){0.f, 0.f}; Z.s23 = (f32x2){0.f, 0.f}; } \
        if (F.wave < NSW) { const LAS float* im = img + ((cc_) % 3) * IMG; LAS float* ypb = ypr + (((cc_) & 1) * NSW + F.wave) * (SC * 64) + F.lane; \
            const LAS float* vtp = im + SC * PSTR + vrow * SC; \
            ScanT Tz; Tz.t01 = Z.s01; Tz.t23 = Z.s23; Tz.c0 = load_ops_s<PSTR>(im, 0, cgi); Tz.c1 = load_ops_s<PSTR>(im, 1, cgi); \
            _Pragma("unroll") for (int q_ = 0; q_ < 4; ++q_) Tz.v4[q_] = *(const LAS f32x4*)(vtp + 4 * q_); \
            scan_chunk_s_impl<PSTR>(im, cgi, Tz, ypb, std::make_integer_sequence<int, 16>()); \
            { const f32x4 wce = *(const LAS f32x4*)(im + 15 * PSTR + cgi * 4); Tz.t01 = Tz.t01 * (f32x2){wce[0], wce[1]}; Tz.t23 = Tz.t23 * (f32x2){wce[2], wce[3]}; } \
            _Pragma("unroll") for (int q_ = 0; q_ < 4; ++q_) Tz.v4[q_] = *(const LAS f32x4*)(vtp + 16 + 4 * q_); \
            scan_chunk_s_impl<PSTR>(im + 16 * PSTR, cgi, Tz, ypb + 16 * 64, std::make_integer_sequence<int, 16>()); \
            { const f32x4 wce = *(const LAS f32x4*)(im + 31 * PSTR + cgi * 4); Z.s01 = Tz.t01 * (f32x2){wce[0], wce[1]}; Z.s23 = Tz.t23 * (f32x2){wce[2], wce[3]}; } } \
        else if (F.wave < 2 * NSW && (cc_) > 0) { const int sw_ = F.wave - NSW, cp_ = ((cc_) - 1) % NCH; \
            const LAS float* ypb = ypr + ((((cc_) - 1) & 1) * NSW + sw_) * (SC * 64) + F.lane; float* yo = Y + (size_t)(mbase + cp_ * SC) * 512 + h * 64 + v0 + sw_ * 4 + rl; \
            yp_reduce_impl(ypb, cgi, yo, 0, std::make_integer_sequence<int, 16>()); yp_reduce_impl(ypb, cgi, yo, 16, std::make_integer_sequence<int, 16>()); } \
        else if ((F.wave == 4 || F.wave == 5) && (cc_) + 1 < NTOT) scan_transform<PSTR, 16>(img + (((cc_) + 1) % 3) * IMG + (F.wave - 4) * 16 * PSTR, F.lane); } while (0)
#define SCAN_ITER(j_, RL_, RS_) do { const int c4_ = cc + (j_); \
        scan_load(F, RL_, mbase + ((c4_ + 4 < NTOT ? c4_ + 4 : NTOT - 1) % NCH) * SC, h, v0);        \
        SCAN_CHUNK(c4_); \
        if (c4_ + 2 < NTOT) scan_store(F, RS_, img + ((c4_ + 2) % 3) * IMG);                         \
        asm volatile("s_waitcnt lgkmcnt(0)\n\ts_barrier" ::: "memory"); } while (0)
#pragma unroll 1
    for (int cc = 0; cc < NTOT; cc += 4) {
        SCAN_ITER(0, R0, R2); SCAN_ITER(1, R1, R3); SCAN_ITER(2, R2, R0); SCAN_ITER(3, R3, R1);
    }
#undef SCAN_ITER
#undef SCAN_CHUNK
    if (F.wave >= NSW && F.wave < 2 * NSW) { const int sw_ = F.wave - NSW, cp_ = (NTOT - 1) % NCH;
        const LAS float* ypb = ypr + (((NTOT - 1) & 1) * NSW + sw_) * (SC * 64) + F.lane; float* yo = Y + (size_t)(mbase + cp_ * SC) * 512 + h * 64 + v0 + sw_ * 4 + rl;
        yp_reduce_impl(ypb, cgi, yo, 0, std::make_integer_sequence<int, 16>()); yp_reduce_impl(ypb, cgi, yo, 16, std::make_integer_sequence<int, 16>()); }
    __syncthreads();
    if (F.wave < NSW) *(f32x4*)(F.out + O_WKVP + ((size_t)(b * 8 + h) * 64 + v0 + vrow) * 64 + cgi * 4) = (f32x4){Z.s01.x, Z.s01.y, Z.s23.x, Z.s23.y};
}
__device__ __forceinline__ void sample_scan(Frame& F, int sblk, int nsblk) {
    LAS float* img = (LAS float*)F.lds;
    float* Y = F.out;
    const int rl = F.lane >> 4, cgi = F.lane & 15;
    for (int chain = sblk; chain < DB * 8; chain += nsblk) {
        const int b = chain >> 3, h = chain & 7; const int m0 = MP + b * DT;
        for (int e = F.tid; e < 6 * DT * 64; e += NT) {
            const int st = e >> 9, row = (e >> 6) & 7, ch = e & 63; const size_t o = (size_t)(m0 + row) * 512 + h * 64 + ch;
            float val;
            if (st == 0) val = ((const float*)(F.ws + WS_SW))[o];
            else { const size_t base = st == 1 ? WS_SB : st == 2 ? WS_SKK : st == 3 ? WS_SK : st == 4 ? WS_SR : WS_SV; val = bf2f(((const bf16_t*)(F.ws + base))[o]); if (st == 1) val = -val; }
            img[row * SSTR + st * 64 + ch] = val;
        }
        __syncthreads();
#pragma unroll 1
        for (int rnd = 0; rnd < 2; ++rnd) {
            const int vrow = (rnd * 8 + F.wave) * 4 + rl;
            const float* s0 = F.in[5] + ((size_t)chain * 64 + vrow) * 64 + cgi * 4;
            const f32x4 S = *(const f32x4*)s0;
            ScanState Z; Z.s01 = (f32x2){S[0], S[1]}; Z.s23 = (f32x2){S[2], S[3]}; Z.ykeep = 0.f; Z.ypart = 0.f;
            Z.c0 = load_ops<SSTR>(img, 0, cgi, vrow); Z.c1 = load_ops<SSTR>(img, 1, cgi, vrow);
            scan_group<SSTR, DT>(img, 0, vrow, cgi, Z, Y + (size_t)m0 * 512 + h * 64 + vrow);
            *(f32x4*)(F.out + O_WKVS + ((size_t)chain * 64 + vrow) * 64 + cgi * 4) = (f32x4){Z.s01.x, Z.s01.y, Z.s23.x, Z.s23.y};
        }
        __syncthreads();
    }
}

__device__ __forceinline__ void post_phase(Frame& F) {
    const bf16_t* HRW = (const bf16_t*)(F.ws + WS_HRW);
    const bf16_t* SR = (const bf16_t*)(F.ws + WS_SR); const bf16_t* SK = (const bf16_t*)(F.ws + WS_SK); const bf16_t* SV = (const bf16_t*)(F.ws + WS_SV);
    const float* Y = F.out; bf16_t* OC = (bf16_t*)(F.ws + WS_OCAT);
    const int fr = F.lane & 15, fq = F.lane >> 4, h = F.wave;
    bf16x8 Ag[4][3];
#pragma unroll
    for (int nt = 0; nt < 4; ++nt)
#pragma unroll
        for (int s3 = 0; s3 < 3; ++s3) Ag[nt][s3] = wfrag(F.in[15], 32 * s3, fq, h * 64 + 16 * (fr >> 2) + 4 * nt + (fr & 3));
    constexpr int NTILE = M / 16;
    for (int tile_ = F.bid; tile_ < NTILE * POST_DUP; tile_ += F.G) {
        const int m = (tile_ % NTILE) * 16 + fr;
        const RowInfo ri = row_info(m);
        bf16x8 xg[3];
#pragma unroll
        for (int s3 = 0; s3 < 3; ++s3) {
            const F8 a = hs8(F, HRW, m, ri, 1600 + 32 * s3 + 8 * fq);
            f32x4 t0, t1;
#pragma unroll
            for (int i = 0; i < 4; ++i) { t0[i] = sigmoidf_(a.a[i]); t1[i] = sigmoidf_(a.b[i]); }
            xg[s3] = __builtin_bit_cast(bf16x8, pk8(t0, t1));
        }
        f32x4 y4[4], v4[4], g4[4]; float sy = 0.f, dot = 0.f;
#pragma unroll
        for (int np = 0; np < 2; ++np) {
            const int c8 = h * 64 + 16 * fq + 8 * np; const size_t o = (size_t)m * 512 + c8;
#pragma unroll
            for (int q = 0; q < 2; ++q) { f32x4 g = {0.f, 0.f, 0.f, 0.f};
#pragma unroll
                for (int s3 = 0; s3 < 3; ++s3) g = __builtin_amdgcn_mfma_f32_16x16x32_bf16(Ag[2 * np + q][s3], xg[s3], g, 0, 0, 0);
                g4[2 * np + q] = g; }
            const f32x4 ya = *(const f32x4*)(Y + o), yb = *(const f32x4*)(Y + o + 4);
            const F8 r8 = ld_bf8(SR + o), k8 = ld_bf8(SK + o), v8 = ld_bf8(SV + o);
            const f32x4 rka = *(const f32x4*)(F.in[18] + c8), rkb = *(const f32x4*)(F.in[18] + c8 + 4);
            y4[2 * np] = ya; y4[2 * np + 1] = yb; v4[2 * np] = v8.a; v4[2 * np + 1] = v8.b;
            sy += ((ya[0] + ya[1]) + (ya[2] + ya[3])) + ((yb[0] + yb[1]) + (yb[2] + yb[3]));
            const f32x4 pa = r8.a * k8.a * rka, pb = r8.b * k8.b * rkb; dot += ((pa[0] + pa[1]) + (pa[2] + pa[3])) + ((pb[0] + pb[1]) + (pb[2] + pb[3]));
        }
        const float mean = xsum_fq(sy) * (1.f / 64.f); dot = xsum_fq(dot);
        float sq = 0.f;
#pragma unroll
        for (int nt = 0; nt < 4; ++nt) { y4[nt] = y4[nt] - mean; const f32x4 d = y4[nt]; sq += (d[0] * d[0] + d[1] * d[1]) + (d[2] * d[2] + d[3] * d[3]); }
        const float rstd = rsqrtf(xsum_fq(sq) * (1.f / 64.f) + GN_EPS);
#pragma unroll
        for (int np = 0; np < 2; ++np) {
            const int c8 = h * 64 + 16 * fq + 8 * np;
            f32x4 oo[2];
#pragma unroll
            for (int q = 0; q < 2; ++q) { const int c4 = c8 + 4 * q; const f32x4 gw = *(const f32x4*)(F.in[19] + c4), gb = *(const f32x4*)(F.in[20] + c4);
                oo[q] = (y4[2 * np + q] * rstd * gw + gb + v4[2 * np + q] * dot) * g4[2 * np + q]; }
            *(u32x4*)(OC + (size_t)m * DM + 512 + c8) = pk8(oo[0], oo[1]);
        }
    }
}

__device__ __forceinline__ f32x4 bf4_to_f(const u32x2 w) { return (f32x4){bflo(w.x), bfhi(w.x), bflo(w.y), bfhi(w.y)}; }
__device__ __forceinline__ float sumsq4(const f32x4 (&v)[4]) { float s = 0.f;
#pragma unroll
    for (int j = 0; j < 4; ++j) s += (v[j].x * v[j].x + v[j].y * v[j].y) + (v[j].z * v[j].z + v[j].w * v[j].w);
    return s; }
__device__ __forceinline__ void rows_mid(Frame& F) {
    const int gw = F.bid * NWAVES + F.wave, NGW = F.G * NWAVES;
    const f32x4* g1 = (const f32x4*)F.in[22]; const f32x4* g2 = (const f32x4*)F.in[23];
    bf16_t* XN = (bf16_t*)(F.ws + WS_XN); const bf16_t* MIXb = (const bf16_t*)(F.ws + WS_MIX);
    for (int m = gw; m < M; m += 2 * NGW) {
        const int m1 = m + NGW; const bool has1 = m1 < M; const int mm1 = has1 ? m1 : m;
        const f32x4* xr0 = (const f32x4*)xrow_ptr(F, m) + F.lane; const f32x4* xr1 = (const f32x4*)xrow_ptr(F, mm1) + F.lane;
        const u32x2* mb0 = (const u32x2*)(MIXb + (size_t)m * DM) + F.lane; const u32x2* mb1 = (const u32x2*)(MIXb + (size_t)mm1 * DM) + F.lane;
        f32x4 v0[4], v1[4], x0[4], x1[4];
#pragma unroll
        for (int j = 0; j < 4; ++j) { v0[j] = bf4_to_f(__builtin_nontemporal_load(mb0 + 64 * j)); x0[j] = __builtin_nontemporal_load(xr0 + 64 * j); }
#pragma unroll
        for (int j = 0; j < 4; ++j) { v1[j] = bf4_to_f(__builtin_nontemporal_load(mb1 + 64 * j)); x1[j] = __builtin_nontemporal_load(xr1 + 64 * j); }
        const float ra = 1.0f / sqrtf(wave_sum(sumsq4(v0)) * (1.f / DM) + RMS_EPS), rb = 1.0f / sqrtf(wave_sum(sumsq4(v1)) * (1.f / DM) + RMS_EPS);
#pragma unroll
        for (int j = 0; j < 4; ++j) { const f32x4 gg = g1[64 * j + F.lane]; v0[j] = x0[j] + v0[j] * ra * gg; v1[j] = x1[j] + v1[j] * rb * gg; }
        const float qa = 1.0f / sqrtf(wave_sum(sumsq4(v0)) * (1.f / DM) + RMS_EPS), qb = 1.0f / sqrtf(wave_sum(sumsq4(v1)) * (1.f / DM) + RMS_EPS);
        u32x2* o0 = (u32x2*)(XN + (size_t)m * DM) + F.lane; u32x2* o1 = (u32x2*)(XN + (size_t)mm1 * DM) + F.lane;
#pragma unroll
        for (int j = 0; j < 4; ++j) { const f32x4 gg = g2[64 * j + F.lane];
            u32x2 w; w.x = pk2(v0[j].x * qa * gg.x, v0[j].y * qa * gg.y); w.y = pk2(v0[j].z * qa * gg.z, v0[j].w * qa * gg.w); o0[64 * j] = w;
            if (has1) { u32x2 q; q.x = pk2(v1[j].x * qb * gg.x, v1[j].y * qb * gg.y); q.y = pk2(v1[j].z * qb * gg.z, v1[j].w * qb * gg.w); o1[64 * j] = q; } }
    }
}
__device__ __forceinline__ void rows_final(Frame& F) {
    const int gw = F.bid * NWAVES + F.wave, NGW = F.G * NWAVES;
    const f32x4* g0 = (const f32x4*)F.in[22]; const f32x4* g1 = (const f32x4*)F.in[28];
    const bf16_t* Fb = (const bf16_t*)(F.ws + WS_F); const bf16_t* MIXb = (const bf16_t*)(F.ws + WS_MIX);
    for (int m = gw; m < M; m += 2 * NGW) {
        const int m1 = m + NGW; const bool has1 = m1 < M; const int mm1 = has1 ? m1 : m;
        f32x4 f0[4], f1[4], a0[4], a1[4], x0[4], x1[4];
        { const u32x2* fr = (const u32x2*)(Fb + (size_t)m * DM) + F.lane; const u32x2* mb = (const u32x2*)(MIXb + (size_t)m * DM) + F.lane; const f32x4* xr = (const f32x4*)xrow_ptr(F, m) + F.lane;
#pragma unroll
          for (int j = 0; j < 4; ++j) { f0[j] = bf4_to_f(__builtin_nontemporal_load(fr + 64 * j)); a0[j] = bf4_to_f(__builtin_nontemporal_load(mb + 64 * j)); x0[j] = __builtin_nontemporal_load(xr + 64 * j); } }
        { const u32x2* fr = (const u32x2*)(Fb + (size_t)mm1 * DM) + F.lane; const u32x2* mb = (const u32x2*)(MIXb + (size_t)mm1 * DM) + F.lane; const f32x4* xr = (const f32x4*)xrow_ptr(F, mm1) + F.lane;
#pragma unroll
          for (int j = 0; j < 4; ++j) { f1[j] = bf4_to_f(__builtin_nontemporal_load(fr + 64 * j)); a1[j] = bf4_to_f(__builtin_nontemporal_load(mb + 64 * j)); x1[j] = __builtin_nontemporal_load(xr + 64 * j); } }
        const float rf0 = 1.0f / sqrtf(wave_sum(sumsq4(f0)) * (1.f / DM) + RMS_EPS), rm0 = 1.0f / sqrtf(wave_sum(sumsq4(a0)) * (1.f / DM) + RMS_EPS);
        const float rf1 = 1.0f / sqrtf(wave_sum(sumsq4(f1)) * (1.f / DM) + RMS_EPS), rm1 = 1.0f / sqrtf(wave_sum(sumsq4(a1)) * (1.f / DM) + RMS_EPS);
        f32x4* y0 = (f32x4*)(F.out + (size_t)m * DM) + F.lane; f32x4* y1 = (f32x4*)(F.out + (size_t)mm1 * DM) + F.lane;
#pragma unroll
        for (int j = 0; j < 4; ++j) { const f32x4 ga = g0[64 * j + F.lane], gb = g1[64 * j + F.lane];
            __builtin_nontemporal_store((x0[j] + a0[j] * rm0 * ga) + f0[j] * rf0 * gb, y0 + 64 * j);
            if (has1) __builtin_nontemporal_store((x1[j] + a1[j] * rm1 * ga) + f1[j] * rf1 * gb, y1 + 64 * j); }
    }
}
__device__ __forceinline__ void conv_phase(Frame& F, int half) {
    const bf16_t* ZU = (const bf16_t*)(F.ws + WS_ZU); bf16_t* HID = (bf16_t*)(F.ws + WS_HID);
    const float* cw = F.in[25]; const float* cb = F.in[26]; const float* sc = F.in[6];
    const long total = (long)M * 176;
    for (long e = (long)F.bid * NT + F.tid; e < total; e += (long)F.G * NT) {
        const int m = (int)(e / 176), r = (int)(e - (long)m * 176); const int tile = r >> 4, c8 = (r & 15) * 8;
        const int ch = (half * 11 + tile) * 128 + c8;
        const RowInfo ri = row_info(m);
        const bf16_t* zp = ZU + (size_t)m * DFF + tile * 256 + c8;
        const u32x4 z0 = *(const u32x4*)zp, uu = *(const u32x4*)(zp + 128);
        float z[8], z1[8], z2[8], u8[8];
        z[0] = bflo(z0.x); z[1] = bfhi(z0.x); z[2] = bflo(z0.y); z[3] = bfhi(z0.y); z[4] = bflo(z0.z); z[5] = bfhi(z0.z); z[6] = bflo(z0.w); z[7] = bfhi(z0.w);
        u8[0] = bflo(uu.x); u8[1] = bfhi(uu.x); u8[2] = bflo(uu.y); u8[3] = bfhi(uu.y); u8[4] = bflo(uu.z); u8[5] = bfhi(uu.z); u8[6] = bflo(uu.w); u8[7] = bfhi(uu.w);
        if (ri.t >= 1) { const u32x4 w = *(const u32x4*)(zp - DFF); z1[0] = bflo(w.x); z1[1] = bfhi(w.x); z1[2] = bflo(w.y); z1[3] = bfhi(w.y); z1[4] = bflo(w.z); z1[5] = bfhi(w.z); z1[6] = bflo(w.w); z1[7] = bfhi(w.w); }
        else {
#pragma unroll
            for (int j = 0; j < 8; ++j) z1[j] = ri.samp ? sc[((size_t)ri.b * 2 + 1) * DFF + ch + j] : 0.f; }
        if (ri.t >= 2) { const u32x4 w = *(const u32x4*)(zp - 2 * DFF); z2[0] = bflo(w.x); z2[1] = bfhi(w.x); z2[2] = bflo(w.y); z2[3] = bfhi(w.y); z2[4] = bflo(w.z); z2[5] = bfhi(w.z); z2[6] = bflo(w.w); z2[7] = bfhi(w.w); }
        else {
#pragma unroll
            for (int j = 0; j < 8; ++j) z2[j] = ri.samp ? sc[((size_t)ri.b * 2 + ri.t) * DFF + ch + j] : 0.f; }
        float hd[8];
#pragma unroll
        for (int j = 0; j < 8; ++j) { const float zc = cb[ch + j] + cw[ch + j] * z2[j] + cw[DFF + ch + j] * z1[j] + cw[2 * DFF + ch + j] * z[j]; hd[j] = zc * sigmoidf_(zc) * u8[j]; }
        u32x4 w; w.x = pk2(hd[0], hd[1]); w.y = pk2(hd[2], hd[3]); w.z = pk2(hd[4], hd[5]); w.w = pk2(hd[6], hd[7]);
        *(u32x4*)(HID + (size_t)m * DFF + ch) = w;
    }
}

constexpr int NPHASE = 10;
__global__ void __launch_bounds__(NT, 2) fwd_megakernel(Args args) {
    extern __shared__ __attribute__((aligned(16))) unsigned char lds_raw[];
    Frame F;
    F.lds = (LAS unsigned char*)lds_raw; F.ws = args.ws; F.out = args.out; F.in = args.in;
    F.tid = threadIdx.x; F.lane = F.tid & 63; F.wave = __builtin_amdgcn_readfirstlane(F.tid >> 6); F.G = gridDim.x; F.bid = blockIdx.x;
    const int lo = args.ph_lo, hi = args.ph_hi;
#ifndef PH_MASK
#define PH_MASK 0x3ff
#endif
#ifndef DUP_MASK
#define DUP_MASK 0
#endif
#define IN(k) (((PH_MASK >> (k)) & 1) && lo <= (k) && (k) < hi)
#define REP(k) for (int rep_ = 0; rep_ < 1 + ((DUP_MASK >> (k)) & 1); ++rep_)
    unsigned* barw = (unsigned*)F.ws;
    volatile LAS unsigned* bst = (volatile LAS unsigned*)(F.lds + LDS_BYTES - 64);
    if (F.tid < 2) bst[F.tid] = 0u;
    XcdBarrier xbar; xbar.bar = barw; xbar.x = 0; xbar.st = bst;
    if (lo + 1 < hi) xbar = xcd_barrier_post(barw, bst);
    if (args.ph_lo < -12345) cg::this_grid().sync();
#define SEAM(k) do { if (IN(k) && IN((k) + 1)) xcd_barrier(xbar); } while (0)
    bf16_t* XN = (bf16_t*)(F.ws + WS_XN);
    if (IN(0)) REP(0) { p0_prologue(F); } SEAM(0);
    if (IN(1)) REP(1) {
        pg8::Gemm g{XN, (const bf16_t*)(F.ws + WS_WIN), M, DINP, DM, DM, DM, 0}; pg8::StaticOrder S; S.init(M, DINP, F.G, F.bid);
        Epi1 E{(const float*)(F.ws + WS_ROPE), (bf16_t*)(F.ws + WS_Q), (bf16_t*)(F.ws + WS_K), (bf16_t*)(F.ws + WS_VT), (bf16_t*)(F.ws + WS_HRW), F.out};
        pg8::gemm_phase<Epi1, true>(F.lds, g, S, E);
    } SEAM(1);
    if (IN(2)) REP(2) { prep_phase(F); sample_attn_phase(F); } SEAM(2);
    if (IN(3)) {
        for (int u = F.bid; u < NB * 64 * 2; u += F.G) prompt_attn_unit(F, u);
        sample_scan(F, F.bid, F.G);
        for (int sb = F.bid; sb < 256; sb += F.G) prompt_scan(F, sb);
    } SEAM(3);
    if (IN(4)) REP(4) { post_phase(F); } SEAM(4);
    if (IN(5)) REP(5) {
        pg8::Gemm g{(const bf16_t*)(F.ws + WS_OCAT), (const bf16_t*)(F.ws + WS_WOUT), M, DM, DM, DM, DM, 0}; pg8::StaticOrder S; S.init(M, DM, F.G, F.bid);
        EpiBf16 E{(bf16_t*)(F.ws + WS_MIX), DM};
        pg8::gemm_phase<EpiBf16, true>(F.lds, g, S, E);
    } SEAM(5);
    if (IN(6)) { rows_mid(F); } SEAM(6);
    if (IN(7)) REP(7) {
        pg8::Gemm g{XN, (const bf16_t*)(F.ws + WS_WFI), 136 * 256, 2 * DFF, DM, DM, DM, 1}; pg8::StaticOrder S; S.init(136 * 256, 2 * DFF, F.G, F.bid);
        EpiConv E{(bf16_t*)(F.ws + WS_HID), F.out, F.in[25], F.in[26], F.in[6], (LAS float*)(F.lds + 131072)};
        pg8::gemm_phase<EpiConv, true>(F.lds, g, S, E);
    } SEAM(7);
    if (IN(8)) REP(11) {
        pg8::Gemm g{(const bf16_t*)(F.ws + WS_HID), (const bf16_t*)(F.ws + WS_WFO), M, DM, DFF, DFF, DFF, 0}; pg8::StaticOrder S; S.init(M, DM, F.G, F.bid);
        EpiBf16 E{(bf16_t*)(F.ws + WS_F), DM};
        pg8::gemm_phase<EpiBf16, true>(F.lds, g, S, E);
    } SEAM(8);
    if (IN(9)) { rows_final(F); }
#undef IN
#undef SEAM
}

extern "C" void kernel_launch(void* const* d_in, const int* in_sizes, int n_in, void* d_out, int out_size, void* d_ws, size_t ws_size, hipStream_t stream) {
    static int grid = 0;
    if (grid == 0) {
        if (n_in != 29 || ws_size < WS_END) { fprintf(stderr, "kernel_launch: unexpected n_in %d / ws_size %zu\n", n_in, ws_size); grid = -1; return; }
        int dev = 0, cus = 0, per_cu = 0;
        hipGetDevice(&dev); hipDeviceGetAttribute(&cus, hipDeviceAttributeMultiprocessorCount, dev);
        if (hipFuncSetAttribute((const void*)fwd_megakernel, hipFuncAttributeMaxDynamicSharedMemorySize, LDS_BYTES) != hipSuccess) { fprintf(stderr, "kernel_launch: hipFuncSetAttribute failed\n"); grid = -1; return; }
        if (hipOccupancyMaxActiveBlocksPerMultiprocessor(&per_cu, (const void*)fwd_megakernel, NT, LDS_BYTES) != hipSuccess || per_cu < 1) { fprintf(stderr, "kernel_launch: occupancy query failed (%d)\n", per_cu); (void)hipGetLastError(); per_cu = 1; }
        grid = cus * (per_cu > 1 ? 1 : per_cu);
        fprintf(stderr, "kernel_launch: grid %d (cus %d, per_cu %d), ws %zu\n", grid, cus, per_cu, ws_size);
    }
    if (grid < 0) return;
    Args a{};
    for (int i = 0; i < 29; ++i) a.in[i] = (const float*)d_in[i];
    a.out = (float*)d_out; a.ws = (unsigned char*)d_ws;
#if MK_PER_PHASE
    for (int p = 0; p < NPHASE; ++p) { a.ph_lo = p; a.ph_hi = p + 1; hipLaunchKernelGGL(fwd_megakernel, dim3(grid), dim3(NT), LDS_BYTES, stream, a); }
#else
    a.ph_lo = 0; a.ph_hi = NPHASE;
    if (hipMemsetAsync(d_ws, 0, 16384, stream) != hipSuccess) { fprintf(stderr, "kernel_launch: hipMemsetAsync of the barrier words failed\n"); return; }
    void* kargs[] = {&a};
    hipError_t e = hipLaunchCooperativeKernel((const void*)fwd_megakernel, dim3(grid), dim3(NT), kargs, LDS_BYTES, stream);
    if (e != hipSuccess) fprintf(stderr, "cooperative launch failed: %s (grid %d)\n", hipGetErrorString(e), grid);
#endif
}
```

```cpp
#include <hip/hip_runtime.h>
#include <hip/hip_cooperative_groups.h>
#include <cstdio>
#include <cstdint>
#include <utility>
namespace cg = cooperative_groups;

#ifndef MK_PER_PHASE
#define MK_PER_PHASE 0
#endif

#define LAS __attribute__((address_space(3)))
typedef unsigned short bf16_t;
typedef short bf16x8 __attribute__((ext_vector_type(8)));
typedef float f32x4 __attribute__((ext_vector_type(4)));
typedef float f32x2 __attribute__((ext_vector_type(2)));
typedef unsigned u32x4 __attribute__((ext_vector_type(4)));
typedef unsigned u32x2 __attribute__((ext_vector_type(2)));

constexpr int DM = 1024, NB = 4, T = 8192, MP = NB * T, DB = 128, DT = 8, MS = DB * DT, M = MP + MS;
constexpr int WIN = 128, DSH = 1696, DINP = 2560, DFF = 2816, DFFH = 1408;
constexpr float RMS_EPS = 1e-6f, GN_EPS = 64e-5f;
constexpr float QSCALE = 0.125f * 1.4426950408889634f;
constexpr size_t O_Y = 0, O_KWP = 34603008, O_VWP = 34668544, O_SHP = 34734080, O_WKVP = 34740864, O_CVP = 34871936,
                 O_KWS = 34894464, O_VWS = 36991616, O_SHS = 39088768, O_WKVS = 39305856, O_CVS = 43500160;
constexpr size_t MiB = 1u << 20;
constexpr size_t WS_WIN = 1 * MiB, WS_WOUT = 6 * MiB, WS_WFI = 8 * MiB, WS_WFO = 19 * MiB, WS_ROPE = 25 * MiB;
constexpr size_t WS_XN = 32 * MiB;
constexpr size_t WS_SR = 32 * MiB, WS_SK = 65 * MiB;
constexpr size_t WS_Q = 98 * MiB, WS_K = 131 * MiB, WS_VT = 140 * MiB;
constexpr size_t WS_HRW = 150 * MiB;
constexpr size_t WS_OCAT = 260 * MiB;
constexpr size_t WS_SW = 326 * MiB;
constexpr size_t WS_SV = 392 * MiB, WS_SKK = 425 * MiB, WS_SB = 458 * MiB;
constexpr size_t WS_ZU = 100 * MiB;
constexpr size_t WS_HID = 282 * MiB;
constexpr size_t WS_F = 216 * MiB;
constexpr size_t WS_MIX = 150 * MiB;
constexpr size_t WS_END = 491 * MiB;

__device__ __forceinline__ unsigned f2bf(float f) { unsigned u = __float_as_uint(f); return (u + 0x7fffu + ((u >> 16) & 1u)) >> 16; }

__device__ __forceinline__ float bf2f(unsigned short h) { return __uint_as_float(((unsigned)h) << 16); }
__device__ __forceinline__ float bflo(unsigned w) { return __uint_as_float(w << 16); }
__device__ __forceinline__ float bfhi(unsigned w) { return __uint_as_float(w & 0xffff0000u); }
__device__ __forceinline__ unsigned cvt_pk_bf16(float lo, float hi) { unsigned r; asm volatile("v_cvt_pk_bf16_f32 %0, %1, %2" : "=v"(r) : "v"(lo), "v"(hi)); return r; }
__device__ __forceinline__ unsigned pk2(float lo, float hi) { return cvt_pk_bf16(lo, hi); }
template <int CTRL> __device__ __forceinline__ float dppf(float x) { return __int_as_float(__builtin_amdgcn_update_dpp(0, __float_as_int(x), CTRL, 0xF, 0xF, false)); }
__device__ __forceinline__ float allsum16(float x) {
    x += dppf<0xB1>(x); x += dppf<0x4E>(x); x += dppf<0x141>(x); x += dppf<0x140>(x); return x;
}
__device__ __forceinline__ void allsum16_2(float& a, float& b) {
    a += dppf<0xB1>(a); b += dppf<0xB1>(b); a += dppf<0x4E>(a); b += dppf<0x4E>(b); a += dppf<0x141>(a); b += dppf<0x141>(b); a += dppf<0x140>(a); b += dppf<0x140>(b);
}
__device__ __forceinline__ float wave_sum(float v) {
    v = allsum16(v);
    { auto r = __builtin_amdgcn_permlane16_swap(__float_as_uint(v), __float_as_uint(v), false, false); v = __uint_as_float(r[0]) + __uint_as_float(r[1]); }
    { auto r = __builtin_amdgcn_permlane32_swap(__float_as_uint(v), __float_as_uint(v), false, false); v = __uint_as_float(r[0]) + __uint_as_float(r[1]); }
    return v;
}
__device__ __forceinline__ float sigmoidf_(float x) { return __builtin_amdgcn_rcpf(1.0f + __expf(-x)); }

namespace pg8 {
constexpr int BM = 256, BK = 64, HALF = 128, HTB = HALF * BK * 2, STAGE_BYTES = 8 * HTB, NXCD = 8, WGM = 8;
__host__ __device__ __forceinline__ int lds_byte(int r, int c) { const int st = (r >> 4) * 2 + (c >> 5), rr = r & 15, cc = c & 31, ob = rr * 64 + cc * 2; return st * 1024 + (ob ^ (((ob >> 9) & 1) << 5)); }
__host__ __device__ __forceinline__ void stage_rc(int b, int& R, int& C) { const int st = b / 1024, sb = b % 1024, swz = sb ^ (((sb >> 9) & 1) << 5); R = (st >> 1) * 16 + swz / 64; C = (st & 1) * 32 + (swz % 64) / 2; }
__host__ __device__ __forceinline__ int perm32(int rho) { const int n = rho >> 4, i = rho & 15; return 8 * (i >> 2) + 4 * n + (i & 3); }
struct Unit { int pm, pn; };
struct Gemm { const bf16_t* A; const bf16_t* Bt; int M, N, K, lda, ldb, conv; };
__device__ __forceinline__ long arow(const Gemm& g, int pm) {
    if (!g.conv) return (long)pm * 256;
    if (pm < 132) { const int b = pm / 33; return (long)b * 8192 + 254 * (pm - 33 * b) - 2; }
    return 32768 + (long)(pm - 132) * 256;
}
struct StaticOrder {
    int nM, nN, nwg, G, c;
    __device__ void init(int M_, int N_, int G_, int c_) { nM = M_ / BM; nN = N_ / BM; nwg = nM * nN; G = G_; c = c_; }
    __device__ bool next(int i, Unit& u) const {
        const long L = (long)i * G + c; if (L >= nwg) return false;
        int wgid = (int)L; { const int q = nwg / NXCD, r = nwg % NXCD, xcd = wgid % NXCD, off = wgid / NXCD; wgid = (xcd < r ? xcd * (q + 1) : r * (q + 1) + (xcd - r) * q) + off; }
        const int nig = WGM * nN, gid = wgid / nig, fm = gid * WGM, gsz = (nM - fm) < WGM ? (nM - fm) : WGM;
        u.pm = fm + ((wgid % nig) % gsz); u.pn = (wgid % nig) / gsz; return true;
    }
};
template <class Epi, bool ALIGN_EPI>
__device__ __forceinline__ void gemm_phase(LAS unsigned char* lds, const Gemm g, const StaticOrder& S, const Epi& E) {
    const int tid = threadIdx.x, wid = __builtin_amdgcn_readfirstlane(tid >> 6), lane = tid & 63, wr = wid >> 2, wc = wid & 3, fr = lane & 15, fq = lane >> 4;
    const int nt = g.K / BK;
    unsigned voffA[2], voffB[2];
#pragma unroll
    for (int i = 0; i < 2; ++i) { int R, C; stage_rc(tid * 16 + i * 8192, R, C); const int Rb = (R & ~31) + perm32(R & 31);
        voffA[i] = (unsigned)(R * g.lda + C) * 2u; voffB[i] = (unsigned)(Rb * g.ldb + C) * 2u; }
    const size_t kstep = (size_t)(BK * 2);
    const size_t hstepA = (size_t)HALF * g.lda * 2, hstepB = (size_t)HALF * g.ldb * 2;
    const size_t rowA = (size_t)g.lda * 2, tstepB = 2 * hstepB;
    const unsigned ldsw = (unsigned)wid * 1024u;
    const int aoff = lds_byte(wr * 64 + fr, fq * 8), boff = lds_byte(wc * 32 + fr, fq * 8);
#define PG8_SA(b, h) (((b) * 2 + (h)) * HTB)
#define PG8_SB(b, h) ((4 + (b) * 2 + (h)) * HTB)
#define PG8_STAGE(bufoff, gbase, voff) do { _Pragma("unroll") for (int _i = 0; _i < 2; ++_i) \
        __builtin_amdgcn_global_load_lds((const unsigned*)((const char*)(gbase) + (voff)[_i]), (LAS unsigned*)(lds + (bufoff) + ldsw + _i * 8192), 16, 0, 0); } while (0)
#define PG8_LDA(dst, b, h) do { _Pragma("unroll") for (int m = 0; m < 4; ++m) _Pragma("unroll") for (int k = 0; k < 2; ++k) dst[m][k] = *(const LAS bf16x8*)(lds + PG8_SA(b, h) + aoff + m * 2048 + k * 1024); } while (0)
#define PG8_LDB(dst, b, h) do { _Pragma("unroll") for (int n = 0; n < 2; ++n) _Pragma("unroll") for (int k = 0; k < 2; ++k) dst[n][k] = *(const LAS bf16x8*)(lds + PG8_SB(b, h) + boff + n * 2048 + k * 1024); } while (0)
#define PG8_MMA(ai, bj, At, Bt) do { __builtin_amdgcn_s_setprio(1); _Pragma("unroll") for (int m = 0; m < 4; ++m) _Pragma("unroll") for (int n = 0; n < 2; ++n) _Pragma("unroll") for (int k = 0; k < 2; ++k) \
        acc[ai][bj][m][n] = __builtin_amdgcn_mfma_f32_16x16x32_bf16(Bt[n][k], At[m][k], acc[ai][bj][m][n], 0, 0, 0); __builtin_amdgcn_s_setprio(0); } while (0)
#define PG8_WAIT_V(n) asm volatile("s_waitcnt vmcnt(" #n ")" ::: "memory")
#define PG8_WAIT_L(n) asm volatile("s_waitcnt lgkmcnt(" #n ")" ::: "memory")
#define PG8_BAR __builtin_amdgcn_s_barrier()
#define PG8_SCHED __builtin_amdgcn_sched_barrier(0)
    Unit cur, nxt; int ui = 0;
    if (!S.next(0, cur)) return;
    f32x4 acc[2][2][4][2];
#pragma unroll
    for (int a = 0; a < 2; ++a)
#pragma unroll
        for (int b = 0; b < 2; ++b)
#pragma unroll
            for (int m = 0; m < 4; ++m)
#pragma unroll
                for (int n = 0; n < 2; ++n) acc[a][b][m][n] = (f32x4){0.f, 0.f, 0.f, 0.f};
    bf16x8 At[4][2], B0[2][2], B1[2][2];
    const char* cA = (const char*)g.A + arow(g, cur.pm) * (long)rowA; const char* cB = (const char*)g.Bt + (size_t)cur.pn * tstepB;
    PG8_STAGE(PG8_SB(0, 0), cB, voffB); PG8_STAGE(PG8_SB(0, 1), cB + hstepB, voffB); PG8_STAGE(PG8_SA(0, 0), cA, voffA); PG8_STAGE(PG8_SA(0, 1), cA + hstepA, voffA);
    if (wr == 1) PG8_BAR;
    PG8_WAIT_V(2); PG8_BAR;
    PG8_STAGE(PG8_SB(1, 0), cB + kstep, voffB); PG8_STAGE(PG8_SA(1, 0), cA + kstep, voffA); PG8_STAGE(PG8_SB(1, 1), cB + hstepB + kstep, voffB);
    PG8_WAIT_V(6); PG8_BAR;
    for (;;) {
        const bool has_next = S.next(ui + 1, nxt);
        const char* nA = has_next ? (const char*)g.A + arow(g, nxt.pm) * (long)rowA : cA; const char* nB = has_next ? (const char*)g.Bt + (size_t)nxt.pn * tstepB : cB;
        for (int t = 0; t < nt; t += 2) {
            const bool last = (t == nt - 2);
            const char* a1 = cA + (size_t)(t + 1) * kstep;
            const char* a2 = last ? nA : cA + (size_t)(t + 2) * kstep; const char* b2 = last ? nB : cB + (size_t)(t + 2) * kstep;
            const char* a3 = a2 + kstep; const char* b3 = b2 + kstep;
            PG8_LDB(B0, 0, 0); PG8_LDB(B1, 0, 1); PG8_SCHED; PG8_LDA(At, 0, 0); PG8_STAGE(PG8_SA(1, 1), a1 + hstepA, voffA);
            PG8_WAIT_V(8); PG8_WAIT_L(0); PG8_BAR; PG8_MMA(0, 0, At, B0); PG8_MMA(0, 1, At, B1); PG8_BAR; PG8_SCHED;
            PG8_LDA(At, 0, 1); PG8_STAGE(PG8_SB(0, 0), b2, voffB); PG8_STAGE(PG8_SB(0, 1), b2 + hstepB, voffB); PG8_STAGE(PG8_SA(0, 0), a2, voffA);
            PG8_WAIT_V(8); PG8_WAIT_L(0); PG8_BAR; PG8_MMA(1, 0, At, B0); PG8_MMA(1, 1, At, B1); PG8_BAR; PG8_SCHED;
            PG8_LDB(B0, 1, 0); PG8_LDB(B1, 1, 1); PG8_SCHED; PG8_LDA(At, 1, 0); PG8_STAGE(PG8_SA(0, 1), a2 + hstepA, voffA);
            PG8_WAIT_V(8); PG8_WAIT_L(0); PG8_BAR; PG8_MMA(0, 0, At, B0); PG8_MMA(0, 1, At, B1); PG8_BAR; PG8_SCHED;
            PG8_LDA(At, 1, 1); PG8_STAGE(PG8_SB(1, 0), b3, voffB); PG8_STAGE(PG8_SB(1, 1), b3 + hstepB, voffB); PG8_STAGE(PG8_SA(1, 0), a3, voffA);
            PG8_WAIT_V(8); PG8_WAIT_L(0); PG8_BAR; PG8_MMA(1, 0, At, B0); PG8_MMA(1, 1, At, B1); PG8_BAR; PG8_SCHED;
        }
        if constexpr (ALIGN_EPI) { if (wr == 0) PG8_BAR; }
        asm volatile("s_nop 7\n\ts_nop 7" ::: "memory");
        E(acc, cur, wr, wc, fr, fq);
        if (!has_next) break;
#pragma unroll
        for (int a = 0; a < 2; ++a)
#pragma unroll
            for (int b = 0; b < 2; ++b)
#pragma unroll
                for (int m = 0; m < 4; ++m)
#pragma unroll
                    for (int n = 0; n < 2; ++n) acc[a][b][m][n] = (f32x4){0.f, 0.f, 0.f, 0.f};
        cur = nxt; cA = nA; cB = nB; ++ui;
        if constexpr (ALIGN_EPI) { if (wr == 1) PG8_BAR; }
    }
    PG8_WAIT_V(0);
    if constexpr (!ALIGN_EPI) { if (wr == 0) PG8_BAR; }
    PG8_BAR;
#undef PG8_SA
#undef PG8_SB
#undef PG8_STAGE
#undef PG8_LDA
#undef PG8_LDB
#undef PG8_MMA
#undef PG8_WAIT_V
#undef PG8_WAIT_L
#undef PG8_BAR
#undef PG8_SCHED
}
}

struct RowInfo { int b, t, samp; };
__device__ __forceinline__ RowInfo row_info(int row) { RowInfo r; if (row < MP) { r.samp = 0; r.b = row >> 13; r.t = row & (T - 1); } else { const int rs = row - MP; r.samp = 1; r.b = rs >> 3; r.t = rs & 7; } return r; }

struct Epi1 {
    const float* rope; bf16_t* Q; bf16_t* Kb; bf16_t* VT; bf16_t* HRW; float* out;
    __device__ __forceinline__ void operator()(const f32x4 (&acc)[2][2][4][2], const pg8::Unit& u, int wr, int wc, int fr, int fq) const {
#pragma unroll
        for (int ai = 0; ai < 2; ++ai)
#pragma unroll
            for (int m = 0; m < 4; ++m) {
                const int row = u.pm * 256 + ai * 128 + wr * 64 + m * 16 + fr;
                const RowInfo ri = row_info(row);
                const int pidx = ri.samp ? (T + ri.t) : ri.t;
#pragma unroll
                for (int bj = 0; bj < 2; ++bj) {
                    const int cb = u.pn * 256 + bj * 128;
                    const int c0 = cb + wc * 32 + fq * 8;
                    const f32x4 v0 = acc[ai][bj][m][0], v1 = acc[ai][bj][m][1];
                    if (cb < 640) {
                        const int d0 = ((c0 & 63) >> 3) * 4;
                        const f32x4* rp = (const f32x4*)(rope + ((size_t)pidx * 32 + d0) * 2);
                        const f32x4 cs0 = rp[0], cs1 = rp[1];
                        f32x4 o1, o2;
                        o1[0] = v0[0] * cs0[0] - v1[0] * cs0[1]; o2[0] = v1[0] * cs0[0] + v0[0] * cs0[1];
                        o1[1] = v0[1] * cs0[2] - v1[1] * cs0[3]; o2[1] = v1[1] * cs0[2] + v0[1] * cs0[3];
                        o1[2] = v0[2] * cs1[0] - v1[2] * cs1[1]; o2[2] = v1[2] * cs1[0] + v0[2] * cs1[1];
                        o1[3] = v0[3] * cs1[2] - v1[3] * cs1[3]; o2[3] = v1[3] * cs1[2] + v0[3] * cs1[3];
                        if (cb < 512) {
                            o1 = o1 * QSCALE; o2 = o2 * QSCALE;
                            bf16_t* qp = Q + (size_t)row * 512 + (c0 & ~63) + d0;
                            u32x2 w1, w2; w1.x = cvt_pk_bf16(o1[0], o1[1]); w1.y = cvt_pk_bf16(o1[2], o1[3]); w2.x = cvt_pk_bf16(o2[0], o2[1]); w2.y = cvt_pk_bf16(o2[2], o2[3]);
                            *(u32x2*)qp = w1; *(u32x2*)(qp + 32) = w2;
                        } else {
                            const int kvh = (c0 - 512) >> 6;
                            bf16_t* kp = Kb + (size_t)row * 128 + kvh * 64 + d0;
                            u32x2 w1, w2; w1.x = cvt_pk_bf16(o1[0], o1[1]); w1.y = cvt_pk_bf16(o1[2], o1[3]); w2.x = cvt_pk_bf16(o2[0], o2[1]); w2.y = cvt_pk_bf16(o2[2], o2[3]);
                            *(u32x2*)kp = w1; *(u32x2*)(kp + 32) = w2;
                            if (!ri.samp) { if (ri.t >= T - WIN) { float* o = out + O_KWP + ((size_t)(ri.b * WIN + (ri.t - (T - WIN))) * 2 + kvh) * 64 + d0; *(f32x4*)o = o1; *(f32x4*)(o + 32) = o2; } }
                            else { float* o = out + O_KWS + ((size_t)(ri.b * WIN + (WIN - DT) + ri.t) * 2 + kvh) * 64 + d0; *(f32x4*)o = o1; *(f32x4*)(o + 32) = o2; }
                        }
                    } else if (cb < 768) {
                        const int kvh = (c0 - 640) >> 6, d0 = (c0 - 640) & 63;
                        if (!ri.samp) {
                            bf16_t* vp = VT + ((size_t)(ri.b * 2 + kvh) * 64 + d0) * T + ri.t;
                            vp[0] = (bf16_t)f2bf(v0[0]); vp[(size_t)T] = (bf16_t)f2bf(v0[1]); vp[(size_t)2 * T] = (bf16_t)f2bf(v0[2]); vp[(size_t)3 * T] = (bf16_t)f2bf(v0[3]);
                            vp[(size_t)4 * T] = (bf16_t)f2bf(v1[0]); vp[(size_t)5 * T] = (bf16_t)f2bf(v1[1]); vp[(size_t)6 * T] = (bf16_t)f2bf(v1[2]); vp[(size_t)7 * T] = (bf16_t)f2bf(v1[3]);
                            if (ri.t >= T - WIN) { float* o = out + O_VWP + ((size_t)(ri.b * WIN + (ri.t - (T - WIN))) * 2 + kvh) * 64 + d0; *(f32x4*)o = v0; *(f32x4*)(o + 4) = v1; }
                        } else { float* o = out + O_VWS + ((size_t)(ri.b * WIN + (WIN - DT) + ri.t) * 2 + kvh) * 64 + d0; *(f32x4*)o = v0; *(f32x4*)(o + 4) = v1; }
                    } else if (c0 < 2464) {
                        const int col = c0 - 768;
                        u32x4 w; w.x = cvt_pk_bf16(v0[0], v0[1]); w.y = cvt_pk_bf16(v0[2], v0[3]); w.z = cvt_pk_bf16(v1[0], v1[1]); w.w = cvt_pk_bf16(v1[2], v1[3]);
                        *(u32x4*)(HRW + (size_t)row * DSH + col) = w;
                        if (!ri.samp) { if (ri.t == T - 1) { float* o = out + O_SHP + (size_t)ri.b * DSH + col; *(f32x4*)o = v0; *(f32x4*)(o + 4) = v1; } }
                        else if (ri.t == DT - 1) { float* o = out + O_SHS + (size_t)ri.b * DSH + col; *(f32x4*)o = v0; *(f32x4*)(o + 4) = v1; }
                    }
                }
            }
    }
};
struct EpiF32 {
    float* O; int ldc;
    __device__ __forceinline__ void operator()(const f32x4 (&acc)[2][2][4][2], const pg8::Unit& u, int wr, int wc, int fr, int fq) const {
#pragma unroll
        for (int ai = 0; ai < 2; ++ai)
#pragma unroll
            for (int m = 0; m < 4; ++m) {
                float* rowp = O + (size_t)(u.pm * 256 + ai * 128 + wr * 64 + m * 16 + fr) * ldc + u.pn * 256 + wc * 32 + fq * 8;
#pragma unroll
                for (int bj = 0; bj < 2; ++bj) { *(f32x4*)(rowp + bj * 128) = acc[ai][bj][m][0]; *(f32x4*)(rowp + bj * 128 + 4) = acc[ai][bj][m][1]; }
            }
    }
};
struct EpiBf16 {
    bf16_t* O; int ldc;
    __device__ __forceinline__ void operator()(const f32x4 (&acc)[2][2][4][2], const pg8::Unit& u, int wr, int wc, int fr, int fq) const {
#pragma unroll
        for (int ai = 0; ai < 2; ++ai)
#pragma unroll
            for (int m = 0; m < 4; ++m) {
                bf16_t* rowp = O + (size_t)(u.pm * 256 + ai * 128 + wr * 64 + m * 16 + fr) * ldc + u.pn * 256 + wc * 32 + fq * 8;
#pragma unroll
                for (int bj = 0; bj < 2; ++bj) { const f32x4 v0 = acc[ai][bj][m][0], v1 = acc[ai][bj][m][1];
                    u32x4 w; w.x = cvt_pk_bf16(v0[0], v0[1]); w.y = cvt_pk_bf16(v0[2], v0[3]); w.z = cvt_pk_bf16(v1[0], v1[1]); w.w = cvt_pk_bf16(v1[2], v1[3]);
                    *(u32x4*)(rowp + bj * 128) = w; }
            }
    }
};
template <int CTRL> __device__ __forceinline__ float dpp_old(float old, float src) { return __int_as_float(__builtin_amdgcn_update_dpp(__float_as_int(old), __float_as_int(src), CTRL, 0xF, 0xF, false)); }
struct EpiConv {
    bf16_t* HID; float* out; const float* cw; const float* cb; const float* sc; LAS float* exch;
    __device__ __forceinline__ void operator()(const f32x4 (&acc)[2][2][4][2], const pg8::Unit& u, int wr, int wc, int fr, int fq) const {
        const int cw8 = wc * 32 + fq * 8, ch0 = u.pn * 128 + cw8;
        if (fr >= 14) {
#pragma unroll
            for (int ai = 0; ai < 2; ++ai)
#pragma unroll
                for (int n = 0; n < 2; ++n) *(LAS f32x4*)(exch + ((ai * 2 + wr) * 2 + (fr - 14)) * 128 + cw8 + 4 * n) = acc[ai][0][3][n];
        }
        asm volatile("s_waitcnt lgkmcnt(0)\n\ts_barrier" ::: "memory");
        int row0, b0 = 0, i0 = 0; const bool samp = u.pm >= 132;
        if (!samp) { b0 = u.pm / 33; i0 = u.pm - 33 * b0; row0 = b0 * T + 254 * i0 - 2; } else row0 = MP + (u.pm - 132) * 256;
        f32x4 w0[2], w1[2], w2[2], bb[2];
#pragma unroll
        for (int n = 0; n < 2; ++n) { w0[n] = *(const f32x4*)(cw + ch0 + 4 * n); w1[n] = *(const f32x4*)(cw + DFF + ch0 + 4 * n); w2[n] = *(const f32x4*)(cw + 2 * DFF + ch0 + 4 * n); bb[n] = *(const f32x4*)(cb + ch0 + 4 * n); }
#pragma unroll
        for (int ai = 0; ai < 2; ++ai) {
            const int strip = ai * 2 + wr;
            f32x4 h1[2], h2[2];
#pragma unroll
            for (int n = 0; n < 2; ++n) {
                if (strip > 0) { h1[n] = *(const LAS f32x4*)(exch + ((strip - 1) * 2 + 1) * 128 + cw8 + 4 * n); h2[n] = *(const LAS f32x4*)(exch + ((strip - 1) * 2) * 128 + cw8 + 4 * n); }
                else { h1[n] = (f32x4){0.f, 0.f, 0.f, 0.f}; h2[n] = (f32x4){0.f, 0.f, 0.f, 0.f}; }
            }
#pragma unroll
            for (int m = 0; m < 4; ++m) {
                const int lr = ai * 128 + wr * 64 + m * 16 + fr;
                int t, b; bool valid;
                if (!samp) { t = 254 * i0 + lr - 2; b = b0; valid = lr >= 2 && t < T; } else { const int rs = row0 - MP + lr; b = rs >> 3; t = rs & 7; valid = true; }
                const size_t R = (size_t)((long)row0 + lr);
                f32x4 hd[2];
#pragma unroll
                for (int n = 0; n < 2; ++n) {
                    const f32x4 z = acc[ai][0][m][n], uu = acc[ai][1][m][n];
                    f32x4 o1, o2, zm1, zm2;
                    if (m == 0) { o1 = h1[n]; o2 = (fr == 0) ? h2[n] : h1[n]; }
                    else {
#pragma unroll
                        for (int e = 0; e < 4; ++e) { o1[e] = dppf<0x121>(acc[ai][0][m > 0 ? m - 1 : 0][n][e]); o2[e] = dppf<0x122>(acc[ai][0][m > 0 ? m - 1 : 0][n][e]); }
                    }
#pragma unroll
                    for (int e = 0; e < 4; ++e) { zm1[e] = dpp_old<0x111>(o1[e], z[e]); zm2[e] = dpp_old<0x112>(o2[e], z[e]); }
                    if (t == 0) {
                        if (samp) { zm1 = *(const f32x4*)(sc + ((size_t)b * 2 + 1) * DFF + ch0 + 4 * n); zm2 = *(const f32x4*)(sc + ((size_t)b * 2) * DFF + ch0 + 4 * n); }
                        else { zm1 = (f32x4){0.f, 0.f, 0.f, 0.f}; zm2 = (f32x4){0.f, 0.f, 0.f, 0.f}; }
                    } else if (t == 1) {
                        if (samp) zm2 = *(const f32x4*)(sc + ((size_t)b * 2 + 1) * DFF + ch0 + 4 * n); else zm2 = (f32x4){0.f, 0.f, 0.f, 0.f};
                    }
                    const f32x4 zc = bb[n] + w0[n] * zm2 + w1[n] * zm1 + w2[n] * z;
#pragma unroll
                    for (int e = 0; e < 4; ++e) hd[n][e] = zc[e] * sigmoidf_(zc[e]) * uu[e];
                }
                if (valid) {
                    u32x4 w; w.x = cvt_pk_bf16(hd[0][0], hd[0][1]); w.y = cvt_pk_bf16(hd[0][2], hd[0][3]); w.z = cvt_pk_bf16(hd[1][0], hd[1][1]); w.w = cvt_pk_bf16(hd[1][2], hd[1][3]);
                    *(u32x4*)(HID + R * DFF + ch0) = w;
                    if (!samp) { if (t >= T - 2) { float* o = out + O_CVP + (size_t)(b * 2 + (t - (T - 2))) * DFF + ch0; *(f32x4*)o = acc[ai][0][m][0]; *(f32x4*)(o + 4) = acc[ai][0][m][1]; } }
                    else if (t >= DT - 2) { float* o = out + O_CVS + (size_t)(b * 2 + (t - (DT - 2))) * DFF + ch0; *(f32x4*)o = acc[ai][0][m][0]; *(f32x4*)(o + 4) = acc[ai][0][m][1]; }
                }
            }
        }
    }
};

#define XB_TMO      128
#define XB_XCNT(j)  (256  + 64 * (j))
#define XB_XSUB(j)  (1280 + 64 * (j))
#define XB_XGEN(j)  (2304 + 64 * (j))
#define XB_TOP      3328
#define XB_TOPGEN   3392
#define XCD_BAR_WORDS 3456
#define XB_SPIN_CAP (1u << 20)
__device__ __forceinline__ unsigned xb_ld(unsigned* p)              { return __hip_atomic_load(p, __ATOMIC_RELAXED, __HIP_MEMORY_SCOPE_AGENT); }
__device__ __forceinline__ unsigned xb_add(unsigned* p, unsigned v) { return __hip_atomic_fetch_add(p, v, __ATOMIC_RELAXED, __HIP_MEMORY_SCOPE_AGENT); }
__device__ __forceinline__ unsigned xb_xcc_id() { return (unsigned)__builtin_amdgcn_s_getreg((3 << 11) | 20) & 0xFu; }
#define XB_SPIN(cond, bar) do { unsigned _sp = 0; while (cond) { __builtin_amdgcn_s_sleep(1); \
    if ((++_sp & 255u) == 0u) { if (xb_ld(&(bar)[XB_TMO])) break; if (_sp > XB_SPIN_CAP) { atomicAdd(&(bar)[XB_TMO], 1u); break; } } } } while (0)
struct XcdBarrier { unsigned* bar; unsigned x; volatile LAS unsigned* st; };
__device__ __forceinline__ XcdBarrier xcd_barrier_post(unsigned* bar, volatile LAS unsigned* st) {
    XcdBarrier b; b.bar = bar; b.x = xb_xcc_id(); b.st = st;
    if (threadIdx.x == 0) (void)xb_add(&bar[XB_XCNT(b.x)], 1u);
    return b;
}
__device__ __forceinline__ void xcd_barrier_complete(unsigned* bar, unsigned x, unsigned& nloc, unsigned& nx) {
    const unsigned G = gridDim.x * gridDim.y * gridDim.z;
    unsigned sum, cnt, mine, sp = 0u;
    for (;;) {
        sum = 0u; cnt = 0u; mine = 0u;
#pragma unroll
        for (unsigned j = 0; j < 16; ++j) { const unsigned c = xb_ld(&bar[XB_XCNT(j)]); sum += c; cnt += (c > 0u) ? 1u : 0u; mine = (j == x) ? c : mine; }
        if (sum == G) break;
        __builtin_amdgcn_s_sleep(1);
        if ((++sp & 255u) == 0u) { if (xb_ld(&bar[XB_TMO])) break; if (sp > XB_SPIN_CAP) { atomicAdd(&bar[XB_TMO], 1u); break; } }
    }
    nloc = mine > 0u ? mine : 1u; nx = cnt > 0u ? cnt : 1u;
}
__device__ __forceinline__ void xcd_barrier(const XcdBarrier& b) {
    asm volatile("s_waitcnt vmcnt(0)" ::: "memory");
    __syncthreads();
    if (threadIdx.x == 0) {
        unsigned* bar = b.bar;
        __builtin_amdgcn_s_waitcnt(0);
        unsigned nloc = b.st[0], nx = b.st[1];
        if (nloc == 0u) { xcd_barrier_complete(bar, b.x, nloc, nx); b.st[0] = nloc; b.st[1] = nx; }
        const unsigned old = xb_add(&bar[XB_XSUB(b.x)], 1u);
        const unsigned gen = old / nloc;
        if (old + 1u == (gen + 1u) * nloc) {
            __builtin_amdgcn_fence(__ATOMIC_RELEASE, "agent");
            asm volatile("s_waitcnt vmcnt(0)" ::: "memory");
            const unsigned og = xb_add(&bar[XB_TOP], 1u);
            const unsigned tg = og / nx;
            if (og + 1u == (tg + 1u) * nx) xb_add(&bar[XB_TOPGEN], 1u);
            else XB_SPIN(xb_ld(&bar[XB_TOPGEN]) == tg, bar);
            __builtin_amdgcn_fence(__ATOMIC_ACQUIRE, "agent");
            xb_add(&bar[XB_XGEN(b.x)], 1u);
            asm volatile("s_waitcnt vmcnt(0)" ::: "memory");
        } else {
            XB_SPIN(xb_ld(&bar[XB_XGEN(b.x)]) == gen, bar);
            __builtin_amdgcn_fence(__ATOMIC_ACQUIRE, "agent");
            asm volatile("s_waitcnt vmcnt(0)" ::: "memory");
        }
    }
    __syncthreads();
}

constexpr int NWAVES = 8, NT = 512;
constexpr int LDS_BYTES = 163840;
constexpr int YP_OFF = 129536;
struct Args { const float* in[29]; float* out; unsigned char* ws; int ph_lo, ph_hi; };
struct Frame {
    LAS unsigned char* lds; unsigned char* ws; float* out; const float* const* in;
    int tid, lane, wave, G, bid;
};
__device__ __forceinline__ const float* xrow_ptr(const Frame& F, int m) { return m < MP ? F.in[0] + (size_t)m * DM : F.in[1] + (size_t)(m - MP) * DM; }

template <class MAP>
__device__ __forceinline__ void p0_transpose_item(const float* W, int K, int N, int Nout, bf16_t* WT, LAS float* scr, int item, int lane, MAP map) {
    const int nblk = Nout / 32, kb = item / nblk, nb = item % nblk, k0 = 64 * kb, n0 = 32 * nb;
    const int src = map(n0 + (lane & 31));
    float tv[32];
#pragma unroll
    for (int i = 0; i < 32; ++i) { const int kk = 2 * i + (lane >> 5); tv[i] = src >= 0 ? W[(size_t)(k0 + kk) * N + src] : 0.f; }
#pragma unroll
    for (int i = 0; i < 32; ++i) { const int kk = 2 * i + (lane >> 5); scr[kk * 33 + (lane & 31)] = tv[i]; }
    asm volatile("s_waitcnt lgkmcnt(0)" ::: "memory");
    const int c = lane & 7;
#pragma unroll
    for (int j = 0; j < 4; ++j) { const int n = (lane >> 3) + 8 * j; const LAS float* s = scr + (8 * c) * 33 + n;
        u32x4 o; o.x = pk2(s[0 * 33], s[1 * 33]); o.y = pk2(s[2 * 33], s[3 * 33]); o.z = pk2(s[4 * 33], s[5 * 33]); o.w = pk2(s[6 * 33], s[7 * 33]);
        *(u32x4*)(WT + (size_t)(n0 + n) * K + k0 + 8 * c) = o; }
    asm volatile("s_waitcnt lgkmcnt(0)" ::: "memory");
}
struct MapIn { __device__ int operator()(int n) const { if (n < 640) { const int w = n & 63; return (n & ~63) + (w >> 3) * 4 + (w & 3) + 32 * ((w >> 2) & 1); } return n < 2464 ? n : -1; } };
struct MapId { __device__ int operator()(int n) const { return n; } };
struct MapFfn { __device__ int operator()(int n) const { const int tile = n >> 8, sub = n & 255, ch = tile * 128 + (sub & 127); return sub < 128 ? ch : DFF + ch; } };

__device__ __forceinline__ void p0_prologue(Frame& F) {
    LAS float* scr = (LAS float*)(F.lds + F.wave * 16384);
    const int gw = F.bid * NWAVES + F.wave, NGW = F.G * NWAVES;
    constexpr int I_IN = 16 * (DINP / 32), I_OUT = 16 * 32, I_FI = 16 * (2 * DFF / 32), I_FO = (DFF / 64) * 32;
    constexpr int NITEMS = I_IN + I_OUT + I_FI + I_FO;
#ifndef TR_DUP
#define TR_DUP 1
#endif
    for (int it_ = gw; it_ < NITEMS * TR_DUP; it_ += NGW) {
        const int it = it_ % NITEMS;
        int r = it;
        if (r < I_IN) { p0_transpose_item(F.in[8], DM, 2464, DINP, (bf16_t*)(F.ws + WS_WIN), scr, r, F.lane, MapIn()); continue; } r -= I_IN;
        if (r < I_OUT) { p0_transpose_item(F.in[21], DM, DM, DM, (bf16_t*)(F.ws + WS_WOUT), scr, r, F.lane, MapId()); continue; } r -= I_OUT;
        if (r < I_FI) { p0_transpose_item(F.in[24], DM, 2 * DFF, 2 * DFF, (bf16_t*)(F.ws + WS_WFI), scr, r, F.lane, MapFfn()); continue; } r -= I_FI;
        p0_transpose_item(F.in[27], DFF, DM, DM, (bf16_t*)(F.ws + WS_WFO), scr, r, F.lane, MapId());
    }
    float* rope = (float*)(F.ws + WS_ROPE);
    for (int e = F.bid * NT + F.tid; e < (T + DT) * 32; e += F.G * NT) {
        const int pidx = e >> 5, i = e & 31; const int pos = pidx < T ? pidx : 16384 + (pidx - T);
        const float inv = (float)exp2(-(double)i * (13.287712379549449 / 32.0));
        const float angf = (float)pos * inv;
        const double a = (double)angf;
        const double TWO_PI = 6.283185307179586476925286766559;
        const double n = rint(a / TWO_PI);
        const double r = a - n * TWO_PI;
        const double r2 = r * r;
        double c = 1.0, s = 1.0, tc = 1.0, ts = 1.0;
#pragma unroll
        for (int k = 1; k <= 14; ++k) { tc = -tc * r2 * (1.0 / (double)((2 * k - 1) * (2 * k))); ts = -ts * r2 * (1.0 / (double)((2 * k) * (2 * k + 1))); c += tc; s += ts; }
        s *= r;
        rope[(size_t)e * 2] = (float)c; rope[(size_t)e * 2 + 1] = (float)s;
    }
    const float* g = F.in[7];
    bf16_t* XN = (bf16_t*)(F.ws + WS_XN);
    for (int m = gw; m < M; m += 2 * NGW) {
        const int m1 = m + NGW; const bool has1 = m1 < M;
        const f32x4* xr0 = (const f32x4*)xrow_ptr(F, m) + F.lane; const f32x4* xr1 = (const f32x4*)xrow_ptr(F, has1 ? m1 : m) + F.lane;
        f32x4 v0[4], v1[4];
#pragma unroll
        for (int j = 0; j < 4; ++j) v0[j] = __builtin_nontemporal_load(xr0 + 64 * j);
#pragma unroll
        for (int j = 0; j < 4; ++j) v1[j] = __builtin_nontemporal_load(xr1 + 64 * j);
        float s0 = 0.f, s1 = 0.f;
#pragma unroll
        for (int j = 0; j < 4; ++j) { s0 += (v0[j].x * v0[j].x + v0[j].y * v0[j].y) + (v0[j].z * v0[j].z + v0[j].w * v0[j].w); s1 += (v1[j].x * v1[j].x + v1[j].y * v1[j].y) + (v1[j].z * v1[j].z + v1[j].w * v1[j].w); }
        const float r0 = 1.0f / sqrtf(wave_sum(s0) * (1.f / DM) + RMS_EPS), r1 = 1.0f / sqrtf(wave_sum(s1) * (1.f / DM) + RMS_EPS);
        u32x2* o0 = (u32x2*)(XN + (size_t)m * DM) + F.lane; u32x2* o1 = (u32x2*)(XN + (size_t)m1 * DM) + F.lane;
#pragma unroll
        for (int j = 0; j < 4; ++j) { const f32x4 gg = ((const f32x4*)g)[64 * j + F.lane];
            u32x2 w; w.x = pk2(v0[j].x * r0 * gg.x, v0[j].y * r0 * gg.y); w.y = pk2(v0[j].z * r0 * gg.z, v0[j].w * r0 * gg.w); o0[64 * j] = w;
            if (has1) { u32x2 q; q.x = pk2(v1[j].x * r1 * gg.x, v1[j].y * r1 * gg.y); q.y = pk2(v1[j].z * r1 * gg.z, v1[j].w * r1 * gg.w); o1[64 * j] = q; } }
    }
}

__device__ __forceinline__ float hprev_val(const Frame& F, const bf16_t* HRW, int m, int col) {
    const RowInfo ri = row_info(m);
    if (ri.t == 0) return ri.samp ? F.in[4][(size_t)ri.b * DSH + col] : 0.f;
    return bf2f(HRW[(size_t)(m - 1) * DSH + col]);
}
__device__ __forceinline__ f32x4 ld_bf4(const bf16_t* p) { const u32x2 w = *(const u32x2*)p; return (f32x4){bflo(w.x), bfhi(w.x), bflo(w.y), bfhi(w.y)}; }
__device__ __forceinline__ f32x4 hs4(const Frame& F, const bf16_t* HRW, int m, const RowInfo& ri, int col) {
    const f32x4 h = ld_bf4(HRW + (size_t)m * DSH + col);
    f32x4 hp;
    if (ri.t == 0) hp = ri.samp ? *(const f32x4*)(F.in[4] + (size_t)ri.b * DSH + col) : (f32x4){0.f, 0.f, 0.f, 0.f};
    else hp = ld_bf4(HRW + (size_t)(m - 1) * DSH + col);
    const f32x4 mu = *(const f32x4*)(F.in[10] + col);
    return h + (hp - h) * mu;
}
struct F8 { f32x4 a, b; };
__device__ __forceinline__ F8 ld_bf8(const bf16_t* p) { const u32x4 w = *(const u32x4*)p; F8 r; r.a = (f32x4){bflo(w.x), bfhi(w.x), bflo(w.y), bfhi(w.y)}; r.b = (f32x4){bflo(w.z), bfhi(w.z), bflo(w.w), bfhi(w.w)}; return r; }
__device__ __forceinline__ u32x4 pk8(const f32x4 a, const f32x4 b) { u32x4 w; w.x = cvt_pk_bf16(a[0], a[1]); w.y = cvt_pk_bf16(a[2], a[3]); w.z = cvt_pk_bf16(b[0], b[1]); w.w = cvt_pk_bf16(b[2], b[3]); return w; }
__device__ __forceinline__ F8 hs8m(const Frame& F, const bf16_t* HRW, int m, const RowInfo& ri, int col, const f32x4 mua, const f32x4 mub) {
    const F8 h = ld_bf8(HRW + (size_t)m * DSH + col);
    F8 hp;
    if (ri.t == 0) {
        if (ri.samp) { hp.a = *(const f32x4*)(F.in[4] + (size_t)ri.b * DSH + col); hp.b = *(const f32x4*)(F.in[4] + (size_t)ri.b * DSH + col + 4); }
        else { hp.a = (f32x4){0.f, 0.f, 0.f, 0.f}; hp.b = (f32x4){0.f, 0.f, 0.f, 0.f}; }
    } else hp = ld_bf8(HRW + (size_t)(m - 1) * DSH + col);
    F8 r; r.a = h.a + (hp.a - h.a) * mua; r.b = h.b + (hp.b - h.b) * mub; return r;
}
__device__ __forceinline__ F8 hs8(const Frame& F, const bf16_t* HRW, int m, const RowInfo& ri, int col) {
    const F8 h = ld_bf8(HRW + (size_t)m * DSH + col);
    F8 hp;
    if (ri.t == 0) {
        if (ri.samp) { hp.a = *(const f32x4*)(F.in[4] + (size_t)ri.b * DSH + col); hp.b = *(const f32x4*)(F.in[4] + (size_t)ri.b * DSH + col + 4); }
        else { hp.a = (f32x4){0.f, 0.f, 0.f, 0.f}; hp.b = (f32x4){0.f, 0.f, 0.f, 0.f}; }
    } else hp = ld_bf8(HRW + (size_t)(m - 1) * DSH + col);
    const f32x4 mua = *(const f32x4*)(F.in[10] + col), mub = *(const f32x4*)(F.in[10] + col + 4);
    F8 r; r.a = h.a + (hp.a - h.a) * mua; r.b = h.b + (hp.b - h.b) * mub; return r;
}
__device__ __forceinline__ float xsum_fq(float v) {
    { auto r = __builtin_amdgcn_permlane16_swap(__float_as_uint(v), __float_as_uint(v), false, false); v = __uint_as_float(r[0]) + __uint_as_float(r[1]); }
    { auto r = __builtin_amdgcn_permlane32_swap(__float_as_uint(v), __float_as_uint(v), false, false); v = __uint_as_float(r[0]) + __uint_as_float(r[1]); }
    return v;
}
__device__ __forceinline__ u32x2 pk4(const f32x4 v) { u32x2 w; w.x = cvt_pk_bf16(v[0], v[1]); w.y = cvt_pk_bf16(v[2], v[3]); return w; }
__device__ __forceinline__ bf16x8 wfrag(const float* W, int k0, int fq, int ch) {
    u32x4 w; const float* p = W + (size_t)(k0 + 8 * fq) * 512 + ch;
    w.x = cvt_pk_bf16(p[0], p[512]); w.y = cvt_pk_bf16(p[1024], p[1536]); w.z = cvt_pk_bf16(p[2048], p[2560]); w.w = cvt_pk_bf16(p[3072], p[3584]);
    return __builtin_bit_cast(bf16x8, w);
}
#ifndef PREP_DUP
#define PREP_DUP 1
#endif
#ifndef POST_DUP
#define POST_DUP 1
#endif
__device__ __forceinline__ void prep_phase(Frame& F) {
    const bf16_t* HRW = (const bf16_t*)(F.ws + WS_HRW);
    bf16_t* SR = (bf16_t*)(F.ws + WS_SR); bf16_t* SK = (bf16_t*)(F.ws + WS_SK); bf16_t* SV = (bf16_t*)(F.ws + WS_SV);
    bf16_t* SKK = (bf16_t*)(F.ws + WS_SKK); bf16_t* SB = (bf16_t*)(F.ws + WS_SB); float* SW = (float*)(F.ws + WS_SW);
    const int fr = F.lane & 15, fq = F.lane >> 4, h = F.wave;
    bf16x8 Aw[4], Aa[4];
#pragma unroll
    for (int nt = 0; nt < 4; ++nt) { const int ch = h * 64 + 16 * (fr >> 2) + 4 * nt + (fr & 3); Aw[nt] = wfrag(F.in[12], 0, fq, ch); Aa[nt] = wfrag(F.in[14], 0, fq, ch); }
    constexpr int NTILE = M / 16;
    f32x4 pw0[4], pa0[4], pkk[4], pka[4];
    f32x4 pmu[3][4];
#pragma unroll
    for (int st = 0; st < 3; ++st)
#pragma unroll
        for (int i = 0; i < 4; ++i) pmu[st][i] = *(const f32x4*)(F.in[10] + st * 512 + h * 64 + 16 * fq + 4 * i);
#pragma unroll
    for (int i = 0; i < 4; ++i) { const int c4 = h * 64 + 16 * fq + 4 * i; pw0[i] = *(const f32x4*)(F.in[11] + c4); pa0[i] = *(const f32x4*)(F.in[13] + c4); pkk[i] = *(const f32x4*)(F.in[16] + c4); pka[i] = *(const f32x4*)(F.in[17] + c4); }
    for (int tile_ = F.bid; tile_ < NTILE * PREP_DUP; tile_ += F.G) {
        const int m = (tile_ % NTILE) * 16 + fr;
        const RowInfo ri = row_info(m);
        bf16x8 xw, xa;
        { const F8 a = hs8(F, HRW, m, ri, 1536 + 8 * fq);
          f32x4 t0, t1;
#pragma unroll
          for (int i = 0; i < 4; ++i) { t0[i] = 1.f - 2.f * __builtin_amdgcn_rcpf(__expf(2.f * a.a[i]) + 1.f); t1[i] = 1.f - 2.f * __builtin_amdgcn_rcpf(__expf(2.f * a.b[i]) + 1.f); }
          xw = __builtin_bit_cast(bf16x8, pk8(t0, t1)); }
        { const F8 a = hs8(F, HRW, m, ri, 1568 + 8 * fq); xa = __builtin_bit_cast(bf16x8, pk8(a.a, a.b)); }
        f32x4 kkr[4], av[4]; float ss = 0.f;
#pragma unroll
        for (int np = 0; np < 2; ++np) {
            const int c8 = h * 64 + 16 * fq + 8 * np;
            const f32x4 z = {0.f, 0.f, 0.f, 0.f};
            f32x4 accw[2], acca[2];
#pragma unroll
            for (int q = 0; q < 2; ++q) { accw[q] = __builtin_amdgcn_mfma_f32_16x16x32_bf16(Aw[2 * np + q], xw, z, 0, 0, 0); acca[q] = __builtin_amdgcn_mfma_f32_16x16x32_bf16(Aa[2 * np + q], xa, z, 0, 0, 0); }
            const F8 r8 = hs8m(F, HRW, m, ri, c8, pmu[0][2 * np], pmu[0][2 * np + 1]), k8 = hs8m(F, HRW, m, ri, 512 + c8, pmu[1][2 * np], pmu[1][2 * np + 1]), v8 = hs8m(F, HRW, m, ri, 1024 + c8, pmu[2][2 * np], pmu[2][2 * np + 1]);
            f32x4 dec[2], k2[2];
#pragma unroll
            for (int q = 0; q < 2; ++q) {
                const f32x4 k = q ? k8.b : k8.a;
                const f32x4 w0 = pw0[2 * np + q], a0 = pa0[2 * np + q], kkc = pkk[2 * np + q], kac = pka[2 * np + q];
                f32x4 a;
#pragma unroll
                for (int j = 0; j < 4; ++j) {
                    const float x = -(w0[j] + accw[q][j]);
                    const float sp = fmaxf(x, 0.f) + __logf(1.f + __expf(-fabsf(x)));
                    dec[q][j] = __expf(-__expf(-sp - 0.5f));
                    a[j] = sigmoidf_(a0[j] + acca[q][j]);
                    k2[q][j] = k[j] * (1.f + (a[j] - 1.f) * kac[j]);
                }
                const f32x4 kk = k * kkc;
                ss += (kk[0] * kk[0] + kk[1] * kk[1]) + (kk[2] * kk[2] + kk[3] * kk[3]);
                kkr[2 * np + q] = kk; av[2 * np + q] = a;
            }
            const size_t o = (size_t)m * 512 + c8;
            *(f32x4*)(SW + o) = dec[0]; *(f32x4*)(SW + o + 4) = dec[1];
            *(u32x4*)(SR + o) = pk8(r8.a, r8.b); *(u32x4*)(SK + o) = pk8(k2[0], k2[1]); *(u32x4*)(SV + o) = pk8(v8.a, v8.b);
        }
        ss = xsum_fq(ss);
        const float rs = rsqrtf(fmaxf(ss, 1e-24f));
#pragma unroll
        for (int np = 0; np < 2; ++np) {
            const size_t o = (size_t)m * 512 + h * 64 + 16 * fq + 8 * np;
            const f32x4 ka = kkr[2 * np] * rs, kb = kkr[2 * np + 1] * rs;
            *(u32x4*)(SKK + o) = pk8(ka, kb); *(u32x4*)(SB + o) = pk8(ka * av[2 * np], kb * av[2 * np + 1]);
        }
    }
}

__device__ __forceinline__ void sample_attn_phase(Frame& F) {
    constexpr int NK = WIN + DT, KS = 68;
    LAS float* Kl = (LAS float*)F.lds;
    LAS float* Vl = Kl + NK * KS;
    LAS float* Pl = Vl + NK * KS;
    const bf16_t* Q = (const bf16_t*)(F.ws + WS_Q);
    bf16_t* OC = (bf16_t*)(F.ws + WS_OCAT);
    for (int unit = F.bid; unit < DB * 2; unit += F.G) {
        const int b = unit >> 1, kvh = unit & 1;
        for (int e = F.tid; e < NK * 16; e += NT) {
            const int key = e >> 4, d4 = (e & 15) * 4;
            f32x4 kv, vv;
            if (key < WIN) { kv = *(const f32x4*)(F.in[2] + ((size_t)(b * WIN + key) * 2 + kvh) * 64 + d4); vv = *(const f32x4*)(F.in[3] + ((size_t)(b * WIN + key) * 2 + kvh) * 64 + d4); }
            else { kv = *(const f32x4*)(F.out + O_KWS + ((size_t)(b * WIN + key - DT) * 2 + kvh) * 64 + d4); vv = *(const f32x4*)(F.out + O_VWS + ((size_t)(b * WIN + key - DT) * 2 + kvh) * 64 + d4); }
            *(LAS f32x4*)(Kl + key * KS + d4) = kv; *(LAS f32x4*)(Vl + key * KS + d4) = vv;
            if (key >= DT && key < WIN) { *(f32x4*)(F.out + O_KWS + ((size_t)(b * WIN + key - DT) * 2 + kvh) * 64 + d4) = kv; *(f32x4*)(F.out + O_VWS + ((size_t)(b * WIN + key - DT) * 2 + kvh) * 64 + d4) = vv; }
        }
        __syncthreads();
        const int qi = F.tid >> 4, sub = F.tid & 15;
        const int t = qi >> 2, g = qi & 3, head = kvh * 4 + g;
        const int m = MP + b * DT + t;
        float mx = F.in[9][head] * 1.4426950408889634f;
        {
            const bf16_t* qp = Q + (size_t)m * 512 + head * 64;
            float q[64];
#pragma unroll
            for (int i = 0; i < 8; ++i) { const u32x4 w = *(const u32x4*)(qp + 8 * i); q[8 * i] = bflo(w.x); q[8 * i + 1] = bfhi(w.x); q[8 * i + 2] = bflo(w.y); q[8 * i + 3] = bfhi(w.y); q[8 * i + 4] = bflo(w.z); q[8 * i + 5] = bfhi(w.z); q[8 * i + 6] = bflo(w.w); q[8 * i + 7] = bfhi(w.w); }
#pragma unroll 1
            for (int key = sub; key < NK; key += 16) {
                float a = 0.f; const LAS f32x4* kr = (const LAS f32x4*)(Kl + key * KS);
#pragma unroll
                for (int i = 0; i < 16; ++i) { const f32x4 kx = kr[i]; a += q[4 * i] * kx[0] + q[4 * i + 1] * kx[1] + q[4 * i + 2] * kx[2] + q[4 * i + 3] * kx[3]; }
                const int dist = t + WIN - key;
                const float s = (dist >= 0 && dist <= WIN) ? a : -1e30f;
                Pl[qi * NK + key] = s; mx = fmaxf(mx, s);
            }
        }
        mx = fmaxf(mx, __shfl_xor(mx, 1)); mx = fmaxf(mx, __shfl_xor(mx, 2)); mx = fmaxf(mx, __shfl_xor(mx, 4)); mx = fmaxf(mx, __shfl_xor(mx, 8));
        float sum = 0.f;
#pragma unroll 1
        for (int key = sub; key < NK; key += 16) { const float sv = Pl[qi * NK + key]; const float p = sv > -1e29f ? __builtin_amdgcn_exp2f(sv - mx) : 0.f; sum += p; Pl[qi * NK + key] = p; }
        sum += __shfl_xor(sum, 1); sum += __shfl_xor(sum, 2); sum += __shfl_xor(sum, 4); sum += __shfl_xor(sum, 8);
        const float inv = __builtin_amdgcn_rcpf(sum + __builtin_amdgcn_exp2f(F.in[9][head] * 1.4426950408889634f - mx));
        __syncthreads();
        f32x4 o = {0.f, 0.f, 0.f, 0.f};
        for (int key = 0; key < NK; ++key) { const float p = Pl[qi * NK + key]; const f32x4 vv = *(const LAS f32x4*)(Vl + key * KS + sub * 4); o += vv * p; }
        o = o * inv;
        u32x2 w; w.x = pk2(o[0], o[1]); w.y = pk2(o[2], o[3]);
        *(u32x2*)(OC + (size_t)m * DM + head * 64 + sub * 4) = w;
        __syncthreads();
    }
}

__device__ __forceinline__ void prompt_attn_unit(Frame& F, int unit) {
    constexpr int KST = 144, VST = 528;
    LAS unsigned char* Kl = F.lds; LAS unsigned char* Vl = F.lds + 256 * KST;
    const bf16_t* Q = (const bf16_t*)(F.ws + WS_Q); const bf16_t* Kb = (const bf16_t*)(F.ws + WS_K); const bf16_t* VT = (const bf16_t*)(F.ws + WS_VT);
    bf16_t* OC = (bf16_t*)(F.ws + WS_OCAT);
    const int kvh = unit & 1, qb = (unit >> 1) & 63, b = unit >> 7;
    const int key0 = (qb - 1) * 128;
    for (int e = F.tid; e < 256 * 8; e += NT) {
        const int key = e >> 3, ch = e & 7; const int pos = key0 + key;
        u32x4 v = {0u, 0u, 0u, 0u};
        if (pos >= 0) v = *(const u32x4*)(Kb + (size_t)(b * T + pos) * 128 + kvh * 64 + ch * 8);
        *(LAS u32x4*)(Kl + key * KST + ch * 16) = v;
    }
    for (int e = F.tid; e < 64 * 32; e += NT) {
        const int d = e >> 5, ch = e & 31; const int pos = key0 + ch * 8;
        u32x4 v = {0u, 0u, 0u, 0u};
        if (pos >= 0) v = *(const u32x4*)(VT + ((size_t)(b * 2 + kvh) * 64 + d) * T + pos);
        *(LAS u32x4*)(Vl + d * VST + ch * 16) = v;
    }
    __syncthreads();
    const int fr = F.lane & 15, fq = F.lane >> 4;
    const int head = kvh * 4 + (F.wave >> 1);
    const float sink = F.in[9][head] * 1.4426950408889634f;
#pragma unroll 1
    for (int sb = 0; sb < 4; ++sb) {
        const int qi0 = (F.wave & 1) * 64 + sb * 16;
        const int qi = qi0 + fr;
        const size_t mrow = (size_t)b * T + qb * 128 + qi;
        const bf16x8 q0 = *(const bf16x8*)(Q + mrow * 512 + head * 64 + fq * 8);
        const bf16x8 q1 = *(const bf16x8*)(Q + mrow * 512 + head * 64 + 32 + fq * 8);
        const int ktlo = (F.wave & 1) * 4 + sb;
        f32x4 s[9];
#pragma unroll
        for (int kr = 0; kr < 9; ++kr) {
            const int kt = ktlo + kr;
            const bf16x8 k0 = *(const LAS bf16x8*)(Kl + (kt * 16 + fr) * KST + fq * 16);
            const bf16x8 k1 = *(const LAS bf16x8*)(Kl + (kt * 16 + fr) * KST + 64 + fq * 16);
            f32x4 a = {0.f, 0.f, 0.f, 0.f};
            a = __builtin_amdgcn_mfma_f32_16x16x32_bf16(k0, q0, a, 0, 0, 0);
            a = __builtin_amdgcn_mfma_f32_16x16x32_bf16(k1, q1, a, 0, 0, 0);
            s[kr] = a;
        }
        float mx = sink;
#pragma unroll
        for (int kr = 0; kr < 9; ++kr)
#pragma unroll
            for (int j = 0; j < 4; ++j) { const int sj = (ktlo + kr) * 16 + fq * 4 + j; const int dist = qi + 128 - sj; const bool ok = dist >= 0 && dist <= WIN && (key0 + sj) >= 0; const float v = ok ? s[kr][j] : -1e30f; s[kr][j] = v; mx = fmaxf(mx, v); }
        mx = fmaxf(mx, __shfl_xor(mx, 16)); mx = fmaxf(mx, __shfl_xor(mx, 32));
        float sum = 0.f;
        u32x2 pw[10];
#pragma unroll
        for (int kr = 0; kr < 9; ++kr) {
            f32x4 p;
#pragma unroll
            for (int j = 0; j < 4; ++j) { p[j] = s[kr][j] > -1e29f ? __builtin_amdgcn_exp2f(s[kr][j] - mx) : 0.f; sum += p[j]; }
            pw[kr].x = cvt_pk_bf16(p[0], p[1]); pw[kr].y = cvt_pk_bf16(p[2], p[3]);
        }
        pw[9].x = 0u; pw[9].y = 0u;
        sum += __shfl_xor(sum, 16); sum += __shfl_xor(sum, 32);
        const float inv = __builtin_amdgcn_rcpf(sum + __builtin_amdgcn_exp2f(sink - mx));
        f32x4 o[4];
#pragma unroll
        for (int dt = 0; dt < 4; ++dt) o[dt] = (f32x4){0.f, 0.f, 0.f, 0.f};
#pragma unroll
        for (int u = 0; u < 5; ++u) {
            u32x4 pb; pb.x = pw[2 * u].x; pb.y = pw[2 * u].y; pb.z = pw[2 * u + 1].x; pb.w = pw[2 * u + 1].y;
            const bf16x8 pf = __builtin_bit_cast(bf16x8, pb);
            const int kta = ktlo + 2 * u, ktb = u < 4 ? kta + 1 : kta;
#pragma unroll
            for (int dt = 0; dt < 4; ++dt) {
                const LAS unsigned char* vr = Vl + (dt * 16 + fr) * VST + (fq * 4) * 2;
                const u32x2 va = *(const LAS u32x2*)(vr + kta * 32), vb = *(const LAS u32x2*)(vr + ktb * 32);
                u32x4 vv; vv.x = va.x; vv.y = va.y; vv.z = vb.x; vv.w = vb.y;
                o[dt] = __builtin_amdgcn_mfma_f32_16x16x32_bf16(__builtin_bit_cast(bf16x8, vv), pf, o[dt], 0, 0, 0);
            }
        }
#pragma unroll
        for (int dt = 0; dt < 4; ++dt) { const f32x4 v = o[dt] * inv; u32x2 w; w.x = cvt_pk_bf16(v[0], v[1]); w.y = cvt_pk_bf16(v[2], v[3]); *(u32x2*)(OC + mrow * DM + head * 64 + dt * 16 + fq * 4) = w; }
    }
    __syncthreads();
}

struct StepOps { f32x4 w, nbe, kk, k, r; float v; };
template <int STRIDE_F> __device__ __forceinline__ StepOps load_ops(const LAS float* img, int s, int cgi, int vrow) {
    const LAS float* p = img + s * STRIDE_F + cgi * 4; StepOps o;
    o.w = *(const LAS f32x4*)(p); o.nbe = *(const LAS f32x4*)(p + 64); o.kk = *(const LAS f32x4*)(p + 128); o.k = *(const LAS f32x4*)(p + 192); o.r = *(const LAS f32x4*)(p + 256);
    o.v = img[s * STRIDE_F + 320 + vrow]; return o;
}
template <int J> __device__ __forceinline__ float sel_lane16(float oldv, float newv) {
    float r; const unsigned long long m = 0x0001000100010001ull << J;
    asm("v_cndmask_b32_e64 %0, %1, %2, %3" : "=v"(r) : "v"(oldv), "v"(newv), "s"(m));
    return r;
}
struct ScanState { f32x2 s01, s23; float ykeep, ypart; StepOps c0, c1; };
template <int STRIDE_F, int J>
__device__ __forceinline__ void scan_step(const LAS float* img, int s0, int vrow, int cgi, ScanState& Z) {
    const StepOps nx = load_ops<STRIDE_F>(img, s0 + J + 2, cgi, vrow);
    const StepOps& c = Z.c0;
    const f32x2 kk01 = {c.kk[0], c.kk[1]}, kk23 = {c.kk[2], c.kk[3]}, w01 = {c.w[0], c.w[1]}, w23 = {c.w[2], c.w[3]}, k01 = {c.k[0], c.k[1]}, k23 = {c.k[2], c.k[3]};
    const f32x2 b01 = {c.nbe[0], c.nbe[1]}, b23 = {c.nbe[2], c.nbe[3]}, r01 = {c.r[0], c.r[1]}, r23 = {c.r[2], c.r[3]};
    f32x2 t = Z.s01 * kk01; t = Z.s23 * kk23 + t;
    float sa = t.x + t.y;
    const f32x2 u01 = Z.s01 * w01 + k01 * c.v, u23 = Z.s23 * w23 + k23 * c.v;
    if (J > 0) { allsum16_2(sa, Z.ypart); Z.ykeep = sel_lane16<(J > 0 ? J - 1 : 0)>(Z.ykeep, Z.ypart); } else sa = allsum16(sa);
    Z.s01 = b01 * sa + u01; Z.s23 = b23 * sa + u23;
    f32x2 y2 = Z.s01 * r01; y2 = Z.s23 * r23 + y2;
    Z.ypart = y2.x + y2.y;
    Z.c0 = Z.c1; Z.c1 = nx;
}
template <int STRIDE_F, int GS, int... Js>
__device__ __forceinline__ void scan_group_impl(const LAS float* img, int s0, int vrow, int cgi, ScanState& Z, float* yout, std::integer_sequence<int, Js...>) {
    (scan_step<STRIDE_F, Js>(img, s0, vrow, cgi, Z), ...);
    Z.ypart = allsum16(Z.ypart); Z.ykeep = sel_lane16<GS - 1>(Z.ykeep, Z.ypart);
    if (cgi < GS) yout[(size_t)(s0 + cgi) * 512] = Z.ykeep;
}
template <int STRIDE_F, int J>
__device__ __forceinline__ void scan_step_yp(const LAS float* img, int s0, int vrow, int cgi, ScanState& Z, LAS float* ypb) {
    const StepOps nx = load_ops<STRIDE_F>(img, s0 + J + 2, cgi, vrow);
    const StepOps& c = Z.c0;
    const f32x2 kk01 = {c.kk[0], c.kk[1]}, kk23 = {c.kk[2], c.kk[3]}, w01 = {c.w[0], c.w[1]}, w23 = {c.w[2], c.w[3]}, k01 = {c.k[0], c.k[1]}, k23 = {c.k[2], c.k[3]};
    const f32x2 b01 = {c.nbe[0], c.nbe[1]}, b23 = {c.nbe[2], c.nbe[3]}, r01 = {c.r[0], c.r[1]}, r23 = {c.r[2], c.r[3]};
    f32x2 t = Z.s01 * kk01; t = Z.s23 * kk23 + t;
    float sa = t.x + t.y;
    const f32x2 u01 = Z.s01 * w01 + k01 * c.v, u23 = Z.s23 * w23 + k23 * c.v;
    sa = allsum16(sa);
    Z.s01 = b01 * sa + u01; Z.s23 = b23 * sa + u23;
    f32x2 y2 = Z.s01 * r01; y2 = Z.s23 * r23 + y2;
    ypb[(s0 + J) * 64] = y2.x + y2.y;
    Z.c0 = Z.c1; Z.c1 = nx;
}
struct StepOpsS { f32x4 nbe, kk, k, r; };
template <int STRIDE_F> __device__ __forceinline__ StepOpsS load_ops_s(const LAS float* img, int s, int cgi) {
    const LAS float* p = img + s * STRIDE_F + cgi * 4; StepOpsS o;
    o.nbe = *(const LAS f32x4*)(p + 64); o.kk = *(const LAS f32x4*)(p + 128); o.k = *(const LAS f32x4*)(p + 192); o.r = *(const LAS f32x4*)(p + 256);
    return o;
}
struct ScanT { f32x2 t01, t23; StepOpsS c0, c1; f32x4 v4[4]; };
template <int STRIDE_F, int J>
__device__ __forceinline__ void scan_step_s(const LAS float* img, int cgi, ScanT& Z, LAS float* ypb) {
    const StepOpsS nx = load_ops_s<STRIDE_F>(img, J + 2, cgi);
    const StepOpsS& c = Z.c0;
    const float v = Z.v4[J >> 2][J & 3];
    f32x2 t = Z.t01 * (f32x2){c.kk[0], c.kk[1]}; t = Z.t23 * (f32x2){c.kk[2], c.kk[3]} + t;
    float sa = t.x + t.y;
    const f32x2 a01 = (f32x2){c.k[0], c.k[1]} * v + Z.t01, a23 = (f32x2){c.k[2], c.k[3]} * v + Z.t23;
    sa = allsum16(sa);
    Z.t01 = (f32x2){c.nbe[0], c.nbe[1]} * sa + a01; Z.t23 = (f32x2){c.nbe[2], c.nbe[3]} * sa + a23;
    f32x2 y2 = Z.t01 * (f32x2){c.r[0], c.r[1]}; y2 = Z.t23 * (f32x2){c.r[2], c.r[3]} + y2;
    ypb[J * 64] = y2.x + y2.y;
    Z.c0 = Z.c1; Z.c1 = nx;
}
template <int STRIDE_F, int... Js>
__device__ __forceinline__ void scan_chunk_s_impl(const LAS float* img, int cgi, ScanT& Z, LAS float* ypb, std::integer_sequence<int, Js...>) {
    (scan_step_s<STRIDE_F, Js>(img, cgi, Z, ypb), ...);
}
template <int STRIDE_F, int NS>
__device__ __forceinline__ void scan_transform(LAS float* img, int lane) {
    LAS float* p = img + lane; float Wc = 1.f;
#pragma unroll
    for (int t = 0; t < NS; ++t, p += STRIDE_F) {
        const float w = p[0], nb = p[64], kk = p[128], k = p[192], r = p[256];
        p[128] = Wc * kk;
        Wc *= w; const float inv = __builtin_amdgcn_rcpf(Wc);
        p[64] = nb * inv; p[192] = k * inv; p[256] = Wc * r;
    }
    img[(NS - 1) * STRIDE_F + lane] = Wc;
}
template <int STRIDE_F, int... Js>
__device__ __forceinline__ void scan_group_yp_impl(const LAS float* img, int s0, int vrow, int cgi, ScanState& Z, LAS float* ypb, std::integer_sequence<int, Js...>) {
    (scan_step_yp<STRIDE_F, Js>(img, s0, vrow, cgi, Z, ypb), ...);
}
template <int... Js>
__device__ __forceinline__ void yp_reduce_impl(const LAS float* ypb, int cgi, float* yout, int s0, std::integer_sequence<int, Js...>) {
    float ykeep = 0.f;
    ((ykeep = sel_lane16<Js>(ykeep, allsum16(ypb[(s0 + Js) * 64]))), ...);
    yout[(size_t)(s0 + cgi) * 512] = ykeep;
}
template <int STRIDE_F, int GS>
__device__ __forceinline__ void scan_group(const LAS float* img, int s0, int vrow, int cgi, ScanState& Z, float* yout) {
    scan_group_impl<STRIDE_F, GS>(img, s0, vrow, cgi, Z, yout, std::make_integer_sequence<int, GS>());
}
constexpr int SC = 32;
constexpr int PSTR = 328;
constexpr int SSTR = 384;
struct ScanRegs { f32x4 w[2]; u32x4 b0[2], b1[2]; u32x4 v; };
__device__ __forceinline__ void scan_load(const Frame& F, ScanRegs& R, int m0, int h, int v0) {
    if (F.wave < 4) return;
    const int vt = F.tid - 256;
#pragma unroll
    for (int i = 0; i < 2; ++i) {
        const int tid = vt + 256 * i;
        { const int row = tid >> 4, c4 = (tid & 15) * 4; R.w[i] = *(const f32x4*)((const float*)(F.ws + WS_SW) + (size_t)(m0 + row) * 512 + h * 64 + c4); }
        { const int st = tid >> 7, row = (tid & 127) >> 2, seg = tid & 3;
          const size_t base = st == 0 ? WS_SB : st == 1 ? WS_SKK : st == 2 ? WS_SK : WS_SR;
          const bf16_t* p = (const bf16_t*)(F.ws + base) + (size_t)(m0 + row) * 512 + h * 64 + seg * 16;
          R.b0[i] = *(const u32x4*)p; R.b1[i] = *(const u32x4*)(p + 8); }
    }
    { R.v = *(const u32x4*)((const bf16_t*)(F.ws + WS_SV) + (size_t)(m0 + (vt & 31)) * 512 + h * 64 + v0); }
}
__device__ __forceinline__ void scan_store(const Frame& F, const ScanRegs& R, LAS float* img) {
    if (F.wave < 4) return;
    const int vt = F.tid - 256;
#pragma unroll
    for (int i = 0; i < 2; ++i) {
        const int tid = vt + 256 * i;
        { const int row = tid >> 4, c4 = (tid & 15) * 4; *(LAS f32x4*)(img + row * PSTR + c4) = R.w[i]; }
        { const int st = tid >> 7, row = (tid & 127) >> 2, seg = tid & 3;
          LAS float* d = img + row * PSTR + 64 + st * 64 + seg * 16;
          const float sg = st == 0 ? -1.f : 1.f; const u32x4 b0 = R.b0[i], b1 = R.b1[i];
          *(LAS f32x4*)(d) = (f32x4){bflo(b0.x), bfhi(b0.x), bflo(b0.y), bfhi(b0.y)} * sg; *(LAS f32x4*)(d + 4) = (f32x4){bflo(b0.z), bfhi(b0.z), bflo(b0.w), bfhi(b0.w)} * sg;
          *(LAS f32x4*)(d + 8) = (f32x4){bflo(b1.x), bfhi(b1.x), bflo(b1.y), bfhi(b1.y)} * sg; *(LAS f32x4*)(d + 12) = (f32x4){bflo(b1.z), bfhi(b1.z), bflo(b1.w), bfhi(b1.w)} * sg; }
    }
    if (vt < 32) { LAS float* d = img + SC * PSTR + vt;
      d[0 * SC] = bflo(R.v.x); d[1 * SC] = bfhi(R.v.x); d[2 * SC] = bflo(R.v.y); d[3 * SC] = bfhi(R.v.y); d[4 * SC] = bflo(R.v.z); d[5 * SC] = bfhi(R.v.z); d[6 * SC] = bflo(R.v.w); d[7 * SC] = bfhi(R.v.w); }
}
constexpr int NSW = 2;
__device__ __forceinline__ void prompt_scan(Frame& F, int sblk) {
    const int xcd = sblk & 7, k = sblk >> 3;
    const int chain = xcd * 4 + (k >> 3), rg = k & 7;
    const int b = chain >> 3, h = chain & 7, v0 = rg * 8;
    LAS float* img = (LAS float*)F.lds;
    constexpr int IMG = SC * PSTR + 8 * SC;
    const int rl = F.lane >> 4, cgi = F.lane & 15;
    const int vrow = F.wave * 4 + rl;
    float* Y = F.out;
    ScanState Z; Z.s01 = (f32x2){0.f, 0.f}; Z.s23 = (f32x2){0.f, 0.f}; Z.ykeep = 0.f; Z.ypart = 0.f;
    ScanRegs R0, R1, R2, R3;
    const int mbase = b * T;
    constexpr int NCH = T / SC;
#ifndef SCAN_DUP
#define SCAN_DUP 1
#endif
    constexpr int NTOT = NCH * SCAN_DUP;
    scan_load(F, R0, mbase, h, v0); scan_store(F, R0, img);
    scan_load(F, R1, mbase + SC, h, v0); scan_store(F, R1, img + IMG);
    scan_load(F, R2, mbase + 2 * SC, h, v0); scan_load(F, R3, mbase + 3 * SC, h, v0);
    __syncthreads();
    if (F.wave == 4 || F.wave == 5) scan_transform<PSTR, 16>(img + (F.wave - 4) * 16 * PSTR, F.lane);
    __syncthreads();
    LAS float* ypr = (LAS float*)(F.lds + YP_OFF);
#define SCAN_CHUNK(cc_) do { const int c_ = (cc_) % NCH; \
        if (SCAN_DUP > 1 && c_ == 0) { Z.s01 = (f32x2){0.f, 0.f}; Z.s23 = (f32x2){0.f, 0.f}; } \
        if (F.wave < NSW) { const LAS float* im = img + ((cc_) % 3) * IMG; LAS float* ypb = ypr + (((cc_) & 1) * NSW + F.wave) * (SC * 64) + F.lane; \
            const LAS float* vtp = im + SC * PSTR + vrow * SC; \
            ScanT Tz; Tz.t01 = Z.s01; Tz.t23 = Z.s23; Tz.c0 = load_ops_s<PSTR>(im, 0, cgi); Tz.c1 = load_ops_s<PSTR>(im, 1, cgi); \
            _Pragma("unroll") for (int q_ = 0; q_ < 4; ++q_) Tz.v4[q_] = *(const LAS f32x4*)(vtp + 4 * q_); \
            scan_chunk_s_impl<PSTR>(im, cgi, Tz, ypb, std::make_integer_sequence<int, 16>()); \
            { const f32x4 wce = *(const LAS f32x4*)(im + 15 * PSTR + cgi * 4); Tz.t01 = Tz.t01 * (f32x2){wce[0], wce[1]}; Tz.t23 = Tz.t23 * (f32x2){wce[2], wce[3]}; } \
            _Pragma("unroll") for (int q_ = 0; q_ < 4; ++q_) Tz.v4[q_] = *(const LAS f32x4*)(vtp + 16 + 4 * q_); \
            scan_chunk_s_impl<PSTR>(im + 16 * PSTR, cgi, Tz, ypb + 16 * 64, std::make_integer_sequence<int, 16>()); \
            { const f32x4 wce = *(const LAS f32x4*)(im + 31 * PSTR + cgi * 4); Z.s01 = Tz.t01 * (f32x2){wce[0], wce[1]}; Z.s23 = Tz.t23 * (f32x2){wce[2], wce[3]}; } } \
        else if (F.wave < 2 * NSW && (cc_) > 0) { const int sw_ = F.wave - NSW, cp_ = ((cc_) - 1) % NCH; \
            const LAS float* ypb = ypr + ((((cc_) - 1) & 1) * NSW + sw_) * (SC * 64) + F.lane; float* yo = Y + (size_t)(mbase + cp_ * SC) * 512 + h * 64 + v0 + sw_ * 4 + rl; \
            yp_reduce_impl(ypb, cgi, yo, 0, std::make_integer_sequence<int, 16>()); yp_reduce_impl(ypb, cgi, yo, 16, std::make_integer_sequence<int, 16>()); } \
        else if ((F.wave == 4 || F.wave == 5) && (cc_) + 1 < NTOT) scan_transform<PSTR, 16>(img + (((cc_) + 1) % 3) * IMG + (F.wave - 4) * 16 * PSTR, F.lane); } while (0)
#define SCAN_ITER(j_, RL_, RS_) do { const int c4_ = cc + (j_); \
        scan_load(F, RL_, mbase + ((c4_ + 4 < NTOT ? c4_ + 4 : NTOT - 1) % NCH) * SC, h, v0);        \
        SCAN_CHUNK(c4_); \
        if (c4_ + 2 < NTOT) scan_store(F, RS_, img + ((c4_ + 2) % 3) * IMG);                         \
        asm volatile("s_waitcnt lgkmcnt(0)\n\ts_barrier" ::: "memory"); } while (0)
#pragma unroll 1
    for (int cc = 0; cc < NTOT; cc += 4) {
        SCAN_ITER(0, R0, R2); SCAN_ITER(1, R1, R3); SCAN_ITER(2, R2, R0); SCAN_ITER(3, R3, R1);
    }
#undef SCAN_ITER
#undef SCAN_CHUNK
    if (F.wave >= NSW && F.wave < 2 * NSW) { const int sw_ = F.wave - NSW, cp_ = (NTOT - 1) % NCH;
        const LAS float* ypb = ypr + (((NTOT - 1) & 1) * NSW + sw_) * (SC * 64) + F.lane; float* yo = Y + (size_t)(mbase + cp_ * SC) * 512 + h * 64 + v0 + sw_ * 4 + rl;
        yp_reduce_impl(ypb, cgi, yo, 0, std::make_integer_sequence<int, 16>()); yp_reduce_impl(ypb, cgi, yo, 16, std::make_integer_sequence<int, 16>()); }
    __syncthreads();
    if (F.wave < NSW) *(f32x4*)(F.out + O_WKVP + ((size_t)(b * 8 + h) * 64 + v0 + vrow) * 64 + cgi * 4) = (f32x4){Z.s01.x, Z.s01.y, Z.s23.x, Z.s23.y};
}
__device__ __forceinline__ void sample_scan(Frame& F, int sblk, int nsblk) {
    LAS float* img = (LAS float*)F.lds;
    float* Y = F.out;
    const int rl = F.lane >> 4, cgi = F.lane & 15;
    for (int chain = sblk; chain < DB * 8; chain += nsblk) {
        const int b = chain >> 3, h = chain & 7; const int m0 = MP + b * DT;
        for (int e = F.tid; e < 6 * DT * 64; e += NT) {
            const int st = e >> 9, row = (e >> 6) & 7, ch = e & 63; const size_t o = (size_t)(m0 + row) * 512 + h * 64 + ch;
            float val;
            if (st == 0) val = ((const float*)(F.ws + WS_SW))[o];
            else { const size_t base = st == 1 ? WS_SB : st == 2 ? WS_SKK : st == 3 ? WS_SK : st == 4 ? WS_SR : WS_SV; val = bf2f(((const bf16_t*)(F.ws + base))[o]); if (st == 1) val = -val; }
            img[row * SSTR + st * 64 + ch] = val;
        }
        __syncthreads();
#pragma unroll 1
        for (int rnd = 0; rnd < 2; ++rnd) {
            const int vrow = (rnd * 8 + F.wave) * 4 + rl;
            const float* s0 = F.in[5] + ((size_t)chain * 64 + vrow) * 64 + cgi * 4;
            const f32x4 S = *(const f32x4*)s0;
            ScanState Z; Z.s01 = (f32x2){S[0], S[1]}; Z.s23 = (f32x2){S[2], S[3]}; Z.ykeep = 0.f; Z.ypart = 0.f;
            Z.c0 = load_ops<SSTR>(img, 0, cgi, vrow); Z.c1 = load_ops<SSTR>(img, 1, cgi, vrow);
            scan_group<SSTR, DT>(img, 0, vrow, cgi, Z, Y + (size_t)m0 * 512 + h * 64 + vrow);
            *(f32x4*)(F.out + O_WKVS + ((size_t)chain * 64 + vrow) * 64 + cgi * 4) = (f32x4){Z.s01.x, Z.s01.y, Z.s23.x, Z.s23.y};
        }
        __syncthreads();
    }
}

__device__ __forceinline__ void post_phase(Frame& F) {
    const bf16_t* HRW = (const bf16_t*)(F.ws + WS_HRW);
    const bf16_t* SR = (const bf16_t*)(F.ws + WS_SR); const bf16_t* SK = (const bf16_t*)(F.ws + WS_SK); const bf16_t* SV = (const bf16_t*)(F.ws + WS_SV);
    const float* Y = F.out; bf16_t* OC = (bf16_t*)(F.ws + WS_OCAT);
    const int fr = F.lane & 15, fq = F.lane >> 4, h = F.wave;
    bf16x8 Ag[4][3];
#pragma unroll
    for (int nt = 0; nt < 4; ++nt)
#pragma unroll
        for (int s3 = 0; s3 < 3; ++s3) Ag[nt][s3] = wfrag(F.in[15], 32 * s3, fq, h * 64 + 16 * (fr >> 2) + 4 * nt + (fr & 3));
    constexpr int NTILE = M / 16;
    for (int tile_ = F.bid; tile_ < NTILE * POST_DUP; tile_ += F.G) {
        const int m = (tile_ % NTILE) * 16 + fr;
        const RowInfo ri = row_info(m);
        bf16x8 xg[3];
#pragma unroll
        for (int s3 = 0; s3 < 3; ++s3) {
            const F8 a = hs8(F, HRW, m, ri, 1600 + 32 * s3 + 8 * fq);
            f32x4 t0, t1;
#pragma unroll
            for (int i = 0; i < 4; ++i) { t0[i] = sigmoidf_(a.a[i]); t1[i] = sigmoidf_(a.b[i]); }
            xg[s3] = __builtin_bit_cast(bf16x8, pk8(t0, t1));
        }
        f32x4 y4[4], v4[4], g4[4]; float sy = 0.f, dot = 0.f;
#pragma unroll
        for (int np = 0; np < 2; ++np) {
            const int c8 = h * 64 + 16 * fq + 8 * np; const size_t o = (size_t)m * 512 + c8;
#pragma unroll
            for (int q = 0; q < 2; ++q) { f32x4 g = {0.f, 0.f, 0.f, 0.f};
#pragma unroll
                for (int s3 = 0; s3 < 3; ++s3) g = __builtin_amdgcn_mfma_f32_16x16x32_bf16(Ag[2 * np + q][s3], xg[s3], g, 0, 0, 0);
                g4[2 * np + q] = g; }
            const f32x4 ya = *(const f32x4*)(Y + o), yb = *(const f32x4*)(Y + o + 4);
            const F8 r8 = ld_bf8(SR + o), k8 = ld_bf8(SK + o), v8 = ld_bf8(SV + o);
            const f32x4 rka = *(const f32x4*)(F.in[18] + c8), rkb = *(const f32x4*)(F.in[18] + c8 + 4);
            y4[2 * np] = ya; y4[2 * np + 1] = yb; v4[2 * np] = v8.a; v4[2 * np + 1] = v8.b;
            sy += ((ya[0] + ya[1]) + (ya[2] + ya[3])) + ((yb[0] + yb[1]) + (yb[2] + yb[3]));
            const f32x4 pa = r8.a * k8.a * rka, pb = r8.b * k8.b * rkb; dot += ((pa[0] + pa[1]) + (pa[2] + pa[3])) + ((pb[0] + pb[1]) + (pb[2] + pb[3]));
        }
        const float mean = xsum_fq(sy) * (1.f / 64.f); dot = xsum_fq(dot);
        float sq = 0.f;
#pragma unroll
        for (int nt = 0; nt < 4; ++nt) { y4[nt] = y4[nt] - mean; const f32x4 d = y4[nt]; sq += (d[0] * d[0] + d[1] * d[1]) + (d[2] * d[2] + d[3] * d[3]); }
        const float rstd = rsqrtf(xsum_fq(sq) * (1.f / 64.f) + GN_EPS);
#pragma unroll
        for (int np = 0; np < 2; ++np) {
            const int c8 = h * 64 + 16 * fq + 8 * np;
            f32x4 oo[2];
#pragma unroll
            for (int q = 0; q < 2; ++q) { const int c4 = c8 + 4 * q; const f32x4 gw = *(const f32x4*)(F.in[19] + c4), gb = *(const f32x4*)(F.in[20] + c4);
                oo[q] = (y4[2 * np + q] * rstd * gw + gb + v4[2 * np + q] * dot) * g4[2 * np + q]; }
            *(u32x4*)(OC + (size_t)m * DM + 512 + c8) = pk8(oo[0], oo[1]);
        }
    }
}

__device__ __forceinline__ f32x4 bf4_to_f(const u32x2 w) { return (f32x4){bflo(w.x), bfhi(w.x), bflo(w.y), bfhi(w.y)}; }
__device__ __forceinline__ float sumsq4(const f32x4 (&v)[4]) { float s = 0.f;
#pragma unroll
    for (int j = 0; j < 4; ++j) s += (v[j].x * v[j].x + v[j].y * v[j].y) + (v[j].z * v[j].z + v[j].w * v[j].w);
    return s; }
__device__ __forceinline__ void rows_mid(Frame& F) {
    const int gw = F.bid * NWAVES + F.wave, NGW = F.G * NWAVES;
    const f32x4* g1 = (const f32x4*)F.in[22]; const f32x4* g2 = (const f32x4*)F.in[23];
    bf16_t* XN = (bf16_t*)(F.ws + WS_XN); const bf16_t* MIXb = (const bf16_t*)(F.ws + WS_MIX);
    for (int m = gw; m < M; m += 2 * NGW) {
        const int m1 = m + NGW; const bool has1 = m1 < M; const int mm1 = has1 ? m1 : m;
        const f32x4* xr0 = (const f32x4*)xrow_ptr(F, m) + F.lane; const f32x4* xr1 = (const f32x4*)xrow_ptr(F, mm1) + F.lane;
        const u32x2* mb0 = (const u32x2*)(MIXb + (size_t)m * DM) + F.lane; const u32x2* mb1 = (const u32x2*)(MIXb + (size_t)mm1 * DM) + F.lane;
        f32x4 v0[4], v1[4], x0[4], x1[4];
#pragma unroll
        for (int j = 0; j < 4; ++j) { v0[j] = bf4_to_f(__builtin_nontemporal_load(mb0 + 64 * j)); x0[j] = __builtin_nontemporal_load(xr0 + 64 * j); }
#pragma unroll
        for (int j = 0; j < 4; ++j) { v1[j] = bf4_to_f(__builtin_nontemporal_load(mb1 + 64 * j)); x1[j] = __builtin_nontemporal_load(xr1 + 64 * j); }
        const float ra = 1.0f / sqrtf(wave_sum(sumsq4(v0)) * (1.f / DM) + RMS_EPS), rb = 1.0f / sqrtf(wave_sum(sumsq4(v1)) * (1.f / DM) + RMS_EPS);
#pragma unroll
        for (int j = 0; j < 4; ++j) { const f32x4 gg = g1[64 * j + F.lane]; v0[j] = x0[j] + v0[j] * ra * gg; v1[j] = x1[j] + v1[j] * rb * gg; }
        const float qa = 1.0f / sqrtf(wave_sum(sumsq4(v0)) * (1.f / DM) + RMS_EPS), qb = 1.0f / sqrtf(wave_sum(sumsq4(v1)) * (1.f / DM) + RMS_EPS);
        u32x2* o0 = (u32x2*)(XN + (size_t)m * DM) + F.lane; u32x2* o1 = (u32x2*)(XN + (size_t)mm1 * DM) + F.lane;
#pragma unroll
        for (int j = 0; j < 4; ++j) { const f32x4 gg = g2[64 * j + F.lane];
            u32x2 w; w.x = pk2(v0[j].x * qa * gg.x, v0[j].y * qa * gg.y); w.y = pk2(v0[j].z * qa * gg.z, v0[j].w * qa * gg.w); o0[64 * j] = w;
            if (has1) { u32x2 q; q.x = pk2(v1[j].x * qb * gg.x, v1[j].y * qb * gg.y); q.y = pk2(v1[j].z * qb * gg.z, v1[j].w * qb * gg.w); o1[64 * j] = q; } }
    }
}
__device__ __forceinline__ void rows_final(Frame& F) {
    const int gw = F.bid * NWAVES + F.wave, NGW = F.G * NWAVES;
    const f32x4* g0 = (const f32x4*)F.in[22]; const f32x4* g1 = (const f32x4*)F.in[28];
    const bf16_t* Fb = (const bf16_t*)(F.ws + WS_F); const bf16_t* MIXb = (const bf16_t*)(F.ws + WS_MIX);
    for (int m = gw; m < M; m += 2 * NGW) {
        const int m1 = m + NGW; const bool has1 = m1 < M; const int mm1 = has1 ? m1 : m;
        f32x4 f0[4], f1[4], a0[4], a1[4], x0[4], x1[4];
        { const u32x2* fr = (const u32x2*)(Fb + (size_t)m * DM) + F.lane; const u32x2* mb = (const u32x2*)(MIXb + (size_t)m * DM) + F.lane; const f32x4* xr = (const f32x4*)xrow_ptr(F, m) + F.lane;
#pragma unroll
          for (int j = 0; j < 4; ++j) { f0[j] = bf4_to_f(__builtin_nontemporal_load(fr + 64 * j)); a0[j] = bf4_to_f(__builtin_nontemporal_load(mb + 64 * j)); x0[j] = __builtin_nontemporal_load(xr + 64 * j); } }
        { const u32x2* fr = (const u32x2*)(Fb + (size_t)mm1 * DM) + F.lane; const u32x2* mb = (const u32x2*)(MIXb + (size_t)mm1 * DM) + F.lane; const f32x4* xr = (const f32x4*)xrow_ptr(F, mm1) + F.lane;
#pragma unroll
          for (int j = 0; j < 4; ++j) { f1[j] = bf4_to_f(__builtin_nontemporal_load(fr + 64 * j)); a1[j] = bf4_to_f(__builtin_nontemporal_load(mb + 64 * j)); x1[j] = __builtin_nontemporal_load(xr + 64 * j); } }
        const float rf0 = 1.0f / sqrtf(wave_sum(sumsq4(f0)) * (1.f / DM) + RMS_EPS), rm0 = 1.0f / sqrtf(wave_sum(sumsq4(a0)) * (1.f / DM) + RMS_EPS);
        const float rf1 = 1.0f / sqrtf(wave_sum(sumsq4(f1)) * (1.f / DM) + RMS_EPS), rm1 = 1.0f / sqrtf(wave_sum(sumsq4(a1)) * (1.f / DM) + RMS_EPS);
        f32x4* y0 = (f32x4*)(F.out + (size_t)m * DM) + F.lane; f32x4* y1 = (f32x4*)(F.out + (size_t)mm1 * DM) + F.lane;
#pragma unroll
        for (int j = 0; j < 4; ++j) { const f32x4 ga = g0[64 * j + F.lane], gb = g1[64 * j + F.lane];
            __builtin_nontemporal_store((x0[j] + a0[j] * rm0 * ga) + f0[j] * rf0 * gb, y0 + 64 * j);
            if (has1) __builtin_nontemporal_store((x1[j] + a1[j] * rm1 * ga) + f1[j] * rf1 * gb, y1 + 64 * j); }
    }
}
__device__ __forceinline__ void conv_phase(Frame& F, int half) {
    const bf16_t* ZU = (const bf16_t*)(F.ws + WS_ZU); bf16_t* HID = (bf16_t*)(F.ws + WS_HID);
    const float* cw = F.in[25]; const float* cb = F.in[26]; const float* sc = F.in[6];
    const long total = (long)M * 176;
    for (long e = (long)F.bid * NT + F.tid; e < total; e += (long)F.G * NT) {
        const int m = (int)(e / 176), r = (int)(e - (long)m * 176); const int tile = r >> 4, c8 = (r & 15) * 8;
        const int ch = (half * 11 + tile) * 128 + c8;
        const RowInfo ri = row_info(m);
        const bf16_t* zp = ZU + (size_t)m * DFF + tile * 256 + c8;
        const u32x4 z0 = *(const u32x4*)zp, uu = *(const u32x4*)(zp + 128);
        float z[8], z1[8], z2[8], u8[8];
        z[0] = bflo(z0.x); z[1] = bfhi(z0.x); z[2] = bflo(z0.y); z[3] = bfhi(z0.y); z[4] = bflo(z0.z); z[5] = bfhi(z0.z); z[6] = bflo(z0.w); z[7] = bfhi(z0.w);
        u8[0] = bflo(uu.x); u8[1] = bfhi(uu.x); u8[2] = bflo(uu.y); u8[3] = bfhi(uu.y); u8[4] = bflo(uu.z); u8[5] = bfhi(uu.z); u8[6] = bflo(uu.w); u8[7] = bfhi(uu.w);
        if (ri.t >= 1) { const u32x4 w = *(const u32x4*)(zp - DFF); z1[0] = bflo(w.x); z1[1] = bfhi(w.x); z1[2] = bflo(w.y); z1[3] = bfhi(w.y); z1[4] = bflo(w.z); z1[5] = bfhi(w.z); z1[6] = bflo(w.w); z1[7] = bfhi(w.w); }
        else {
#pragma unroll
            for (int j = 0; j < 8; ++j) z1[j] = ri.samp ? sc[((size_t)ri.b * 2 + 1) * DFF + ch + j] : 0.f; }
        if (ri.t >= 2) { const u32x4 w = *(const u32x4*)(zp - 2 * DFF); z2[0] = bflo(w.x); z2[1] = bfhi(w.x); z2[2] = bflo(w.y); z2[3] = bfhi(w.y); z2[4] = bflo(w.z); z2[5] = bfhi(w.z); z2[6] = bflo(w.w); z2[7] = bfhi(w.w); }
        else {
#pragma unroll
            for (int j = 0; j < 8; ++j) z2[j] = ri.samp ? sc[((size_t)ri.b * 2 + ri.t) * DFF + ch + j] : 0.f; }
        float hd[8];
#pragma unroll
        for (int j = 0; j < 8; ++j) { const float zc = cb[ch + j] + cw[ch + j] * z2[j] + cw[DFF + ch + j] * z1[j] + cw[2 * DFF + ch + j] * z[j]; hd[j] = zc * sigmoidf_(zc) * u8[j]; }
        u32x4 w; w.x = pk2(hd[0], hd[1]); w.y = pk2(hd[2], hd[3]); w.z = pk2(hd[4], hd[5]); w.w = pk2(hd[6], hd[7]);
        *(u32x4*)(HID + (size_t)m * DFF + ch) = w;
    }
}

constexpr int NPHASE = 10;
__global__ void __launch_bounds__(NT, 2) fwd_megakernel(Args args) {
    extern __shared__ __attribute__((aligned(16))) unsigned char lds_raw[];
    Frame F;
    F.lds = (LAS unsigned char*)lds_raw; F.ws = args.ws; F.out = args.out; F.in = args.in;
    F.tid = threadIdx.x; F.lane = F.tid & 63; F.wave = __builtin_amdgcn_readfirstlane(F.tid >> 6); F.G = gridDim.x; F.bid = blockIdx.x;
    const int lo = args.ph_lo, hi = args.ph_hi;
#ifndef PH_MASK
#define PH_MASK 0x3ff
#endif
#ifndef DUP_MASK
#define DUP_MASK 0
#endif
#define IN(k) (((PH_MASK >> (k)) & 1) && lo <= (k) && (k) < hi)
#define REP(k) for (int rep_ = 0; rep_ < 1 + ((DUP_MASK >> (k)) & 1); ++rep_)
    unsigned* barw = (unsigned*)F.ws;
    volatile LAS unsigned* bst = (volatile LAS unsigned*)(F.lds + LDS_BYTES - 64);
    if (F.tid < 2) bst[F.tid] = 0u;
    XcdBarrier xbar; xbar.bar = barw; xbar.x = 0; xbar.st = bst;
    bool posted = false;
    if (lo + 1 < hi && F.bid == 0) { for (int i = F.tid; i < XCD_BAR_WORDS; i += NT) barw[i] = 0u; }
#define SEAM(k) do { if (IN(k) && IN((k) + 1)) { if (!posted) { cg::this_grid().sync(); xbar = xcd_barrier_post(barw, bst); posted = true; } else xcd_barrier(xbar); } } while (0)
    bf16_t* XN = (bf16_t*)(F.ws + WS_XN);
    if (IN(0)) REP(0) { p0_prologue(F); } SEAM(0);
    if (IN(1)) REP(1) {
        pg8::Gemm g{XN, (const bf16_t*)(F.ws + WS_WIN), M, DINP, DM, DM, DM, 0}; pg8::StaticOrder S; S.init(M, DINP, F.G, F.bid);
        Epi1 E{(const float*)(F.ws + WS_ROPE), (bf16_t*)(F.ws + WS_Q), (bf16_t*)(F.ws + WS_K), (bf16_t*)(F.ws + WS_VT), (bf16_t*)(F.ws + WS_HRW), F.out};
        pg8::gemm_phase<Epi1, true>(F.lds, g, S, E);
    } SEAM(1);
    if (IN(2)) REP(2) { prep_phase(F); sample_attn_phase(F); } SEAM(2);
    if (IN(3)) {
        for (int u = F.bid; u < NB * 64 * 2; u += F.G) prompt_attn_unit(F, u);
        sample_scan(F, F.bid, F.G);
        for (int sb = F.bid; sb < 256; sb += F.G) prompt_scan(F, sb);
    } SEAM(3);
    if (IN(4)) REP(4) { post_phase(F); } SEAM(4);
    if (IN(5)) REP(5) {
        pg8::Gemm g{(const bf16_t*)(F.ws + WS_OCAT), (const bf16_t*)(F.ws + WS_WOUT), M, DM, DM, DM, DM, 0}; pg8::StaticOrder S; S.init(M, DM, F.G, F.bid);
        EpiBf16 E{(bf16_t*)(F.ws + WS_MIX), DM};
        pg8::gemm_phase<EpiBf16, true>(F.lds, g, S, E);
    } SEAM(5);
    if (IN(6)) { rows_mid(F); } SEAM(6);
    if (IN(7)) REP(7) {
        pg8::Gemm g{XN, (const bf16_t*)(F.ws + WS_WFI), 136 * 256, 2 * DFF, DM, DM, DM, 1}; pg8::StaticOrder S; S.init(136 * 256, 2 * DFF, F.G, F.bid);
        EpiConv E{(bf16_t*)(F.ws + WS_HID), F.out, F.in[25], F.in[26], F.in[6], (LAS float*)(F.lds + 131072)};
        pg8::gemm_phase<EpiConv, true>(F.lds, g, S, E);
    } SEAM(7);
    if (IN(8)) REP(11) {
        pg8::Gemm g{(const bf16_t*)(F.ws + WS_HID), (const bf16_t*)(F.ws + WS_WFO), M, DM, DFF, DFF, DFF, 0}; pg8::StaticOrder S; S.init(M, DM, F.G, F.bid);
        EpiBf16 E{(bf16_t*)(F.ws + WS_F), DM};
        pg8::gemm_phase<EpiBf16, true>(F.lds, g, S, E);
    } SEAM(8);
    if (IN(9)) { rows_final(F); }
#undef IN
#undef SEAM
}

extern "C" void kernel_launch(void* const* d_in, const int* in_sizes, int n_in, void* d_out, int out_size, void* d_ws, size_t ws_size, hipStream_t stream) {
    static int grid = 0;
    if (grid == 0) {
        if (n_in != 29 || ws_size < WS_END) { fprintf(stderr, "kernel_launch: unexpected n_in %d / ws_size %zu\n", n_in, ws_size); grid = -1; return; }
        int dev = 0, cus = 0, per_cu = 0;
        hipGetDevice(&dev); hipDeviceGetAttribute(&cus, hipDeviceAttributeMultiprocessorCount, dev);
        if (hipFuncSetAttribute((const void*)fwd_megakernel, hipFuncAttributeMaxDynamicSharedMemorySize, LDS_BYTES) != hipSuccess) { fprintf(stderr, "kernel_launch: hipFuncSetAttribute failed\n"); grid = -1; return; }
        if (hipOccupancyMaxActiveBlocksPerMultiprocessor(&per_cu, (const void*)fwd_megakernel, NT, LDS_BYTES) != hipSuccess || per_cu < 1) { fprintf(stderr, "kernel_launch: occupancy query failed (%d)\n", per_cu); (void)hipGetLastError(); per_cu = 1; }
        grid = cus * (per_cu > 1 ? 1 : per_cu);
        fprintf(stderr, "kernel_launch: grid %d (cus %d, per_cu %d), ws %zu\n", grid, cus, per_cu, ws_size);
    }
    if (grid < 0) return;
    Args a{};
    for (int i = 0; i < 29; ++i) a.in[i] = (const float*)d_in[i];
    a.out = (float*)d_out; a.ws = (unsigned char*)d_ws;
#if MK_PER_PHASE
    for (int p = 0; p < NPHASE; ++p) { a.ph_lo = p; a.ph_hi = p + 1; hipLaunchKernelGGL(fwd_megakernel, dim3(grid), dim3(NT), LDS_BYTES, stream, a); }
#else
    a.ph_lo = 0; a.ph_hi = NPHASE;
    void* kargs[] = {&a};
    hipError_t e = hipLaunchCooperativeKernel((const void*)fwd_megakernel, dim3(grid), dim3(NT), kargs, LDS_BYTES, stream);
    if (e != hipSuccess) fprintf(stderr, "cooperative launch failed: %s (grid %d)\n", hipGetErrorString(e), grid);
#endif
}
```

```cpp
#include <hip/hip_runtime.h>
#include <hip/hip_cooperative_groups.h>
#include <cstdio>
#include <cstdint>
#include <utility>
namespace cg = cooperative_groups;

#ifndef MK_PER_PHASE
#define MK_PER_PHASE 0
#endif

#define LAS __attribute__((address_space(3)))
typedef unsigned short bf16_t;
typedef short bf16x8 __attribute__((ext_vector_type(8)));
typedef float f32x4 __attribute__((ext_vector_type(4)));
typedef float f32x2 __attribute__((ext_vector_type(2)));
typedef unsigned u32x4 __attribute__((ext_vector_type(4)));
typedef unsigned u32x2 __attribute__((ext_vector_type(2)));

constexpr int DM = 1024, NB = 4, T = 8192, MP = NB * T, DB = 128, DT = 8, MS = DB * DT, M = MP + MS;
constexpr int WIN = 128, DSH = 1696, DINP = 2560, DFF = 2816, DFFH = 1408;
constexpr float RMS_EPS = 1e-6f, GN_EPS = 64e-5f;
constexpr float QSCALE = 0.125f * 1.4426950408889634f;
constexpr size_t O_Y = 0, O_KWP = 34603008, O_VWP = 34668544, O_SHP = 34734080, O_WKVP = 34740864, O_CVP = 34871936,
                 O_KWS = 34894464, O_VWS = 36991616, O_SHS = 39088768, O_WKVS = 39305856, O_CVS = 43500160;
constexpr size_t MiB = 1u << 20;
constexpr size_t WS_WIN = 1 * MiB, WS_WOUT = 6 * MiB, WS_WFI = 8 * MiB, WS_WFO = 19 * MiB, WS_ROPE = 25 * MiB;
constexpr size_t WS_XN = 32 * MiB;
constexpr size_t WS_SR = 32 * MiB, WS_SK = 65 * MiB;
constexpr size_t WS_Q = 98 * MiB, WS_K = 131 * MiB, WS_VT = 140 * MiB;
constexpr size_t WS_HRW = 150 * MiB;
constexpr size_t WS_OCAT = 260 * MiB;
constexpr size_t WS_SW = 326 * MiB;
constexpr size_t WS_SV = 392 * MiB, WS_SKK = 425 * MiB, WS_SB = 458 * MiB;
constexpr size_t WS_ZU = 100 * MiB;
constexpr size_t WS_HID = 282 * MiB;
constexpr size_t WS_F = 216 * MiB;
constexpr size_t WS_MIX = 150 * MiB;
constexpr size_t WS_END = 491 * MiB;

__device__ __forceinline__ unsigned f2bf(float f) { unsigned u = __float_as_uint(f); return (u + 0x7fffu + ((u >> 16) & 1u)) >> 16; }

__device__ __forceinline__ float bf2f(unsigned short h) { return __uint_as_float(((unsigned)h) << 16); }
__device__ __forceinline__ float bflo(unsigned w) { return __uint_as_float(w << 16); }
__device__ __forceinline__ float bfhi(unsigned w) { return __uint_as_float(w & 0xffff0000u); }
__device__ __forceinline__ unsigned cvt_pk_bf16(float lo, float hi) { unsigned r; asm volatile("v_cvt_pk_bf16_f32 %0, %1, %2" : "=v"(r) : "v"(lo), "v"(hi)); return r; }
__device__ __forceinline__ unsigned pk2(float lo, float hi) { return cvt_pk_bf16(lo, hi); }
template <int CTRL> __device__ __forceinline__ float dppf(float x) { return __int_as_float(__builtin_amdgcn_update_dpp(0, __float_as_int(x), CTRL, 0xF, 0xF, false)); }
__device__ __forceinline__ float allsum16(float x) {
    x += dppf<0xB1>(x); x += dppf<0x4E>(x); x += dppf<0x141>(x); x += dppf<0x140>(x); return x;
}
__device__ __forceinline__ void allsum16_2(float& a, float& b) {
    a += dppf<0xB1>(a); b += dppf<0xB1>(b); a += dppf<0x4E>(a); b += dppf<0x4E>(b); a += dppf<0x141>(a); b += dppf<0x141>(b); a += dppf<0x140>(a); b += dppf<0x140>(b);
}
__device__ __forceinline__ float wave_sum(float v) {
    v = allsum16(v);
    { auto r = __builtin_amdgcn_permlane16_swap(__float_as_uint(v), __float_as_uint(v), false, false); v = __uint_as_float(r[0]) + __uint_as_float(r[1]); }
    { auto r = __builtin_amdgcn_permlane32_swap(__float_as_uint(v), __float_as_uint(v), false, false); v = __uint_as_float(r[0]) + __uint_as_float(r[1]); }
    return v;
}
__device__ __forceinline__ float sigmoidf_(float x) { return __builtin_amdgcn_rcpf(1.0f + __expf(-x)); }

namespace pg8 {
constexpr int BM = 256, BK = 64, HALF = 128, HTB = HALF * BK * 2, STAGE_BYTES = 8 * HTB, NXCD = 8, WGM = 8;
__host__ __device__ __forceinline__ int lds_byte(int r, int c) { const int st = (r >> 4) * 2 + (c >> 5), rr = r & 15, cc = c & 31, ob = rr * 64 + cc * 2; return st * 1024 + (ob ^ (((ob >> 9) & 1) << 5)); }
__host__ __device__ __forceinline__ void stage_rc(int b, int& R, int& C) { const int st = b / 1024, sb = b % 1024, swz = sb ^ (((sb >> 9) & 1) << 5); R = (st >> 1) * 16 + swz / 64; C = (st & 1) * 32 + (swz % 64) / 2; }
__host__ __device__ __forceinline__ int perm32(int rho) { const int n = rho >> 4, i = rho & 15; return 8 * (i >> 2) + 4 * n + (i & 3); }
struct Unit { int pm, pn; };
struct Gemm { const bf16_t* A; const bf16_t* Bt; int M, N, K, lda, ldb, conv; };
__device__ __forceinline__ long arow(const Gemm& g, int pm) {
    if (!g.conv) return (long)pm * 256;
    if (pm < 132) { const int b = pm / 33; return (long)b * 8192 + 254 * (pm - 33 * b) - 2; }
    return 32768 + (long)(pm - 132) * 256;
}
struct StaticOrder {
    int nM, nN, nwg, G, c;
    __device__ void init(int M_, int N_, int G_, int c_) { nM = M_ / BM; nN = N_ / BM; nwg = nM * nN; G = G_; c = c_; }
    __device__ bool next(int i, Unit& u) const {
        const long L = (long)i * G + c; if (L >= nwg) return false;
        int wgid = (int)L; { const int q = nwg / NXCD, r = nwg % NXCD, xcd = wgid % NXCD, off = wgid / NXCD; wgid = (xcd < r ? xcd * (q + 1) : r * (q + 1) + (xcd - r) * q) + off; }
        const int nig = WGM * nN, gid = wgid / nig, fm = gid * WGM, gsz = (nM - fm) < WGM ? (nM - fm) : WGM;
        u.pm = fm + ((wgid % nig) % gsz); u.pn = (wgid % nig) / gsz; return true;
    }
};
template <class Epi, bool ALIGN_EPI>
__device__ __forceinline__ void gemm_phase(LAS unsigned char* lds, const Gemm g, const StaticOrder& S, const Epi& E) {
    const int tid = threadIdx.x, wid = __builtin_amdgcn_readfirstlane(tid >> 6), lane = tid & 63, wr = wid >> 2, wc = wid & 3, fr = lane & 15, fq = lane >> 4;
    const int nt = g.K / BK;
    unsigned voffA[2], voffB[2];
#pragma unroll
    for (int i = 0; i < 2; ++i) { int R, C; stage_rc(tid * 16 + i * 8192, R, C); const int Rb = (R & ~31) + perm32(R & 31);
        voffA[i] = (unsigned)(R * g.lda + C) * 2u; voffB[i] = (unsigned)(Rb * g.ldb + C) * 2u; }
    const size_t kstep = (size_t)(BK * 2);
    const size_t hstepA = (size_t)HALF * g.lda * 2, hstepB = (size_t)HALF * g.ldb * 2;
    const size_t rowA = (size_t)g.lda * 2, tstepB = 2 * hstepB;
    const unsigned ldsw = (unsigned)wid * 1024u;
    const int aoff = lds_byte(wr * 64 + fr, fq * 8), boff = lds_byte(wc * 32 + fr, fq * 8);
#define PG8_SA(b, h) (((b) * 2 + (h)) * HTB)
#define PG8_SB(b, h) ((4 + (b) * 2 + (h)) * HTB)
#define PG8_STAGE(bufoff, gbase, voff) do { _Pragma("unroll") for (int _i = 0; _i < 2; ++_i) \
        __builtin_amdgcn_global_load_lds((const unsigned*)((const char*)(gbase) + (voff)[_i]), (LAS unsigned*)(lds + (bufoff) + ldsw + _i * 8192), 16, 0, 0); } while (0)
#define PG8_LDA(dst, b, h) do { _Pragma("unroll") for (int m = 0; m < 4; ++m) _Pragma("unroll") for (int k = 0; k < 2; ++k) dst[m][k] = *(const LAS bf16x8*)(lds + PG8_SA(b, h) + aoff + m * 2048 + k * 1024); } while (0)
#define PG8_LDB(dst, b, h) do { _Pragma("unroll") for (int n = 0; n < 2; ++n) _Pragma("unroll") for (int k = 0; k < 2; ++k) dst[n][k] = *(const LAS bf16x8*)(lds + PG8_SB(b, h) + boff + n * 2048 + k * 1024); } while (0)
#define PG8_MMA(ai, bj, At, Bt) do { __builtin_amdgcn_s_setprio(1); _Pragma("unroll") for (int m = 0; m < 4; ++m) _Pragma("unroll") for (int n = 0; n < 2; ++n) _Pragma("unroll") for (int k = 0; k < 2; ++k) \
        acc[ai][bj][m][n] = __builtin_amdgcn_mfma_f32_16x16x32_bf16(Bt[n][k], At[m][k], acc[ai][bj][m][n], 0, 0, 0); __builtin_amdgcn_s_setprio(0); } while (0)
#define PG8_WAIT_V(n) asm volatile("s_waitcnt vmcnt(" #n ")" ::: "memory")
#define PG8_WAIT_L(n) asm volatile("s_waitcnt lgkmcnt(" #n ")" ::: "memory")
#define PG8_BAR __builtin_amdgcn_s_barrier()
#define PG8_SCHED __builtin_amdgcn_sched_barrier(0)
    Unit cur, nxt; int ui = 0;
    if (!S.next(0, cur)) return;
    f32x4 acc[2][2][4][2];
#pragma unroll
    for (int a = 0; a < 2; ++a)
#pragma unroll
        for (int b = 0; b < 2; ++b)
#pragma unroll
            for (int m = 0; m < 4; ++m)
#pragma unroll
                for (int n = 0; n < 2; ++n) acc[a][b][m][n] = (f32x4){0.f, 0.f, 0.f, 0.f};
    bf16x8 At[4][2], B0[2][2], B1[2][2];
    const char* cA = (const char*)g.A + arow(g, cur.pm) * (long)rowA; const char* cB = (const char*)g.Bt + (size_t)cur.pn * tstepB;
    PG8_STAGE(PG8_SB(0, 0), cB, voffB); PG8_STAGE(PG8_SB(0, 1), cB + hstepB, voffB); PG8_STAGE(PG8_SA(0, 0), cA, voffA); PG8_STAGE(PG8_SA(0, 1), cA + hstepA, voffA);
    if (wr == 1) PG8_BAR;
    PG8_WAIT_V(2); PG8_BAR;
    PG8_STAGE(PG8_SB(1, 0), cB + kstep, voffB); PG8_STAGE(PG8_SA(1, 0), cA + kstep, voffA); PG8_STAGE(PG8_SB(1, 1), cB + hstepB + kstep, voffB);
    PG8_WAIT_V(6); PG8_BAR;
    for (;;) {
        const bool has_next = S.next(ui + 1, nxt);
        const char* nA = has_next ? (const char*)g.A + arow(g, nxt.pm) * (long)rowA : cA; const char* nB = has_next ? (const char*)g.Bt + (size_t)nxt.pn * tstepB : cB;
        for (int t = 0; t < nt; t += 2) {
            const bool last = (t == nt - 2);
            const char* a1 = cA + (size_t)(t + 1) * kstep;
            const char* a2 = last ? nA : cA + (size_t)(t + 2) * kstep; const char* b2 = last ? nB : cB + (size_t)(t + 2) * kstep;
            const char* a3 = a2 + kstep; const char* b3 = b2 + kstep;
            PG8_LDB(B0, 0, 0); PG8_LDB(B1, 0, 1); PG8_SCHED; PG8_LDA(At, 0, 0); PG8_STAGE(PG8_SA(1, 1), a1 + hstepA, voffA);
            PG8_WAIT_V(8); PG8_WAIT_L(0); PG8_BAR; PG8_MMA(0, 0, At, B0); PG8_MMA(0, 1, At, B1); PG8_BAR; PG8_SCHED;
            PG8_LDA(At, 0, 1); PG8_STAGE(PG8_SB(0, 0), b2, voffB); PG8_STAGE(PG8_SB(0, 1), b2 + hstepB, voffB); PG8_STAGE(PG8_SA(0, 0), a2, voffA);
            PG8_WAIT_V(8); PG8_WAIT_L(0); PG8_BAR; PG8_MMA(1, 0, At, B0); PG8_MMA(1, 1, At, B1); PG8_BAR; PG8_SCHED;
            PG8_LDB(B0, 1, 0); PG8_LDB(B1, 1, 1); PG8_SCHED; PG8_LDA(At, 1, 0); PG8_STAGE(PG8_SA(0, 1), a2 + hstepA, voffA);
            PG8_WAIT_V(8); PG8_WAIT_L(0); PG8_BAR; PG8_MMA(0, 0, At, B0); PG8_MMA(0, 1, At, B1); PG8_BAR; PG8_SCHED;
            PG8_LDA(At, 1, 1); PG8_STAGE(PG8_SB(1, 0), b3, voffB); PG8_STAGE(PG8_SB(1, 1), b3 + hstepB, voffB); PG8_STAGE(PG8_SA(1, 0), a3, voffA);
            PG8_WAIT_V(8); PG8_WAIT_L(0); PG8_BAR; PG8_MMA(1, 0, At, B0); PG8_MMA(1, 1, At, B1); PG8_BAR; PG8_SCHED;
        }
        if constexpr (ALIGN_EPI) { if (wr == 0) PG8_BAR; }
        asm volatile("s_nop 7\n\ts_nop 7" ::: "memory");
        E(acc, cur, wr, wc, fr, fq);
        if (!has_next) break;
#pragma unroll
        for (int a = 0; a < 2; ++a)
#pragma unroll
            for (int b = 0; b < 2; ++b)
#pragma unroll
                for (int m = 0; m < 4; ++m)
#pragma unroll
                    for (int n = 0; n < 2; ++n) acc[a][b][m][n] = (f32x4){0.f, 0.f, 0.f, 0.f};
        cur = nxt; cA = nA; cB = nB; ++ui;
        if constexpr (ALIGN_EPI) { if (wr == 1) PG8_BAR; }
    }
    PG8_WAIT_V(0);
    if constexpr (!ALIGN_EPI) { if (wr == 0) PG8_BAR; }
    PG8_BAR;
#undef PG8_SA
#undef PG8_SB
#undef PG8_STAGE
#undef PG8_LDA
#undef PG8_LDB
#undef PG8_MMA
#undef PG8_WAIT_V
#undef PG8_WAIT_L
#undef PG8_BAR
#undef PG8_SCHED
}
}

struct RowInfo { int b, t, samp; };
__device__ __forceinline__ RowInfo row_info(int row) { RowInfo r; if (row < MP) { r.samp = 0; r.b = row >> 13; r.t = row & (T - 1); } else { const int rs = row - MP; r.samp = 1; r.b = rs >> 3; r.t = rs & 7; } return r; }

struct Epi1 {
    const float* rope; bf16_t* Q; bf16_t* Kb; bf16_t* VT; bf16_t* HRW; float* out;
    __device__ __forceinline__ void operator()(const f32x4 (&acc)[2][2][4][2], const pg8::Unit& u, int wr, int wc, int fr, int fq) const {
#pragma unroll
        for (int ai = 0; ai < 2; ++ai)
#pragma unroll
            for (int m = 0; m < 4; ++m) {
                const int row = u.pm * 256 + ai * 128 + wr * 64 + m * 16 + fr;
                const RowInfo ri = row_info(row);
                const int pidx = ri.samp ? (T + ri.t) : ri.t;
#pragma unroll
                for (int bj = 0; bj < 2; ++bj) {
                    const int cb = u.pn * 256 + bj * 128;
                    const int c0 = cb + wc * 32 + fq * 8;
                    const f32x4 v0 = acc[ai][bj][m][0], v1 = acc[ai][bj][m][1];
                    if (cb < 640) {
                        const int d0 = ((c0 & 63) >> 3) * 4;
                        const f32x4* rp = (const f32x4*)(rope + ((size_t)pidx * 32 + d0) * 2);
                        const f32x4 cs0 = rp[0], cs1 = rp[1];
                        f32x4 o1, o2;
                        o1[0] = v0[0] * cs0[0] - v1[0] * cs0[1]; o2[0] = v1[0] * cs0[0] + v0[0] * cs0[1];
                        o1[1] = v0[1] * cs0[2] - v1[1] * cs0[3]; o2[1] = v1[1] * cs0[2] + v0[1] * cs0[3];
                        o1[2] = v0[2] * cs1[0] - v1[2] * cs1[1]; o2[2] = v1[2] * cs1[0] + v0[2] * cs1[1];
                        o1[3] = v0[3] * cs1[2] - v1[3] * cs1[3]; o2[3] = v1[3] * cs1[2] + v0[3] * cs1[3];
                        if (cb < 512) {
                            o1 = o1 * QSCALE; o2 = o2 * QSCALE;
                            bf16_t* qp = Q + (size_t)row * 512 + (c0 & ~63) + d0;
                            u32x2 w1, w2; w1.x = cvt_pk_bf16(o1[0], o1[1]); w1.y = cvt_pk_bf16(o1[2], o1[3]); w2.x = cvt_pk_bf16(o2[0], o2[1]); w2.y = cvt_pk_bf16(o2[2], o2[3]);
                            *(u32x2*)qp = w1; *(u32x2*)(qp + 32) = w2;
                        } else {
                            const int kvh = (c0 - 512) >> 6;
                            bf16_t* kp = Kb + (size_t)row * 128 + kvh * 64 + d0;
                            u32x2 w1, w2; w1.x = cvt_pk_bf16(o1[0], o1[1]); w1.y = cvt_pk_bf16(o1[2], o1[3]); w2.x = cvt_pk_bf16(o2[0], o2[1]); w2.y = cvt_pk_bf16(o2[2], o2[3]);
                            *(u32x2*)kp = w1; *(u32x2*)(kp + 32) = w2;
                            if (!ri.samp) { if (ri.t >= T - WIN) { float* o = out + O_KWP + ((size_t)(ri.b * WIN + (ri.t - (T - WIN))) * 2 + kvh) * 64 + d0; *(f32x4*)o = o1; *(f32x4*)(o + 32) = o2; } }
                            else { float* o = out + O_KWS + ((size_t)(ri.b * WIN + (WIN - DT) + ri.t) * 2 + kvh) * 64 + d0; *(f32x4*)o = o1; *(f32x4*)(o + 32) = o2; }
                        }
                    } else if (cb < 768) {
                        const int kvh = (c0 - 640) >> 6, d0 = (c0 - 640) & 63;
                        if (!ri.samp) {
                            bf16_t* vp = VT + ((size_t)(ri.b * 2 + kvh) * 64 + d0) * T + ri.t;
                            vp[0] = (bf16_t)f2bf(v0[0]); vp[(size_t)T] = (bf16_t)f2bf(v0[1]); vp[(size_t)2 * T] = (bf16_t)f2bf(v0[2]); vp[(size_t)3 * T] = (bf16_t)f2bf(v0[3]);
                            vp[(size_t)4 * T] = (bf16_t)f2bf(v1[0]); vp[(size_t)5 * T] = (bf16_t)f2bf(v1[1]); vp[(size_t)6 * T] = (bf16_t)f2bf(v1[2]); vp[(size_t)7 * T] = (bf16_t)f2bf(v1[3]);
                            if (ri.t >= T - WIN) { float* o = out + O_VWP + ((size_t)(ri.b * WIN + (ri.t - (T - WIN))) * 2 + kvh) * 64 + d0; *(f32x4*)o = v0; *(f32x4*)(o + 4) = v1; }
                        } else { float* o = out + O_VWS + ((size_t)(ri.b * WIN + (WIN - DT) + ri.t) * 2 + kvh) * 64 + d0; *(f32x4*)o = v0; *(f32x4*)(o + 4) = v1; }
                    } else if (c0 < 2464) {
                        const int col = c0 - 768;
                        u32x4 w; w.x = cvt_pk_bf16(v0[0], v0[1]); w.y = cvt_pk_bf16(v0[2], v0[3]); w.z = cvt_pk_bf16(v1[0], v1[1]); w.w = cvt_pk_bf16(v1[2], v1[3]);
                        *(u32x4*)(HRW + (size_t)row * DSH + col) = w;
                        if (!ri.samp) { if (ri.t == T - 1) { float* o = out + O_SHP + (size_t)ri.b * DSH + col; *(f32x4*)o = v0; *(f32x4*)(o + 4) = v1; } }
                        else if (ri.t == DT - 1) { float* o = out + O_SHS + (size_t)ri.b * DSH + col; *(f32x4*)o = v0; *(f32x4*)(o + 4) = v1; }
                    }
                }
            }
    }
};
struct EpiF32 {
    float* O; int ldc;
    __device__ __forceinline__ void operator()(const f32x4 (&acc)[2][2][4][2], const pg8::Unit& u, int wr, int wc, int fr, int fq) const {
#pragma unroll
        for (int ai = 0; ai < 2; ++ai)
#pragma unroll
            for (int m = 0; m < 4; ++m) {
                float* rowp = O + (size_t)(u.pm * 256 + ai * 128 + wr * 64 + m * 16 + fr) * ldc + u.pn * 256 + wc * 32 + fq * 8;
#pragma unroll
                for (int bj = 0; bj < 2; ++bj) { *(f32x4*)(rowp + bj * 128) = acc[ai][bj][m][0]; *(f32x4*)(rowp + bj * 128 + 4) = acc[ai][bj][m][1]; }
            }
    }
};
struct EpiBf16 {
    bf16_t* O; int ldc;
    __device__ __forceinline__ void operator()(const f32x4 (&acc)[2][2][4][2], const pg8::Unit& u, int wr, int wc, int fr, int fq) const {
#pragma unroll
        for (int ai = 0; ai < 2; ++ai)
#pragma unroll
            for (int m = 0; m < 4; ++m) {
                bf16_t* rowp = O + (size_t)(u.pm * 256 + ai * 128 + wr * 64 + m * 16 + fr) * ldc + u.pn * 256 + wc * 32 + fq * 8;
#pragma unroll
                for (int bj = 0; bj < 2; ++bj) { const f32x4 v0 = acc[ai][bj][m][0], v1 = acc[ai][bj][m][1];
                    u32x4 w; w.x = cvt_pk_bf16(v0[0], v0[1]); w.y = cvt_pk_bf16(v0[2], v0[3]); w.z = cvt_pk_bf16(v1[0], v1[1]); w.w = cvt_pk_bf16(v1[2], v1[3]);
                    *(u32x4*)(rowp + bj * 128) = w; }
            }
    }
};
template <int CTRL> __device__ __forceinline__ float dpp_old(float old, float src) { return __int_as_float(__builtin_amdgcn_update_dpp(__float_as_int(old), __float_as_int(src), CTRL, 0xF, 0xF, false)); }
struct EpiConv {
    bf16_t* HID; float* out; const float* cw; const float* cb; const float* sc; LAS float* exch;
    __device__ __forceinline__ void operator()(const f32x4 (&acc)[2][2][4][2], const pg8::Unit& u, int wr, int wc, int fr, int fq) const {
        const int cw8 = wc * 32 + fq * 8, ch0 = u.pn * 128 + cw8;
        if (fr >= 14) {
#pragma unroll
            for (int ai = 0; ai < 2; ++ai)
#pragma unroll
                for (int n = 0; n < 2; ++n) *(LAS f32x4*)(exch + ((ai * 2 + wr) * 2 + (fr - 14)) * 128 + cw8 + 4 * n) = acc[ai][0][3][n];
        }
        asm volatile("s_waitcnt lgkmcnt(0)\n\ts_barrier" ::: "memory");
        int row0, b0 = 0, i0 = 0; const bool samp = u.pm >= 132;
        if (!samp) { b0 = u.pm / 33; i0 = u.pm - 33 * b0; row0 = b0 * T + 254 * i0 - 2; } else row0 = MP + (u.pm - 132) * 256;
        f32x4 w0[2], w1[2], w2[2], bb[2];
#pragma unroll
        for (int n = 0; n < 2; ++n) { w0[n] = *(const f32x4*)(cw + ch0 + 4 * n); w1[n] = *(const f32x4*)(cw + DFF + ch0 + 4 * n); w2[n] = *(const f32x4*)(cw + 2 * DFF + ch0 + 4 * n); bb[n] = *(const f32x4*)(cb + ch0 + 4 * n); }
#pragma unroll
        for (int ai = 0; ai < 2; ++ai) {
            const int strip = ai * 2 + wr;
            f32x4 h1[2], h2[2];
#pragma unroll
            for (int n = 0; n < 2; ++n) {
                if (strip > 0) { h1[n] = *(const LAS f32x4*)(exch + ((strip - 1) * 2 + 1) * 128 + cw8 + 4 * n); h2[n] = *(const LAS f32x4*)(exch + ((strip - 1) * 2) * 128 + cw8 + 4 * n); }
                else { h1[n] = (f32x4){0.f, 0.f, 0.f, 0.f}; h2[n] = (f32x4){0.f, 0.f, 0.f, 0.f}; }
            }
#pragma unroll
            for (int m = 0; m < 4; ++m) {
                const int lr = ai * 128 + wr * 64 + m * 16 + fr;
                int t, b; bool valid;
                if (!samp) { t = 254 * i0 + lr - 2; b = b0; valid = lr >= 2 && t < T; } else { const int rs = row0 - MP + lr; b = rs >> 3; t = rs & 7; valid = true; }
                const size_t R = (size_t)((long)row0 + lr);
                f32x4 hd[2];
#pragma unroll
                for (int n = 0; n < 2; ++n) {
                    const f32x4 z = acc[ai][0][m][n], uu = acc[ai][1][m][n];
                    f32x4 o1, o2, zm1, zm2;
                    if (m == 0) { o1 = h1[n]; o2 = (fr == 0) ? h2[n] : h1[n]; }
                    else {
#pragma unroll
                        for (int e = 0; e < 4; ++e) { o1[e] = dppf<0x121>(acc[ai][0][m > 0 ? m - 1 : 0][n][e]); o2[e] = dppf<0x122>(acc[ai][0][m > 0 ? m - 1 : 0][n][e]); }
                    }
#pragma unroll
                    for (int e = 0; e < 4; ++e) { zm1[e] = dpp_old<0x111>(o1[e], z[e]); zm2[e] = dpp_old<0x112>(o2[e], z[e]); }
                    if (t == 0) {
                        if (samp) { zm1 = *(const f32x4*)(sc + ((size_t)b * 2 + 1) * DFF + ch0 + 4 * n); zm2 = *(const f32x4*)(sc + ((size_t)b * 2) * DFF + ch0 + 4 * n); }
                        else { zm1 = (f32x4){0.f, 0.f, 0.f, 0.f}; zm2 = (f32x4){0.f, 0.f, 0.f, 0.f}; }
                    } else if (t == 1) {
                        if (samp) zm2 = *(const f32x4*)(sc + ((size_t)b * 2 + 1) * DFF + ch0 + 4 * n); else zm2 = (f32x4){0.f, 0.f, 0.f, 0.f};
                    }
                    const f32x4 zc = bb[n] + w0[n] * zm2 + w1[n] * zm1 + w2[n] * z;
#pragma unroll
                    for (int e = 0; e < 4; ++e) hd[n][e] = zc[e] * sigmoidf_(zc[e]) * uu[e];
                }
                if (valid) {
                    u32x4 w; w.x = cvt_pk_bf16(hd[0][0], hd[0][1]); w.y = cvt_pk_bf16(hd[0][2], hd[0][3]); w.z = cvt_pk_bf16(hd[1][0], hd[1][1]); w.w = cvt_pk_bf16(hd[1][2], hd[1][3]);
                    *(u32x4*)(HID + R * DFF + ch0) = w;
                    if (!samp) { if (t >= T - 2) { float* o = out + O_CVP + (size_t)(b * 2 + (t - (T - 2))) * DFF + ch0; *(f32x4*)o = acc[ai][0][m][0]; *(f32x4*)(o + 4) = acc[ai][0][m][1]; } }
                    else if (t >= DT - 2) { float* o = out + O_CVS + (size_t)(b * 2 + (t - (DT - 2))) * DFF + ch0; *(f32x4*)o = acc[ai][0][m][0]; *(f32x4*)(o + 4) = acc[ai][0][m][1]; }
                }
            }
        }
    }
};

#define XB_TMO      128
#define XB_XCNT(j)  (256  + 64 * (j))
#define XB_XSUB(j)  (1280 + 64 * (j))
#define XB_XGEN(j)  (2304 + 64 * (j))
#define XB_TOP      3328
#define XB_TOPGEN   3392
#define XCD_BAR_WORDS 3456
#define XB_SPIN_CAP (1u << 20)
__device__ __forceinline__ unsigned xb_ld(unsigned* p)              { return __hip_atomic_load(p, __ATOMIC_RELAXED, __HIP_MEMORY_SCOPE_AGENT); }
__device__ __forceinline__ unsigned xb_add(unsigned* p, unsigned v) { return __hip_atomic_fetch_add(p, v, __ATOMIC_RELAXED, __HIP_MEMORY_SCOPE_AGENT); }
__device__ __forceinline__ unsigned xb_xcc_id() { return (unsigned)__builtin_amdgcn_s_getreg((3 << 11) | 20) & 0xFu; }
#define XB_SPIN(cond, bar) do { unsigned _sp = 0; while (cond) { __builtin_amdgcn_s_sleep(1); \
    if ((++_sp & 255u) == 0u) { if (xb_ld(&(bar)[XB_TMO])) break; if (_sp > XB_SPIN_CAP) { atomicAdd(&(bar)[XB_TMO], 1u); break; } } } } while (0)
struct XcdBarrier { unsigned* bar; unsigned x; volatile LAS unsigned* st; };
__device__ __forceinline__ XcdBarrier xcd_barrier_post(unsigned* bar, volatile LAS unsigned* st) {
    XcdBarrier b; b.bar = bar; b.x = xb_xcc_id(); b.st = st;
    if (threadIdx.x == 0) (void)xb_add(&bar[XB_XCNT(b.x)], 1u);
    return b;
}
__device__ __forceinline__ void xcd_barrier_complete(unsigned* bar, unsigned x, unsigned& nloc, unsigned& nx) {
    const unsigned G = gridDim.x * gridDim.y * gridDim.z;
    unsigned sum, cnt, mine, sp = 0u;
    for (;;) {
        sum = 0u; cnt = 0u; mine = 0u;
#pragma unroll
        for (unsigned j = 0; j < 16; ++j) { const unsigned c = xb_ld(&bar[XB_XCNT(j)]); sum += c; cnt += (c > 0u) ? 1u : 0u; mine = (j == x) ? c : mine; }
        if (sum == G) break;
        __builtin_amdgcn_s_sleep(1);
        if ((++sp & 255u) == 0u) { if (xb_ld(&bar[XB_TMO])) break; if (sp > XB_SPIN_CAP) { atomicAdd(&bar[XB_TMO], 1u); break; } }
    }
    nloc = mine > 0u ? mine : 1u; nx = cnt > 0u ? cnt : 1u;
}
__device__ __forceinline__ void xcd_barrier(const XcdBarrier& b) {
    asm volatile("s_waitcnt vmcnt(0)" ::: "memory");
    __syncthreads();
    if (threadIdx.x == 0) {
        unsigned* bar = b.bar;
        __builtin_amdgcn_s_waitcnt(0);
        unsigned nloc = b.st[0], nx = b.st[1];
        if (nloc == 0u) { xcd_barrier_complete(bar, b.x, nloc, nx); b.st[0] = nloc; b.st[1] = nx; }
        const unsigned old = xb_add(&bar[XB_XSUB(b.x)], 1u);
        const unsigned gen = old / nloc;
        if (old + 1u == (gen + 1u) * nloc) {
            __builtin_amdgcn_fence(__ATOMIC_RELEASE, "agent");
            asm volatile("s_waitcnt vmcnt(0)" ::: "memory");
            const unsigned og = xb_add(&bar[XB_TOP], 1u);
            const unsigned tg = og / nx;
            if (og + 1u == (tg + 1u) * nx) xb_add(&bar[XB_TOPGEN], 1u);
            else XB_SPIN(xb_ld(&bar[XB_TOPGEN]) == tg, bar);
            __builtin_amdgcn_fence(__ATOMIC_ACQUIRE, "agent");
            xb_add(&bar[XB_XGEN(b.x)], 1u);
            asm volatile("s_waitcnt vmcnt(0)" ::: "memory");
        } else {
            XB_SPIN(xb_ld(&bar[XB_XGEN(b.x)]) == gen, bar);
            __builtin_amdgcn_fence(__ATOMIC_ACQUIRE, "agent");
            asm volatile("s_waitcnt vmcnt(0)" ::: "memory");
        }
    }
    __syncthreads();
}

constexpr int NWAVES = 8, NT = 512;
constexpr int LDS_BYTES = 163840;
constexpr int YP_OFF = 129536;
struct Args { const float* in[29]; float* out; unsigned char* ws; int ph_lo, ph_hi; };
struct Frame {
    LAS unsigned char* lds; unsigned char* ws; float* out; const float* const* in;
    int tid, lane, wave, G, bid;
};
__device__ __forceinline__ const float* xrow_ptr(const Frame& F, int m) { return m < MP ? F.in[0] + (size_t)m * DM : F.in[1] + (size_t)(m - MP) * DM; }

template <class MAP>
__device__ __forceinline__ void p0_transpose_item(const float* W, int K, int N, int Nout, bf16_t* WT, LAS float* scr, int item, int lane, MAP map) {
    const int nblk = Nout / 32, kb = item / nblk, nb = item % nblk, k0 = 64 * kb, n0 = 32 * nb;
    const int src = map(n0 + (lane & 31));
    float tv[32];
#pragma unroll
    for (int i = 0; i < 32; ++i) { const int kk = 2 * i + (lane >> 5); tv[i] = src >= 0 ? W[(size_t)(k0 + kk) * N + src] : 0.f; }
#pragma unroll
    for (int i = 0; i < 32; ++i) { const int kk = 2 * i + (lane >> 5); scr[kk * 33 + (lane & 31)] = tv[i]; }
    asm volatile("s_waitcnt lgkmcnt(0)" ::: "memory");
    const int c = lane & 7;
#pragma unroll
    for (int j = 0; j < 4; ++j) { const int n = (lane >> 3) + 8 * j; const LAS float* s = scr + (8 * c) * 33 + n;
        u32x4 o; o.x = pk2(s[0 * 33], s[1 * 33]); o.y = pk2(s[2 * 33], s[3 * 33]); o.z = pk2(s[4 * 33], s[5 * 33]); o.w = pk2(s[6 * 33], s[7 * 33]);
        *(u32x4*)(WT + (size_t)(n0 + n) * K + k0 + 8 * c) = o; }
    asm volatile("s_waitcnt lgkmcnt(0)" ::: "memory");
}
struct MapIn { __device__ int operator()(int n) const { if (n < 640) { const int w = n & 63; return (n & ~63) + (w >> 3) * 4 + (w & 3) + 32 * ((w >> 2) & 1); } return n < 2464 ? n : -1; } };
struct MapId { __device__ int operator()(int n) const { return n; } };
struct MapFfn { __device__ int operator()(int n) const { const int tile = n >> 8, sub = n & 255, ch = tile * 128 + (sub & 127); return sub < 128 ? ch : DFF + ch; } };

__device__ __forceinline__ void p0_prologue(Frame& F) {
    LAS float* scr = (LAS float*)(F.lds + F.wave * 16384);
    const int gw = F.bid * NWAVES + F.wave, NGW = F.G * NWAVES;
    constexpr int I_IN = 16 * (DINP / 32), I_OUT = 16 * 32, I_FI = 16 * (2 * DFF / 32), I_FO = (DFF / 64) * 32;
    constexpr int NITEMS = I_IN + I_OUT + I_FI + I_FO;
#ifndef TR_DUP
#define TR_DUP 1
#endif
    for (int it_ = gw; it_ < NITEMS * TR_DUP; it_ += NGW) {
        const int it = it_ % NITEMS;
        int r = it;
        if (r < I_IN) { p0_transpose_item(F.in[8], DM, 2464, DINP, (bf16_t*)(F.ws + WS_WIN), scr, r, F.lane, MapIn()); continue; } r -= I_IN;
        if (r < I_OUT) { p0_transpose_item(F.in[21], DM, DM, DM, (bf16_t*)(F.ws + WS_WOUT), scr, r, F.lane, MapId()); continue; } r -= I_OUT;
        if (r < I_FI) { p0_transpose_item(F.in[24], DM, 2 * DFF, 2 * DFF, (bf16_t*)(F.ws + WS_WFI), scr, r, F.lane, MapFfn()); continue; } r -= I_FI;
        p0_transpose_item(F.in[27], DFF, DM, DM, (bf16_t*)(F.ws + WS_WFO), scr, r, F.lane, MapId());
    }
    float* rope = (float*)(F.ws + WS_ROPE);
    for (int e = F.bid * NT + F.tid; e < (T + DT) * 32; e += F.G * NT) {
        const int pidx = e >> 5, i = e & 31; const int pos = pidx < T ? pidx : 16384 + (pidx - T);
        const float inv = (float)exp2(-(double)i * (13.287712379549449 / 32.0));
        const float angf = (float)pos * inv;
        const double a = (double)angf;
        const double TWO_PI = 6.283185307179586476925286766559;
        const double n = rint(a / TWO_PI);
        const double r = a - n * TWO_PI;
        const double r2 = r * r;
        double c = 1.0, s = 1.0, tc = 1.0, ts = 1.0;
#pragma unroll
        for (int k = 1; k <= 14; ++k) { tc = -tc * r2 * (1.0 / (double)((2 * k - 1) * (2 * k))); ts = -ts * r2 * (1.0 / (double)((2 * k) * (2 * k + 1))); c += tc; s += ts; }
        s *= r;
        rope[(size_t)e * 2] = (float)c; rope[(size_t)e * 2 + 1] = (float)s;
    }
    const float* g = F.in[7];
    bf16_t* XN = (bf16_t*)(F.ws + WS_XN);
    for (int m = gw; m < M; m += 2 * NGW) {
        const int m1 = m + NGW; const bool has1 = m1 < M;
        const f32x4* xr0 = (const f32x4*)xrow_ptr(F, m) + F.lane; const f32x4* xr1 = (const f32x4*)xrow_ptr(F, has1 ? m1 : m) + F.lane;
        f32x4 v0[4], v1[4];
#pragma unroll
        for (int j = 0; j < 4; ++j) v0[j] = __builtin_nontemporal_load(xr0 + 64 * j);
#pragma unroll
        for (int j = 0; j < 4; ++j) v1[j] = __builtin_nontemporal_load(xr1 + 64 * j);
        float s0 = 0.f, s1 = 0.f;
#pragma unroll
        for (int j = 0; j < 4; ++j) { s0 += (v0[j].x * v0[j].x + v0[j].y * v0[j].y) + (v0[j].z * v0[j].z + v0[j].w * v0[j].w); s1 += (v1[j].x * v1[j].x + v1[j].y * v1[j].y) + (v1[j].z * v1[j].z + v1[j].w * v1[j].w); }
        const float r0 = 1.0f / sqrtf(wave_sum(s0) * (1.f / DM) + RMS_EPS), r1 = 1.0f / sqrtf(wave_sum(s1) * (1.f / DM) + RMS_EPS);
        u32x2* o0 = (u32x2*)(XN + (size_t)m * DM) + F.lane; u32x2* o1 = (u32x2*)(XN + (size_t)m1 * DM) + F.lane;
#pragma unroll
        for (int j = 0; j < 4; ++j) { const f32x4 gg = ((const f32x4*)g)[64 * j + F.lane];
            u32x2 w; w.x = pk2(v0[j].x * r0 * gg.x, v0[j].y * r0 * gg.y); w.y = pk2(v0[j].z * r0 * gg.z, v0[j].w * r0 * gg.w); o0[64 * j] = w;
            if (has1) { u32x2 q; q.x = pk2(v1[j].x * r1 * gg.x, v1[j].y * r1 * gg.y); q.y = pk2(v1[j].z * r1 * gg.z, v1[j].w * r1 * gg.w); o1[64 * j] = q; } }
    }
}

__device__ __forceinline__ float hprev_val(const Frame& F, const bf16_t* HRW, int m, int col) {
    const RowInfo ri = row_info(m);
    if (ri.t == 0) return ri.samp ? F.in[4][(size_t)ri.b * DSH + col] : 0.f;
    return bf2f(HRW[(size_t)(m - 1) * DSH + col]);
}
__device__ __forceinline__ f32x4 ld_bf4(const bf16_t* p) { const u32x2 w = *(const u32x2*)p; return (f32x4){bflo(w.x), bfhi(w.x), bflo(w.y), bfhi(w.y)}; }
__device__ __forceinline__ f32x4 hs4(const Frame& F, const bf16_t* HRW, int m, const RowInfo& ri, int col) {
    const f32x4 h = ld_bf4(HRW + (size_t)m * DSH + col);
    f32x4 hp;
    if (ri.t == 0) hp = ri.samp ? *(const f32x4*)(F.in[4] + (size_t)ri.b * DSH + col) : (f32x4){0.f, 0.f, 0.f, 0.f};
    else hp = ld_bf4(HRW + (size_t)(m - 1) * DSH + col);
    const f32x4 mu = *(const f32x4*)(F.in[10] + col);
    return h + (hp - h) * mu;
}
struct F8 { f32x4 a, b; };
__device__ __forceinline__ F8 ld_bf8(const bf16_t* p) { const u32x4 w = *(const u32x4*)p; F8 r; r.a = (f32x4){bflo(w.x), bfhi(w.x), bflo(w.y), bfhi(w.y)}; r.b = (f32x4){bflo(w.z), bfhi(w.z), bflo(w.w), bfhi(w.w)}; return r; }
__device__ __forceinline__ u32x4 pk8(const f32x4 a, const f32x4 b) { u32x4 w; w.x = cvt_pk_bf16(a[0], a[1]); w.y = cvt_pk_bf16(a[2], a[3]); w.z = cvt_pk_bf16(b[0], b[1]); w.w = cvt_pk_bf16(b[2], b[3]); return w; }
__device__ __forceinline__ F8 hs8m(const Frame& F, const bf16_t* HRW, int m, const RowInfo& ri, int col, const f32x4 mua, const f32x4 mub) {
    const F8 h = ld_bf8(HRW + (size_t)m * DSH + col);
    F8 hp;
    if (ri.t == 0) {
        if (ri.samp) { hp.a = *(const f32x4*)(F.in[4] + (size_t)ri.b * DSH + col); hp.b = *(const f32x4*)(F.in[4] + (size_t)ri.b * DSH + col + 4); }
        else { hp.a = (f32x4){0.f, 0.f, 0.f, 0.f}; hp.b = (f32x4){0.f, 0.f, 0.f, 0.f}; }
    } else hp = ld_bf8(HRW + (size_t)(m - 1) * DSH + col);
    F8 r; r.a = h.a + (hp.a - h.a) * mua; r.b = h.b + (hp.b - h.b) * mub; return r;
}
__device__ __forceinline__ F8 hs8(const Frame& F, const bf16_t* HRW, int m, const RowInfo& ri, int col) {
    const F8 h = ld_bf8(HRW + (size_t)m * DSH + col);
    F8 hp;
    if (ri.t == 0) {
        if (ri.samp) { hp.a = *(const f32x4*)(F.in[4] + (size_t)ri.b * DSH + col); hp.b = *(const f32x4*)(F.in[4] + (size_t)ri.b * DSH + col + 4); }
        else { hp.a = (f32x4){0.f, 0.f, 0.f, 0.f}; hp.b = (f32x4){0.f, 0.f, 0.f, 0.f}; }
    } else hp = ld_bf8(HRW + (size_t)(m - 1) * DSH + col);
    const f32x4 mua = *(const f32x4*)(F.in[10] + col), mub = *(const f32x4*)(F.in[10] + col + 4);
    F8 r; r.a = h.a + (hp.a - h.a) * mua; r.b = h.b + (hp.b - h.b) * mub; return r;
}
__device__ __forceinline__ float xsum_fq(float v) {
    { auto r = __builtin_amdgcn_permlane16_swap(__float_as_uint(v), __float_as_uint(v), false, false); v = __uint_as_float(r[0]) + __uint_as_float(r[1]); }
    { auto r = __builtin_amdgcn_permlane32_swap(__float_as_uint(v), __float_as_uint(v), false, false); v = __uint_as_float(r[0]) + __uint_as_float(r[1]); }
    return v;
}
__device__ __forceinline__ u32x2 pk4(const f32x4 v) { u32x2 w; w.x = cvt_pk_bf16(v[0], v[1]); w.y = cvt_pk_bf16(v[2], v[3]); return w; }
__device__ __forceinline__ bf16x8 wfrag(const float* W, int k0, int fq, int ch) {
    u32x4 w; const float* p = W + (size_t)(k0 + 8 * fq) * 512 + ch;
    w.x = cvt_pk_bf16(p[0], p[512]); w.y = cvt_pk_bf16(p[1024], p[1536]); w.z = cvt_pk_bf16(p[2048], p[2560]); w.w = cvt_pk_bf16(p[3072], p[3584]);
    return __builtin_bit_cast(bf16x8, w);
}
#ifndef PREP_DUP
#define PREP_DUP 1
#endif
#ifndef POST_DUP
#define POST_DUP 1
#endif
__device__ __forceinline__ void prep_phase(Frame& F) {
    const bf16_t* HRW = (const bf16_t*)(F.ws + WS_HRW);
    bf16_t* SR = (bf16_t*)(F.ws + WS_SR); bf16_t* SK = (bf16_t*)(F.ws + WS_SK); bf16_t* SV = (bf16_t*)(F.ws + WS_SV);
    bf16_t* SKK = (bf16_t*)(F.ws + WS_SKK); bf16_t* SB = (bf16_t*)(F.ws + WS_SB); float* SW = (float*)(F.ws + WS_SW);
    const int fr = F.lane & 15, fq = F.lane >> 4, h = F.wave;
    bf16x8 Aw[4], Aa[4];
#pragma unroll
    for (int nt = 0; nt < 4; ++nt) { const int ch = h * 64 + 16 * (fr >> 2) + 4 * nt + (fr & 3); Aw[nt] = wfrag(F.in[12], 0, fq, ch); Aa[nt] = wfrag(F.in[14], 0, fq, ch); }
    constexpr int NTILE = M / 16;
    f32x4 pw0[4], pa0[4], pkk[4], pka[4];
    f32x4 pmu[3][4];
#pragma unroll
    for (int st = 0; st < 3; ++st)
#pragma unroll
        for (int i = 0; i < 4; ++i) pmu[st][i] = *(const f32x4*)(F.in[10] + st * 512 + h * 64 + 16 * fq + 4 * i);
#pragma unroll
    for (int i = 0; i < 4; ++i) { const int c4 = h * 64 + 16 * fq + 4 * i; pw0[i] = *(const f32x4*)(F.in[11] + c4); pa0[i] = *(const f32x4*)(F.in[13] + c4); pkk[i] = *(const f32x4*)(F.in[16] + c4); pka[i] = *(const f32x4*)(F.in[17] + c4); }
    for (int tile_ = F.bid; tile_ < NTILE * PREP_DUP; tile_ += F.G) {
        const int m = (tile_ % NTILE) * 16 + fr;
        const RowInfo ri = row_info(m);
        bf16x8 xw, xa;
        { const F8 a = hs8(F, HRW, m, ri, 1536 + 8 * fq);
          f32x4 t0, t1;
#pragma unroll
          for (int i = 0; i < 4; ++i) { t0[i] = 1.f - 2.f * __builtin_amdgcn_rcpf(__expf(2.f * a.a[i]) + 1.f); t1[i] = 1.f - 2.f * __builtin_amdgcn_rcpf(__expf(2.f * a.b[i]) + 1.f); }
          xw = __builtin_bit_cast(bf16x8, pk8(t0, t1)); }
        { const F8 a = hs8(F, HRW, m, ri, 1568 + 8 * fq); xa = __builtin_bit_cast(bf16x8, pk8(a.a, a.b)); }
        f32x4 kkr[4], av[4]; float ss = 0.f;
#pragma unroll
        for (int np = 0; np < 2; ++np) {
            const int c8 = h * 64 + 16 * fq + 8 * np;
            const f32x4 z = {0.f, 0.f, 0.f, 0.f};
            f32x4 accw[2], acca[2];
#pragma unroll
            for (int q = 0; q < 2; ++q) { accw[q] = __builtin_amdgcn_mfma_f32_16x16x32_bf16(Aw[2 * np + q], xw, z, 0, 0, 0); acca[q] = __builtin_amdgcn_mfma_f32_16x16x32_bf16(Aa[2 * np + q], xa, z, 0, 0, 0); }
            const F8 r8 = hs8m(F, HRW, m, ri, c8, pmu[0][2 * np], pmu[0][2 * np + 1]), k8 = hs8m(F, HRW, m, ri, 512 + c8, pmu[1][2 * np], pmu[1][2 * np + 1]), v8 = hs8m(F, HRW, m, ri, 1024 + c8, pmu[2][2 * np], pmu[2][2 * np + 1]);
            f32x4 dec[2], k2[2];
#pragma unroll
            for (int q = 0; q < 2; ++q) {
                const f32x4 k = q ? k8.b : k8.a;
                const f32x4 w0 = pw0[2 * np + q], a0 = pa0[2 * np + q], kkc = pkk[2 * np + q], kac = pka[2 * np + q];
                f32x4 a;
#pragma unroll
                for (int j = 0; j < 4; ++j) {
                    const float x = -(w0[j] + accw[q][j]);
                    const float sp = fmaxf(x, 0.f) + __logf(1.f + __expf(-fabsf(x)));
                    dec[q][j] = __expf(-__expf(-sp - 0.5f));
                    a[j] = sigmoidf_(a0[j] + acca[q][j]);
                    k2[q][j] = k[j] * (1.f + (a[j] - 1.f) * kac[j]);
                }
                const f32x4 kk = k * kkc;
                ss += (kk[0] * kk[0] + kk[1] * kk[1]) + (kk[2] * kk[2] + kk[3] * kk[3]);
                kkr[2 * np + q] = kk; av[2 * np + q] = a;
            }
            const size_t o = (size_t)m * 512 + c8;
            *(f32x4*)(SW + o) = dec[0]; *(f32x4*)(SW + o + 4) = dec[1];
            *(u32x4*)(SR + o) = pk8(r8.a, r8.b); *(u32x4*)(SK + o) = pk8(k2[0], k2[1]); *(u32x4*)(SV + o) = pk8(v8.a, v8.b);
        }
        ss = xsum_fq(ss);
        const float rs = rsqrtf(fmaxf(ss, 1e-24f));
#pragma unroll
        for (int np = 0; np < 2; ++np) {
            const size_t o = (size_t)m * 512 + h * 64 + 16 * fq + 8 * np;
            const f32x4 ka = kkr[2 * np] * rs, kb = kkr[2 * np + 1] * rs;
            *(u32x4*)(SKK + o) = pk8(ka, kb); *(u32x4*)(SB + o) = pk8(ka * av[2 * np], kb * av[2 * np + 1]);
        }
    }
}

__device__ __forceinline__ void sample_attn_phase(Frame& F) {
    constexpr int NK = WIN + DT, KS = 68;
    LAS float* Kl = (LAS float*)F.lds;
    LAS float* Vl = Kl + NK * KS;
    LAS float* Pl = Vl + NK * KS;
    const bf16_t* Q = (const bf16_t*)(F.ws + WS_Q);
    bf16_t* OC = (bf16_t*)(F.ws + WS_OCAT);
    for (int unit = F.bid; unit < DB * 2; unit += F.G) {
        const int b = unit >> 1, kvh = unit & 1;
        for (int e = F.tid; e < NK * 16; e += NT) {
            const int key = e >> 4, d4 = (e & 15) * 4;
            f32x4 kv, vv;
            if (key < WIN) { kv = *(const f32x4*)(F.in[2] + ((size_t)(b * WIN + key) * 2 + kvh) * 64 + d4); vv = *(const f32x4*)(F.in[3] + ((size_t)(b * WIN + key) * 2 + kvh) * 64 + d4); }
            else { kv = *(const f32x4*)(F.out + O_KWS + ((size_t)(b * WIN + key - DT) * 2 + kvh) * 64 + d4); vv = *(const f32x4*)(F.out + O_VWS + ((size_t)(b * WIN + key - DT) * 2 + kvh) * 64 + d4); }
            *(LAS f32x4*)(Kl + key * KS + d4) = kv; *(LAS f32x4*)(Vl + key * KS + d4) = vv;
            if (key >= DT && key < WIN) { *(f32x4*)(F.out + O_KWS + ((size_t)(b * WIN + key - DT) * 2 + kvh) * 64 + d4) = kv; *(f32x4*)(F.out + O_VWS + ((size_t)(b * WIN + key - DT) * 2 + kvh) * 64 + d4) = vv; }
        }
        __syncthreads();
        const int qi = F.tid >> 4, sub = F.tid & 15;
        const int t = qi >> 2, g = qi & 3, head = kvh * 4 + g;
        const int m = MP + b * DT + t;
        float mx = F.in[9][head] * 1.4426950408889634f;
        {
            const bf16_t* qp = Q + (size_t)m * 512 + head * 64;
            float q[64];
#pragma unroll
            for (int i = 0; i < 8; ++i) { const u32x4 w = *(const u32x4*)(qp + 8 * i); q[8 * i] = bflo(w.x); q[8 * i + 1] = bfhi(w.x); q[8 * i + 2] = bflo(w.y); q[8 * i + 3] = bfhi(w.y); q[8 * i + 4] = bflo(w.z); q[8 * i + 5] = bfhi(w.z); q[8 * i + 6] = bflo(w.w); q[8 * i + 7] = bfhi(w.w); }
#pragma unroll 1
            for (int key = sub; key < NK; key += 16) {
                float a = 0.f; const LAS f32x4* kr = (const LAS f32x4*)(Kl + key * KS);
#pragma unroll
                for (int i = 0; i < 16; ++i) { const f32x4 kx = kr[i]; a += q[4 * i] * kx[0] + q[4 * i + 1] * kx[1] + q[4 * i + 2] * kx[2] + q[4 * i + 3] * kx[3]; }
                const int dist = t + WIN - key;
                const float s = (dist >= 0 && dist <= WIN) ? a : -1e30f;
                Pl[qi * NK + key] = s; mx = fmaxf(mx, s);
            }
        }
        mx = fmaxf(mx, __shfl_xor(mx, 1)); mx = fmaxf(mx, __shfl_xor(mx, 2)); mx = fmaxf(mx, __shfl_xor(mx, 4)); mx = fmaxf(mx, __shfl_xor(mx, 8));
        float sum = 0.f;
#pragma unroll 1
        for (int key = sub; key < NK; key += 16) { const float sv = Pl[qi * NK + key]; const float p = sv > -1e29f ? __builtin_amdgcn_exp2f(sv - mx) : 0.f; sum += p; Pl[qi * NK + key] = p; }
        sum += __shfl_xor(sum, 1); sum += __shfl_xor(sum, 2); sum += __shfl_xor(sum, 4); sum += __shfl_xor(sum, 8);
        const float inv = __builtin_amdgcn_rcpf(sum + __builtin_amdgcn_exp2f(F.in[9][head] * 1.4426950408889634f - mx));
        __syncthreads();
        f32x4 o = {0.f, 0.f, 0.f, 0.f};
        for (int key = 0; key < NK; ++key) { const float p = Pl[qi * NK + key]; const f32x4 vv = *(const LAS f32x4*)(Vl + key * KS + sub * 4); o += vv * p; }
        o = o * inv;
        u32x2 w; w.x = pk2(o[0], o[1]); w.y = pk2(o[2], o[3]);
        *(u32x2*)(OC + (size_t)m * DM + head * 64 + sub * 4) = w;
        __syncthreads();
    }
}

__device__ __forceinline__ void prompt_attn_unit(Frame& F, int unit) {
    constexpr int KST = 144, VST = 528;
    LAS unsigned char* Kl = F.lds; LAS unsigned char* Vl = F.lds + 256 * KST;
    const bf16_t* Q = (const bf16_t*)(F.ws + WS_Q); const bf16_t* Kb = (const bf16_t*)(F.ws + WS_K); const bf16_t* VT = (const bf16_t*)(F.ws + WS_VT);
    bf16_t* OC = (bf16_t*)(F.ws + WS_OCAT);
    const int kvh = unit & 1, qb = (unit >> 1) & 63, b = unit >> 7;
    const int key0 = (qb - 1) * 128;
    for (int e = F.tid; e < 256 * 8; e += NT) {
        const int key = e >> 3, ch = e & 7; const int pos = key0 + key;
        u32x4 v = {0u, 0u, 0u, 0u};
        if (pos >= 0) v = *(const u32x4*)(Kb + (size_t)(b * T + pos) * 128 + kvh * 64 + ch * 8);
        *(LAS u32x4*)(Kl + key * KST + ch * 16) = v;
    }
    for (int e = F.tid; e < 64 * 32; e += NT) {
        const int d = e >> 5, ch = e & 31; const int pos = key0 + ch * 8;
        u32x4 v = {0u, 0u, 0u, 0u};
        if (pos >= 0) v = *(const u32x4*)(VT + ((size_t)(b * 2 + kvh) * 64 + d) * T + pos);
        *(LAS u32x4*)(Vl + d * VST + ch * 16) = v;
    }
    __syncthreads();
    const int fr = F.lane & 15, fq = F.lane >> 4;
    const int head = kvh * 4 + (F.wave >> 1);
    const float sink = F.in[9][head] * 1.4426950408889634f;
#pragma unroll 1
    for (int sb = 0; sb < 4; ++sb) {
        const int qi0 = (F.wave & 1) * 64 + sb * 16;
        const int qi = qi0 + fr;
        const size_t mrow = (size_t)b * T + qb * 128 + qi;
        const bf16x8 q0 = *(const bf16x8*)(Q + mrow * 512 + head * 64 + fq * 8);
        const bf16x8 q1 = *(const bf16x8*)(Q + mrow * 512 + head * 64 + 32 + fq * 8);
        const int ktlo = (F.wave & 1) * 4 + sb;
        f32x4 s[9];
#pragma unroll
        for (int kr = 0; kr < 9; ++kr) {
            const int kt = ktlo + kr;
            const bf16x8 k0 = *(const LAS bf16x8*)(Kl + (kt * 16 + fr) * KST + fq * 16);
            const bf16x8 k1 = *(const LAS bf16x8*)(Kl + (kt * 16 + fr) * KST + 64 + fq * 16);
            f32x4 a = {0.f, 0.f, 0.f, 0.f};
            a = __builtin_amdgcn_mfma_f32_16x16x32_bf16(k0, q0, a, 0, 0, 0);
            a = __builtin_amdgcn_mfma_f32_16x16x32_bf16(k1, q1, a, 0, 0, 0);
            s[kr] = a;
        }
        float mx = sink;
#pragma unroll
        for (int kr = 0; kr < 9; ++kr)
#pragma unroll
            for (int j = 0; j < 4; ++j) { const int sj = (ktlo + kr) * 16 + fq * 4 + j; const int dist = qi + 128 - sj; const bool ok = dist >= 0 && dist <= WIN && (key0 + sj) >= 0; const float v = ok ? s[kr][j] : -1e30f; s[kr][j] = v; mx = fmaxf(mx, v); }
        mx = fmaxf(mx, __shfl_xor(mx, 16)); mx = fmaxf(mx, __shfl_xor(mx, 32));
        float sum = 0.f;
        u32x2 pw[10];
#pragma unroll
        for (int kr = 0; kr < 9; ++kr) {
            f32x4 p;
#pragma unroll
            for (int j = 0; j < 4; ++j) { p[j] = s[kr][j] > -1e29f ? __builtin_amdgcn_exp2f(s[kr][j] - mx) : 0.f; sum += p[j]; }
            pw[kr].x = cvt_pk_bf16(p[0], p[1]); pw[kr].y = cvt_pk_bf16(p[2], p[3]);
        }
        pw[9].x = 0u; pw[9].y = 0u;
        sum += __shfl_xor(sum, 16); sum += __shfl_xor(sum, 32);
        const float inv = __builtin_amdgcn_rcpf(sum + __builtin_amdgcn_exp2f(sink - mx));
        f32x4 o[4];
#pragma unroll
        for (int dt = 0; dt < 4; ++dt) o[dt] = (f32x4){0.f, 0.f, 0.f, 0.f};
#pragma unroll
        for (int u = 0; u < 5; ++u) {
            u32x4 pb; pb.x = pw[2 * u].x; pb.y = pw[2 * u].y; pb.z = pw[2 * u + 1].x; pb.w = pw[2 * u + 1].y;
            const bf16x8 pf = __builtin_bit_cast(bf16x8, pb);
            const int kta = ktlo + 2 * u, ktb = u < 4 ? kta + 1 : kta;
#pragma unroll
            for (int dt = 0; dt < 4; ++dt) {
                const LAS unsigned char* vr = Vl + (dt * 16 + fr) * VST + (fq * 4) * 2;
                const u32x2 va = *(const LAS u32x2*)(vr + kta * 32), vb = *(const LAS u32x2*)(vr + ktb * 32);
                u32x4 vv; vv.x = va.x; vv.y = va.y; vv.z = vb.x; vv.w = vb.y;
                o[dt] = __builtin_amdgcn_mfma_f32_16x16x32_bf16(__builtin_bit_cast(bf16x8, vv), pf, o[dt], 0, 0, 0);
            }
        }
#pragma unroll
        for (int dt = 0; dt < 4; ++dt) { const f32x4 v = o[dt] * inv; u32x2 w; w.x = cvt_pk_bf16(v[0], v[1]); w.y = cvt_pk_bf16(v[2], v[3]); *(u32x2*)(OC + mrow * DM + head * 64 + dt * 16 + fq * 4) = w; }
    }
    __syncthreads();
}

struct StepOps { f32x4 w, nbe, kk, k, r; float v; };
template <int STRIDE_F> __device__ __forceinline__ StepOps load_ops(const LAS float* img, int s, int cgi, int vrow) {
    const LAS float* p = img + s * STRIDE_F + cgi * 4; StepOps o;
    o.w = *(const LAS f32x4*)(p); o.nbe = *(const LAS f32x4*)(p + 64); o.kk = *(const LAS f32x4*)(p + 128); o.k = *(const LAS f32x4*)(p + 192); o.r = *(const LAS f32x4*)(p + 256);
    o.v = img[s * STRIDE_F + 320 + vrow]; return o;
}
template <int J> __device__ __forceinline__ float sel_lane16(float oldv, float newv) {
    float r; const unsigned long long m = 0x0001000100010001ull << J;
    asm("v_cndmask_b32_e64 %0, %1, %2, %3" : "=v"(r) : "v"(oldv), "v"(newv), "s"(m));
    return r;
}
struct ScanState { f32x2 s01, s23; float ykeep, ypart; StepOps c0, c1; };
template <int STRIDE_F, int J>
__device__ __forceinline__ void scan_step(const LAS float* img, int s0, int vrow, int cgi, ScanState& Z) {
    const StepOps nx = load_ops<STRIDE_F>(img, s0 + J + 2, cgi, vrow);
    const StepOps& c = Z.c0;
    const f32x2 kk01 = {c.kk[0], c.kk[1]}, kk23 = {c.kk[2], c.kk[3]}, w01 = {c.w[0], c.w[1]}, w23 = {c.w[2], c.w[3]}, k01 = {c.k[0], c.k[1]}, k23 = {c.k[2], c.k[3]};
    const f32x2 b01 = {c.nbe[0], c.nbe[1]}, b23 = {c.nbe[2], c.nbe[3]}, r01 = {c.r[0], c.r[1]}, r23 = {c.r[2], c.r[3]};
    f32x2 t = Z.s01 * kk01; t = Z.s23 * kk23 + t;
    float sa = t.x + t.y;
    const f32x2 u01 = Z.s01 * w01 + k01 * c.v, u23 = Z.s23 * w23 + k23 * c.v;
    if (J > 0) { allsum16_2(sa, Z.ypart); Z.ykeep = sel_lane16<(J > 0 ? J - 1 : 0)>(Z.ykeep, Z.ypart); } else sa = allsum16(sa);
    Z.s01 = b01 * sa + u01; Z.s23 = b23 * sa + u23;
    f32x2 y2 = Z.s01 * r01; y2 = Z.s23 * r23 + y2;
    Z.ypart = y2.x + y2.y;
    Z.c0 = Z.c1; Z.c1 = nx;
}
template <int STRIDE_F, int GS, int... Js>
__device__ __forceinline__ void scan_group_impl(const LAS float* img, int s0, int vrow, int cgi, ScanState& Z, float* yout, std::integer_sequence<int, Js...>) {
    (scan_step<STRIDE_F, Js>(img, s0, vrow, cgi, Z), ...);
    Z.ypart = allsum16(Z.ypart); Z.ykeep = sel_lane16<GS - 1>(Z.ykeep, Z.ypart);
    if (cgi < GS) yout[(size_t)(s0 + cgi) * 512] = Z.ykeep;
}
template <int STRIDE_F, int J>
__device__ __forceinline__ void scan_step_yp(const LAS float* img, int s0, int vrow, int cgi, ScanState& Z, LAS float* ypb) {
    const StepOps nx = load_ops<STRIDE_F>(img, s0 + J + 2, cgi, vrow);
    const StepOps& c = Z.c0;
    const f32x2 kk01 = {c.kk[0], c.kk[1]}, kk23 = {c.kk[2], c.kk[3]}, w01 = {c.w[0], c.w[1]}, w23 = {c.w[2], c.w[3]}, k01 = {c.k[0], c.k[1]}, k23 = {c.k[2], c.k[3]};
    const f32x2 b01 = {c.nbe[0], c.nbe[1]}, b23 = {c.nbe[2], c.nbe[3]}, r01 = {c.r[0], c.r[1]}, r23 = {c.r[2], c.r[3]};
    f32x2 t = Z.s01 * kk01; t = Z.s23 * kk23 + t;
    float sa = t.x + t.y;
    const f32x2 u01 = Z.s01 * w01 + k01 * c.v, u23 = Z.s23 * w23 + k23 * c.v;
    sa = allsum16(sa);
    Z.s01 = b01 * sa + u01; Z.s23 = b23 * sa + u23;
    f32x2 y2 = Z.s01 * r01; y2 = Z.s23 * r23 + y2;
    ypb[(s0 + J) * 64] = y2.x + y2.y;
    Z.c0 = Z.c1; Z.c1 = nx;
}
struct StepOpsS { f32x4 nbe, kk, k, r; };
template <int STRIDE_F> __device__ __forceinline__ StepOpsS load_ops_s(const LAS float* img, int s, int cgi) {
    const LAS float* p = img + s * STRIDE_F + cgi * 4; StepOpsS o;
    o.nbe = *(const LAS f32x4*)(p + 64); o.kk = *(const LAS f32x4*)(p + 128); o.k = *(const LAS f32x4*)(p + 192); o.r = *(const LAS f32x4*)(p + 256);
    return o;
}
struct ScanT { f32x2 t01, t23; StepOpsS c0, c1; f32x4 v4[4]; };
template <int STRIDE_F, int J>
__device__ __forceinline__ void scan_step_s(const LAS float* img, int cgi, ScanT& Z, LAS float* ypb) {
    const StepOpsS nx = load_ops_s<STRIDE_F>(img, J + 2, cgi);
    const StepOpsS& c = Z.c0;
    const float v = Z.v4[J >> 2][J & 3];
    f32x2 t = Z.t01 * (f32x2){c.kk[0], c.kk[1]}; t = Z.t23 * (f32x2){c.kk[2], c.kk[3]} + t;
    float sa = t.x + t.y;
    const f32x2 a01 = (f32x2){c.k[0], c.k[1]} * v + Z.t01, a23 = (f32x2){c.k[2], c.k[3]} * v + Z.t23;
    sa = allsum16(sa);
    Z.t01 = (f32x2){c.nbe[0], c.nbe[1]} * sa + a01; Z.t23 = (f32x2){c.nbe[2], c.nbe[3]} * sa + a23;
    f32x2 y2 = Z.t01 * (f32x2){c.r[0], c.r[1]}; y2 = Z.t23 * (f32x2){c.r[2], c.r[3]} + y2;
    ypb[J * 64] = y2.x + y2.y;
    Z.c0 = Z.c1; Z.c1 = nx;
}
template <int STRIDE_F, int... Js>
__device__ __forceinline__ void scan_chunk_s_impl(const LAS float* img, int cgi, ScanT& Z, LAS float* ypb, std::integer_sequence<int, Js...>) {
    (scan_step_s<STRIDE_F, Js>(img, cgi, Z, ypb), ...);
}
template <int STRIDE_F, int NS>
__device__ __forceinline__ void scan_transform(LAS float* img, int lane) {
    LAS float* p = img + lane; float Wc = 1.f;
#pragma unroll
    for (int t = 0; t < NS; ++t, p += STRIDE_F) {
        const float w = p[0], nb = p[64], kk = p[128], k = p[192], r = p[256];
        p[128] = Wc * kk;
        Wc *= w; const float inv = __builtin_amdgcn_rcpf(Wc);
        p[64] = nb * inv; p[192] = k * inv; p[256] = Wc * r;
    }
    img[(NS - 1) * STRIDE_F + lane] = Wc;
}
template <int STRIDE_F, int... Js>
__device__ __forceinline__ void scan_group_yp_impl(const LAS float* img, int s0, int vrow, int cgi, ScanState& Z, LAS float* ypb, std::integer_sequence<int, Js...>) {
    (scan_step_yp<STRIDE_F, Js>(img, s0, vrow, cgi, Z, ypb), ...);
}
template <int... Js>
__device__ __forceinline__ void yp_reduce_impl(const LAS float* ypb, int cgi, float* yout, int s0, std::integer_sequence<int, Js...>) {
    float ykeep = 0.f;
    ((ykeep = sel_lane16<Js>(ykeep, allsum16(ypb[(s0 + Js) * 64]))), ...);
    yout[(size_t)(s0 + cgi) * 512] = ykeep;
}
template <int STRIDE_F, int GS>
__device__ __forceinline__ void scan_group(const LAS float* img, int s0, int vrow, int cgi, ScanState& Z, float* yout) {
    scan_group_impl<STRIDE_F, GS>(img, s0, vrow, cgi, Z, yout, std::make_integer_sequence<int, GS>());
}
constexpr int SC = 32;
constexpr int PSTR = 328;
constexpr int SSTR = 384;
struct ScanRegs { f32x4 w[2]; u32x4 b0[2], b1[2]; u32x4 v; };
__device__ __forceinline__ void scan_load(const Frame& F, ScanRegs& R, int m0, int h, int v0) {
    if (F.wave < 4) return;
    const int vt = F.tid - 256;
#pragma unroll
    for (int i = 0; i < 2; ++i) {
        const int tid = vt + 256 * i;
        { const int row = tid >> 4, c4 = (tid & 15) * 4; R.w[i] = *(const f32x4*)((const float*)(F.ws + WS_SW) + (size_t)(m0 + row) * 512 + h * 64 + c4); }
        { const int st = tid >> 7, row = (tid & 127) >> 2, seg = tid & 3;
          const size_t base = st == 0 ? WS_SB : st == 1 ? WS_SKK : st == 2 ? WS_SK : WS_SR;
          const bf16_t* p = (const bf16_t*)(F.ws + base) + (size_t)(m0 + row) * 512 + h * 64 + seg * 16;
          R.b0[i] = *(const u32x4*)p; R.b1[i] = *(const u32x4*)(p + 8); }
    }
    { R.v = *(const u32x4*)((const bf16_t*)(F.ws + WS_SV) + (size_t)(m0 + (vt & 31)) * 512 + h * 64 + v0); }
}
__device__ __forceinline__ void scan_store(const Frame& F, const ScanRegs& R, LAS float* img) {
    if (F.wave < 4) return;
    const int vt = F.tid - 256;
#pragma unroll
    for (int i = 0; i < 2; ++i) {
        const int tid = vt + 256 * i;
        { const int row = tid >> 4, c4 = (tid & 15) * 4; *(LAS f32x4*)(img + row * PSTR + c4) = R.w[i]; }
        { const int st = tid >> 7, row = (tid & 127) >> 2, seg = tid & 3;
          LAS float* d = img + row * PSTR + 64 + st * 64 + seg * 16;
          const float sg = st == 0 ? -1.f : 1.f; const u32x4 b0 = R.b0[i], b1 = R.b1[i];
          *(LAS f32x4*)(d) = (f32x4){bflo(b0.x), bfhi(b0.x), bflo(b0.y), bfhi(b0.y)} * sg; *(LAS f32x4*)(d + 4) = (f32x4){bflo(b0.z), bfhi(b0.z), bflo(b0.w), bfhi(b0.w)} * sg;
          *(LAS f32x4*)(d + 8) = (f32x4){bflo(b1.x), bfhi(b1.x), bflo(b1.y), bfhi(b1.y)} * sg; *(LAS f32x4*)(d + 12) = (f32x4){bflo(b1.z), bfhi(b1.z), bflo(b1.w), bfhi(b1.w)} * sg; }
    }
    if (vt < 32) { LAS float* d = img + SC * PSTR + vt;
      d[0 * SC] = bflo(R.v.x); d[1 * SC] = bfhi(R.v.x); d[2 * SC] = bflo(R.v.y); d[3 * SC] = bfhi(R.v.y); d[4 * SC] = bflo(R.v.z); d[5 * SC] = bfhi(R.v.z); d[6 * SC] = bflo(R.v.w); d[7 * SC] = bfhi(R.v.w); }
}
constexpr int NSW = 2;
__device__ __forceinline__ void prompt_scan(Frame& F, int sblk) {
    const int xcd = sblk & 7, k = sblk >> 3;
    const int chain = xcd * 4 + (k >> 3), rg = k & 7;
    const int b = chain >> 3, h = chain & 7, v0 = rg * 8;
    LAS float* img = (LAS float*)F.lds;
    constexpr int IMG = SC * PSTR + 8 * SC;
    const int rl = F.lane >> 4, cgi = F.lane & 15;
    const int vrow = F.wave * 4 + rl;
    float* Y = F.out;
    ScanState Z; Z.s01 = (f32x2){0.f, 0.f}; Z.s23 = (f32x2){0.f, 0.f}; Z.ykeep = 0.f; Z.ypart = 0.f;
    ScanRegs R0, R1, R2, R3;
    const int mbase = b * T;
    constexpr int NCH = T / SC;
#ifndef SCAN_DUP
#define SCAN_DUP 1
#endif
    constexpr int NTOT = NCH * SCAN_DUP;
    scan_load(F, R0, mbase, h, v0); scan_store(F, R0, img);
    scan_load(F, R1, mbase + SC, h, v0); scan_store(F, R1, img + IMG);
    scan_load(F, R2, mbase + 2 * SC, h, v0); scan_load(F, R3, mbase + 3 * SC, h, v0);
    __syncthreads();
    if (F.wave == 4 || F.wave == 5) scan_transform<PSTR, 16>(img + (F.wave - 4) * 16 * PSTR, F.lane);
    __syncthreads();
    LAS float* ypr = (LAS float*)(F.lds + YP_OFF);
#define SCAN_CHUNK(cc_) do { const int c_ = (cc_) % NCH; \
        if (SCAN_DUP > 1 && c_ == 0) { Z.s01 = (f32x2){0.f, 0.f}; Z.s23 = (f32x2){0.f, 0.f}; } \
        if (F.wave < NSW) { const LAS float* im = img + ((cc_) % 3) * IMG; LAS float* ypb = ypr + (((cc_) & 1) * NSW + F.wave) * (SC * 64) + F.lane; \
            const LAS float* vtp = im + SC * PSTR + vrow * SC; \
            ScanT Tz; Tz.t01 = Z.s01; Tz.t23 = Z.s23; Tz.c0 = load_ops_s<PSTR>(im, 0, cgi); Tz.c1 = load_ops_s<PSTR>(im, 1, cgi); \
            _Pragma("unroll") for (int q_ = 0; q_ < 4; ++q_) Tz.v4[q_] = *(const LAS f32x4*)(vtp + 4 * q_); \
            scan_chunk_s_impl<PSTR>(im, cgi, Tz, ypb, std::make_integer_sequence<int, 16>()); \
            { const f32x4 wce = *(const LAS f32x4*)(im + 15 * PSTR + cgi * 4); Tz.t01 = Tz.t01 * (f32x2){wce[0], wce[1]}; Tz.t23 = Tz.t23 * (f32x2){wce[2], wce[3]}; } \
            _Pragma("unroll") for (int q_ = 0; q_ < 4; ++q_) Tz.v4[q_] = *(const LAS f32x4*)(vtp + 16 + 4 * q_); \
            scan_chunk_s_impl<PSTR>(im + 16 * PSTR, cgi, Tz, ypb + 16 * 64, std::make_integer_sequence<int, 16>()); \
            { const f32x4 wce = *(const LAS f32x4*)(im + 31 * PSTR + cgi * 4); Z.s01 = Tz.t01 * (f32x2){wce[0], wce[1]}; Z.s23 = Tz.t23 * (f32x2){wce[2], wce[3]}; } } \
        else if (F.wave < 2 * NSW && (cc_) > 0) { const int sw_ = F.wave - NSW, cp_ = ((cc_) - 1) % NCH; \
            const LAS float* ypb = ypr + ((((cc_) - 1) & 1) * NSW + sw_) * (SC * 64) + F.lane; float* yo = Y + (size_t)(mbase + cp_ * SC) * 512 + h * 64 + v0 + sw_ * 4 + rl; \
            yp_reduce_impl(ypb, cgi, yo, 0, std::make_integer_sequence<int, 16>()); yp_reduce_impl(ypb, cgi, yo, 16, std::make_integer_sequence<int, 16>()); } \
        else if ((F.wave == 4 || F.wave == 5) && (cc_) + 1 < NTOT) scan_transform<PSTR, 16>(img + (((cc_) + 1) % 3) * IMG + (F.wave - 4) * 16 * PSTR, F.lane); } while (0)
#define SCAN_ITER(j_, RL_, RS_) do { const int c4_ = cc + (j_); \
        scan_load(F, RL_, mbase + ((c4_ + 4 < NTOT ? c4_ + 4 : NTOT - 1) % NCH) * SC, h, v0);        \
        SCAN_CHUNK(c4_); \
        if (c4_ + 2 < NTOT) scan_store(F, RS_, img + ((c4_ + 2) % 3) * IMG);                         \
        asm volatile("s_waitcnt lgkmcnt(0)\n\ts_barrier" ::: "memory"); } while (0)
#pragma unroll 1
    for (int cc = 0; cc < NTOT; cc += 4) {
        SCAN_ITER(0, R0, R2); SCAN_ITER(1, R1, R3); SCAN_ITER(2, R2, R0); SCAN_ITER(3, R3, R1);
    }
#undef SCAN_ITER
#undef SCAN_CHUNK
    if (F.wave >= NSW && F.wave < 2 * NSW) { const int sw_ = F.wave - NSW, cp_ = (NTOT - 1) % NCH;
        const LAS float* ypb = ypr + (((NTOT - 1) & 1) * NSW + sw_) * (SC * 64) + F.lane; float* yo = Y + (size_t)(mbase + cp_ * SC) * 512 + h * 64 + v0 + sw_ * 4 + rl;
        yp_reduce_impl(ypb, cgi, yo, 0, std::make_integer_sequence<int, 16>()); yp_reduce_impl(ypb, cgi, yo, 16, std::make_integer_sequence<int, 16>()); }
    __syncthreads();
    if (F.wave < NSW) *(f32x4*)(F.out + O_WKVP + ((size_t)(b * 8 + h) * 64 + v0 + vrow) * 64 + cgi * 4) = (f32x4){Z.s01.x, Z.s01.y, Z.s23.x, Z.s23.y};
}
__device__ __forceinline__ void sample_scan(Frame& F, int sblk, int nsblk) {
    LAS float* img = (LAS float*)F.lds;
    float* Y = F.out;
    const int rl = F.lane >> 4, cgi = F.lane & 15;
    for (int chain = sblk; chain < DB * 8; chain += nsblk) {
        const int b = chain >> 3, h = chain & 7; const int m0 = MP + b * DT;
        for (int e = F.tid; e < 6 * DT * 64; e += NT) {
            const int st = e >> 9, row = (e >> 6) & 7, ch = e & 63; const size_t o = (size_t)(m0 + row) * 512 + h * 64 + ch;
            float val;
            if (st == 0) val = ((const float*)(F.ws + WS_SW))[o];
            else { const size_t base = st == 1 ? WS_SB : st == 2 ? WS_SKK : st == 3 ? WS_SK : st == 4 ? WS_SR : WS_SV; val = bf2f(((const bf16_t*)(F.ws + base))[o]); if (st == 1) val = -val; }
            img[row * SSTR + st * 64 + ch] = val;
        }
        __syncthreads();
#pragma unroll 1
        for (int rnd = 0; rnd < 2; ++rnd) {
            const int vrow = (rnd * 8 + F.wave) * 4 + rl;
            const float* s0 = F.in[5] + ((size_t)chain * 64 + vrow) * 64 + cgi * 4;
            const f32x4 S = *(const f32x4*)s0;
            ScanState Z; Z.s01 = (f32x2){S[0], S[1]}; Z.s23 = (f32x2){S[2], S[3]}; Z.ykeep = 0.f; Z.ypart = 0.f;
            Z.c0 = load_ops<SSTR>(img, 0, cgi, vrow); Z.c1 = load_ops<SSTR>(img, 1, cgi, vrow);
            scan_group<SSTR, DT>(img, 0, vrow, cgi, Z, Y + (size_t)m0 * 512 + h * 64 + vrow);
            *(f32x4*)(F.out + O_WKVS + ((size_t)chain * 64 + vrow) * 64 + cgi * 4) = (f32x4){Z.s01.x, Z.s01.y, Z.s23.x, Z.s23.y};
        }
        __syncthreads();
    }
}

__device__ __forceinline__ void post_phase(Frame& F) {
    const bf16_t* HRW = (const bf16_t*)(F.ws + WS_HRW);
    const bf16_t* SR = (const bf16_t*)(F.ws + WS_SR); const bf16_t* SK = (const bf16_t*)(F.ws + WS_SK); const bf16_t* SV = (const bf16_t*)(F.ws + WS_SV);
    const float* Y = F.out; bf16_t* OC = (bf16_t*)(F.ws + WS_OCAT);
    const int fr = F.lane & 15, fq = F.lane >> 4, h = F.wave;
    bf16x8 Ag[4][3];
#pragma unroll
    for (int nt = 0; nt < 4; ++nt)
#pragma unroll
        for (int s3 = 0; s3 < 3; ++s3) Ag[nt][s3] = wfrag(F.in[15], 32 * s3, fq, h * 64 + 16 * (fr >> 2) + 4 * nt + (fr & 3));
    constexpr int NTILE = M / 16;
    f32x4 prk[4], pgw[4], pgb[4], pmg[3][2];
#pragma unroll
    for (int i = 0; i < 4; ++i) { const int c4 = h * 64 + 16 * fq + 4 * i; prk[i] = *(const f32x4*)(F.in[18] + c4); pgw[i] = *(const f32x4*)(F.in[19] + c4); pgb[i] = *(const f32x4*)(F.in[20] + c4); }
#pragma unroll
    for (int s3 = 0; s3 < 3; ++s3) { pmg[s3][0] = *(const f32x4*)(F.in[10] + 1600 + 32 * s3 + 8 * fq); pmg[s3][1] = *(const f32x4*)(F.in[10] + 1604 + 32 * s3 + 8 * fq); }
    for (int tile_ = F.bid; tile_ < NTILE * POST_DUP; tile_ += F.G) {
        const int m = (tile_ % NTILE) * 16 + fr;
        const RowInfo ri = row_info(m);
        bf16x8 xg[3];
#pragma unroll
        for (int s3 = 0; s3 < 3; ++s3) {
            const F8 a = hs8m(F, HRW, m, ri, 1600 + 32 * s3 + 8 * fq, pmg[s3][0], pmg[s3][1]);
            f32x4 t0, t1;
#pragma unroll
            for (int i = 0; i < 4; ++i) { t0[i] = sigmoidf_(a.a[i]); t1[i] = sigmoidf_(a.b[i]); }
            xg[s3] = __builtin_bit_cast(bf16x8, pk8(t0, t1));
        }
        f32x4 y4[4], v4[4], g4[4]; float sy = 0.f, dot = 0.f;
#pragma unroll
        for (int np = 0; np < 2; ++np) {
            const int c8 = h * 64 + 16 * fq + 8 * np; const size_t o = (size_t)m * 512 + c8;
#pragma unroll
            for (int q = 0; q < 2; ++q) { f32x4 g = {0.f, 0.f, 0.f, 0.f};
#pragma unroll
                for (int s3 = 0; s3 < 3; ++s3) g = __builtin_amdgcn_mfma_f32_16x16x32_bf16(Ag[2 * np + q][s3], xg[s3], g, 0, 0, 0);
                g4[2 * np + q] = g; }
            const f32x4 ya = *(const f32x4*)(Y + o), yb = *(const f32x4*)(Y + o + 4);
            const F8 r8 = ld_bf8(SR + o), k8 = ld_bf8(SK + o), v8 = ld_bf8(SV + o);
            const f32x4 rka = prk[2 * np], rkb = prk[2 * np + 1];
            y4[2 * np] = ya; y4[2 * np + 1] = yb; v4[2 * np] = v8.a; v4[2 * np + 1] = v8.b;
            sy += ((ya[0] + ya[1]) + (ya[2] + ya[3])) + ((yb[0] + yb[1]) + (yb[2] + yb[3]));
            const f32x4 pa = r8.a * k8.a * rka, pb = r8.b * k8.b * rkb; dot += ((pa[0] + pa[1]) + (pa[2] + pa[3])) + ((pb[0] + pb[1]) + (pb[2] + pb[3]));
        }
        const float mean = xsum_fq(sy) * (1.f / 64.f); dot = xsum_fq(dot);
        float sq = 0.f;
#pragma unroll
        for (int nt = 0; nt < 4; ++nt) { y4[nt] = y4[nt] - mean; const f32x4 d = y4[nt]; sq += (d[0] * d[0] + d[1] * d[1]) + (d[2] * d[2] + d[3] * d[3]); }
        const float rstd = rsqrtf(xsum_fq(sq) * (1.f / 64.f) + GN_EPS);
#pragma unroll
        for (int np = 0; np < 2; ++np) {
            const int c8 = h * 64 + 16 * fq + 8 * np;
            f32x4 oo[2];
#pragma unroll
            for (int q = 0; q < 2; ++q) { const f32x4 gw = pgw[2 * np + q], gb = pgb[2 * np + q];
                oo[q] = (y4[2 * np + q] * rstd * gw + gb + v4[2 * np + q] * dot) * g4[2 * np + q]; }
            *(u32x4*)(OC + (size_t)m * DM + 512 + c8) = pk8(oo[0], oo[1]);
        }
    }
}

__device__ __forceinline__ f32x4 bf4_to_f(const u32x2 w) { return (f32x4){bflo(w.x), bfhi(w.x), bflo(w.y), bfhi(w.y)}; }
__device__ __forceinline__ float sumsq4(const f32x4 (&v)[4]) { float s = 0.f;
#pragma unroll
    for (int j = 0; j < 4; ++j) s += (v[j].x * v[j].x + v[j].y * v[j].y) + (v[j].z * v[j].z + v[j].w * v[j].w);
    return s; }
__device__ __forceinline__ void rows_mid(Frame& F) {
    const int gw = F.bid * NWAVES + F.wave, NGW = F.G * NWAVES;
    const f32x4* g1 = (const f32x4*)F.in[22]; const f32x4* g2 = (const f32x4*)F.in[23];
    bf16_t* XN = (bf16_t*)(F.ws + WS_XN); const bf16_t* MIXb = (const bf16_t*)(F.ws + WS_MIX);
    for (int m = gw; m < M; m += 2 * NGW) {
        const int m1 = m + NGW; const bool has1 = m1 < M; const int mm1 = has1 ? m1 : m;
        const f32x4* xr0 = (const f32x4*)xrow_ptr(F, m) + F.lane; const f32x4* xr1 = (const f32x4*)xrow_ptr(F, mm1) + F.lane;
        const u32x2* mb0 = (const u32x2*)(MIXb + (size_t)m * DM) + F.lane; const u32x2* mb1 = (const u32x2*)(MIXb + (size_t)mm1 * DM) + F.lane;
        f32x4 v0[4], v1[4], x0[4], x1[4];
#pragma unroll
        for (int j = 0; j < 4; ++j) { v0[j] = bf4_to_f(__builtin_nontemporal_load(mb0 + 64 * j)); x0[j] = __builtin_nontemporal_load(xr0 + 64 * j); }
#pragma unroll
        for (int j = 0; j < 4; ++j) { v1[j] = bf4_to_f(__builtin_nontemporal_load(mb1 + 64 * j)); x1[j] = __builtin_nontemporal_load(xr1 + 64 * j); }
        const float ra = 1.0f / sqrtf(wave_sum(sumsq4(v0)) * (1.f / DM) + RMS_EPS), rb = 1.0f / sqrtf(wave_sum(sumsq4(v1)) * (1.f / DM) + RMS_EPS);
#pragma unroll
        for (int j = 0; j < 4; ++j) { const f32x4 gg = g1[64 * j + F.lane]; v0[j] = x0[j] + v0[j] * ra * gg; v1[j] = x1[j] + v1[j] * rb * gg; }
        const float qa = 1.0f / sqrtf(wave_sum(sumsq4(v0)) * (1.f / DM) + RMS_EPS), qb = 1.0f / sqrtf(wave_sum(sumsq4(v1)) * (1.f / DM) + RMS_EPS);
        u32x2* o0 = (u32x2*)(XN + (size_t)m * DM) + F.lane; u32x2* o1 = (u32x2*)(XN + (size_t)mm1 * DM) + F.lane;
#pragma unroll
        for (int j = 0; j < 4; ++j) { const f32x4 gg = g2[64 * j + F.lane];
            u32x2 w; w.x = pk2(v0[j].x * qa * gg.x, v0[j].y * qa * gg.y); w.y = pk2(v0[j].z * qa * gg.z, v0[j].w * qa * gg.w); o0[64 * j] = w;
            if (has1) { u32x2 q; q.x = pk2(v1[j].x * qb * gg.x, v1[j].y * qb * gg.y); q.y = pk2(v1[j].z * qb * gg.z, v1[j].w * qb * gg.w); o1[64 * j] = q; } }
    }
}
__device__ __forceinline__ void rows_final(Frame& F) {
    const int gw = F.bid * NWAVES + F.wave, NGW = F.G * NWAVES;
    const f32x4* g0 = (const f32x4*)F.in[22]; const f32x4* g1 = (const f32x4*)F.in[28];
    const bf16_t* Fb = (const bf16_t*)(F.ws + WS_F); const bf16_t* MIXb = (const bf16_t*)(F.ws + WS_MIX);
    for (int m = gw; m < M; m += 2 * NGW) {
        const int m1 = m + NGW; const bool has1 = m1 < M; const int mm1 = has1 ? m1 : m;
        f32x4 f0[4], f1[4], a0[4], a1[4], x0[4], x1[4];
        { const u32x2* fr = (const u32x2*)(Fb + (size_t)m * DM) + F.lane; const u32x2* mb = (const u32x2*)(MIXb + (size_t)m * DM) + F.lane; const f32x4* xr = (const f32x4*)xrow_ptr(F, m) + F.lane;
#pragma unroll
          for (int j = 0; j < 4; ++j) { f0[j] = bf4_to_f(__builtin_nontemporal_load(fr + 64 * j)); a0[j] = bf4_to_f(__builtin_nontemporal_load(mb + 64 * j)); x0[j] = __builtin_nontemporal_load(xr + 64 * j); } }
        { const u32x2* fr = (const u32x2*)(Fb + (size_t)mm1 * DM) + F.lane; const u32x2* mb = (const u32x2*)(MIXb + (size_t)mm1 * DM) + F.lane; const f32x4* xr = (const f32x4*)xrow_ptr(F, mm1) + F.lane;
#pragma unroll
          for (int j = 0; j < 4; ++j) { f1[j] = bf4_to_f(__builtin_nontemporal_load(fr + 64 * j)); a1[j] = bf4_to_f(__builtin_nontemporal_load(mb + 64 * j)); x1[j] = __builtin_nontemporal_load(xr + 64 * j); } }
        const float rf0 = 1.0f / sqrtf(wave_sum(sumsq4(f0)) * (1.f / DM) + RMS_EPS), rm0 = 1.0f / sqrtf(wave_sum(sumsq4(a0)) * (1.f / DM) + RMS_EPS);
        const float rf1 = 1.0f / sqrtf(wave_sum(sumsq4(f1)) * (1.f / DM) + RMS_EPS), rm1 = 1.0f / sqrtf(wave_sum(sumsq4(a1)) * (1.f / DM) + RMS_EPS);
        f32x4* y0 = (f32x4*)(F.out + (size_t)m * DM) + F.lane; f32x4* y1 = (f32x4*)(F.out + (size_t)mm1 * DM) + F.lane;
#pragma unroll
        for (int j = 0; j < 4; ++j) { const f32x4 ga = g0[64 * j + F.lane], gb = g1[64 * j + F.lane];
            __builtin_nontemporal_store((x0[j] + a0[j] * rm0 * ga) + f0[j] * rf0 * gb, y0 + 64 * j);
            if (has1) __builtin_nontemporal_store((x1[j] + a1[j] * rm1 * ga) + f1[j] * rf1 * gb, y1 + 64 * j); }
    }
}
__device__ __forceinline__ void conv_phase(Frame& F, int half) {
    const bf16_t* ZU = (const bf16_t*)(F.ws + WS_ZU); bf16_t* HID = (bf16_t*)(F.ws + WS_HID);
    const float* cw = F.in[25]; const float* cb = F.in[26]; const float* sc = F.in[6];
    const long total = (long)M * 176;
    for (long e = (long)F.bid * NT + F.tid; e < total; e += (long)F.G * NT) {
        const int m = (int)(e / 176), r = (int)(e - (long)m * 176); const int tile = r >> 4, c8 = (r & 15) * 8;
        const int ch = (half * 11 + tile) * 128 + c8;
        const RowInfo ri = row_info(m);
        const bf16_t* zp = ZU + (size_t)m * DFF + tile * 256 + c8;
        const u32x4 z0 = *(const u32x4*)zp, uu = *(const u32x4*)(zp + 128);
        float z[8], z1[8], z2[8], u8[8];
        z[0] = bflo(z0.x); z[1] = bfhi(z0.x); z[2] = bflo(z0.y); z[3] = bfhi(z0.y); z[4] = bflo(z0.z); z[5] = bfhi(z0.z); z[6] = bflo(z0.w); z[7] = bfhi(z0.w);
        u8[0] = bflo(uu.x); u8[1] = bfhi(uu.x); u8[2] = bflo(uu.y); u8[3] = bfhi(uu.y); u8[4] = bflo(uu.z); u8[5] = bfhi(uu.z); u8[6] = bflo(uu.w); u8[7] = bfhi(uu.w);
        if (ri.t >= 1) { const u32x4 w = *(const u32x4*)(zp - DFF); z1[0] = bflo(w.x); z1[1] = bfhi(w.x); z1[2] = bflo(w.y); z1[3] = bfhi(w.y); z1[4] = bflo(w.z); z1[5] = bfhi(w.z); z1[6] = bflo(w.w); z1[7] = bfhi(w.w); }
        else {
#pragma unroll
            for (int j = 0; j < 8; ++j) z1[j] = ri.samp ? sc[((size_t)ri.b * 2 + 1) * DFF + ch + j] : 0.f; }
        if (ri.t >= 2) { const u32x4 w = *(const u32x4*)(zp - 2 * DFF); z2[0] = bflo(w.x); z2[1] = bfhi(w.x); z2[2] = bflo(w.y); z2[3] = bfhi(w.y); z2[4] = bflo(w.z); z2[5] = bfhi(w.z); z2[6] = bflo(w.w); z2[7] = bfhi(w.w); }
        else {
#pragma unroll
            for (int j = 0; j < 8; ++j) z2[j] = ri.samp ? sc[((size_t)ri.b * 2 + ri.t) * DFF + ch + j] : 0.f; }
        float hd[8];
#pragma unroll
        for (int j = 0; j < 8; ++j) { const float zc = cb[ch + j] + cw[ch + j] * z2[j] + cw[DFF + ch + j] * z1[j] + cw[2 * DFF + ch + j] * z[j]; hd[j] = zc * sigmoidf_(zc) * u8[j]; }
        u32x4 w; w.x = pk2(hd[0], hd[1]); w.y = pk2(hd[2], hd[3]); w.z = pk2(hd[4], hd[5]); w.w = pk2(hd[6], hd[7]);
        *(u32x4*)(HID + (size_t)m * DFF + ch) = w;
    }
}

constexpr int NPHASE = 10;
__global__ void __launch_bounds__(NT, 2) fwd_megakernel(Args args) {
    extern __shared__ __attribute__((aligned(16))) unsigned char lds_raw[];
    Frame F;
    F.lds = (LAS unsigned char*)lds_raw; F.ws = args.ws; F.out = args.out; F.in = args.in;
    F.tid = threadIdx.x; F.lane = F.tid & 63; F.wave = __builtin_amdgcn_readfirstlane(F.tid >> 6); F.G = gridDim.x; F.bid = blockIdx.x;
    const int lo = args.ph_lo, hi = args.ph_hi;
#ifndef PH_MASK
#define PH_MASK 0x3ff
#endif
#ifndef DUP_MASK
#define DUP_MASK 0
#endif
#define IN(k) (((PH_MASK >> (k)) & 1) && lo <= (k) && (k) < hi)
#define REP(k) for (int rep_ = 0; rep_ < 1 + ((DUP_MASK >> (k)) & 1); ++rep_)
    unsigned* barw = (unsigned*)F.ws;
    volatile LAS unsigned* bst = (volatile LAS unsigned*)(F.lds + LDS_BYTES - 64);
    if (F.tid < 2) bst[F.tid] = 0u;
    XcdBarrier xbar; xbar.bar = barw; xbar.x = 0; xbar.st = bst;
    bool posted = false;
    if (lo + 1 < hi && F.bid == 0) { for (int i = F.tid; i < XCD_BAR_WORDS; i += NT) barw[i] = 0u; }
#define SEAM(k) do { if (IN(k) && IN((k) + 1)) { if (!posted) { cg::this_grid().sync(); xbar = xcd_barrier_post(barw, bst); posted = true; } else xcd_barrier(xbar); } } while (0)
    bf16_t* XN = (bf16_t*)(F.ws + WS_XN);
    if (IN(0)) REP(0) { p0_prologue(F); } SEAM(0);
    if (IN(1)) REP(1) {
        pg8::Gemm g{XN, (const bf16_t*)(F.ws + WS_WIN), M, DINP, DM, DM, DM, 0}; pg8::StaticOrder S; S.init(M, DINP, F.G, F.bid);
        Epi1 E{(const float*)(F.ws + WS_ROPE), (bf16_t*)(F.ws + WS_Q), (bf16_t*)(F.ws + WS_K), (bf16_t*)(F.ws + WS_VT), (bf16_t*)(F.ws + WS_HRW), F.out};
        pg8::gemm_phase<Epi1, true>(F.lds, g, S, E);
    } SEAM(1);
    if (IN(2)) REP(2) { prep_phase(F); sample_attn_phase(F); } SEAM(2);
    if (IN(3)) {
        for (int u = F.bid; u < NB * 64 * 2; u += F.G) prompt_attn_unit(F, u);
        sample_scan(F, F.bid, F.G);
        for (int sb = F.bid; sb < 256; sb += F.G) prompt_scan(F, sb);
    } SEAM(3);
    if (IN(4)) REP(4) { post_phase(F); } SEAM(4);
    if (IN(5)) REP(5) {
        pg8::Gemm g{(const bf16_t*)(F.ws + WS_OCAT), (const bf16_t*)(F.ws + WS_WOUT), M, DM, DM, DM, DM, 0}; pg8::StaticOrder S; S.init(M, DM, F.G, F.bid);
        EpiBf16 E{(bf16_t*)(F.ws + WS_MIX), DM};
        pg8::gemm_phase<EpiBf16, true>(F.lds, g, S, E);
    } SEAM(5);
    if (IN(6)) { rows_mid(F); } SEAM(6);
    if (IN(7)) REP(7) {
        pg8::Gemm g{XN, (const bf16_t*)(F.ws + WS_WFI), 136 * 256, 2 * DFF, DM, DM, DM, 1}; pg8::StaticOrder S; S.init(136 * 256, 2 * DFF, F.G, F.bid);
        EpiConv E{(bf16_t*)(F.ws + WS_HID), F.out, F.in[25], F.in[26], F.in[6], (LAS float*)(F.lds + 131072)};
        pg8::gemm_phase<EpiConv, true>(F.lds, g, S, E);
    } SEAM(7);
    if (IN(8)) REP(11) {
        pg8::Gemm g{(const bf16_t*)(F.ws + WS_HID), (const bf16_t*)(F.ws + WS_WFO), M, DM, DFF, DFF, DFF, 0}; pg8::StaticOrder S; S.init(M, DM, F.G, F.bid);
        EpiBf16 E{(bf16_t*)(F.ws + WS_F), DM};
        pg8::gemm_phase<EpiBf16, true>(F.lds, g, S, E);
    } SEAM(8);
    if (IN(9)) { rows_final(F); }
#undef IN
#undef SEAM
}

extern "C" void kernel_launch(void* const* d_in, const int* in_sizes, int n_in, void* d_out, int out_size, void* d_ws, size_t ws_size, hipStream_t stream) {
    static int grid = 0;
    if (grid == 0) {
        if (n_in != 29 || ws_size < WS_END) { fprintf(stderr, "kernel_launch: unexpected n_in %d / ws_size %zu\n", n_in, ws_size); grid = -1; return; }
        int dev = 0, cus = 0, per_cu = 0;
        hipGetDevice(&dev); hipDeviceGetAttribute(&cus, hipDeviceAttributeMultiprocessorCount, dev);
        if (hipFuncSetAttribute((const void*)fwd_megakernel, hipFuncAttributeMaxDynamicSharedMemorySize, LDS_BYTES) != hipSuccess) { fprintf(stderr, "kernel_launch: hipFuncSetAttribute failed\n"); grid = -1; return; }
        if (hipOccupancyMaxActiveBlocksPerMultiprocessor(&per_cu, (const void*)fwd_megakernel, NT, LDS_BYTES) != hipSuccess || per_cu < 1) { fprintf(stderr, "kernel_launch: occupancy query failed (%d)\n", per_cu); (void)hipGetLastError(); per_cu = 1; }
        grid = cus * (per_cu > 1 ? 1 : per_cu);
        fprintf(stderr, "kernel_launch: grid %d (cus %d, per_cu %d), ws %zu\n", grid, cus, per_cu, ws_size);
    }
    if (grid < 0) return;
    Args a{};
    for (int i = 0; i < 29; ++i) a.in[i] = (const float*)d_in[i];
    a.out = (float*)d_out; a.ws = (unsigned char*)d_ws;
#if MK_PER_PHASE
    for (int p = 0; p < NPHASE; ++p) { a.ph_lo = p; a.ph_hi = p + 1; hipLaunchKernelGGL(fwd_megakernel, dim3(grid), dim3(NT), LDS_BYTES, stream, a); }
#else
    a.ph_lo = 0; a.ph_hi = NPHASE;
    void* kargs[] = {&a};
    hipError_t e = hipLaunchCooperativeKernel((const void*)fwd_megakernel, dim3(grid), dim3(NT), kargs, LDS_BYTES, stream);
    if (e != hipSuccess) fprintf(stderr, "cooperative launch failed: %s (grid %d)\n", hipGetErrorString(e), grid);
#endif
}
```

```cpp
#include <hip/hip_runtime.h>
#include <hip/hip_cooperative_groups.h>
#include <cstdio>
#include <cstdint>
#include <utility>
namespace cg = cooperative_groups;

#ifndef MK_PER_PHASE
#define MK_PER_PHASE 0
#endif

#define LAS __attribute__((address_space(3)))
typedef unsigned short bf16_t;
typedef short bf16x8 __attribute__((ext_vector_type(8)));
typedef float f32x4 __attribute__((ext_vector_type(4)));
typedef float f32x2 __attribute__((ext_vector_type(2)));
typedef unsigned u32x4 __attribute__((ext_vector_type(4)));
typedef unsigned u32x2 __attribute__((ext_vector_type(2)));

constexpr int DM = 1024, NB = 4, T = 8192, MP = NB * T, DB = 128, DT = 8, MS = DB * DT, M = MP + MS;
constexpr int WIN = 128, DSH = 1696, DINP = 2560, DFF = 2816, DFFH = 1408;
constexpr float RMS_EPS = 1e-6f, GN_EPS = 64e-5f;
constexpr float QSCALE = 0.125f * 1.4426950408889634f;
constexpr size_t O_Y = 0, O_KWP = 34603008, O_VWP = 34668544, O_SHP = 34734080, O_WKVP = 34740864, O_CVP = 34871936,
                 O_KWS = 34894464, O_VWS = 36991616, O_SHS = 39088768, O_WKVS = 39305856, O_CVS = 43500160;
constexpr size_t MiB = 1u << 20;
constexpr size_t WS_WIN = 1 * MiB, WS_WOUT = 6 * MiB, WS_WFI = 8 * MiB, WS_WFO = 19 * MiB, WS_ROPE = 25 * MiB;
constexpr size_t WS_XN = 32 * MiB;
constexpr size_t WS_SR = 32 * MiB, WS_SK = 65 * MiB;
constexpr size_t WS_Q = 98 * MiB, WS_K = 131 * MiB, WS_VT = 140 * MiB;
constexpr size_t WS_HRW = 150 * MiB;
constexpr size_t WS_OCAT = 260 * MiB;
constexpr size_t WS_SW = 326 * MiB;
constexpr size_t WS_SV = 392 * MiB, WS_SKK = 425 * MiB, WS_SB = 458 * MiB;
constexpr size_t WS_ZU = 100 * MiB;
constexpr size_t WS_HID = 282 * MiB;
constexpr size_t WS_F = 216 * MiB;
constexpr size_t WS_MIX = 150 * MiB;
constexpr size_t WS_END = 491 * MiB;

__device__ __forceinline__ unsigned f2bf(float f) { unsigned u = __float_as_uint(f); return (u + 0x7fffu + ((u >> 16) & 1u)) >> 16; }

__device__ __forceinline__ float bf2f(unsigned short h) { return __uint_as_float(((unsigned)h) << 16); }
__device__ __forceinline__ float bflo(unsigned w) { return __uint_as_float(w << 16); }
__device__ __forceinline__ float bfhi(unsigned w) { return __uint_as_float(w & 0xffff0000u); }
__device__ __forceinline__ unsigned cvt_pk_bf16(float lo, float hi) { unsigned r; asm volatile("v_cvt_pk_bf16_f32 %0, %1, %2" : "=v"(r) : "v"(lo), "v"(hi)); return r; }
__device__ __forceinline__ unsigned pk2(float lo, float hi) { return cvt_pk_bf16(lo, hi); }
template <int CTRL> __device__ __forceinline__ float dppf(float x) { return __int_as_float(__builtin_amdgcn_update_dpp(0, __float_as_int(x), CTRL, 0xF, 0xF, false)); }
__device__ __forceinline__ float allsum16(float x) {
    x += dppf<0xB1>(x); x += dppf<0x4E>(x); x += dppf<0x141>(x); x += dppf<0x140>(x); return x;
}
__device__ __forceinline__ void allsum16_2(float& a, float& b) {
    a += dppf<0xB1>(a); b += dppf<0xB1>(b); a += dppf<0x4E>(a); b += dppf<0x4E>(b); a += dppf<0x141>(a); b += dppf<0x141>(b); a += dppf<0x140>(a); b += dppf<0x140>(b);
}
__device__ __forceinline__ float wave_sum(float v) {
    v = allsum16(v);
    { auto r = __builtin_amdgcn_permlane16_swap(__float_as_uint(v), __float_as_uint(v), false, false); v = __uint_as_float(r[0]) + __uint_as_float(r[1]); }
    { auto r = __builtin_amdgcn_permlane32_swap(__float_as_uint(v), __float_as_uint(v), false, false); v = __uint_as_float(r[0]) + __uint_as_float(r[1]); }
    return v;
}
__device__ __forceinline__ float sigmoidf_(float x) { return __builtin_amdgcn_rcpf(1.0f + __expf(-x)); }

namespace pg8 {
constexpr int BM = 256, BK = 64, HALF = 128, HTB = HALF * BK * 2, STAGE_BYTES = 8 * HTB, NXCD = 8, WGM = 8;
__host__ __device__ __forceinline__ int lds_byte(int r, int c) { const int st = (r >> 4) * 2 + (c >> 5), rr = r & 15, cc = c & 31, ob = rr * 64 + cc * 2; return st * 1024 + (ob ^ (((ob >> 9) & 1) << 5)); }
__host__ __device__ __forceinline__ void stage_rc(int b, int& R, int& C) { const int st = b / 1024, sb = b % 1024, swz = sb ^ (((sb >> 9) & 1) << 5); R = (st >> 1) * 16 + swz / 64; C = (st & 1) * 32 + (swz % 64) / 2; }
__host__ __device__ __forceinline__ int perm32(int rho) { const int n = rho >> 4, i = rho & 15; return 8 * (i >> 2) + 4 * n + (i & 3); }
struct Unit { int pm, pn; };
struct Gemm { const bf16_t* A; const bf16_t* Bt; int M, N, K, lda, ldb, conv; };
__device__ __forceinline__ long arow(const Gemm& g, int pm) {
    if (!g.conv) return (long)pm * 256;
    if (pm < 132) { const int b = pm / 33; return (long)b * 8192 + 254 * (pm - 33 * b) - 2; }
    return 32768 + (long)(pm - 132) * 256;
}
struct StaticOrder {
    int nM, nN, nwg, G, c;
    __device__ void init(int M_, int N_, int G_, int c_) { nM = M_ / BM; nN = N_ / BM; nwg = nM * nN; G = G_; c = c_; }
    __device__ bool next(int i, Unit& u) const {
        const long L = (long)i * G + c; if (L >= nwg) return false;
        int wgid = (int)L; { const int q = nwg / NXCD, r = nwg % NXCD, xcd = wgid % NXCD, off = wgid / NXCD; wgid = (xcd < r ? xcd * (q + 1) : r * (q + 1) + (xcd - r) * q) + off; }
        const int nig = WGM * nN, gid = wgid / nig, fm = gid * WGM, gsz = (nM - fm) < WGM ? (nM - fm) : WGM;
        u.pm = fm + ((wgid % nig) % gsz); u.pn = (wgid % nig) / gsz; return true;
    }
};
template <class Epi, bool ALIGN_EPI>
__device__ __forceinline__ void gemm_phase(LAS unsigned char* lds, const Gemm g, const StaticOrder& S, const Epi& E) {
    const int tid = threadIdx.x, wid = __builtin_amdgcn_readfirstlane(tid >> 6), lane = tid & 63, wr = wid >> 2, wc = wid & 3, fr = lane & 15, fq = lane >> 4;
    const int nt = g.K / BK;
    unsigned voffA[2], voffB[2];
#pragma unroll
    for (int i = 0; i < 2; ++i) { int R, C; stage_rc(tid * 16 + i * 8192, R, C); const int Rb = (R & ~31) + perm32(R & 31);
        voffA[i] = (unsigned)(R * g.lda + C) * 2u; voffB[i] = (unsigned)(Rb * g.ldb + C) * 2u; }
    const size_t kstep = (size_t)(BK * 2);
    const size_t hstepA = (size_t)HALF * g.lda * 2, hstepB = (size_t)HALF * g.ldb * 2;
    const size_t rowA = (size_t)g.lda * 2, tstepB = 2 * hstepB;
    const unsigned ldsw = (unsigned)wid * 1024u;
    const int aoff = lds_byte(wr * 64 + fr, fq * 8), boff = lds_byte(wc * 32 + fr, fq * 8);
#define PG8_SA(b, h) (((b) * 2 + (h)) * HTB)
#define PG8_SB(b, h) ((4 + (b) * 2 + (h)) * HTB)
#define PG8_STAGE(bufoff, gbase, voff) do { _Pragma("unroll") for (int _i = 0; _i < 2; ++_i) \
        __builtin_amdgcn_global_load_lds((const unsigned*)((const char*)(gbase) + (voff)[_i]), (LAS unsigned*)(lds + (bufoff) + ldsw + _i * 8192), 16, 0, 0); } while (0)
#define PG8_LDA(dst, b, h) do { _Pragma("unroll") for (int m = 0; m < 4; ++m) _Pragma("unroll") for (int k = 0; k < 2; ++k) dst[m][k] = *(const LAS bf16x8*)(lds + PG8_SA(b, h) + aoff + m * 2048 + k * 1024); } while (0)
#define PG8_LDB(dst, b, h) do { _Pragma("unroll") for (int n = 0; n < 2; ++n) _Pragma("unroll") for (int k = 0; k < 2; ++k) dst[n][k] = *(const LAS bf16x8*)(lds + PG8_SB(b, h) + boff + n * 2048 + k * 1024); } while (0)
#define PG8_MMA(ai, bj, At, Bt) do { __builtin_amdgcn_s_setprio(1); _Pragma("unroll") for (int m = 0; m < 4; ++m) _Pragma("unroll") for (int n = 0; n < 2; ++n) _Pragma("unroll") for (int k = 0; k < 2; ++k) \
        acc[ai][bj][m][n] = __builtin_amdgcn_mfma_f32_16x16x32_bf16(Bt[n][k], At[m][k], acc[ai][bj][m][n], 0, 0, 0); __builtin_amdgcn_s_setprio(0); } while (0)
#define PG8_WAIT_V(n) asm volatile("s_waitcnt vmcnt(" #n ")" ::: "memory")
#define PG8_WAIT_L(n) asm volatile("s_waitcnt lgkmcnt(" #n ")" ::: "memory")
#define PG8_BAR __builtin_amdgcn_s_barrier()
#define PG8_SCHED __builtin_amdgcn_sched_barrier(0)
    Unit cur, nxt; int ui = 0;
    if (!S.next(0, cur)) return;
    f32x4 acc[2][2][4][2];
#pragma unroll
    for (int a = 0; a < 2; ++a)
#pragma unroll
        for (int b = 0; b < 2; ++b)
#pragma unroll
            for (int m = 0; m < 4; ++m)
#pragma unroll
                for (int n = 0; n < 2; ++n) acc[a][b][m][n] = (f32x4){0.f, 0.f, 0.f, 0.f};
    bf16x8 At[4][2], B0[2][2], B1[2][2];
    const char* cA = (const char*)g.A + arow(g, cur.pm) * (long)rowA; const char* cB = (const char*)g.Bt + (size_t)cur.pn * tstepB;
    PG8_STAGE(PG8_SB(0, 0), cB, voffB); PG8_STAGE(PG8_SB(0, 1), cB + hstepB, voffB); PG8_STAGE(PG8_SA(0, 0), cA, voffA); PG8_STAGE(PG8_SA(0, 1), cA + hstepA, voffA);
    if (wr == 1) PG8_BAR;
    PG8_WAIT_V(2); PG8_BAR;
    PG8_STAGE(PG8_SB(1, 0), cB + kstep, voffB); PG8_STAGE(PG8_SA(1, 0), cA + kstep, voffA); PG8_STAGE(PG8_SB(1, 1), cB + hstepB + kstep, voffB);
    PG8_WAIT_V(6); PG8_BAR;
    for (;;) {
        const bool has_next = S.next(ui + 1, nxt);
        const char* nA = has_next ? (const char*)g.A + arow(g, nxt.pm) * (long)rowA : cA; const char* nB = has_next ? (const char*)g.Bt + (size_t)nxt.pn * tstepB : cB;
        for (int t = 0; t < nt; t += 2) {
            const bool last = (t == nt - 2);
            const char* a1 = cA + (size_t)(t + 1) * kstep;
            const char* a2 = last ? nA : cA + (size_t)(t + 2) * kstep; const char* b2 = last ? nB : cB + (size_t)(t + 2) * kstep;
            const char* a3 = a2 + kstep; const char* b3 = b2 + kstep;
            PG8_LDB(B0, 0, 0); PG8_LDB(B1, 0, 1); PG8_SCHED; PG8_LDA(At, 0, 0); PG8_STAGE(PG8_SA(1, 1), a1 + hstepA, voffA);
            PG8_WAIT_V(8); PG8_WAIT_L(0); PG8_BAR; PG8_MMA(0, 0, At, B0); PG8_MMA(0, 1, At, B1); PG8_BAR; PG8_SCHED;
            PG8_LDA(At, 0, 1); PG8_STAGE(PG8_SB(0, 0), b2, voffB); PG8_STAGE(PG8_SB(0, 1), b2 + hstepB, voffB); PG8_STAGE(PG8_SA(0, 0), a2, voffA);
            PG8_WAIT_V(8); PG8_WAIT_L(0); PG8_BAR; PG8_MMA(1, 0, At, B0); PG8_MMA(1, 1, At, B1); PG8_BAR; PG8_SCHED;
            PG8_LDB(B0, 1, 0); PG8_LDB(B1, 1, 1); PG8_SCHED; PG8_LDA(At, 1, 0); PG8_STAGE(PG8_SA(0, 1), a2 + hstepA, voffA);
            PG8_WAIT_V(8); PG8_WAIT_L(0); PG8_BAR; PG8_MMA(0, 0, At, B0); PG8_MMA(0, 1, At, B1); PG8_BAR; PG8_SCHED;
            PG8_LDA(At, 1, 1); PG8_STAGE(PG8_SB(1, 0), b3, voffB); PG8_STAGE(PG8_SB(1, 1), b3 + hstepB, voffB); PG8_STAGE(PG8_SA(1, 0), a3, voffA);
            PG8_WAIT_V(8); PG8_WAIT_L(0); PG8_BAR; PG8_MMA(1, 0, At, B0); PG8_MMA(1, 1, At, B1); PG8_BAR; PG8_SCHED;
        }
        if constexpr (ALIGN_EPI) { if (wr == 0) PG8_BAR; }
        asm volatile("s_nop 7\n\ts_nop 7" ::: "memory");
        E(acc, cur, wr, wc, fr, fq);
        if (!has_next) break;
#pragma unroll
        for (int a = 0; a < 2; ++a)
#pragma unroll
            for (int b = 0; b < 2; ++b)
#pragma unroll
                for (int m = 0; m < 4; ++m)
#pragma unroll
                    for (int n = 0; n < 2; ++n) acc[a][b][m][n] = (f32x4){0.f, 0.f, 0.f, 0.f};
        cur = nxt; cA = nA; cB = nB; ++ui;
        if constexpr (ALIGN_EPI) { if (wr == 1) PG8_BAR; }
    }
    PG8_WAIT_V(0);
    if constexpr (!ALIGN_EPI) { if (wr == 0) PG8_BAR; }
    PG8_BAR;
#undef PG8_SA
#undef PG8_SB
#undef PG8_STAGE
#undef PG8_LDA
#undef PG8_LDB
#undef PG8_MMA
#undef PG8_WAIT_V
#undef PG8_WAIT_L
#undef PG8_BAR
#undef PG8_SCHED
}
}

struct RowInfo { int b, t, samp; };
__device__ __forceinline__ RowInfo row_info(int row) { RowInfo r; if (row < MP) { r.samp = 0; r.b = row >> 13; r.t = row & (T - 1); } else { const int rs = row - MP; r.samp = 1; r.b = rs >> 3; r.t = rs & 7; } return r; }

struct Epi1 {
    const float* rope; bf16_t* Q; bf16_t* Kb; bf16_t* VT; bf16_t* HRW; float* out;
    __device__ __forceinline__ void operator()(const f32x4 (&acc)[2][2][4][2], const pg8::Unit& u, int wr, int wc, int fr, int fq) const {
#pragma unroll
        for (int ai = 0; ai < 2; ++ai)
#pragma unroll
            for (int m = 0; m < 4; ++m) {
                const int row = u.pm * 256 + ai * 128 + wr * 64 + m * 16 + fr;
                const RowInfo ri = row_info(row);
                const int pidx = ri.samp ? (T + ri.t) : ri.t;
#pragma unroll
                for (int bj = 0; bj < 2; ++bj) {
                    const int cb = u.pn * 256 + bj * 128;
                    const int c0 = cb + wc * 32 + fq * 8;
                    const f32x4 v0 = acc[ai][bj][m][0], v1 = acc[ai][bj][m][1];
                    if (cb < 640) {
                        const int d0 = ((c0 & 63) >> 3) * 4;
                        const f32x4* rp = (const f32x4*)(rope + ((size_t)pidx * 32 + d0) * 2);
                        const f32x4 cs0 = rp[0], cs1 = rp[1];
                        f32x4 o1, o2;
                        o1[0] = v0[0] * cs0[0] - v1[0] * cs0[1]; o2[0] = v1[0] * cs0[0] + v0[0] * cs0[1];
                        o1[1] = v0[1] * cs0[2] - v1[1] * cs0[3]; o2[1] = v1[1] * cs0[2] + v0[1] * cs0[3];
                        o1[2] = v0[2] * cs1[0] - v1[2] * cs1[1]; o2[2] = v1[2] * cs1[0] + v0[2] * cs1[1];
                        o1[3] = v0[3] * cs1[2] - v1[3] * cs1[3]; o2[3] = v1[3] * cs1[2] + v0[3] * cs1[3];
                        if (cb < 512) {
                            o1 = o1 * QSCALE; o2 = o2 * QSCALE;
                            bf16_t* qp = Q + (size_t)row * 512 + (c0 & ~63) + d0;
                            u32x2 w1, w2; w1.x = cvt_pk_bf16(o1[0], o1[1]); w1.y = cvt_pk_bf16(o1[2], o1[3]); w2.x = cvt_pk_bf16(o2[0], o2[1]); w2.y = cvt_pk_bf16(o2[2], o2[3]);
                            *(u32x2*)qp = w1; *(u32x2*)(qp + 32) = w2;
                        } else {
                            const int kvh = (c0 - 512) >> 6;
                            bf16_t* kp = Kb + (size_t)row * 128 + kvh * 64 + d0;
                            u32x2 w1, w2; w1.x = cvt_pk_bf16(o1[0], o1[1]); w1.y = cvt_pk_bf16(o1[2], o1[3]); w2.x = cvt_pk_bf16(o2[0], o2[1]); w2.y = cvt_pk_bf16(o2[2], o2[3]);
                            *(u32x2*)kp = w1; *(u32x2*)(kp + 32) = w2;
                            if (!ri.samp) { if (ri.t >= T - WIN) { float* o = out + O_KWP + ((size_t)(ri.b * WIN + (ri.t - (T - WIN))) * 2 + kvh) * 64 + d0; *(f32x4*)o = o1; *(f32x4*)(o + 32) = o2; } }
                            else { float* o = out + O_KWS + ((size_t)(ri.b * WIN + (WIN - DT) + ri.t) * 2 + kvh) * 64 + d0; *(f32x4*)o = o1; *(f32x4*)(o + 32) = o2; }
                        }
                    } else if (cb < 768) {
                        const int kvh = (c0 - 640) >> 6, d0 = (c0 - 640) & 63;
                        if (!ri.samp) {
                            bf16_t* vp = VT + ((size_t)(ri.b * 2 + kvh) * 64 + d0) * T + ri.t;
                            vp[0] = (bf16_t)f2bf(v0[0]); vp[(size_t)T] = (bf16_t)f2bf(v0[1]); vp[(size_t)2 * T] = (bf16_t)f2bf(v0[2]); vp[(size_t)3 * T] = (bf16_t)f2bf(v0[3]);
                            vp[(size_t)4 * T] = (bf16_t)f2bf(v1[0]); vp[(size_t)5 * T] = (bf16_t)f2bf(v1[1]); vp[(size_t)6 * T] = (bf16_t)f2bf(v1[2]); vp[(size_t)7 * T] = (bf16_t)f2bf(v1[3]);
                            if (ri.t >= T - WIN) { float* o = out + O_VWP + ((size_t)(ri.b * WIN + (ri.t - (T - WIN))) * 2 + kvh) * 64 + d0; *(f32x4*)o = v0; *(f32x4*)(o + 4) = v1; }
                        } else { float* o = out + O_VWS + ((size_t)(ri.b * WIN + (WIN - DT) + ri.t) * 2 + kvh) * 64 + d0; *(f32x4*)o = v0; *(f32x4*)(o + 4) = v1; }
                    } else if (c0 < 2464) {
                        const int col = c0 - 768;
                        u32x4 w; w.x = cvt_pk_bf16(v0[0], v0[1]); w.y = cvt_pk_bf16(v0[2], v0[3]); w.z = cvt_pk_bf16(v1[0], v1[1]); w.w = cvt_pk_bf16(v1[2], v1[3]);
                        *(u32x4*)(HRW + (size_t)row * DSH + col) = w;
                        if (!ri.samp) { if (ri.t == T - 1) { float* o = out + O_SHP + (size_t)ri.b * DSH + col; *(f32x4*)o = v0; *(f32x4*)(o + 4) = v1; } }
                        else if (ri.t == DT - 1) { float* o = out + O_SHS + (size_t)ri.b * DSH + col; *(f32x4*)o = v0; *(f32x4*)(o + 4) = v1; }
                    }
                }
            }
    }
};
struct EpiF32 {
    float* O; int ldc;
    __device__ __forceinline__ void operator()(const f32x4 (&acc)[2][2][4][2], const pg8::Unit& u, int wr, int wc, int fr, int fq) const {
#pragma unroll
        for (int ai = 0; ai < 2; ++ai)
#pragma unroll
            for (int m = 0; m < 4; ++m) {
                float* rowp = O + (size_t)(u.pm * 256 + ai * 128 + wr * 64 + m * 16 + fr) * ldc + u.pn * 256 + wc * 32 + fq * 8;
#pragma unroll
                for (int bj = 0; bj < 2; ++bj) { *(f32x4*)(rowp + bj * 128) = acc[ai][bj][m][0]; *(f32x4*)(rowp + bj * 128 + 4) = acc[ai][bj][m][1]; }
            }
    }
};
struct EpiBf16 {
    bf16_t* O; int ldc;
    __device__ __forceinline__ void operator()(const f32x4 (&acc)[2][2][4][2], const pg8::Unit& u, int wr, int wc, int fr, int fq) const {
#pragma unroll
        for (int ai = 0; ai < 2; ++ai)
#pragma unroll
            for (int m = 0; m < 4; ++m) {
                bf16_t* rowp = O + (size_t)(u.pm * 256 + ai * 128 + wr * 64 + m * 16 + fr) * ldc + u.pn * 256 + wc * 32 + fq * 8;
#pragma unroll
                for (int bj = 0; bj < 2; ++bj) { const f32x4 v0 = acc[ai][bj][m][0], v1 = acc[ai][bj][m][1];
                    u32x4 w; w.x = cvt_pk_bf16(v0[0], v0[1]); w.y = cvt_pk_bf16(v0[2], v0[3]); w.z = cvt_pk_bf16(v1[0], v1[1]); w.w = cvt_pk_bf16(v1[2], v1[3]);
                    *(u32x4*)(rowp + bj * 128) = w; }
            }
    }
};
template <int CTRL> __device__ __forceinline__ float dpp_old(float old, float src) { return __int_as_float(__builtin_amdgcn_update_dpp(__float_as_int(old), __float_as_int(src), CTRL, 0xF, 0xF, false)); }
struct EpiConv {
    bf16_t* HID; float* out; const float* cw; const float* cb; const float* sc; LAS float* exch;
    __device__ __forceinline__ void operator()(const f32x4 (&acc)[2][2][4][2], const pg8::Unit& u, int wr, int wc, int fr, int fq) const {
        const int cw8 = wc * 32 + fq * 8, ch0 = u.pn * 128 + cw8;
        if (fr >= 14) {
#pragma unroll
            for (int ai = 0; ai < 2; ++ai)
#pragma unroll
                for (int n = 0; n < 2; ++n) *(LAS f32x4*)(exch + ((ai * 2 + wr) * 2 + (fr - 14)) * 128 + cw8 + 4 * n) = acc[ai][0][3][n];
        }
        asm volatile("s_waitcnt lgkmcnt(0)\n\ts_barrier" ::: "memory");
        int row0, b0 = 0, i0 = 0; const bool samp = u.pm >= 132;
        if (!samp) { b0 = u.pm / 33; i0 = u.pm - 33 * b0; row0 = b0 * T + 254 * i0 - 2; } else row0 = MP + (u.pm - 132) * 256;
        f32x4 w0[2], w1[2], w2[2], bb[2];
#pragma unroll
        for (int n = 0; n < 2; ++n) { w0[n] = *(const f32x4*)(cw + ch0 + 4 * n); w1[n] = *(const f32x4*)(cw + DFF + ch0 + 4 * n); w2[n] = *(const f32x4*)(cw + 2 * DFF + ch0 + 4 * n); bb[n] = *(const f32x4*)(cb + ch0 + 4 * n); }
#pragma unroll
        for (int ai = 0; ai < 2; ++ai) {
            const int strip = ai * 2 + wr;
            f32x4 h1[2], h2[2];
#pragma unroll
            for (int n = 0; n < 2; ++n) {
                if (strip > 0) { h1[n] = *(const LAS f32x4*)(exch + ((strip - 1) * 2 + 1) * 128 + cw8 + 4 * n); h2[n] = *(const LAS f32x4*)(exch + ((strip - 1) * 2) * 128 + cw8 + 4 * n); }
                else { h1[n] = (f32x4){0.f, 0.f, 0.f, 0.f}; h2[n] = (f32x4){0.f, 0.f, 0.f, 0.f}; }
            }
#pragma unroll
            for (int m = 0; m < 4; ++m) {
                const int lr = ai * 128 + wr * 64 + m * 16 + fr;
                int t, b; bool valid;
                if (!samp) { t = 254 * i0 + lr - 2; b = b0; valid = lr >= 2 && t < T; } else { const int rs = row0 - MP + lr; b = rs >> 3; t = rs & 7; valid = true; }
                const size_t R = (size_t)((long)row0 + lr);
                f32x4 hd[2];
#pragma unroll
                for (int n = 0; n < 2; ++n) {
                    const f32x4 z = acc[ai][0][m][n], uu = acc[ai][1][m][n];
                    f32x4 o1, o2, zm1, zm2;
                    if (m == 0) { o1 = h1[n]; o2 = (fr == 0) ? h2[n] : h1[n]; }
                    else {
#pragma unroll
                        for (int e = 0; e < 4; ++e) { o1[e] = dppf<0x121>(acc[ai][0][m > 0 ? m - 1 : 0][n][e]); o2[e] = dppf<0x122>(acc[ai][0][m > 0 ? m - 1 : 0][n][e]); }
                    }
#pragma unroll
                    for (int e = 0; e < 4; ++e) { zm1[e] = dpp_old<0x111>(o1[e], z[e]); zm2[e] = dpp_old<0x112>(o2[e], z[e]); }
                    if (t == 0) {
                        if (samp) { zm1 = *(const f32x4*)(sc + ((size_t)b * 2 + 1) * DFF + ch0 + 4 * n); zm2 = *(const f32x4*)(sc + ((size_t)b * 2) * DFF + ch0 + 4 * n); }
                        else { zm1 = (f32x4){0.f, 0.f, 0.f, 0.f}; zm2 = (f32x4){0.f, 0.f, 0.f, 0.f}; }
                    } else if (t == 1) {
                        if (samp) zm2 = *(const f32x4*)(sc + ((size_t)b * 2 + 1) * DFF + ch0 + 4 * n); else zm2 = (f32x4){0.f, 0.f, 0.f, 0.f};
                    }
                    const f32x4 zc = bb[n] + w0[n] * zm2 + w1[n] * zm1 + w2[n] * z;
#pragma unroll
                    for (int e = 0; e < 4; ++e) hd[n][e] = zc[e] * sigmoidf_(zc[e]) * uu[e];
                }
                if (valid) {
                    u32x4 w; w.x = cvt_pk_bf16(hd[0][0], hd[0][1]); w.y = cvt_pk_bf16(hd[0][2], hd[0][3]); w.z = cvt_pk_bf16(hd[1][0], hd[1][1]); w.w = cvt_pk_bf16(hd[1][2], hd[1][3]);
                    *(u32x4*)(HID + R * DFF + ch0) = w;
                    if (!samp) { if (t >= T - 2) { float* o = out + O_CVP + (size_t)(b * 2 + (t - (T - 2))) * DFF + ch0; *(f32x4*)o = acc[ai][0][m][0]; *(f32x4*)(o + 4) = acc[ai][0][m][1]; } }
                    else if (t >= DT - 2) { float* o = out + O_CVS + (size_t)(b * 2 + (t - (DT - 2))) * DFF + ch0; *(f32x4*)o = acc[ai][0][m][0]; *(f32x4*)(o + 4) = acc[ai][0][m][1]; }
                }
            }
        }
    }
};

#define XB_TMO      128
#define XB_XCNT(j)  (256  + 64 * (j))
#define XB_XSUB(j)  (1280 + 64 * (j))
#define XB_XGEN(j)  (2304 + 64 * (j))
#define XB_TOP      3328
#define XB_TOPGEN   3392
#define XCD_BAR_WORDS 3456
#define XB_SPIN_CAP (1u << 20)
__device__ __forceinline__ unsigned xb_ld(unsigned* p)              { return __hip_atomic_load(p, __ATOMIC_RELAXED, __HIP_MEMORY_SCOPE_AGENT); }
__device__ __forceinline__ unsigned xb_add(unsigned* p, unsigned v) { return __hip_atomic_fetch_add(p, v, __ATOMIC_RELAXED, __HIP_MEMORY_SCOPE_AGENT); }
__device__ __forceinline__ unsigned xb_xcc_id() { return (unsigned)__builtin_amdgcn_s_getreg((3 << 11) | 20) & 0xFu; }
#define XB_SPIN(cond, bar) do { unsigned _sp = 0; while (cond) { __builtin_amdgcn_s_sleep(1); \
    if ((++_sp & 255u) == 0u) { if (xb_ld(&(bar)[XB_TMO])) break; if (_sp > XB_SPIN_CAP) { atomicAdd(&(bar)[XB_TMO], 1u); break; } } } } while (0)
struct XcdBarrier { unsigned* bar; unsigned x; volatile LAS unsigned* st; };
__device__ __forceinline__ XcdBarrier xcd_barrier_post(unsigned* bar, volatile LAS unsigned* st) {
    XcdBarrier b; b.bar = bar; b.x = xb_xcc_id(); b.st = st;
    if (threadIdx.x == 0) (void)xb_add(&bar[XB_XCNT(b.x)], 1u);
    return b;
}
__device__ __forceinline__ void xcd_barrier_complete(unsigned* bar, unsigned x, unsigned& nloc, unsigned& nx) {
    const unsigned G = gridDim.x * gridDim.y * gridDim.z;
    unsigned sum, cnt, mine, sp = 0u;
    for (;;) {
        sum = 0u; cnt = 0u; mine = 0u;
#pragma unroll
        for (unsigned j = 0; j < 16; ++j) { const unsigned c = xb_ld(&bar[XB_XCNT(j)]); sum += c; cnt += (c > 0u) ? 1u : 0u; mine = (j == x) ? c : mine; }
        if (sum == G) break;
        __builtin_amdgcn_s_sleep(1);
        if ((++sp & 255u) == 0u) { if (xb_ld(&bar[XB_TMO])) break; if (sp > XB_SPIN_CAP) { atomicAdd(&bar[XB_TMO], 1u); break; } }
    }
    nloc = mine > 0u ? mine : 1u; nx = cnt > 0u ? cnt : 1u;
}
__device__ __forceinline__ void xcd_barrier(const XcdBarrier& b) {
    asm volatile("s_waitcnt vmcnt(0)" ::: "memory");
    __syncthreads();
    if (threadIdx.x == 0) {
        unsigned* bar = b.bar;
        __builtin_amdgcn_s_waitcnt(0);
        unsigned nloc = b.st[0], nx = b.st[1];
        if (nloc == 0u) { xcd_barrier_complete(bar, b.x, nloc, nx); b.st[0] = nloc; b.st[1] = nx; }
        const unsigned old = xb_add(&bar[XB_XSUB(b.x)], 1u);
        const unsigned gen = old / nloc;
        if (old + 1u == (gen + 1u) * nloc) {
            __builtin_amdgcn_fence(__ATOMIC_RELEASE, "agent");
            asm volatile("s_waitcnt vmcnt(0)" ::: "memory");
            const unsigned og = xb_add(&bar[XB_TOP], 1u);
            const unsigned tg = og / nx;
            if (og + 1u == (tg + 1u) * nx) xb_add(&bar[XB_TOPGEN], 1u);
            else XB_SPIN(xb_ld(&bar[XB_TOPGEN]) == tg, bar);
            __builtin_amdgcn_fence(__ATOMIC_ACQUIRE, "agent");
            xb_add(&bar[XB_XGEN(b.x)], 1u);
            asm volatile("s_waitcnt vmcnt(0)" ::: "memory");
        } else {
            XB_SPIN(xb_ld(&bar[XB_XGEN(b.x)]) == gen, bar);
            __builtin_amdgcn_fence(__ATOMIC_ACQUIRE, "agent");
            asm volatile("s_waitcnt vmcnt(0)" ::: "memory");
        }
    }
    __syncthreads();
}

constexpr int NWAVES = 8, NT = 512;
constexpr int LDS_BYTES = 163840;
constexpr int YP_OFF = 129536;
struct Args { const float* in[29]; float* out; unsigned char* ws; int ph_lo, ph_hi; };
struct Frame {
    LAS unsigned char* lds; unsigned char* ws; float* out; const float* const* in;
    int tid, lane, wave, G, bid;
};
__device__ __forceinline__ const float* xrow_ptr(const Frame& F, int m) { return m < MP ? F.in[0] + (size_t)m * DM : F.in[1] + (size_t)(m - MP) * DM; }

template <class MAP>
__device__ __forceinline__ void p0_transpose_item(const float* W, int K, int N, int Nout, bf16_t* WT, LAS float* scr, int item, int lane, MAP map) {
    const int nblk = Nout / 32, kb = item / nblk, nb = item % nblk, k0 = 64 * kb, n0 = 32 * nb;
    const int src = map(n0 + (lane & 31));
    float tv[32];
#pragma unroll
    for (int i = 0; i < 32; ++i) { const int kk = 2 * i + (lane >> 5); tv[i] = src >= 0 ? W[(size_t)(k0 + kk) * N + src] : 0.f; }
#pragma unroll
    for (int i = 0; i < 32; ++i) { const int kk = 2 * i + (lane >> 5); scr[kk * 33 + (lane & 31)] = tv[i]; }
    asm volatile("s_waitcnt lgkmcnt(0)" ::: "memory");
    const int c = lane & 7;
#pragma unroll
    for (int j = 0; j < 4; ++j) { const int n = (lane >> 3) + 8 * j; const LAS float* s = scr + (8 * c) * 33 + n;
        u32x4 o; o.x = pk2(s[0 * 33], s[1 * 33]); o.y = pk2(s[2 * 33], s[3 * 33]); o.z = pk2(s[4 * 33], s[5 * 33]); o.w = pk2(s[6 * 33], s[7 * 33]);
        *(u32x4*)(WT + (size_t)(n0 + n) * K + k0 + 8 * c) = o; }
    asm volatile("s_waitcnt lgkmcnt(0)" ::: "memory");
}
struct MapIn { __device__ int operator()(int n) const { if (n < 640) { const int w = n & 63; return (n & ~63) + (w >> 3) * 4 + (w & 3) + 32 * ((w >> 2) & 1); } return n < 2464 ? n : -1; } };
struct MapId { __device__ int operator()(int n) const { return n; } };
struct MapFfn { __device__ int operator()(int n) const { const int tile = n >> 8, sub = n & 255, ch = tile * 128 + (sub & 127); return sub < 128 ? ch : DFF + ch; } };

__device__ __forceinline__ void p0_prologue(Frame& F) {
    LAS float* scr = (LAS float*)(F.lds + F.wave * 16384);
    const int gw = F.bid * NWAVES + F.wave, NGW = F.G * NWAVES;
    constexpr int I_IN = 16 * (DINP / 32), I_OUT = 16 * 32, I_FI = 16 * (2 * DFF / 32), I_FO = (DFF / 64) * 32;
    constexpr int NITEMS = I_IN + I_OUT + I_FI + I_FO;
#ifndef TR_DUP
#define TR_DUP 1
#endif
    for (int it_ = gw; it_ < NITEMS * TR_DUP; it_ += NGW) {
        const int it = it_ % NITEMS;
        int r = it;
        if (r < I_IN) { p0_transpose_item(F.in[8], DM, 2464, DINP, (bf16_t*)(F.ws + WS_WIN), scr, r, F.lane, MapIn()); continue; } r -= I_IN;
        if (r < I_OUT) { p0_transpose_item(F.in[21], DM, DM, DM, (bf16_t*)(F.ws + WS_WOUT), scr, r, F.lane, MapId()); continue; } r -= I_OUT;
        if (r < I_FI) { p0_transpose_item(F.in[24], DM, 2 * DFF, 2 * DFF, (bf16_t*)(F.ws + WS_WFI), scr, r, F.lane, MapFfn()); continue; } r -= I_FI;
        p0_transpose_item(F.in[27], DFF, DM, DM, (bf16_t*)(F.ws + WS_WFO), scr, r, F.lane, MapId());
    }
    float* rope = (float*)(F.ws + WS_ROPE);
    for (int e = F.bid * NT + F.tid; e < (T + DT) * 32; e += F.G * NT) {
        const int pidx = e >> 5, i = e & 31; const int pos = pidx < T ? pidx : 16384 + (pidx - T);
        const float inv = (float)exp2(-(double)i * (13.287712379549449 / 32.0));
        const float angf = (float)pos * inv;
        const double a = (double)angf;
        const double TWO_PI = 6.283185307179586476925286766559;
        const double n = rint(a / TWO_PI);
        const double r = a - n * TWO_PI;
        const double r2 = r * r;
        double c = 1.0, s = 1.0, tc = 1.0, ts = 1.0;
#pragma unroll
        for (int k = 1; k <= 14; ++k) { tc = -tc * r2 * (1.0 / (double)((2 * k - 1) * (2 * k))); ts = -ts * r2 * (1.0 / (double)((2 * k) * (2 * k + 1))); c += tc; s += ts; }
        s *= r;
        rope[(size_t)e * 2] = (float)c; rope[(size_t)e * 2 + 1] = (float)s;
    }
    const float* g = F.in[7];
    bf16_t* XN = (bf16_t*)(F.ws + WS_XN);
    f32x4 gq[4];
#pragma unroll
    for (int j = 0; j < 4; ++j) gq[j] = ((const f32x4*)g)[64 * j + F.lane];
    for (int m = gw; m < M; m += 2 * NGW) {
        const int m1 = m + NGW; const bool has1 = m1 < M;
        const f32x4* xr0 = (const f32x4*)xrow_ptr(F, m) + F.lane; const f32x4* xr1 = (const f32x4*)xrow_ptr(F, has1 ? m1 : m) + F.lane;
        f32x4 v0[4], v1[4];
#pragma unroll
        for (int j = 0; j < 4; ++j) v0[j] = __builtin_nontemporal_load(xr0 + 64 * j);
#pragma unroll
        for (int j = 0; j < 4; ++j) v1[j] = __builtin_nontemporal_load(xr1 + 64 * j);
        float s0 = 0.f, s1 = 0.f;
#pragma unroll
        for (int j = 0; j < 4; ++j) { s0 += (v0[j].x * v0[j].x + v0[j].y * v0[j].y) + (v0[j].z * v0[j].z + v0[j].w * v0[j].w); s1 += (v1[j].x * v1[j].x + v1[j].y * v1[j].y) + (v1[j].z * v1[j].z + v1[j].w * v1[j].w); }
        const float r0 = 1.0f / sqrtf(wave_sum(s0) * (1.f / DM) + RMS_EPS), r1 = 1.0f / sqrtf(wave_sum(s1) * (1.f / DM) + RMS_EPS);
        u32x2* o0 = (u32x2*)(XN + (size_t)m * DM) + F.lane; u32x2* o1 = (u32x2*)(XN + (size_t)m1 * DM) + F.lane;
#pragma unroll
        for (int j = 0; j < 4; ++j) { const f32x4 gg = gq[j];
            u32x2 w; w.x = pk2(v0[j].x * r0 * gg.x, v0[j].y * r0 * gg.y); w.y = pk2(v0[j].z * r0 * gg.z, v0[j].w * r0 * gg.w); o0[64 * j] = w;
            if (has1) { u32x2 q; q.x = pk2(v1[j].x * r1 * gg.x, v1[j].y * r1 * gg.y); q.y = pk2(v1[j].z * r1 * gg.z, v1[j].w * r1 * gg.w); o1[64 * j] = q; } }
    }
}

__device__ __forceinline__ float hprev_val(const Frame& F, const bf16_t* HRW, int m, int col) {
    const RowInfo ri = row_info(m);
    if (ri.t == 0) return ri.samp ? F.in[4][(size_t)ri.b * DSH + col] : 0.f;
    return bf2f(HRW[(size_t)(m - 1) * DSH + col]);
}
__device__ __forceinline__ f32x4 ld_bf4(const bf16_t* p) { const u32x2 w = *(const u32x2*)p; return (f32x4){bflo(w.x), bfhi(w.x), bflo(w.y), bfhi(w.y)}; }
__device__ __forceinline__ f32x4 hs4(const Frame& F, const bf16_t* HRW, int m, const RowInfo& ri, int col) {
    const f32x4 h = ld_bf4(HRW + (size_t)m * DSH + col);
    f32x4 hp;
    if (ri.t == 0) hp = ri.samp ? *(const f32x4*)(F.in[4] + (size_t)ri.b * DSH + col) : (f32x4){0.f, 0.f, 0.f, 0.f};
    else hp = ld_bf4(HRW + (size_t)(m - 1) * DSH + col);
    const f32x4 mu = *(const f32x4*)(F.in[10] + col);
    return h + (hp - h) * mu;
}
struct F8 { f32x4 a, b; };
__device__ __forceinline__ F8 ld_bf8(const bf16_t* p) { const u32x4 w = *(const u32x4*)p; F8 r; r.a = (f32x4){bflo(w.x), bfhi(w.x), bflo(w.y), bfhi(w.y)}; r.b = (f32x4){bflo(w.z), bfhi(w.z), bflo(w.w), bfhi(w.w)}; return r; }
__device__ __forceinline__ u32x4 pk8(const f32x4 a, const f32x4 b) { u32x4 w; w.x = cvt_pk_bf16(a[0], a[1]); w.y = cvt_pk_bf16(a[2], a[3]); w.z = cvt_pk_bf16(b[0], b[1]); w.w = cvt_pk_bf16(b[2], b[3]); return w; }
__device__ __forceinline__ F8 hs8m(const Frame& F, const bf16_t* HRW, int m, const RowInfo& ri, int col, const f32x4 mua, const f32x4 mub) {
    const F8 h = ld_bf8(HRW + (size_t)m * DSH + col);
    F8 hp;
    if (ri.t == 0) {
        if (ri.samp) { hp.a = *(const f32x4*)(F.in[4] + (size_t)ri.b * DSH + col); hp.b = *(const f32x4*)(F.in[4] + (size_t)ri.b * DSH + col + 4); }
        else { hp.a = (f32x4){0.f, 0.f, 0.f, 0.f}; hp.b = (f32x4){0.f, 0.f, 0.f, 0.f}; }
    } else hp = ld_bf8(HRW + (size_t)(m - 1) * DSH + col);
    F8 r; r.a = h.a + (hp.a - h.a) * mua; r.b = h.b + (hp.b - h.b) * mub; return r;
}
__device__ __forceinline__ F8 hs8(const Frame& F, const bf16_t* HRW, int m, const RowInfo& ri, int col) {
    const F8 h = ld_bf8(HRW + (size_t)m * DSH + col);
    F8 hp;
    if (ri.t == 0) {
        if (ri.samp) { hp.a = *(const f32x4*)(F.in[4] + (size_t)ri.b * DSH + col); hp.b = *(const f32x4*)(F.in[4] + (size_t)ri.b * DSH + col + 4); }
        else { hp.a = (f32x4){0.f, 0.f, 0.f, 0.f}; hp.b = (f32x4){0.f, 0.f, 0.f, 0.f}; }
    } else hp = ld_bf8(HRW + (size_t)(m - 1) * DSH + col);
    const f32x4 mua = *(const f32x4*)(F.in[10] + col), mub = *(const f32x4*)(F.in[10] + col + 4);
    F8 r; r.a = h.a + (hp.a - h.a) * mua; r.b = h.b + (hp.b - h.b) * mub; return r;
}
__device__ __forceinline__ float xsum_fq(float v) {
    { auto r = __builtin_amdgcn_permlane16_swap(__float_as_uint(v), __float_as_uint(v), false, false); v = __uint_as_float(r[0]) + __uint_as_float(r[1]); }
    { auto r = __builtin_amdgcn_permlane32_swap(__float_as_uint(v), __float_as_uint(v), false, false); v = __uint_as_float(r[0]) + __uint_as_float(r[1]); }
    return v;
}
__device__ __forceinline__ u32x2 pk4(const f32x4 v) { u32x2 w; w.x = cvt_pk_bf16(v[0], v[1]); w.y = cvt_pk_bf16(v[2], v[3]); return w; }
__device__ __forceinline__ bf16x8 wfrag(const float* W, int k0, int fq, int ch) {
    u32x4 w; const float* p = W + (size_t)(k0 + 8 * fq) * 512 + ch;
    w.x = cvt_pk_bf16(p[0], p[512]); w.y = cvt_pk_bf16(p[1024], p[1536]); w.z = cvt_pk_bf16(p[2048], p[2560]); w.w = cvt_pk_bf16(p[3072], p[3584]);
    return __builtin_bit_cast(bf16x8, w);
}
#ifndef PREP_DUP
#define PREP_DUP 1
#endif
#ifndef POST_DUP
#define POST_DUP 1
#endif
__device__ __forceinline__ void prep_phase(Frame& F) {
    const bf16_t* HRW = (const bf16_t*)(F.ws + WS_HRW);
    bf16_t* SR = (bf16_t*)(F.ws + WS_SR); bf16_t* SK = (bf16_t*)(F.ws + WS_SK); bf16_t* SV = (bf16_t*)(F.ws + WS_SV);
    bf16_t* SKK = (bf16_t*)(F.ws + WS_SKK); bf16_t* SB = (bf16_t*)(F.ws + WS_SB); float* SW = (float*)(F.ws + WS_SW);
    const int fr = F.lane & 15, fq = F.lane >> 4, h = F.wave;
    bf16x8 Aw[4], Aa[4];
#pragma unroll
    for (int nt = 0; nt < 4; ++nt) { const int ch = h * 64 + 16 * (fr >> 2) + 4 * nt + (fr & 3); Aw[nt] = wfrag(F.in[12], 0, fq, ch); Aa[nt] = wfrag(F.in[14], 0, fq, ch); }
    constexpr int NTILE = M / 16;
    f32x4 pw0[4], pa0[4], pkk[4], pka[4];
    f32x4 pmu[3][4];
#pragma unroll
    for (int st = 0; st < 3; ++st)
#pragma unroll
        for (int i = 0; i < 4; ++i) pmu[st][i] = *(const f32x4*)(F.in[10] + st * 512 + h * 64 + 16 * fq + 4 * i);
#pragma unroll
    for (int i = 0; i < 4; ++i) { const int c4 = h * 64 + 16 * fq + 4 * i; pw0[i] = *(const f32x4*)(F.in[11] + c4); pa0[i] = *(const f32x4*)(F.in[13] + c4); pkk[i] = *(const f32x4*)(F.in[16] + c4); pka[i] = *(const f32x4*)(F.in[17] + c4); }
    for (int tile_ = F.bid; tile_ < NTILE * PREP_DUP; tile_ += F.G) {
        const int m = (tile_ % NTILE) * 16 + fr;
        const RowInfo ri = row_info(m);
        bf16x8 xw, xa;
        { const F8 a = hs8(F, HRW, m, ri, 1536 + 8 * fq);
          f32x4 t0, t1;
#pragma unroll
          for (int i = 0; i < 4; ++i) { t0[i] = 1.f - 2.f * __builtin_amdgcn_rcpf(__expf(2.f * a.a[i]) + 1.f); t1[i] = 1.f - 2.f * __builtin_amdgcn_rcpf(__expf(2.f * a.b[i]) + 1.f); }
          xw = __builtin_bit_cast(bf16x8, pk8(t0, t1)); }
        { const F8 a = hs8(F, HRW, m, ri, 1568 + 8 * fq); xa = __builtin_bit_cast(bf16x8, pk8(a.a, a.b)); }
        f32x4 kkr[4], av[4]; float ss = 0.f;
#pragma unroll
        for (int np = 0; np < 2; ++np) {
            const int c8 = h * 64 + 16 * fq + 8 * np;
            const f32x4 z = {0.f, 0.f, 0.f, 0.f};
            f32x4 accw[2], acca[2];
#pragma unroll
            for (int q = 0; q < 2; ++q) { accw[q] = __builtin_amdgcn_mfma_f32_16x16x32_bf16(Aw[2 * np + q], xw, z, 0, 0, 0); acca[q] = __builtin_amdgcn_mfma_f32_16x16x32_bf16(Aa[2 * np + q], xa, z, 0, 0, 0); }
            const F8 r8 = hs8m(F, HRW, m, ri, c8, pmu[0][2 * np], pmu[0][2 * np + 1]), k8 = hs8m(F, HRW, m, ri, 512 + c8, pmu[1][2 * np], pmu[1][2 * np + 1]), v8 = hs8m(F, HRW, m, ri, 1024 + c8, pmu[2][2 * np], pmu[2][2 * np + 1]);
            f32x4 dec[2], k2[2];
#pragma unroll
            for (int q = 0; q < 2; ++q) {
                const f32x4 k = q ? k8.b : k8.a;
                const f32x4 w0 = pw0[2 * np + q], a0 = pa0[2 * np + q], kkc = pkk[2 * np + q], kac = pka[2 * np + q];
                f32x4 a;
#pragma unroll
                for (int j = 0; j < 4; ++j) {
                    const float x = -(w0[j] + accw[q][j]);
                    const float sp = fmaxf(x, 0.f) + __logf(1.f + __expf(-fabsf(x)));
                    dec[q][j] = __expf(-__expf(-sp - 0.5f));
                    a[j] = sigmoidf_(a0[j] + acca[q][j]);
                    k2[q][j] = k[j] * (1.f + (a[j] - 1.f) * kac[j]);
                }
                const f32x4 kk = k * kkc;
                ss += (kk[0] * kk[0] + kk[1] * kk[1]) + (kk[2] * kk[2] + kk[3] * kk[3]);
                kkr[2 * np + q] = kk; av[2 * np + q] = a;
            }
            const size_t o = (size_t)m * 512 + c8;
            *(f32x4*)(SW + o) = dec[0]; *(f32x4*)(SW + o + 4) = dec[1];
            *(u32x4*)(SR + o) = pk8(r8.a, r8.b); *(u32x4*)(SK + o) = pk8(k2[0], k2[1]); *(u32x4*)(SV + o) = pk8(v8.a, v8.b);
        }
        ss = xsum_fq(ss);
        const float rs = rsqrtf(fmaxf(ss, 1e-24f));
#pragma unroll
        for (int np = 0; np < 2; ++np) {
            const size_t o = (size_t)m * 512 + h * 64 + 16 * fq + 8 * np;
            const f32x4 ka = kkr[2 * np] * rs, kb = kkr[2 * np + 1] * rs;
            *(u32x4*)(SKK + o) = pk8(ka, kb); *(u32x4*)(SB + o) = pk8(ka * av[2 * np], kb * av[2 * np + 1]);
        }
    }
}

__device__ __forceinline__ void sample_attn_phase(Frame& F) {
    constexpr int NK = WIN + DT, KS = 68;
    LAS float* Kl = (LAS float*)F.lds;
    LAS float* Vl = Kl + NK * KS;
    LAS float* Pl = Vl + NK * KS;
    const bf16_t* Q = (const bf16_t*)(F.ws + WS_Q);
    bf16_t* OC = (bf16_t*)(F.ws + WS_OCAT);
    for (int unit = F.bid; unit < DB * 2; unit += F.G) {
        const int b = unit >> 1, kvh = unit & 1;
        for (int e = F.tid; e < NK * 16; e += NT) {
            const int key = e >> 4, d4 = (e & 15) * 4;
            f32x4 kv, vv;
            if (key < WIN) { kv = *(const f32x4*)(F.in[2] + ((size_t)(b * WIN + key) * 2 + kvh) * 64 + d4); vv = *(const f32x4*)(F.in[3] + ((size_t)(b * WIN + key) * 2 + kvh) * 64 + d4); }
            else { kv = *(const f32x4*)(F.out + O_KWS + ((size_t)(b * WIN + key - DT) * 2 + kvh) * 64 + d4); vv = *(const f32x4*)(F.out + O_VWS + ((size_t)(b * WIN + key - DT) * 2 + kvh) * 64 + d4); }
            *(LAS f32x4*)(Kl + key * KS + d4) = kv; *(LAS f32x4*)(Vl + key * KS + d4) = vv;
            if (key >= DT && key < WIN) { *(f32x4*)(F.out + O_KWS + ((size_t)(b * WIN + key - DT) * 2 + kvh) * 64 + d4) = kv; *(f32x4*)(F.out + O_VWS + ((size_t)(b * WIN + key - DT) * 2 + kvh) * 64 + d4) = vv; }
        }
        __syncthreads();
        const int qi = F.tid >> 4, sub = F.tid & 15;
        const int t = qi >> 2, g = qi & 3, head = kvh * 4 + g;
        const int m = MP + b * DT + t;
        float mx = F.in[9][head] * 1.4426950408889634f;
        {
            const bf16_t* qp = Q + (size_t)m * 512 + head * 64;
            float q[64];
#pragma unroll
            for (int i = 0; i < 8; ++i) { const u32x4 w = *(const u32x4*)(qp + 8 * i); q[8 * i] = bflo(w.x); q[8 * i + 1] = bfhi(w.x); q[8 * i + 2] = bflo(w.y); q[8 * i + 3] = bfhi(w.y); q[8 * i + 4] = bflo(w.z); q[8 * i + 5] = bfhi(w.z); q[8 * i + 6] = bflo(w.w); q[8 * i + 7] = bfhi(w.w); }
#pragma unroll 1
            for (int key = sub; key < NK; key += 16) {
                float a = 0.f; const LAS f32x4* kr = (const LAS f32x4*)(Kl + key * KS);
#pragma unroll
                for (int i = 0; i < 16; ++i) { const f32x4 kx = kr[i]; a += q[4 * i] * kx[0] + q[4 * i + 1] * kx[1] + q[4 * i + 2] * kx[2] + q[4 * i + 3] * kx[3]; }
                const int dist = t + WIN - key;
                const float s = (dist >= 0 && dist <= WIN) ? a : -1e30f;
                Pl[qi * NK + key] = s; mx = fmaxf(mx, s);
            }
        }
        mx = fmaxf(mx, __shfl_xor(mx, 1)); mx = fmaxf(mx, __shfl_xor(mx, 2)); mx = fmaxf(mx, __shfl_xor(mx, 4)); mx = fmaxf(mx, __shfl_xor(mx, 8));
        float sum = 0.f;
#pragma unroll 1
        for (int key = sub; key < NK; key += 16) { const float sv = Pl[qi * NK + key]; const float p = sv > -1e29f ? __builtin_amdgcn_exp2f(sv - mx) : 0.f; sum += p; Pl[qi * NK + key] = p; }
        sum += __shfl_xor(sum, 1); sum += __shfl_xor(sum, 2); sum += __shfl_xor(sum, 4); sum += __shfl_xor(sum, 8);
        const float inv = __builtin_amdgcn_rcpf(sum + __builtin_amdgcn_exp2f(F.in[9][head] * 1.4426950408889634f - mx));
        __syncthreads();
        f32x4 o = {0.f, 0.f, 0.f, 0.f};
        for (int key = 0; key < NK; ++key) { const float p = Pl[qi * NK + key]; const f32x4 vv = *(const LAS f32x4*)(Vl + key * KS + sub * 4); o += vv * p; }
        o = o * inv;
        u32x2 w; w.x = pk2(o[0], o[1]); w.y = pk2(o[2], o[3]);
        *(u32x2*)(OC + (size_t)m * DM + head * 64 + sub * 4) = w;
        __syncthreads();
    }
}

__device__ __forceinline__ void prompt_attn_unit(Frame& F, int unit) {
    constexpr int KST = 144, VST = 528;
    LAS unsigned char* Kl = F.lds; LAS unsigned char* Vl = F.lds + 256 * KST;
    const bf16_t* Q = (const bf16_t*)(F.ws + WS_Q); const bf16_t* Kb = (const bf16_t*)(F.ws + WS_K); const bf16_t* VT = (const bf16_t*)(F.ws + WS_VT);
    bf16_t* OC = (bf16_t*)(F.ws + WS_OCAT);
    const int kvh = unit & 1, qb = (unit >> 1) & 63, b = unit >> 7;
    const int key0 = (qb - 1) * 128;
    for (int e = F.tid; e < 256 * 8; e += NT) {
        const int key = e >> 3, ch = e & 7; const int pos = key0 + key;
        u32x4 v = {0u, 0u, 0u, 0u};
        if (pos >= 0) v = *(const u32x4*)(Kb + (size_t)(b * T + pos) * 128 + kvh * 64 + ch * 8);
        *(LAS u32x4*)(Kl + key * KST + ch * 16) = v;
    }
    for (int e = F.tid; e < 64 * 32; e += NT) {
        const int d = e >> 5, ch = e & 31; const int pos = key0 + ch * 8;
        u32x4 v = {0u, 0u, 0u, 0u};
        if (pos >= 0) v = *(const u32x4*)(VT + ((size_t)(b * 2 + kvh) * 64 + d) * T + pos);
        *(LAS u32x4*)(Vl + d * VST + ch * 16) = v;
    }
    __syncthreads();
    const int fr = F.lane & 15, fq = F.lane >> 4;
    const int head = kvh * 4 + (F.wave >> 1);
    const float sink = F.in[9][head] * 1.4426950408889634f;
#pragma unroll 1
    for (int sb = 0; sb < 4; ++sb) {
        const int qi0 = (F.wave & 1) * 64 + sb * 16;
        const int qi = qi0 + fr;
        const size_t mrow = (size_t)b * T + qb * 128 + qi;
        const bf16x8 q0 = *(const bf16x8*)(Q + mrow * 512 + head * 64 + fq * 8);
        const bf16x8 q1 = *(const bf16x8*)(Q + mrow * 512 + head * 64 + 32 + fq * 8);
        const int ktlo = (F.wave & 1) * 4 + sb;
        f32x4 s[9];
#pragma unroll
        for (int kr = 0; kr < 9; ++kr) {
            const int kt = ktlo + kr;
            const bf16x8 k0 = *(const LAS bf16x8*)(Kl + (kt * 16 + fr) * KST + fq * 16);
            const bf16x8 k1 = *(const LAS bf16x8*)(Kl + (kt * 16 + fr) * KST + 64 + fq * 16);
            f32x4 a = {0.f, 0.f, 0.f, 0.f};
            a = __builtin_amdgcn_mfma_f32_16x16x32_bf16(k0, q0, a, 0, 0, 0);
            a = __builtin_amdgcn_mfma_f32_16x16x32_bf16(k1, q1, a, 0, 0, 0);
            s[kr] = a;
        }
        float mx = sink;
#pragma unroll
        for (int kr = 0; kr < 9; ++kr)
#pragma unroll
            for (int j = 0; j < 4; ++j) { const int sj = (ktlo + kr) * 16 + fq * 4 + j; const int dist = qi + 128 - sj; const bool ok = dist >= 0 && dist <= WIN && (key0 + sj) >= 0; const float v = ok ? s[kr][j] : -1e30f; s[kr][j] = v; mx = fmaxf(mx, v); }
        mx = fmaxf(mx, __shfl_xor(mx, 16)); mx = fmaxf(mx, __shfl_xor(mx, 32));
        float sum = 0.f;
        u32x2 pw[10];
#pragma unroll
        for (int kr = 0; kr < 9; ++kr) {
            f32x4 p;
#pragma unroll
            for (int j = 0; j < 4; ++j) { p[j] = s[kr][j] > -1e29f ? __builtin_amdgcn_exp2f(s[kr][j] - mx) : 0.f; sum += p[j]; }
            pw[kr].x = cvt_pk_bf16(p[0], p[1]); pw[kr].y = cvt_pk_bf16(p[2], p[3]);
        }
        pw[9].x = 0u; pw[9].y = 0u;
        sum += __shfl_xor(sum, 16); sum += __shfl_xor(sum, 32);
        const float inv = __builtin_amdgcn_rcpf(sum + __builtin_amdgcn_exp2f(sink - mx));
        f32x4 o[4];
#pragma unroll
        for (int dt = 0; dt < 4; ++dt) o[dt] = (f32x4){0.f, 0.f, 0.f, 0.f};
#pragma unroll
        for (int u = 0; u < 5; ++u) {
            u32x4 pb; pb.x = pw[2 * u].x; pb.y = pw[2 * u].y; pb.z = pw[2 * u + 1].x; pb.w = pw[2 * u + 1].y;
            const bf16x8 pf = __builtin_bit_cast(bf16x8, pb);
            const int kta = ktlo + 2 * u, ktb = u < 4 ? kta + 1 : kta;
#pragma unroll
            for (int dt = 0; dt < 4; ++dt) {
                const LAS unsigned char* vr = Vl + (dt * 16 + fr) * VST + (fq * 4) * 2;
                const u32x2 va = *(const LAS u32x2*)(vr + kta * 32), vb = *(const LAS u32x2*)(vr + ktb * 32);
                u32x4 vv; vv.x = va.x; vv.y = va.y; vv.z = vb.x; vv.w = vb.y;
                o[dt] = __builtin_amdgcn_mfma_f32_16x16x32_bf16(__builtin_bit_cast(bf16x8, vv), pf, o[dt], 0, 0, 0);
            }
        }
#pragma unroll
        for (int dt = 0; dt < 4; ++dt) { const f32x4 v = o[dt] * inv; u32x2 w; w.x = cvt_pk_bf16(v[0], v[1]); w.y = cvt_pk_bf16(v[2], v[3]); *(u32x2*)(OC + mrow * DM + head * 64 + dt * 16 + fq * 4) = w; }
    }
    __syncthreads();
}

struct StepOps { f32x4 w, nbe, kk, k, r; float v; };
template <int STRIDE_F> __device__ __forceinline__ StepOps load_ops(const LAS float* img, int s, int cgi, int vrow) {
    const LAS float* p = img + s * STRIDE_F + cgi * 4; StepOps o;
    o.w = *(const LAS f32x4*)(p); o.nbe = *(const LAS f32x4*)(p + 64); o.kk = *(const LAS f32x4*)(p + 128); o.k = *(const LAS f32x4*)(p + 192); o.r = *(const LAS f32x4*)(p + 256);
    o.v = img[s * STRIDE_F + 320 + vrow]; return o;
}
template <int J> __device__ __forceinline__ float sel_lane16(float oldv, float newv) {
    float r; const unsigned long long m = 0x0001000100010001ull << J;
    asm("v_cndmask_b32_e64 %0, %1, %2, %3" : "=v"(r) : "v"(oldv), "v"(newv), "s"(m));
    return r;
}
struct ScanState { f32x2 s01, s23; float ykeep, ypart; StepOps c0, c1; };
template <int STRIDE_F, int J>
__device__ __forceinline__ void scan_step(const LAS float* img, int s0, int vrow, int cgi, ScanState& Z) {
    const StepOps nx = load_ops<STRIDE_F>(img, s0 + J + 2, cgi, vrow);
    const StepOps& c = Z.c0;
    const f32x2 kk01 = {c.kk[0], c.kk[1]}, kk23 = {c.kk[2], c.kk[3]}, w01 = {c.w[0], c.w[1]}, w23 = {c.w[2], c.w[3]}, k01 = {c.k[0], c.k[1]}, k23 = {c.k[2], c.k[3]};
    const f32x2 b01 = {c.nbe[0], c.nbe[1]}, b23 = {c.nbe[2], c.nbe[3]}, r01 = {c.r[0], c.r[1]}, r23 = {c.r[2], c.r[3]};
    f32x2 t = Z.s01 * kk01; t = Z.s23 * kk23 + t;
    float sa = t.x + t.y;
    const f32x2 u01 = Z.s01 * w01 + k01 * c.v, u23 = Z.s23 * w23 + k23 * c.v;
    if (J > 0) { allsum16_2(sa, Z.ypart); Z.ykeep = sel_lane16<(J > 0 ? J - 1 : 0)>(Z.ykeep, Z.ypart); } else sa = allsum16(sa);
    Z.s01 = b01 * sa + u01; Z.s23 = b23 * sa + u23;
    f32x2 y2 = Z.s01 * r01; y2 = Z.s23 * r23 + y2;
    Z.ypart = y2.x + y2.y;
    Z.c0 = Z.c1; Z.c1 = nx;
}
template <int STRIDE_F, int GS, int... Js>
__device__ __forceinline__ void scan_group_impl(const LAS float* img, int s0, int vrow, int cgi, ScanState& Z, float* yout, std::integer_sequence<int, Js...>) {
    (scan_step<STRIDE_F, Js>(img, s0, vrow, cgi, Z), ...);
    Z.ypart = allsum16(Z.ypart); Z.ykeep = sel_lane16<GS - 1>(Z.ykeep, Z.ypart);
    if (cgi < GS) yout[(size_t)(s0 + cgi) * 512] = Z.ykeep;
}
template <int STRIDE_F, int J>
__device__ __forceinline__ void scan_step_yp(const LAS float* img, int s0, int vrow, int cgi, ScanState& Z, LAS float* ypb) {
    const StepOps nx = load_ops<STRIDE_F>(img, s0 + J + 2, cgi, vrow);
    const StepOps& c = Z.c0;
    const f32x2 kk01 = {c.kk[0], c.kk[1]}, kk23 = {c.kk[2], c.kk[3]}, w01 = {c.w[0], c.w[1]}, w23 = {c.w[2], c.w[3]}, k01 = {c.k[0], c.k[1]}, k23 = {c.k[2], c.k[3]};
    const f32x2 b01 = {c.nbe[0], c.nbe[1]}, b23 = {c.nbe[2], c.nbe[3]}, r01 = {c.r[0], c.r[1]}, r23 = {c.r[2], c.r[3]};
    f32x2 t = Z.s01 * kk01; t = Z.s23 * kk23 + t;
    float sa = t.x + t.y;
    const f32x2 u01 = Z.s01 * w01 + k01 * c.v, u23 = Z.s23 * w23 + k23 * c.v;
    sa = allsum16(sa);
    Z.s01 = b01 * sa + u01; Z.s23 = b23 * sa + u23;
    f32x2 y2 = Z.s01 * r01; y2 = Z.s23 * r23 + y2;
    ypb[(s0 + J) * 64] = y2.x + y2.y;
    Z.c0 = Z.c1; Z.c1 = nx;
}
struct StepOpsS { f32x4 nbe, kk, k, r; };
template <int STRIDE_F> __device__ __forceinline__ StepOpsS load_ops_s(const LAS float* img, int s, int cgi) {
    const LAS float* p = img + s * STRIDE_F + cgi * 4; StepOpsS o;
    o.nbe = *(const LAS f32x4*)(p + 64); o.kk = *(const LAS f32x4*)(p + 128); o.k = *(const LAS f32x4*)(p + 192); o.r = *(const LAS f32x4*)(p + 256);
    return o;
}
struct ScanT { f32x2 t01, t23; StepOpsS c0, c1; f32x4 v4[4]; };
template <int STRIDE_F, int J>
__device__ __forceinline__ void scan_step_s(const LAS float* img, int cgi, ScanT& Z, LAS float* ypb) {
    const StepOpsS nx = load_ops_s<STRIDE_F>(img, J + 2, cgi);
    const StepOpsS& c = Z.c0;
    const float v = Z.v4[J >> 2][J & 3];
    f32x2 t = Z.t01 * (f32x2){c.kk[0], c.kk[1]}; t = Z.t23 * (f32x2){c.kk[2], c.kk[3]} + t;
    float sa = t.x + t.y;
    const f32x2 a01 = (f32x2){c.k[0], c.k[1]} * v + Z.t01, a23 = (f32x2){c.k[2], c.k[3]} * v + Z.t23;
    sa = allsum16(sa);
    Z.t01 = (f32x2){c.nbe[0], c.nbe[1]} * sa + a01; Z.t23 = (f32x2){c.nbe[2], c.nbe[3]} * sa + a23;
    f32x2 y2 = Z.t01 * (f32x2){c.r[0], c.r[1]}; y2 = Z.t23 * (f32x2){c.r[2], c.r[3]} + y2;
    ypb[J * 64] = y2.x + y2.y;
    Z.c0 = Z.c1; Z.c1 = nx;
}
template <int STRIDE_F, int... Js>
__device__ __forceinline__ void scan_chunk_s_impl(const LAS float* img, int cgi, ScanT& Z, LAS float* ypb, std::integer_sequence<int, Js...>) {
    (scan_step_s<STRIDE_F, Js>(img, cgi, Z, ypb), ...);
}
template <int STRIDE_F, int NS>
__device__ __forceinline__ void scan_transform(LAS float* img, int lane) {
    LAS float* p = img + lane; float Wc = 1.f;
#pragma unroll
    for (int t = 0; t < NS; ++t, p += STRIDE_F) {
        const float w = p[0], nb = p[64], kk = p[128], k = p[192], r = p[256];
        p[128] = Wc * kk;
        Wc *= w; const float inv = __builtin_amdgcn_rcpf(Wc);
        p[64] = nb * inv; p[192] = k * inv; p[256] = Wc * r;
    }
    img[(NS - 1) * STRIDE_F + lane] = Wc;
}
template <int STRIDE_F, int... Js>
__device__ __forceinline__ void scan_group_yp_impl(const LAS float* img, int s0, int vrow, int cgi, ScanState& Z, LAS float* ypb, std::integer_sequence<int, Js...>) {
    (scan_step_yp<STRIDE_F, Js>(img, s0, vrow, cgi, Z, ypb), ...);
}
template <int... Js>
__device__ __forceinline__ void yp_reduce_impl(const LAS float* ypb, int cgi, float* yout, int s0, std::integer_sequence<int, Js...>) {
    float ykeep = 0.f;
    ((ykeep = sel_lane16<Js>(ykeep, allsum16(ypb[(s0 + Js) * 64]))), ...);
    yout[(size_t)(s0 + cgi) * 512] = ykeep;
}
template <int STRIDE_F, int GS>
__device__ __forceinline__ void scan_group(const LAS float* img, int s0, int vrow, int cgi, ScanState& Z, float* yout) {
    scan_group_impl<STRIDE_F, GS>(img, s0, vrow, cgi, Z, yout, std::make_integer_sequence<int, GS>());
}
constexpr int SC = 32;
constexpr int PSTR = 328;
constexpr int SSTR = 384;
struct ScanRegs { f32x4 w[2]; u32x4 b0[2], b1[2]; u32x4 v; };
__device__ __forceinline__ void scan_load(const Frame& F, ScanRegs& R, int m0, int h, int v0) {
    if (F.wave < 4) return;
    const int vt = F.tid - 256;
#pragma unroll
    for (int i = 0; i < 2; ++i) {
        const int tid = vt + 256 * i;
        { const int row = tid >> 4, c4 = (tid & 15) * 4; R.w[i] = *(const f32x4*)((const float*)(F.ws + WS_SW) + (size_t)(m0 + row) * 512 + h * 64 + c4); }
        { const int st = tid >> 7, row = (tid & 127) >> 2, seg = tid & 3;
          const size_t base = st == 0 ? WS_SB : st == 1 ? WS_SKK : st == 2 ? WS_SK : WS_SR;
          const bf16_t* p = (const bf16_t*)(F.ws + base) + (size_t)(m0 + row) * 512 + h * 64 + seg * 16;
          R.b0[i] = *(const u32x4*)p; R.b1[i] = *(const u32x4*)(p + 8); }
    }
    { R.v = *(const u32x4*)((const bf16_t*)(F.ws + WS_SV) + (size_t)(m0 + (vt & 31)) * 512 + h * 64 + v0); }
}
__device__ __forceinline__ void scan_store(const Frame& F, const ScanRegs& R, LAS float* img) {
    if (F.wave < 4) return;
    const int vt = F.tid - 256;
#pragma unroll
    for (int i = 0; i < 2; ++i) {
        const int tid = vt + 256 * i;
        { const int row = tid >> 4, c4 = (tid & 15) * 4; *(LAS f32x4*)(img + row * PSTR + c4) = R.w[i]; }
        { const int st = tid >> 7, row = (tid & 127) >> 2, seg = tid & 3;
          LAS float* d = img + row * PSTR + 64 + st * 64 + seg * 16;
          const float sg = st == 0 ? -1.f : 1.f; const u32x4 b0 = R.b0[i], b1 = R.b1[i];
          *(LAS f32x4*)(d) = (f32x4){bflo(b0.x), bfhi(b0.x), bflo(b0.y), bfhi(b0.y)} * sg; *(LAS f32x4*)(d + 4) = (f32x4){bflo(b0.z), bfhi(b0.z), bflo(b0.w), bfhi(b0.w)} * sg;
          *(LAS f32x4*)(d + 8) = (f32x4){bflo(b1.x), bfhi(b1.x), bflo(b1.y), bfhi(b1.y)} * sg; *(LAS f32x4*)(d + 12) = (f32x4){bflo(b1.z), bfhi(b1.z), bflo(b1.w), bfhi(b1.w)} * sg; }
    }
    if (vt < 32) { LAS float* d = img + SC * PSTR + vt;
      d[0 * SC] = bflo(R.v.x); d[1 * SC] = bfhi(R.v.x); d[2 * SC] = bflo(R.v.y); d[3 * SC] = bfhi(R.v.y); d[4 * SC] = bflo(R.v.z); d[5 * SC] = bfhi(R.v.z); d[6 * SC] = bflo(R.v.w); d[7 * SC] = bfhi(R.v.w); }
}
constexpr int NSW = 2;
__device__ __forceinline__ void prompt_scan(Frame& F, int sblk) {
    const int xcd = sblk & 7, k = sblk >> 3;
    const int chain = xcd * 4 + (k >> 3), rg = k & 7;
    const int b = chain >> 3, h = chain & 7, v0 = rg * 8;
    LAS float* img = (LAS float*)F.lds;
    constexpr int IMG = SC * PSTR + 8 * SC;
    const int rl = F.lane >> 4, cgi = F.lane & 15;
    const int vrow = F.wave * 4 + rl;
    float* Y = F.out;
    ScanState Z; Z.s01 = (f32x2){0.f, 0.f}; Z.s23 = (f32x2){0.f, 0.f}; Z.ykeep = 0.f; Z.ypart = 0.f;
    ScanRegs R0, R1, R2, R3;
    const int mbase = b * T;
    constexpr int NCH = T / SC;
#ifndef SCAN_DUP
#define SCAN_DUP 1
#endif
    constexpr int NTOT = NCH * SCAN_DUP;
    scan_load(F, R0, mbase, h, v0); scan_store(F, R0, img);
    scan_load(F, R1, mbase + SC, h, v0); scan_store(F, R1, img + IMG);
    scan_load(F, R2, mbase + 2 * SC, h, v0); scan_load(F, R3, mbase + 3 * SC, h, v0);
    __syncthreads();
    if (F.wave == 4 || F.wave == 5) scan_transform<PSTR, 16>(img + (F.wave - 4) * 16 * PSTR, F.lane);
    __syncthreads();
    LAS float* ypr = (LAS float*)(F.lds + YP_OFF);
#define SCAN_CHUNK(cc_) do { const int c_ = (cc_) % NCH; \
        if (SCAN_DUP > 1 && c_ == 0) { Z.s01 = (f32x2){0.f, 0.f}; Z.s23 = (f32x2){0.f, 0.f}; } \
        if (F.wave < NSW) { const LAS float* im = img + ((cc_) % 3) * IMG; LAS float* ypb = ypr + (((cc_) & 1) * NSW + F.wave) * (SC * 64) + F.lane; \
            const LAS float* vtp = im + SC * PSTR + vrow * SC; \
            ScanT Tz; Tz.t01 = Z.s01; Tz.t23 = Z.s23; Tz.c0 = load_ops_s<PSTR>(im, 0, cgi); Tz.c1 = load_ops_s<PSTR>(im, 1, cgi); \
            _Pragma("unroll") for (int q_ = 0; q_ < 4; ++q_) Tz.v4[q_] = *(const LAS f32x4*)(vtp + 4 * q_); \
            scan_chunk_s_impl<PSTR>(im, cgi, Tz, ypb, std::make_integer_sequence<int, 16>()); \
            { const f32x4 wce = *(const LAS f32x4*)(im + 15 * PSTR + cgi * 4); Tz.t01 = Tz.t01 * (f32x2){wce[0], wce[1]}; Tz.t23 = Tz.t23 * (f32x2){wce[2], wce[3]}; } \
            _Pragma("unroll") for (int q_ = 0; q_ < 4; ++q_) Tz.v4[q_] = *(const LAS f32x4*)(vtp + 16 + 4 * q_); \
            scan_chunk_s_impl<PSTR>(im + 16 * PSTR, cgi, Tz, ypb + 16 * 64, std::make_integer_sequence<int, 16>()); \
            { const f32x4 wce = *(const LAS f32x4*)(im + 31 * PSTR + cgi * 4); Z.s01 = Tz.t01 * (f32x2){wce[0], wce[1]}; Z.s23 = Tz.t23 * (f32x2){wce[2], wce[3]}; } } \
        else if (F.wave < 2 * NSW && (cc_) > 0) { const int sw_ = F.wave - NSW, cp_ = ((cc_) - 1) % NCH; \
            const LAS float* ypb = ypr + ((((cc_) - 1) & 1) * NSW + sw_) * (SC * 64) + F.lane; float* yo = Y + (size_t)(mbase + cp_ * SC) * 512 + h * 64 + v0 + sw_ * 4 + rl; \
            yp_reduce_impl(ypb, cgi, yo, 0, std::make_integer_sequence<int, 16>()); yp_reduce_impl(ypb, cgi, yo, 16, std::make_integer_sequence<int, 16>()); } \
        else if ((F.wave == 4 || F.wave == 5) && (cc_) + 1 < NTOT) scan_transform<PSTR, 16>(img + (((cc_) + 1) % 3) * IMG + (F.wave - 4) * 16 * PSTR, F.lane); } while (0)
#define SCAN_ITER(j_, RL_, RS_) do { const int c4_ = cc + (j_); \
        scan_load(F, RL_, mbase + ((c4_ + 4 < NTOT ? c4_ + 4 : NTOT - 1) % NCH) * SC, h, v0);        \
        SCAN_CHUNK(c4_); \
        if (c4_ + 2 < NTOT) scan_store(F, RS_, img + ((c4_ + 2) % 3) * IMG);                         \
        asm volatile("s_waitcnt lgkmcnt(0)\n\ts_barrier" ::: "memory"); } while (0)
#pragma unroll 1
    for (int cc = 0; cc < NTOT; cc += 4) {
        SCAN_ITER(0, R0, R2); SCAN_ITER(1, R1, R3); SCAN_ITER(2, R2, R0); SCAN_ITER(3, R3, R1);
    }
#undef SCAN_ITER
#undef SCAN_CHUNK
    if (F.wave >= NSW && F.wave < 2 * NSW) { const int sw_ = F.wave - NSW, cp_ = (NTOT - 1) % NCH;
        const LAS float* ypb = ypr + (((NTOT - 1) & 1) * NSW + sw_) * (SC * 64) + F.lane; float* yo = Y + (size_t)(mbase + cp_ * SC) * 512 + h * 64 + v0 + sw_ * 4 + rl;
        yp_reduce_impl(ypb, cgi, yo, 0, std::make_integer_sequence<int, 16>()); yp_reduce_impl(ypb, cgi, yo, 16, std::make_integer_sequence<int, 16>()); }
    __syncthreads();
    if (F.wave < NSW) *(f32x4*)(F.out + O_WKVP + ((size_t)(b * 8 + h) * 64 + v0 + vrow) * 64 + cgi * 4) = (f32x4){Z.s01.x, Z.s01.y, Z.s23.x, Z.s23.y};
}
__device__ __forceinline__ void sample_scan(Frame& F, int sblk, int nsblk) {
    LAS float* img = (LAS float*)F.lds;
    float* Y = F.out;
    const int rl = F.lane >> 4, cgi = F.lane & 15;
    for (int chain = sblk; chain < DB * 8; chain += nsblk) {
        const int b = chain >> 3, h = chain & 7; const int m0 = MP + b * DT;
        for (int e = F.tid; e < 6 * DT * 64; e += NT) {
            const int st = e >> 9, row = (e >> 6) & 7, ch = e & 63; const size_t o = (size_t)(m0 + row) * 512 + h * 64 + ch;
            float val;
            if (st == 0) val = ((const float*)(F.ws + WS_SW))[o];
            else { const size_t base = st == 1 ? WS_SB : st == 2 ? WS_SKK : st == 3 ? WS_SK : st == 4 ? WS_SR : WS_SV; val = bf2f(((const bf16_t*)(F.ws + base))[o]); if (st == 1) val = -val; }
            img[row * SSTR + st * 64 + ch] = val;
        }
        __syncthreads();
#pragma unroll 1
        for (int rnd = 0; rnd < 2; ++rnd) {
            const int vrow = (rnd * 8 + F.wave) * 4 + rl;
            const float* s0 = F.in[5] + ((size_t)chain * 64 + vrow) * 64 + cgi * 4;
            const f32x4 S = *(const f32x4*)s0;
            ScanState Z; Z.s01 = (f32x2){S[0], S[1]}; Z.s23 = (f32x2){S[2], S[3]}; Z.ykeep = 0.f; Z.ypart = 0.f;
            Z.c0 = load_ops<SSTR>(img, 0, cgi, vrow); Z.c1 = load_ops<SSTR>(img, 1, cgi, vrow);
            scan_group<SSTR, DT>(img, 0, vrow, cgi, Z, Y + (size_t)m0 * 512 + h * 64 + vrow);
            *(f32x4*)(F.out + O_WKVS + ((size_t)chain * 64 + vrow) * 64 + cgi * 4) = (f32x4){Z.s01.x, Z.s01.y, Z.s23.x, Z.s23.y};
        }
        __syncthreads();
    }
}

__device__ __forceinline__ void post_phase(Frame& F) {
    const bf16_t* HRW = (const bf16_t*)(F.ws + WS_HRW);
    const bf16_t* SR = (const bf16_t*)(F.ws + WS_SR); const bf16_t* SK = (const bf16_t*)(F.ws + WS_SK); const bf16_t* SV = (const bf16_t*)(F.ws + WS_SV);
    const float* Y = F.out; bf16_t* OC = (bf16_t*)(F.ws + WS_OCAT);
    const int fr = F.lane & 15, fq = F.lane >> 4, h = F.wave;
    bf16x8 Ag[4][3];
#pragma unroll
    for (int nt = 0; nt < 4; ++nt)
#pragma unroll
        for (int s3 = 0; s3 < 3; ++s3) Ag[nt][s3] = wfrag(F.in[15], 32 * s3, fq, h * 64 + 16 * (fr >> 2) + 4 * nt + (fr & 3));
    constexpr int NTILE = M / 16;
    f32x4 prk[4], pgw[4], pgb[4], pmg[3][2];
#pragma unroll
    for (int i = 0; i < 4; ++i) { const int c4 = h * 64 + 16 * fq + 4 * i; prk[i] = *(const f32x4*)(F.in[18] + c4); pgw[i] = *(const f32x4*)(F.in[19] + c4); pgb[i] = *(const f32x4*)(F.in[20] + c4); }
#pragma unroll
    for (int s3 = 0; s3 < 3; ++s3) { pmg[s3][0] = *(const f32x4*)(F.in[10] + 1600 + 32 * s3 + 8 * fq); pmg[s3][1] = *(const f32x4*)(F.in[10] + 1604 + 32 * s3 + 8 * fq); }
    for (int tile_ = F.bid; tile_ < NTILE * POST_DUP; tile_ += F.G) {
        const int m = (tile_ % NTILE) * 16 + fr;
        const RowInfo ri = row_info(m);
        bf16x8 xg[3];
#pragma unroll
        for (int s3 = 0; s3 < 3; ++s3) {
            const F8 a = hs8m(F, HRW, m, ri, 1600 + 32 * s3 + 8 * fq, pmg[s3][0], pmg[s3][1]);
            f32x4 t0, t1;
#pragma unroll
            for (int i = 0; i < 4; ++i) { t0[i] = sigmoidf_(a.a[i]); t1[i] = sigmoidf_(a.b[i]); }
            xg[s3] = __builtin_bit_cast(bf16x8, pk8(t0, t1));
        }
        f32x4 y4[4], v4[4], g4[4]; float sy = 0.f, dot = 0.f;
#pragma unroll
        for (int np = 0; np < 2; ++np) {
            const int c8 = h * 64 + 16 * fq + 8 * np; const size_t o = (size_t)m * 512 + c8;
#pragma unroll
            for (int q = 0; q < 2; ++q) { f32x4 g = {0.f, 0.f, 0.f, 0.f};
#pragma unroll
                for (int s3 = 0; s3 < 3; ++s3) g = __builtin_amdgcn_mfma_f32_16x16x32_bf16(Ag[2 * np + q][s3], xg[s3], g, 0, 0, 0);
                g4[2 * np + q] = g; }
            const f32x4 ya = *(const f32x4*)(Y + o), yb = *(const f32x4*)(Y + o + 4);
            const F8 r8 = ld_bf8(SR + o), k8 = ld_bf8(SK + o), v8 = ld_bf8(SV + o);
            const f32x4 rka = prk[2 * np], rkb = prk[2 * np + 1];
            y4[2 * np] = ya; y4[2 * np + 1] = yb; v4[2 * np] = v8.a; v4[2 * np + 1] = v8.b;
            sy += ((ya[0] + ya[1]) + (ya[2] + ya[3])) + ((yb[0] + yb[1]) + (yb[2] + yb[3]));
            const f32x4 pa = r8.a * k8.a * rka, pb = r8.b * k8.b * rkb; dot += ((pa[0] + pa[1]) + (pa[2] + pa[3])) + ((pb[0] + pb[1]) + (pb[2] + pb[3]));
        }
        const float mean = xsum_fq(sy) * (1.f / 64.f); dot = xsum_fq(dot);
        float sq = 0.f;
#pragma unroll
        for (int nt = 0; nt < 4; ++nt) { y4[nt] = y4[nt] - mean; const f32x4 d = y4[nt]; sq += (d[0] * d[0] + d[1] * d[1]) + (d[2] * d[2] + d[3] * d[3]); }
        const float rstd = rsqrtf(xsum_fq(sq) * (1.f / 64.f) + GN_EPS);
#pragma unroll
        for (int np = 0; np < 2; ++np) {
            const int c8 = h * 64 + 16 * fq + 8 * np;
            f32x4 oo[2];
#pragma unroll
            for (int q = 0; q < 2; ++q) { const f32x4 gw = pgw[2 * np + q], gb = pgb[2 * np + q];
                oo[q] = (y4[2 * np + q] * rstd * gw + gb + v4[2 * np + q] * dot) * g4[2 * np + q]; }
            *(u32x4*)(OC + (size_t)m * DM + 512 + c8) = pk8(oo[0], oo[1]);
        }
    }
}

__device__ __forceinline__ f32x4 bf4_to_f(const u32x2 w) { return (f32x4){bflo(w.x), bfhi(w.x), bflo(w.y), bfhi(w.y)}; }
__device__ __forceinline__ float sumsq4(const f32x4 (&v)[4]) { float s = 0.f;
#pragma unroll
    for (int j = 0; j < 4; ++j) s += (v[j].x * v[j].x + v[j].y * v[j].y) + (v[j].z * v[j].z + v[j].w * v[j].w);
    return s; }
__device__ __forceinline__ void rows_mid(Frame& F) {
    const int gw = F.bid * NWAVES + F.wave, NGW = F.G * NWAVES;
    const f32x4* g1 = (const f32x4*)F.in[22]; const f32x4* g2 = (const f32x4*)F.in[23];
    bf16_t* XN = (bf16_t*)(F.ws + WS_XN); const bf16_t* MIXb = (const bf16_t*)(F.ws + WS_MIX);
    f32x4 ga[4], gb2[4];
#pragma unroll
    for (int j = 0; j < 4; ++j) { ga[j] = g1[64 * j + F.lane]; gb2[j] = g2[64 * j + F.lane]; }
    for (int m = gw; m < M; m += 2 * NGW) {
        const int m1 = m + NGW; const bool has1 = m1 < M; const int mm1 = has1 ? m1 : m;
        const f32x4* xr0 = (const f32x4*)xrow_ptr(F, m) + F.lane; const f32x4* xr1 = (const f32x4*)xrow_ptr(F, mm1) + F.lane;
        const u32x2* mb0 = (const u32x2*)(MIXb + (size_t)m * DM) + F.lane; const u32x2* mb1 = (const u32x2*)(MIXb + (size_t)mm1 * DM) + F.lane;
        f32x4 v0[4], v1[4], x0[4], x1[4];
#pragma unroll
        for (int j = 0; j < 4; ++j) { v0[j] = bf4_to_f(__builtin_nontemporal_load(mb0 + 64 * j)); x0[j] = __builtin_nontemporal_load(xr0 + 64 * j); }
#pragma unroll
        for (int j = 0; j < 4; ++j) { v1[j] = bf4_to_f(__builtin_nontemporal_load(mb1 + 64 * j)); x1[j] = __builtin_nontemporal_load(xr1 + 64 * j); }
        const float ra = 1.0f / sqrtf(wave_sum(sumsq4(v0)) * (1.f / DM) + RMS_EPS), rb = 1.0f / sqrtf(wave_sum(sumsq4(v1)) * (1.f / DM) + RMS_EPS);
#pragma unroll
        for (int j = 0; j < 4; ++j) { const f32x4 gg = ga[j]; v0[j] = x0[j] + v0[j] * ra * gg; v1[j] = x1[j] + v1[j] * rb * gg; }
        const float qa = 1.0f / sqrtf(wave_sum(sumsq4(v0)) * (1.f / DM) + RMS_EPS), qb = 1.0f / sqrtf(wave_sum(sumsq4(v1)) * (1.f / DM) + RMS_EPS);
        u32x2* o0 = (u32x2*)(XN + (size_t)m * DM) + F.lane; u32x2* o1 = (u32x2*)(XN + (size_t)mm1 * DM) + F.lane;
#pragma unroll
        for (int j = 0; j < 4; ++j) { const f32x4 gg = gb2[j];
            u32x2 w; w.x = pk2(v0[j].x * qa * gg.x, v0[j].y * qa * gg.y); w.y = pk2(v0[j].z * qa * gg.z, v0[j].w * qa * gg.w); o0[64 * j] = w;
            if (has1) { u32x2 q; q.x = pk2(v1[j].x * qb * gg.x, v1[j].y * qb * gg.y); q.y = pk2(v1[j].z * qb * gg.z, v1[j].w * qb * gg.w); o1[64 * j] = q; } }
    }
}
__device__ __forceinline__ void rows_final(Frame& F) {
    const int gw = F.bid * NWAVES + F.wave, NGW = F.G * NWAVES;
    const f32x4* g0 = (const f32x4*)F.in[22]; const f32x4* g1 = (const f32x4*)F.in[28];
    const bf16_t* Fb = (const bf16_t*)(F.ws + WS_F); const bf16_t* MIXb = (const bf16_t*)(F.ws + WS_MIX);
    f32x4 gA[4], gB[4];
#pragma unroll
    for (int j = 0; j < 4; ++j) { gA[j] = g0[64 * j + F.lane]; gB[j] = g1[64 * j + F.lane]; }
    for (int m = gw; m < M; m += 2 * NGW) {
        const int m1 = m + NGW; const bool has1 = m1 < M; const int mm1 = has1 ? m1 : m;
        f32x4 f0[4], f1[4], a0[4], a1[4], x0[4], x1[4];
        { const u32x2* fr = (const u32x2*)(Fb + (size_t)m * DM) + F.lane; const u32x2* mb = (const u32x2*)(MIXb + (size_t)m * DM) + F.lane; const f32x4* xr = (const f32x4*)xrow_ptr(F, m) + F.lane;
#pragma unroll
          for (int j = 0; j < 4; ++j) { f0[j] = bf4_to_f(__builtin_nontemporal_load(fr + 64 * j)); a0[j] = bf4_to_f(__builtin_nontemporal_load(mb + 64 * j)); x0[j] = __builtin_nontemporal_load(xr + 64 * j); } }
        { const u32x2* fr = (const u32x2*)(Fb + (size_t)mm1 * DM) + F.lane; const u32x2* mb = (const u32x2*)(MIXb + (size_t)mm1 * DM) + F.lane; const f32x4* xr = (const f32x4*)xrow_ptr(F, mm1) + F.lane;
#pragma unroll
          for (int j = 0; j < 4; ++j) { f1[j] = bf4_to_f(__builtin_nontemporal_load(fr + 64 * j)); a1[j] = bf4_to_f(__builtin_nontemporal_load(mb + 64 * j)); x1[j] = __builtin_nontemporal_load(xr + 64 * j); } }
        const float rf0 = 1.0f / sqrtf(wave_sum(sumsq4(f0)) * (1.f / DM) + RMS_EPS), rm0 = 1.0f / sqrtf(wave_sum(sumsq4(a0)) * (1.f / DM) + RMS_EPS);
        const float rf1 = 1.0f / sqrtf(wave_sum(sumsq4(f1)) * (1.f / DM) + RMS_EPS), rm1 = 1.0f / sqrtf(wave_sum(sumsq4(a1)) * (1.f / DM) + RMS_EPS);
        f32x4* y0 = (f32x4*)(F.out + (size_t)m * DM) + F.lane; f32x4* y1 = (f32x4*)(F.out + (size_t)mm1 * DM) + F.lane;
#pragma unroll
        for (int j = 0; j < 4; ++j) { const f32x4 ga = gA[j], gb = gB[j];
            __builtin_nontemporal_store((x0[j] + a0[j] * rm0 * ga) + f0[j] * rf0 * gb, y0 + 64 * j);
            if (has1) __builtin_nontemporal_store((x1[j] + a1[j] * rm1 * ga) + f1[j] * rf1 * gb, y1 + 64 * j); }
    }
}
__device__ __forceinline__ void conv_phase(Frame& F, int half) {
    const bf16_t* ZU = (const bf16_t*)(F.ws + WS_ZU); bf16_t* HID = (bf16_t*)(F.ws + WS_HID);
    const float* cw = F.in[25]; const float* cb = F.in[26]; const float* sc = F.in[6];
    const long total = (long)M * 176;
    for (long e = (long)F.bid * NT + F.tid; e < total; e += (long)F.G * NT) {
        const int m = (int)(e / 176), r = (int)(e - (long)m * 176); const int tile = r >> 4, c8 = (r & 15) * 8;
        const int ch = (half * 11 + tile) * 128 + c8;
        const RowInfo ri = row_info(m);
        const bf16_t* zp = ZU + (size_t)m * DFF + tile * 256 + c8;
        const u32x4 z0 = *(const u32x4*)zp, uu = *(const u32x4*)(zp + 128);
        float z[8], z1[8], z2[8], u8[8];
        z[0] = bflo(z0.x); z[1] = bfhi(z0.x); z[2] = bflo(z0.y); z[3] = bfhi(z0.y); z[4] = bflo(z0.z); z[5] = bfhi(z0.z); z[6] = bflo(z0.w); z[7] = bfhi(z0.w);
        u8[0] = bflo(uu.x); u8[1] = bfhi(uu.x); u8[2] = bflo(uu.y); u8[3] = bfhi(uu.y); u8[4] = bflo(uu.z); u8[5] = bfhi(uu.z); u8[6] = bflo(uu.w); u8[7] = bfhi(uu.w);
        if (ri.t >= 1) { const u32x4 w = *(const u32x4*)(zp - DFF); z1[0] = bflo(w.x); z1[1] = bfhi(w.x); z1[2] = bflo(w.y); z1[3] = bfhi(w.y); z1[4] = bflo(w.z); z1[5] = bfhi(w.z); z1[6] = bflo(w.w); z1[7] = bfhi(w.w); }
        else {
#pragma unroll
            for (int j = 0; j < 8; ++j) z1[j] = ri.samp ? sc[((size_t)ri.b * 2 + 1) * DFF + ch + j] : 0.f; }
        if (ri.t >= 2) { const u32x4 w = *(const u32x4*)(zp - 2 * DFF); z2[0] = bflo(w.x); z2[1] = bfhi(w.x); z2[2] = bflo(w.y); z2[3] = bfhi(w.y); z2[4] = bflo(w.z); z2[5] = bfhi(w.z); z2[6] = bflo(w.w); z2[7] = bfhi(w.w); }
        else {
#pragma unroll
            for (int j = 0; j < 8; ++j) z2[j] = ri.samp ? sc[((size_t)ri.b * 2 + ri.t) * DFF + ch + j] : 0.f; }
        float hd[8];
#pragma unroll
        for (int j = 0; j < 8; ++j) { const float zc = cb[ch + j] + cw[ch + j] * z2[j] + cw[DFF + ch + j] * z1[j] + cw[2 * DFF + ch + j] * z[j]; hd[j] = zc * sigmoidf_(zc) * u8[j]; }
        u32x4 w; w.x = pk2(hd[0], hd[1]); w.y = pk2(hd[2], hd[3]); w.z = pk2(hd[4], hd[5]); w.w = pk2(hd[6], hd[7]);
        *(u32x4*)(HID + (size_t)m * DFF + ch) = w;
    }
}

constexpr int NPHASE = 10;
__global__ void __launch_bounds__(NT, 2) fwd_megakernel(Args args) {
    extern __shared__ __attribute__((aligned(16))) unsigned char lds_raw[];
    Frame F;
    F.lds = (LAS unsigned char*)lds_raw; F.ws = args.ws; F.out = args.out; F.in = args.in;
    F.tid = threadIdx.x; F.lane = F.tid & 63; F.wave = __builtin_amdgcn_readfirstlane(F.tid >> 6); F.G = gridDim.x; F.bid = blockIdx.x;
    const int lo = args.ph_lo, hi = args.ph_hi;
#ifndef PH_MASK
#define PH_MASK 0x3ff
#endif
#ifndef DUP_MASK
#define DUP_MASK 0
#endif
#define IN(k) (((PH_MASK >> (k)) & 1) && lo <= (k) && (k) < hi)
#define REP(k) for (int rep_ = 0; rep_ < 1 + ((DUP_MASK >> (k)) & 1); ++rep_)
    unsigned* barw = (unsigned*)F.ws;
    volatile LAS unsigned* bst = (volatile LAS unsigned*)(F.lds + LDS_BYTES - 64);
    if (F.tid < 2) bst[F.tid] = 0u;
    XcdBarrier xbar; xbar.bar = barw; xbar.x = 0; xbar.st = bst;
    bool posted = false;
    if (lo + 1 < hi && F.bid == 0) { for (int i = F.tid; i < XCD_BAR_WORDS; i += NT) barw[i] = 0u; }
#define SEAM(k) do { if (IN(k) && IN((k) + 1)) { if (!posted) { cg::this_grid().sync(); xbar = xcd_barrier_post(barw, bst); posted = true; } else xcd_barrier(xbar); } } while (0)
    bf16_t* XN = (bf16_t*)(F.ws + WS_XN);
    if (IN(0)) REP(0) { p0_prologue(F); } SEAM(0);
    if (IN(1)) REP(1) {
        pg8::Gemm g{XN, (const bf16_t*)(F.ws + WS_WIN), M, DINP, DM, DM, DM, 0}; pg8::StaticOrder S; S.init(M, DINP, F.G, F.bid);
        Epi1 E{(const float*)(F.ws + WS_ROPE), (bf16_t*)(F.ws + WS_Q), (bf16_t*)(F.ws + WS_K), (bf16_t*)(F.ws + WS_VT), (bf16_t*)(F.ws + WS_HRW), F.out};
        pg8::gemm_phase<Epi1, true>(F.lds, g, S, E);
    } SEAM(1);
    if (IN(2)) REP(2) { prep_phase(F); sample_attn_phase(F); } SEAM(2);
    if (IN(3)) {
        for (int u = F.bid; u < NB * 64 * 2; u += F.G) prompt_attn_unit(F, u);
        sample_scan(F, F.bid, F.G);
        for (int sb = F.bid; sb < 256; sb += F.G) prompt_scan(F, sb);
    } SEAM(3);
    if (IN(4)) REP(4) { post_phase(F); } SEAM(4);
    if (IN(5)) REP(5) {
        pg8::Gemm g{(const bf16_t*)(F.ws + WS_OCAT), (const bf16_t*)(F.ws + WS_WOUT), M, DM, DM, DM, DM, 0}; pg8::StaticOrder S; S.init(M, DM, F.G, F.bid);
        EpiBf16 E{(bf16_t*)(F.ws + WS_MIX), DM};
        pg8::gemm_phase<EpiBf16, true>(F.lds, g, S, E);
    } SEAM(5);
    if (IN(6)) { rows_mid(F); } SEAM(6);
    if (IN(7)) REP(7) {
        pg8::Gemm g{XN, (const bf16_t*)(F.ws + WS_WFI), 136 * 256, 2 * DFF, DM, DM, DM, 1}; pg8::StaticOrder S; S.init(136 * 256, 2 * DFF, F.G, F.bid);
        EpiConv E{(bf16_t*)(F.ws + WS_HID), F.out, F.in[25], F.in[26], F.in[6], (LAS float*)(F.lds + 131072)};
        pg8::gemm_phase<EpiConv, true>(F.lds, g, S, E);
    } SEAM(7);
    if (IN(8)) REP(11) {
        pg8::Gemm g{(const bf16_t*)(F.ws + WS_HID), (const bf16_t*)(F.ws + WS_WFO), M, DM, DFF, DFF, DFF, 0}; pg8::StaticOrder S; S.init(M, DM, F.G, F.bid);
        EpiBf16 E{(bf16_t*)(F.ws + WS_F), DM};
        pg8::gemm_phase<EpiBf16, true>(F.lds, g, S, E);
    } SEAM(8);
    if (IN(9)) { rows_final(F); }
#undef IN
#undef SEAM
}

extern "C" void kernel_launch(void* const* d_in, const int* in_sizes, int n_in, void* d_out, int out_size, void* d_ws, size_t ws_size, hipStream_t stream) {
    static int grid = 0;
    if (grid == 0) {
        if (n_in != 29 || ws_size < WS_END) { fprintf(stderr, "kernel_launch: unexpected n_in %d / ws_size %zu\n", n_in, ws_size); grid = -1; return; }
        int dev = 0, cus = 0, per_cu = 0;
        hipGetDevice(&dev); hipDeviceGetAttribute(&cus, hipDeviceAttributeMultiprocessorCount, dev);
        if (hipFuncSetAttribute((const void*)fwd_megakernel, hipFuncAttributeMaxDynamicSharedMemorySize, LDS_BYTES) != hipSuccess) { fprintf(stderr, "kernel_launch: hipFuncSetAttribute failed\n"); grid = -1; return; }
        if (hipOccupancyMaxActiveBlocksPerMultiprocessor(&per_cu, (const void*)fwd_megakernel, NT, LDS_BYTES) != hipSuccess || per_cu < 1) { fprintf(stderr, "kernel_launch: occupancy query failed (%d)\n", per_cu); (void)hipGetLastError(); per_cu = 1; }
        grid = cus * (per_cu > 1 ? 1 : per_cu);
        fprintf(stderr, "kernel_launch: grid %d (cus %d, per_cu %d), ws %zu\n", grid, cus, per_cu, ws_size);
    }
    if (grid < 0) return;
    Args a{};
    for (int i = 0; i < 29; ++i) a.in[i] = (const float*)d_in[i];
    a.out = (float*)d_out; a.ws = (unsigned char*)d_ws;
#if MK_PER_PHASE
    for (int p = 0; p < NPHASE; ++p) { a.ph_lo = p; a.ph_hi = p + 1; hipLaunchKernelGGL(fwd_megakernel, dim3(grid), dim3(NT), LDS_BYTES, stream, a); }
#else
    a.ph_lo = 0; a.ph_hi = NPHASE;
    void* kargs[] = {&a};
    hipError_t e = hipLaunchCooperativeKernel((const void*)fwd_megakernel, dim3(grid), dim3(NT), kargs, LDS_BYTES, stream);
    if (e != hipSuccess) fprintf(stderr, "cooperative launch failed: %s (grid %d)\n", hipGetErrorString(e), grid);
#endif
}
```

```cpp
#include <hip/hip_runtime.h>
#include <hip/hip_cooperative_groups.h>
#include <cstdio>
#include <cstdint>
#include <utility>
namespace cg = cooperative_groups;

#ifndef MK_PER_PHASE
#define MK_PER_PHASE 0
#endif

#define LAS __attribute__((address_space(3)))
typedef unsigned short bf16_t;
typedef short bf16x8 __attribute__((ext_vector_type(8)));
typedef float f32x4 __attribute__((ext_vector_type(4)));
typedef float f32x2 __attribute__((ext_vector_type(2)));
typedef unsigned u32x4 __attribute__((ext_vector_type(4)));
typedef unsigned u32x2 __attribute__((ext_vector_type(2)));

constexpr int DM = 1024, NB = 4, T = 8192, MP = NB * T, DB = 128, DT = 8, MS = DB * DT, M = MP + MS;
constexpr int WIN = 128, DSH = 1696, DINP = 2560, DFF = 2816, DFFH = 1408;
constexpr float RMS_EPS = 1e-6f, GN_EPS = 64e-5f;
constexpr float QSCALE = 0.125f * 1.4426950408889634f;
constexpr size_t O_Y = 0, O_KWP = 34603008, O_VWP = 34668544, O_SHP = 34734080, O_WKVP = 34740864, O_CVP = 34871936,
                 O_KWS = 34894464, O_VWS = 36991616, O_SHS = 39088768, O_WKVS = 39305856, O_CVS = 43500160;
constexpr size_t MiB = 1u << 20;
constexpr size_t WS_WIN = 1 * MiB, WS_WOUT = 6 * MiB, WS_WFI = 8 * MiB, WS_WFO = 19 * MiB, WS_ROPE = 25 * MiB;
constexpr size_t WS_XN = 32 * MiB;
constexpr size_t WS_SR = 32 * MiB, WS_SK = 65 * MiB;
constexpr size_t WS_Q = 98 * MiB, WS_K = 131 * MiB, WS_VT = 140 * MiB;
constexpr size_t WS_HRW = 150 * MiB;
constexpr size_t WS_OCAT = 260 * MiB;
constexpr size_t WS_SW = 326 * MiB;
constexpr size_t WS_SV = 392 * MiB, WS_SKK = 425 * MiB, WS_SB = 458 * MiB;
constexpr size_t WS_ZU = 100 * MiB;
constexpr size_t WS_HID = 282 * MiB;
constexpr size_t WS_F = 216 * MiB;
constexpr size_t WS_MIX = 150 * MiB;
constexpr size_t WS_END = 491 * MiB;

__device__ __forceinline__ unsigned f2bf(float f) { unsigned u = __float_as_uint(f); return (u + 0x7fffu + ((u >> 16) & 1u)) >> 16; }

__device__ __forceinline__ float bf2f(unsigned short h) { return __uint_as_float(((unsigned)h) << 16); }
__device__ __forceinline__ float bflo(unsigned w) { return __uint_as_float(w << 16); }
__device__ __forceinline__ float bfhi(unsigned w) { return __uint_as_float(w & 0xffff0000u); }
__device__ __forceinline__ unsigned cvt_pk_bf16(float lo, float hi) { unsigned r; asm volatile("v_cvt_pk_bf16_f32 %0, %1, %2" : "=v"(r) : "v"(lo), "v"(hi)); return r; }
__device__ __forceinline__ unsigned pk2(float lo, float hi) { return cvt_pk_bf16(lo, hi); }
template <int CTRL> __device__ __forceinline__ float dppf(float x) { return __int_as_float(__builtin_amdgcn_update_dpp(0, __float_as_int(x), CTRL, 0xF, 0xF, false)); }
__device__ __forceinline__ float allsum16(float x) {
    x += dppf<0xB1>(x); x += dppf<0x4E>(x); x += dppf<0x141>(x); x += dppf<0x140>(x); return x;
}
__device__ __forceinline__ void allsum16_2(float& a, float& b) {
    a += dppf<0xB1>(a); b += dppf<0xB1>(b); a += dppf<0x4E>(a); b += dppf<0x4E>(b); a += dppf<0x141>(a); b += dppf<0x141>(b); a += dppf<0x140>(a); b += dppf<0x140>(b);
}
__device__ __forceinline__ float wave_sum(float v) {
    v = allsum16(v);
    { auto r = __builtin_amdgcn_permlane16_swap(__float_as_uint(v), __float_as_uint(v), false, false); v = __uint_as_float(r[0]) + __uint_as_float(r[1]); }
    { auto r = __builtin_amdgcn_permlane32_swap(__float_as_uint(v), __float_as_uint(v), false, false); v = __uint_as_float(r[0]) + __uint_as_float(r[1]); }
    return v;
}
__device__ __forceinline__ float sigmoidf_(float x) { return __builtin_amdgcn_rcpf(1.0f + __expf(-x)); }

namespace pg8 {
constexpr int BM = 256, BK = 64, HALF = 128, HTB = HALF * BK * 2, STAGE_BYTES = 8 * HTB, NXCD = 8, WGM = 8;
__host__ __device__ __forceinline__ int lds_byte(int r, int c) { const int st = (r >> 4) * 2 + (c >> 5), rr = r & 15, cc = c & 31, ob = rr * 64 + cc * 2; return st * 1024 + (ob ^ (((ob >> 9) & 1) << 5)); }
__host__ __device__ __forceinline__ void stage_rc(int b, int& R, int& C) { const int st = b / 1024, sb = b % 1024, swz = sb ^ (((sb >> 9) & 1) << 5); R = (st >> 1) * 16 + swz / 64; C = (st & 1) * 32 + (swz % 64) / 2; }
__host__ __device__ __forceinline__ int perm32(int rho) { const int n = rho >> 4, i = rho & 15; return 8 * (i >> 2) + 4 * n + (i & 3); }
struct Unit { int pm, pn; };
struct Gemm { const bf16_t* A; const bf16_t* Bt; int M, N, K, lda, ldb, conv; };
__device__ __forceinline__ long arow(const Gemm& g, int pm) {
    if (!g.conv) return (long)pm * 256;
    if (pm < 132) { const int b = pm / 33; return (long)b * 8192 + 254 * (pm - 33 * b) - 2; }
    return 32768 + (long)(pm - 132) * 256;
}
struct StaticOrder {
    int nM, nN, nwg, G, c;
    __device__ void init(int M_, int N_, int G_, int c_) { nM = M_ / BM; nN = N_ / BM; nwg = nM * nN; G = G_; c = c_; }
    __device__ bool next(int i, Unit& u) const {
        const long L = (long)i * G + c; if (L >= nwg) return false;
        int wgid = (int)L; { const int q = nwg / NXCD, r = nwg % NXCD, xcd = wgid % NXCD, off = wgid / NXCD; wgid = (xcd < r ? xcd * (q + 1) : r * (q + 1) + (xcd - r) * q) + off; }
        const int nig = WGM * nN, gid = wgid / nig, fm = gid * WGM, gsz = (nM - fm) < WGM ? (nM - fm) : WGM;
        u.pm = fm + ((wgid % nig) % gsz); u.pn = (wgid % nig) / gsz; return true;
    }
};
template <class Epi, bool ALIGN_EPI>
__device__ __forceinline__ void gemm_phase(LAS unsigned char* lds, const Gemm g, const StaticOrder& S, const Epi& E) {
    const int tid = threadIdx.x, wid = __builtin_amdgcn_readfirstlane(tid >> 6), lane = tid & 63, wr = wid >> 2, wc = wid & 3, fr = lane & 15, fq = lane >> 4;
    const int nt = g.K / BK;
    unsigned voffA[2], voffB[2];
#pragma unroll
    for (int i = 0; i < 2; ++i) { int R, C; stage_rc(tid * 16 + i * 8192, R, C); const int Rb = (R & ~31) + perm32(R & 31);
        voffA[i] = (unsigned)(R * g.lda + C) * 2u; voffB[i] = (unsigned)(Rb * g.ldb + C) * 2u; }
    const size_t kstep = (size_t)(BK * 2);
    const size_t hstepA = (size_t)HALF * g.lda * 2, hstepB = (size_t)HALF * g.ldb * 2;
    const size_t rowA = (size_t)g.lda * 2, tstepB = 2 * hstepB;
    const unsigned ldsw = (unsigned)wid * 1024u;
    const int aoff = lds_byte(wr * 64 + fr, fq * 8), boff = lds_byte(wc * 32 + fr, fq * 8);
#define PG8_SA(b, h) (((b) * 2 + (h)) * HTB)
#define PG8_SB(b, h) ((4 + (b) * 2 + (h)) * HTB)
#define PG8_STAGE(bufoff, gbase, voff) do { _Pragma("unroll") for (int _i = 0; _i < 2; ++_i) \
        __builtin_amdgcn_global_load_lds((const unsigned*)((const char*)(gbase) + (voff)[_i]), (LAS unsigned*)(lds + (bufoff) + ldsw + _i * 8192), 16, 0, 0); } while (0)
#define PG8_LDA(dst, b, h) do { _Pragma("unroll") for (int m = 0; m < 4; ++m) _Pragma("unroll") for (int k = 0; k < 2; ++k) dst[m][k] = *(const LAS bf16x8*)(lds + PG8_SA(b, h) + aoff + m * 2048 + k * 1024); } while (0)
#define PG8_LDB(dst, b, h) do { _Pragma("unroll") for (int n = 0; n < 2; ++n) _Pragma("unroll") for (int k = 0; k < 2; ++k) dst[n][k] = *(const LAS bf16x8*)(lds + PG8_SB(b, h) + boff + n * 2048 + k * 1024); } while (0)
#define PG8_MMA(ai, bj, At, Bt) do { __builtin_amdgcn_s_setprio(1); _Pragma("unroll") for (int m = 0; m < 4; ++m) _Pragma("unroll") for (int n = 0; n < 2; ++n) _Pragma("unroll") for (int k = 0; k < 2; ++k) \
        acc[ai][bj][m][n] = __builtin_amdgcn_mfma_f32_16x16x32_bf16(Bt[n][k], At[m][k], acc[ai][bj][m][n], 0, 0, 0); __builtin_amdgcn_s_setprio(0); } while (0)
#define PG8_WAIT_V(n) asm volatile("s_waitcnt vmcnt(" #n ")" ::: "memory")
#define PG8_WAIT_L(n) asm volatile("s_waitcnt lgkmcnt(" #n ")" ::: "memory")
#define PG8_BAR __builtin_amdgcn_s_barrier()
#define PG8_SCHED __builtin_amdgcn_sched_barrier(0)
    Unit cur, nxt; int ui = 0;
    if (!S.next(0, cur)) return;
    f32x4 acc[2][2][4][2];
#pragma unroll
    for (int a = 0; a < 2; ++a)
#pragma unroll
        for (int b = 0; b < 2; ++b)
#pragma unroll
            for (int m = 0; m < 4; ++m)
#pragma unroll
                for (int n = 0; n < 2; ++n) acc[a][b][m][n] = (f32x4){0.f, 0.f, 0.f, 0.f};
    bf16x8 At[4][2], B0[2][2], B1[2][2];
    const char* cA = (const char*)g.A + arow(g, cur.pm) * (long)rowA; const char* cB = (const char*)g.Bt + (size_t)cur.pn * tstepB;
    PG8_STAGE(PG8_SB(0, 0), cB, voffB); PG8_STAGE(PG8_SB(0, 1), cB + hstepB, voffB); PG8_STAGE(PG8_SA(0, 0), cA, voffA); PG8_STAGE(PG8_SA(0, 1), cA + hstepA, voffA);
    if (wr == 1) PG8_BAR;
    PG8_WAIT_V(2); PG8_BAR;
    PG8_STAGE(PG8_SB(1, 0), cB + kstep, voffB); PG8_STAGE(PG8_SA(1, 0), cA + kstep, voffA); PG8_STAGE(PG8_SB(1, 1), cB + hstepB + kstep, voffB);
    PG8_WAIT_V(6); PG8_BAR;
    for (;;) {
        const bool has_next = S.next(ui + 1, nxt);
        const char* nA = has_next ? (const char*)g.A + arow(g, nxt.pm) * (long)rowA : cA; const char* nB = has_next ? (const char*)g.Bt + (size_t)nxt.pn * tstepB : cB;
        for (int t = 0; t < nt; t += 2) {
            const bool last = (t == nt - 2);
            const char* a1 = cA + (size_t)(t + 1) * kstep;
            const char* a2 = last ? nA : cA + (size_t)(t + 2) * kstep; const char* b2 = last ? nB : cB + (size_t)(t + 2) * kstep;
            const char* a3 = a2 + kstep; const char* b3 = b2 + kstep;
            PG8_LDB(B0, 0, 0); PG8_LDB(B1, 0, 1); PG8_SCHED; PG8_LDA(At, 0, 0); PG8_STAGE(PG8_SA(1, 1), a1 + hstepA, voffA);
            PG8_WAIT_V(8); PG8_WAIT_L(0); PG8_BAR; PG8_MMA(0, 0, At, B0); PG8_MMA(0, 1, At, B1); PG8_BAR; PG8_SCHED;
            PG8_LDA(At, 0, 1); PG8_STAGE(PG8_SB(0, 0), b2, voffB); PG8_STAGE(PG8_SB(0, 1), b2 + hstepB, voffB); PG8_STAGE(PG8_SA(0, 0), a2, voffA);
            PG8_WAIT_V(8); PG8_WAIT_L(0); PG8_BAR; PG8_MMA(1, 0, At, B0); PG8_MMA(1, 1, At, B1); PG8_BAR; PG8_SCHED;
            PG8_LDB(B0, 1, 0); PG8_LDB(B1, 1, 1); PG8_SCHED; PG8_LDA(At, 1, 0); PG8_STAGE(PG8_SA(0, 1), a2 + hstepA, voffA);
            PG8_WAIT_V(8); PG8_WAIT_L(0); PG8_BAR; PG8_MMA(0, 0, At, B0); PG8_MMA(0, 1, At, B1); PG8_BAR; PG8_SCHED;
            PG8_LDA(At, 1, 1); PG8_STAGE(PG8_SB(1, 0), b3, voffB); PG8_STAGE(PG8_SB(1, 1), b3 + hstepB, voffB); PG8_STAGE(PG8_SA(1, 0), a3, voffA);
            PG8_WAIT_V(8); PG8_WAIT_L(0); PG8_BAR; PG8_MMA(1, 0, At, B0); PG8_MMA(1, 1, At, B1); PG8_BAR; PG8_SCHED;
        }
        if constexpr (ALIGN_EPI) { if (wr == 0) PG8_BAR; }
        asm volatile("s_nop 7\n\ts_nop 7" ::: "memory");
        E(acc, cur, wr, wc, fr, fq);
        if (!has_next) break;
#pragma unroll
        for (int a = 0; a < 2; ++a)
#pragma unroll
            for (int b = 0; b < 2; ++b)
#pragma unroll
                for (int m = 0; m < 4; ++m)
#pragma unroll
                    for (int n = 0; n < 2; ++n) acc[a][b][m][n] = (f32x4){0.f, 0.f, 0.f, 0.f};
        cur = nxt; cA = nA; cB = nB; ++ui;
        if constexpr (ALIGN_EPI) { if (wr == 1) PG8_BAR; }
    }
    PG8_WAIT_V(0);
    if constexpr (!ALIGN_EPI) { if (wr == 0) PG8_BAR; }
    PG8_BAR;
#undef PG8_SA
#undef PG8_SB
#undef PG8_STAGE
#undef PG8_LDA
#undef PG8_LDB
#undef PG8_MMA
#undef PG8_WAIT_V
#undef PG8_WAIT_L
#undef PG8_BAR
#undef PG8_SCHED
}
}

struct RowInfo { int b, t, samp; };
__device__ __forceinline__ RowInfo row_info(int row) { RowInfo r; if (row < MP) { r.samp = 0; r.b = row >> 13; r.t = row & (T - 1); } else { const int rs = row - MP; r.samp = 1; r.b = rs >> 3; r.t = rs & 7; } return r; }

struct Epi1 {
    const float* rope; bf16_t* Q; bf16_t* Kb; bf16_t* VT; bf16_t* HRW; float* out;
    __device__ __forceinline__ void operator()(const f32x4 (&acc)[2][2][4][2], const pg8::Unit& u, int wr, int wc, int fr, int fq) const {
#pragma unroll
        for (int ai = 0; ai < 2; ++ai)
#pragma unroll
            for (int m = 0; m < 4; ++m) {
                const int row = u.pm * 256 + ai * 128 + wr * 64 + m * 16 + fr;
                const RowInfo ri = row_info(row);
                const int pidx = ri.samp ? (T + ri.t) : ri.t;
#pragma unroll
                for (int bj = 0; bj < 2; ++bj) {
                    const int cb = u.pn * 256 + bj * 128;
                    const int c0 = cb + wc * 32 + fq * 8;
                    const f32x4 v0 = acc[ai][bj][m][0], v1 = acc[ai][bj][m][1];
                    if (cb < 640) {
                        const int d0 = ((c0 & 63) >> 3) * 4;
                        const f32x4* rp = (const f32x4*)(rope + ((size_t)pidx * 32 + d0) * 2);
                        const f32x4 cs0 = rp[0], cs1 = rp[1];
                        f32x4 o1, o2;
                        o1[0] = v0[0] * cs0[0] - v1[0] * cs0[1]; o2[0] = v1[0] * cs0[0] + v0[0] * cs0[1];
                        o1[1] = v0[1] * cs0[2] - v1[1] * cs0[3]; o2[1] = v1[1] * cs0[2] + v0[1] * cs0[3];
                        o1[2] = v0[2] * cs1[0] - v1[2] * cs1[1]; o2[2] = v1[2] * cs1[0] + v0[2] * cs1[1];
                        o1[3] = v0[3] * cs1[2] - v1[3] * cs1[3]; o2[3] = v1[3] * cs1[2] + v0[3] * cs1[3];
                        if (cb < 512) {
                            o1 = o1 * QSCALE; o2 = o2 * QSCALE;
                            bf16_t* qp = Q + (size_t)row * 512 + (c0 & ~63) + d0;
                            u32x2 w1, w2; w1.x = cvt_pk_bf16(o1[0], o1[1]); w1.y = cvt_pk_bf16(o1[2], o1[3]); w2.x = cvt_pk_bf16(o2[0], o2[1]); w2.y = cvt_pk_bf16(o2[2], o2[3]);
                            *(u32x2*)qp = w1; *(u32x2*)(qp + 32) = w2;
                        } else {
                            const int kvh = (c0 - 512) >> 6;
                            bf16_t* kp = Kb + (size_t)row * 128 + kvh * 64 + d0;
                            u32x2 w1, w2; w1.x = cvt_pk_bf16(o1[0], o1[1]); w1.y = cvt_pk_bf16(o1[2], o1[3]); w2.x = cvt_pk_bf16(o2[0], o2[1]); w2.y = cvt_pk_bf16(o2[2], o2[3]);
                            *(u32x2*)kp = w1; *(u32x2*)(kp + 32) = w2;
                            if (!ri.samp) { if (ri.t >= T - WIN) { float* o = out + O_KWP + ((size_t)(ri.b * WIN + (ri.t - (T - WIN))) * 2 + kvh) * 64 + d0; *(f32x4*)o = o1; *(f32x4*)(o + 32) = o2; } }
                            else { float* o = out + O_KWS + ((size_t)(ri.b * WIN + (WIN - DT) + ri.t) * 2 + kvh) * 64 + d0; *(f32x4*)o = o1; *(f32x4*)(o + 32) = o2; }
                        }
                    } else if (cb < 768) {
                        const int kvh = (c0 - 640) >> 6, d0 = (c0 - 640) & 63;
                        if (!ri.samp) {
                            bf16_t* vp = VT + ((size_t)(ri.b * 2 + kvh) * 64 + d0) * T + ri.t;
                            vp[0] = (bf16_t)f2bf(v0[0]); vp[(size_t)T] = (bf16_t)f2bf(v0[1]); vp[(size_t)2 * T] = (bf16_t)f2bf(v0[2]); vp[(size_t)3 * T] = (bf16_t)f2bf(v0[3]);
                            vp[(size_t)4 * T] = (bf16_t)f2bf(v1[0]); vp[(size_t)5 * T] = (bf16_t)f2bf(v1[1]); vp[(size_t)6 * T] = (bf16_t)f2bf(v1[2]); vp[(size_t)7 * T] = (bf16_t)f2bf(v1[3]);
                            if (ri.t >= T - WIN) { float* o = out + O_VWP + ((size_t)(ri.b * WIN + (ri.t - (T - WIN))) * 2 + kvh) * 64 + d0; *(f32x4*)o = v0; *(f32x4*)(o + 4) = v1; }
                        } else { float* o = out + O_VWS + ((size_t)(ri.b * WIN + (WIN - DT) + ri.t) * 2 + kvh) * 64 + d0; *(f32x4*)o = v0; *(f32x4*)(o + 4) = v1; }
                    } else if (c0 < 2464) {
                        const int col = c0 - 768;
                        u32x4 w; w.x = cvt_pk_bf16(v0[0], v0[1]); w.y = cvt_pk_bf16(v0[2], v0[3]); w.z = cvt_pk_bf16(v1[0], v1[1]); w.w = cvt_pk_bf16(v1[2], v1[3]);
                        *(u32x4*)(HRW + (size_t)row * DSH + col) = w;
                        if (!ri.samp) { if (ri.t == T - 1) { float* o = out + O_SHP + (size_t)ri.b * DSH + col; *(f32x4*)o = v0; *(f32x4*)(o + 4) = v1; } }
                        else if (ri.t == DT - 1) { float* o = out + O_SHS + (size_t)ri.b * DSH + col; *(f32x4*)o = v0; *(f32x4*)(o + 4) = v1; }
                    }
                }
            }
    }
};
struct EpiF32 {
    float* O; int ldc;
    __device__ __forceinline__ void operator()(const f32x4 (&acc)[2][2][4][2], const pg8::Unit& u, int wr, int wc, int fr, int fq) const {
#pragma unroll
        for (int ai = 0; ai < 2; ++ai)
#pragma unroll
            for (int m = 0; m < 4; ++m) {
                float* rowp = O + (size_t)(u.pm * 256 + ai * 128 + wr * 64 + m * 16 + fr) * ldc + u.pn * 256 + wc * 32 + fq * 8;
#pragma unroll
                for (int bj = 0; bj < 2; ++bj) { *(f32x4*)(rowp + bj * 128) = acc[ai][bj][m][0]; *(f32x4*)(rowp + bj * 128 + 4) = acc[ai][bj][m][1]; }
            }
    }
};
struct EpiBf16 {
    bf16_t* O; int ldc;
    __device__ __forceinline__ void operator()(const f32x4 (&acc)[2][2][4][2], const pg8::Unit& u, int wr, int wc, int fr, int fq) const {
#pragma unroll
        for (int ai = 0; ai < 2; ++ai)
#pragma unroll
            for (int m = 0; m < 4; ++m) {
                bf16_t* rowp = O + (size_t)(u.pm * 256 + ai * 128 + wr * 64 + m * 16 + fr) * ldc + u.pn * 256 + wc * 32 + fq * 8;
#pragma unroll
                for (int bj = 0; bj < 2; ++bj) { const f32x4 v0 = acc[ai][bj][m][0], v1 = acc[ai][bj][m][1];
                    u32x4 w; w.x = cvt_pk_bf16(v0[0], v0[1]); w.y = cvt_pk_bf16(v0[2], v0[3]); w.z = cvt_pk_bf16(v1[0], v1[1]); w.w = cvt_pk_bf16(v1[2], v1[3]);
                    *(u32x4*)(rowp + bj * 128) = w; }
            }
    }
};
template <int CTRL> __device__ __forceinline__ float dpp_old(float old, float src) { return __int_as_float(__builtin_amdgcn_update_dpp(__float_as_int(old), __float_as_int(src), CTRL, 0xF, 0xF, false)); }
struct EpiConv {
    bf16_t* HID; float* out; const float* cw; const float* cb; const float* sc; LAS float* exch;
    __device__ __forceinline__ void operator()(const f32x4 (&acc)[2][2][4][2], const pg8::Unit& u, int wr, int wc, int fr, int fq) const {
        const int cw8 = wc * 32 + fq * 8, ch0 = u.pn * 128 + cw8;
        if (fr >= 14) {
#pragma unroll
            for (int ai = 0; ai < 2; ++ai)
#pragma unroll
                for (int n = 0; n < 2; ++n) *(LAS f32x4*)(exch + ((ai * 2 + wr) * 2 + (fr - 14)) * 128 + cw8 + 4 * n) = acc[ai][0][3][n];
        }
        asm volatile("s_waitcnt lgkmcnt(0)\n\ts_barrier" ::: "memory");
        int row0, b0 = 0, i0 = 0; const bool samp = u.pm >= 132;
        if (!samp) { b0 = u.pm / 33; i0 = u.pm - 33 * b0; row0 = b0 * T + 254 * i0 - 2; } else row0 = MP + (u.pm - 132) * 256;
        f32x4 w0[2], w1[2], w2[2], bb[2];
#pragma unroll
        for (int n = 0; n < 2; ++n) { w0[n] = *(const f32x4*)(cw + ch0 + 4 * n); w1[n] = *(const f32x4*)(cw + DFF + ch0 + 4 * n); w2[n] = *(const f32x4*)(cw + 2 * DFF + ch0 + 4 * n); bb[n] = *(const f32x4*)(cb + ch0 + 4 * n); }
#pragma unroll
        for (int ai = 0; ai < 2; ++ai) {
            const int strip = ai * 2 + wr;
            f32x4 h1[2], h2[2];
#pragma unroll
            for (int n = 0; n < 2; ++n) {
                if (strip > 0) { h1[n] = *(const LAS f32x4*)(exch + ((strip - 1) * 2 + 1) * 128 + cw8 + 4 * n); h2[n] = *(const LAS f32x4*)(exch + ((strip - 1) * 2) * 128 + cw8 + 4 * n); }
                else { h1[n] = (f32x4){0.f, 0.f, 0.f, 0.f}; h2[n] = (f32x4){0.f, 0.f, 0.f, 0.f}; }
            }
#pragma unroll
            for (int m = 0; m < 4; ++m) {
                const int lr = ai * 128 + wr * 64 + m * 16 + fr;
                int t, b; bool valid;
                if (!samp) { t = 254 * i0 + lr - 2; b = b0; valid = lr >= 2 && t < T; } else { const int rs = row0 - MP + lr; b = rs >> 3; t = rs & 7; valid = true; }
                const size_t R = (size_t)((long)row0 + lr);
                f32x4 hd[2];
#pragma unroll
                for (int n = 0; n < 2; ++n) {
                    const f32x4 z = acc[ai][0][m][n], uu = acc[ai][1][m][n];
                    f32x4 o1, o2, zm1, zm2;
                    if (m == 0) { o1 = h1[n]; o2 = (fr == 0) ? h2[n] : h1[n]; }
                    else {
#pragma unroll
                        for (int e = 0; e < 4; ++e) { o1[e] = dppf<0x121>(acc[ai][0][m > 0 ? m - 1 : 0][n][e]); o2[e] = dppf<0x122>(acc[ai][0][m > 0 ? m - 1 : 0][n][e]); }
                    }
#pragma unroll
                    for (int e = 0; e < 4; ++e) { zm1[e] = dpp_old<0x111>(o1[e], z[e]); zm2[e] = dpp_old<0x112>(o2[e], z[e]); }
                    if (t == 0) {
                        if (samp) { zm1 = *(const f32x4*)(sc + ((size_t)b * 2 + 1) * DFF + ch0 + 4 * n); zm2 = *(const f32x4*)(sc + ((size_t)b * 2) * DFF + ch0 + 4 * n); }
                        else { zm1 = (f32x4){0.f, 0.f, 0.f, 0.f}; zm2 = (f32x4){0.f, 0.f, 0.f, 0.f}; }
                    } else if (t == 1) {
                        if (samp) zm2 = *(const f32x4*)(sc + ((size_t)b * 2 + 1) * DFF + ch0 + 4 * n); else zm2 = (f32x4){0.f, 0.f, 0.f, 0.f};
                    }
                    const f32x4 zc = bb[n] + w0[n] * zm2 + w1[n] * zm1 + w2[n] * z;
#pragma unroll
                    for (int e = 0; e < 4; ++e) hd[n][e] = zc[e] * sigmoidf_(zc[e]) * uu[e];
                }
                if (valid) {
                    u32x4 w; w.x = cvt_pk_bf16(hd[0][0], hd[0][1]); w.y = cvt_pk_bf16(hd[0][2], hd[0][3]); w.z = cvt_pk_bf16(hd[1][0], hd[1][1]); w.w = cvt_pk_bf16(hd[1][2], hd[1][3]);
                    *(u32x4*)(HID + R * DFF + ch0) = w;
                    if (!samp) { if (t >= T - 2) { float* o = out + O_CVP + (size_t)(b * 2 + (t - (T - 2))) * DFF + ch0; *(f32x4*)o = acc[ai][0][m][0]; *(f32x4*)(o + 4) = acc[ai][0][m][1]; } }
                    else if (t >= DT - 2) { float* o = out + O_CVS + (size_t)(b * 2 + (t - (DT - 2))) * DFF + ch0; *(f32x4*)o = acc[ai][0][m][0]; *(f32x4*)(o + 4) = acc[ai][0][m][1]; }
                }
            }
        }
    }
};

#define XB_TMO      128
#define XB_XCNT(j)  (256  + 64 * (j))
#define XB_XSUB(j)  (1280 + 64 * (j))
#define XB_XGEN(j)  (2304 + 64 * (j))
#define XB_TOP      3328
#define XB_TOPGEN   3392
#define XCD_BAR_WORDS 3456
#define XB_SPIN_CAP (1u << 20)
__device__ __forceinline__ unsigned xb_ld(unsigned* p)              { return __hip_atomic_load(p, __ATOMIC_RELAXED, __HIP_MEMORY_SCOPE_AGENT); }
__device__ __forceinline__ unsigned xb_add(unsigned* p, unsigned v) { return __hip_atomic_fetch_add(p, v, __ATOMIC_RELAXED, __HIP_MEMORY_SCOPE_AGENT); }
__device__ __forceinline__ unsigned xb_xcc_id() { return (unsigned)__builtin_amdgcn_s_getreg((3 << 11) | 20) & 0xFu; }
#define XB_SPIN(cond, bar) do { unsigned _sp = 0; while (cond) { __builtin_amdgcn_s_sleep(1); \
    if ((++_sp & 255u) == 0u) { if (xb_ld(&(bar)[XB_TMO])) break; if (_sp > XB_SPIN_CAP) { atomicAdd(&(bar)[XB_TMO], 1u); break; } } } } while (0)
struct XcdBarrier { unsigned* bar; unsigned x; volatile LAS unsigned* st; };
__device__ __forceinline__ XcdBarrier xcd_barrier_post(unsigned* bar, volatile LAS unsigned* st) {
    XcdBarrier b; b.bar = bar; b.x = xb_xcc_id(); b.st = st;
    if (threadIdx.x == 0) (void)xb_add(&bar[XB_XCNT(b.x)], 1u);
    return b;
}
__device__ __forceinline__ void xcd_barrier_complete(unsigned* bar, unsigned x, unsigned& nloc, unsigned& nx) {
    const unsigned G = gridDim.x * gridDim.y * gridDim.z;
    unsigned sum, cnt, mine, sp = 0u;
    for (;;) {
        sum = 0u; cnt = 0u; mine = 0u;
#pragma unroll
        for (unsigned j = 0; j < 16; ++j) { const unsigned c = xb_ld(&bar[XB_XCNT(j)]); sum += c; cnt += (c > 0u) ? 1u : 0u; mine = (j == x) ? c : mine; }
        if (sum == G) break;
        __builtin_amdgcn_s_sleep(1);
        if ((++sp & 255u) == 0u) { if (xb_ld(&bar[XB_TMO])) break; if (sp > XB_SPIN_CAP) { atomicAdd(&bar[XB_TMO], 1u); break; } }
    }
    nloc = mine > 0u ? mine : 1u; nx = cnt > 0u ? cnt : 1u;
}
__device__ __forceinline__ void xcd_barrier(const XcdBarrier& b) {
    asm volatile("s_waitcnt vmcnt(0)" ::: "memory");
    __syncthreads();
    if (threadIdx.x == 0) {
        unsigned* bar = b.bar;
        __builtin_amdgcn_s_waitcnt(0);
        unsigned nloc = b.st[0], nx = b.st[1];
        if (nloc == 0u) { xcd_barrier_complete(bar, b.x, nloc, nx); b.st[0] = nloc; b.st[1] = nx; }
        const unsigned old = xb_add(&bar[XB_XSUB(b.x)], 1u);
        const unsigned gen = old / nloc;
        if (old + 1u == (gen + 1u) * nloc) {
            __builtin_amdgcn_fence(__ATOMIC_RELEASE, "agent");
            asm volatile("s_waitcnt vmcnt(0)" ::: "memory");
            const unsigned og = xb_add(&bar[XB_TOP], 1u);
            const unsigned tg = og / nx;
            if (og + 1u == (tg + 1u) * nx) xb_add(&bar[XB_TOPGEN], 1u);
            else XB_SPIN(xb_ld(&bar[XB_TOPGEN]) == tg, bar);
            __builtin_amdgcn_fence(__ATOMIC_ACQUIRE, "agent");
            xb_add(&bar[XB_XGEN(b.x)], 1u);
            asm volatile("s_waitcnt vmcnt(0)" ::: "memory");
        } else {
            XB_SPIN(xb_ld(&bar[XB_XGEN(b.x)]) == gen, bar);
            __builtin_amdgcn_fence(__ATOMIC_ACQUIRE, "agent");
            asm volatile("s_waitcnt vmcnt(0)" ::: "memory");
        }
    }
    __syncthreads();
}

constexpr int NWAVES = 8, NT = 512;
constexpr int LDS_BYTES = 163840;
constexpr int YP_OFF = 129536;
struct Args { const float* in[29]; float* out; unsigned char* ws; int ph_lo, ph_hi; };
struct Frame {
    LAS unsigned char* lds; unsigned char* ws; float* out; const float* const* in;
    int tid, lane, wave, G, bid;
};
__device__ __forceinline__ const float* xrow_ptr(const Frame& F, int m) { return m < MP ? F.in[0] + (size_t)m * DM : F.in[1] + (size_t)(m - MP) * DM; }

template <class MAP>
__device__ __forceinline__ void p0_transpose_item(const float* W, int K, int N, int Nout, bf16_t* WT, LAS float* scr, int item, int lane, MAP map) {
    const int nblk = Nout / 32, kb = item / nblk, nb = item % nblk, k0 = 64 * kb, n0 = 32 * nb;
    const int src = map(n0 + (lane & 31));
    float tv[32];
#pragma unroll
    for (int i = 0; i < 32; ++i) { const int kk = 2 * i + (lane >> 5); tv[i] = src >= 0 ? W[(size_t)(k0 + kk) * N + src] : 0.f; }
#pragma unroll
    for (int i = 0; i < 32; ++i) { const int kk = 2 * i + (lane >> 5); scr[kk * 33 + (lane & 31)] = tv[i]; }
    asm volatile("s_waitcnt lgkmcnt(0)" ::: "memory");
    const int c = lane & 7;
#pragma unroll
    for (int j = 0; j < 4; ++j) { const int n = (lane >> 3) + 8 * j; const LAS float* s = scr + (8 * c) * 33 + n;
        u32x4 o; o.x = pk2(s[0 * 33], s[1 * 33]); o.y = pk2(s[2 * 33], s[3 * 33]); o.z = pk2(s[4 * 33], s[5 * 33]); o.w = pk2(s[6 * 33], s[7 * 33]);
        *(u32x4*)(WT + (size_t)(n0 + n) * K + k0 + 8 * c) = o; }
    asm volatile("s_waitcnt lgkmcnt(0)" ::: "memory");
}
struct MapIn { __device__ int operator()(int n) const { if (n < 640) { const int w = n & 63; return (n & ~63) + (w >> 3) * 4 + (w & 3) + 32 * ((w >> 2) & 1); } return n < 2464 ? n : -1; } };
struct MapId { __device__ int operator()(int n) const { return n; } };
struct MapFfn { __device__ int operator()(int n) const { const int tile = n >> 8, sub = n & 255, ch = tile * 128 + (sub & 127); return sub < 128 ? ch : DFF + ch; } };

__device__ __forceinline__ void p0_prologue(Frame& F) {
    LAS float* scr = (LAS float*)(F.lds + F.wave * 16384);
    const int gw = F.bid * NWAVES + F.wave, NGW = F.G * NWAVES;
    constexpr int I_IN = 16 * (DINP / 32), I_OUT = 16 * 32, I_FI = 16 * (2 * DFF / 32), I_FO = (DFF / 64) * 32;
    constexpr int NITEMS = I_IN + I_OUT + I_FI + I_FO;
#ifndef TR_DUP
#define TR_DUP 1
#endif
    for (int it_ = gw; it_ < NITEMS * TR_DUP; it_ += NGW) {
        const int it = it_ % NITEMS;
        int r = it;
        if (r < I_IN) { p0_transpose_item(F.in[8], DM, 2464, DINP, (bf16_t*)(F.ws + WS_WIN), scr, r, F.lane, MapIn()); continue; } r -= I_IN;
        if (r < I_OUT) { p0_transpose_item(F.in[21], DM, DM, DM, (bf16_t*)(F.ws + WS_WOUT), scr, r, F.lane, MapId()); continue; } r -= I_OUT;
        if (r < I_FI) { p0_transpose_item(F.in[24], DM, 2 * DFF, 2 * DFF, (bf16_t*)(F.ws + WS_WFI), scr, r, F.lane, MapFfn()); continue; } r -= I_FI;
        p0_transpose_item(F.in[27], DFF, DM, DM, (bf16_t*)(F.ws + WS_WFO), scr, r, F.lane, MapId());
    }
    float* rope = (float*)(F.ws + WS_ROPE);
    for (int e = F.bid * NT + F.tid; e < (T + DT) * 32; e += F.G * NT) {
        const int pidx = e >> 5, i = e & 31; const int pos = pidx < T ? pidx : 16384 + (pidx - T);
        const float inv = (float)exp2(-(double)i * (13.287712379549449 / 32.0));
        const float angf = (float)pos * inv;
        const double a = (double)angf;
        const double TWO_PI = 6.283185307179586476925286766559;
        const double n = rint(a / TWO_PI);
        const double r = a - n * TWO_PI;
        const double r2 = r * r;
        double c = 1.0, s = 1.0, tc = 1.0, ts = 1.0;
#pragma unroll
        for (int k = 1; k <= 14; ++k) { tc = -tc * r2 * (1.0 / (double)((2 * k - 1) * (2 * k))); ts = -ts * r2 * (1.0 / (double)((2 * k) * (2 * k + 1))); c += tc; s += ts; }
        s *= r;
        rope[(size_t)e * 2] = (float)c; rope[(size_t)e * 2 + 1] = (float)s;
    }
    const float* g = F.in[7];
    bf16_t* XN = (bf16_t*)(F.ws + WS_XN);
    f32x4 gq[4];
#pragma unroll
    for (int j = 0; j < 4; ++j) gq[j] = ((const f32x4*)g)[64 * j + F.lane];
    for (int m = gw; m < M; m += 2 * NGW) {
        const int m1 = m + NGW; const bool has1 = m1 < M;
        const f32x4* xr0 = (const f32x4*)xrow_ptr(F, m) + F.lane; const f32x4* xr1 = (const f32x4*)xrow_ptr(F, has1 ? m1 : m) + F.lane;
        f32x4 v0[4], v1[4];
#pragma unroll
        for (int j = 0; j < 4; ++j) v0[j] = __builtin_nontemporal_load(xr0 + 64 * j);
#pragma unroll
        for (int j = 0; j < 4; ++j) v1[j] = __builtin_nontemporal_load(xr1 + 64 * j);
        float s0 = 0.f, s1 = 0.f;
#pragma unroll
        for (int j = 0; j < 4; ++j) { s0 += (v0[j].x * v0[j].x + v0[j].y * v0[j].y) + (v0[j].z * v0[j].z + v0[j].w * v0[j].w); s1 += (v1[j].x * v1[j].x + v1[j].y * v1[j].y) + (v1[j].z * v1[j].z + v1[j].w * v1[j].w); }
        const float r0 = 1.0f / sqrtf(wave_sum(s0) * (1.f / DM) + RMS_EPS), r1 = 1.0f / sqrtf(wave_sum(s1) * (1.f / DM) + RMS_EPS);
        u32x2* o0 = (u32x2*)(XN + (size_t)m * DM) + F.lane; u32x2* o1 = (u32x2*)(XN + (size_t)m1 * DM) + F.lane;
#pragma unroll
        for (int j = 0; j < 4; ++j) { const f32x4 gg = gq[j];
            u32x2 w; w.x = pk2(v0[j].x * r0 * gg.x, v0[j].y * r0 * gg.y); w.y = pk2(v0[j].z * r0 * gg.z, v0[j].w * r0 * gg.w); o0[64 * j] = w;
            if (has1) { u32x2 q; q.x = pk2(v1[j].x * r1 * gg.x, v1[j].y * r1 * gg.y); q.y = pk2(v1[j].z * r1 * gg.z, v1[j].w * r1 * gg.w); o1[64 * j] = q; } }
    }
}

__device__ __forceinline__ float hprev_val(const Frame& F, const bf16_t* HRW, int m, int col) {
    const RowInfo ri = row_info(m);
    if (ri.t == 0) return ri.samp ? F.in[4][(size_t)ri.b * DSH + col] : 0.f;
    return bf2f(HRW[(size_t)(m - 1) * DSH + col]);
}
__device__ __forceinline__ f32x4 ld_bf4(const bf16_t* p) { const u32x2 w = *(const u32x2*)p; return (f32x4){bflo(w.x), bfhi(w.x), bflo(w.y), bfhi(w.y)}; }
__device__ __forceinline__ f32x4 hs4(const Frame& F, const bf16_t* HRW, int m, const RowInfo& ri, int col) {
    const f32x4 h = ld_bf4(HRW + (size_t)m * DSH + col);
    f32x4 hp;
    if (ri.t == 0) hp = ri.samp ? *(const f32x4*)(F.in[4] + (size_t)ri.b * DSH + col) : (f32x4){0.f, 0.f, 0.f, 0.f};
    else hp = ld_bf4(HRW + (size_t)(m - 1) * DSH + col);
    const f32x4 mu = *(const f32x4*)(F.in[10] + col);
    return h + (hp - h) * mu;
}
struct F8 { f32x4 a, b; };
__device__ __forceinline__ F8 ld_bf8(const bf16_t* p) { const u32x4 w = *(const u32x4*)p; F8 r; r.a = (f32x4){bflo(w.x), bfhi(w.x), bflo(w.y), bfhi(w.y)}; r.b = (f32x4){bflo(w.z), bfhi(w.z), bflo(w.w), bfhi(w.w)}; return r; }
__device__ __forceinline__ u32x4 pk8(const f32x4 a, const f32x4 b) { u32x4 w; w.x = cvt_pk_bf16(a[0], a[1]); w.y = cvt_pk_bf16(a[2], a[3]); w.z = cvt_pk_bf16(b[0], b[1]); w.w = cvt_pk_bf16(b[2], b[3]); return w; }
__device__ __forceinline__ F8 hs8m(const Frame& F, const bf16_t* HRW, int m, const RowInfo& ri, int col, const f32x4 mua, const f32x4 mub) {
    const F8 h = ld_bf8(HRW + (size_t)m * DSH + col);
    F8 hp;
    if (ri.t == 0) {
        if (ri.samp) { hp.a = *(const f32x4*)(F.in[4] + (size_t)ri.b * DSH + col); hp.b = *(const f32x4*)(F.in[4] + (size_t)ri.b * DSH + col + 4); }
        else { hp.a = (f32x4){0.f, 0.f, 0.f, 0.f}; hp.b = (f32x4){0.f, 0.f, 0.f, 0.f}; }
    } else hp = ld_bf8(HRW + (size_t)(m - 1) * DSH + col);
    F8 r; r.a = h.a + (hp.a - h.a) * mua; r.b = h.b + (hp.b - h.b) * mub; return r;
}
__device__ __forceinline__ F8 hs8(const Frame& F, const bf16_t* HRW, int m, const RowInfo& ri, int col) {
    const F8 h = ld_bf8(HRW + (size_t)m * DSH + col);
    F8 hp;
    if (ri.t == 0) {
        if (ri.samp) { hp.a = *(const f32x4*)(F.in[4] + (size_t)ri.b * DSH + col); hp.b = *(const f32x4*)(F.in[4] + (size_t)ri.b * DSH + col + 4); }
        else { hp.a = (f32x4){0.f, 0.f, 0.f, 0.f}; hp.b = (f32x4){0.f, 0.f, 0.f, 0.f}; }
    } else hp = ld_bf8(HRW + (size_t)(m - 1) * DSH + col);
    const f32x4 mua = *(const f32x4*)(F.in[10] + col), mub = *(const f32x4*)(F.in[10] + col + 4);
    F8 r; r.a = h.a + (hp.a - h.a) * mua; r.b = h.b + (hp.b - h.b) * mub; return r;
}
__device__ __forceinline__ float xsum_fq(float v) {
    { auto r = __builtin_amdgcn_permlane16_swap(__float_as_uint(v), __float_as_uint(v), false, false); v = __uint_as_float(r[0]) + __uint_as_float(r[1]); }
    { auto r = __builtin_amdgcn_permlane32_swap(__float_as_uint(v), __float_as_uint(v), false, false); v = __uint_as_float(r[0]) + __uint_as_float(r[1]); }
    return v;
}
__device__ __forceinline__ u32x2 pk4(const f32x4 v) { u32x2 w; w.x = cvt_pk_bf16(v[0], v[1]); w.y = cvt_pk_bf16(v[2], v[3]); return w; }
__device__ __forceinline__ bf16x8 wfrag(const float* W, int k0, int fq, int ch) {
    u32x4 w; const float* p = W + (size_t)(k0 + 8 * fq) * 512 + ch;
    w.x = cvt_pk_bf16(p[0], p[512]); w.y = cvt_pk_bf16(p[1024], p[1536]); w.z = cvt_pk_bf16(p[2048], p[2560]); w.w = cvt_pk_bf16(p[3072], p[3584]);
    return __builtin_bit_cast(bf16x8, w);
}
#ifndef PREP_DUP
#define PREP_DUP 1
#endif
#ifndef POST_DUP
#define POST_DUP 1
#endif
__device__ __forceinline__ void prep_phase(Frame& F) {
    const bf16_t* HRW = (const bf16_t*)(F.ws + WS_HRW);
    bf16_t* SR = (bf16_t*)(F.ws + WS_SR); bf16_t* SK = (bf16_t*)(F.ws + WS_SK); bf16_t* SV = (bf16_t*)(F.ws + WS_SV);
    bf16_t* SKK = (bf16_t*)(F.ws + WS_SKK); bf16_t* SB = (bf16_t*)(F.ws + WS_SB); float* SW = (float*)(F.ws + WS_SW);
    const int fr = F.lane & 15, fq = F.lane >> 4, h = F.wave;
    bf16x8 Aw[4], Aa[4];
#pragma unroll
    for (int nt = 0; nt < 4; ++nt) { const int ch = h * 64 + 16 * (fr >> 2) + 4 * nt + (fr & 3); Aw[nt] = wfrag(F.in[12], 0, fq, ch); Aa[nt] = wfrag(F.in[14], 0, fq, ch); }
    constexpr int NTILE = M / 16;
    f32x4 pw0[4], pa0[4], pkk[4], pka[4];
    f32x4 pmu[3][4];
#pragma unroll
    for (int st = 0; st < 3; ++st)
#pragma unroll
        for (int i = 0; i < 4; ++i) pmu[st][i] = *(const f32x4*)(F.in[10] + st * 512 + h * 64 + 16 * fq + 4 * i);
#pragma unroll
    for (int i = 0; i < 4; ++i) { const int c4 = h * 64 + 16 * fq + 4 * i; pw0[i] = *(const f32x4*)(F.in[11] + c4); pa0[i] = *(const f32x4*)(F.in[13] + c4); pkk[i] = *(const f32x4*)(F.in[16] + c4); pka[i] = *(const f32x4*)(F.in[17] + c4); }
    for (int tile_ = F.bid; tile_ < NTILE * PREP_DUP; tile_ += F.G) {
        const int m = (tile_ % NTILE) * 16 + fr;
        const RowInfo ri = row_info(m);
        bf16x8 xw, xa;
        { const F8 a = hs8(F, HRW, m, ri, 1536 + 8 * fq);
          f32x4 t0, t1;
#pragma unroll
          for (int i = 0; i < 4; ++i) { t0[i] = 1.f - 2.f * __builtin_amdgcn_rcpf(__expf(2.f * a.a[i]) + 1.f); t1[i] = 1.f - 2.f * __builtin_amdgcn_rcpf(__expf(2.f * a.b[i]) + 1.f); }
          xw = __builtin_bit_cast(bf16x8, pk8(t0, t1)); }
        { const F8 a = hs8(F, HRW, m, ri, 1568 + 8 * fq); xa = __builtin_bit_cast(bf16x8, pk8(a.a, a.b)); }
        f32x4 kkr[4], av[4]; float ss = 0.f;
#pragma unroll
        for (int np = 0; np < 2; ++np) {
            const int c8 = h * 64 + 16 * fq + 8 * np;
            const f32x4 z = {0.f, 0.f, 0.f, 0.f};
            f32x4 accw[2], acca[2];
#pragma unroll
            for (int q = 0; q < 2; ++q) { accw[q] = __builtin_amdgcn_mfma_f32_16x16x32_bf16(Aw[2 * np + q], xw, z, 0, 0, 0); acca[q] = __builtin_amdgcn_mfma_f32_16x16x32_bf16(Aa[2 * np + q], xa, z, 0, 0, 0); }
            const F8 r8 = hs8m(F, HRW, m, ri, c8, pmu[0][2 * np], pmu[0][2 * np + 1]), k8 = hs8m(F, HRW, m, ri, 512 + c8, pmu[1][2 * np], pmu[1][2 * np + 1]), v8 = hs8m(F, HRW, m, ri, 1024 + c8, pmu[2][2 * np], pmu[2][2 * np + 1]);
            f32x4 dec[2], k2[2];
#pragma unroll
            for (int q = 0; q < 2; ++q) {
                const f32x4 k = q ? k8.b : k8.a;
                const f32x4 w0 = pw0[2 * np + q], a0 = pa0[2 * np + q], kkc = pkk[2 * np + q], kac = pka[2 * np + q];
                f32x4 a;
#pragma unroll
                for (int j = 0; j < 4; ++j) {
                    const float x = -(w0[j] + accw[q][j]);
                    const float sp = fmaxf(x, 0.f) + __logf(1.f + __expf(-fabsf(x)));
                    dec[q][j] = __expf(-__expf(-sp - 0.5f));
                    a[j] = sigmoidf_(a0[j] + acca[q][j]);
                    k2[q][j] = k[j] * (1.f + (a[j] - 1.f) * kac[j]);
                }
                const f32x4 kk = k * kkc;
                ss += (kk[0] * kk[0] + kk[1] * kk[1]) + (kk[2] * kk[2] + kk[3] * kk[3]);
                kkr[2 * np + q] = kk; av[2 * np + q] = a;
            }
            const size_t o = (size_t)m * 512 + c8;
            *(f32x4*)(SW + o) = dec[0]; *(f32x4*)(SW + o + 4) = dec[1];
            *(u32x4*)(SR + o) = pk8(r8.a, r8.b); *(u32x4*)(SK + o) = pk8(k2[0], k2[1]); *(u32x4*)(SV + o) = pk8(v8.a, v8.b);
        }
        ss = xsum_fq(ss);
        const float rs = rsqrtf(fmaxf(ss, 1e-24f));
#pragma unroll
        for (int np = 0; np < 2; ++np) {
            const size_t o = (size_t)m * 512 + h * 64 + 16 * fq + 8 * np;
            const f32x4 ka = kkr[2 * np] * rs, kb = kkr[2 * np + 1] * rs;
            *(u32x4*)(SKK + o) = pk8(ka, kb); *(u32x4*)(SB + o) = pk8(ka * av[2 * np], kb * av[2 * np + 1]);
        }
    }
}

__device__ __forceinline__ void sample_attn_phase(Frame& F) {
    constexpr int NK = WIN + DT, KS = 68;
    LAS float* Kl = (LAS float*)F.lds;
    LAS float* Vl = Kl + NK * KS;
    LAS float* Pl = Vl + NK * KS;
    const bf16_t* Q = (const bf16_t*)(F.ws + WS_Q);
    bf16_t* OC = (bf16_t*)(F.ws + WS_OCAT);
    for (int unit = F.bid; unit < DB * 2; unit += F.G) {
        const int b = unit >> 1, kvh = unit & 1;
        for (int e = F.tid; e < NK * 16; e += NT) {
            const int key = e >> 4, d4 = (e & 15) * 4;
            f32x4 kv, vv;
            if (key < WIN) { kv = *(const f32x4*)(F.in[2] + ((size_t)(b * WIN + key) * 2 + kvh) * 64 + d4); vv = *(const f32x4*)(F.in[3] + ((size_t)(b * WIN + key) * 2 + kvh) * 64 + d4); }
            else { kv = *(const f32x4*)(F.out + O_KWS + ((size_t)(b * WIN + key - DT) * 2 + kvh) * 64 + d4); vv = *(const f32x4*)(F.out + O_VWS + ((size_t)(b * WIN + key - DT) * 2 + kvh) * 64 + d4); }
            *(LAS f32x4*)(Kl + key * KS + d4) = kv; *(LAS f32x4*)(Vl + key * KS + d4) = vv;
            if (key >= DT && key < WIN) { *(f32x4*)(F.out + O_KWS + ((size_t)(b * WIN + key - DT) * 2 + kvh) * 64 + d4) = kv; *(f32x4*)(F.out + O_VWS + ((size_t)(b * WIN + key - DT) * 2 + kvh) * 64 + d4) = vv; }
        }
        __syncthreads();
        const int qi = F.tid >> 4, sub = F.tid & 15;
        const int t = qi >> 2, g = qi & 3, head = kvh * 4 + g;
        const int m = MP + b * DT + t;
        float mx = F.in[9][head] * 1.4426950408889634f;
        {
            const bf16_t* qp = Q + (size_t)m * 512 + head * 64;
            float q[64];
#pragma unroll
            for (int i = 0; i < 8; ++i) { const u32x4 w = *(const u32x4*)(qp + 8 * i); q[8 * i] = bflo(w.x); q[8 * i + 1] = bfhi(w.x); q[8 * i + 2] = bflo(w.y); q[8 * i + 3] = bfhi(w.y); q[8 * i + 4] = bflo(w.z); q[8 * i + 5] = bfhi(w.z); q[8 * i + 6] = bflo(w.w); q[8 * i + 7] = bfhi(w.w); }
#pragma unroll 1
            for (int key = sub; key < NK; key += 16) {
                float a = 0.f; const LAS f32x4* kr = (const LAS f32x4*)(Kl + key * KS);
#pragma unroll
                for (int i = 0; i < 16; ++i) { const f32x4 kx = kr[i]; a += q[4 * i] * kx[0] + q[4 * i + 1] * kx[1] + q[4 * i + 2] * kx[2] + q[4 * i + 3] * kx[3]; }
                const int dist = t + WIN - key;
                const float s = (dist >= 0 && dist <= WIN) ? a : -1e30f;
                Pl[qi * NK + key] = s; mx = fmaxf(mx, s);
            }
        }
        mx = fmaxf(mx, __shfl_xor(mx, 1)); mx = fmaxf(mx, __shfl_xor(mx, 2)); mx = fmaxf(mx, __shfl_xor(mx, 4)); mx = fmaxf(mx, __shfl_xor(mx, 8));
        float sum = 0.f;
#pragma unroll 1
        for (int key = sub; key < NK; key += 16) { const float sv = Pl[qi * NK + key]; const float p = sv > -1e29f ? __builtin_amdgcn_exp2f(sv - mx) : 0.f; sum += p; Pl[qi * NK + key] = p; }
        sum += __shfl_xor(sum, 1); sum += __shfl_xor(sum, 2); sum += __shfl_xor(sum, 4); sum += __shfl_xor(sum, 8);
        const float inv = __builtin_amdgcn_rcpf(sum + __builtin_amdgcn_exp2f(F.in[9][head] * 1.4426950408889634f - mx));
        __syncthreads();
        f32x4 o = {0.f, 0.f, 0.f, 0.f};
        for (int key = 0; key < NK; ++key) { const float p = Pl[qi * NK + key]; const f32x4 vv = *(const LAS f32x4*)(Vl + key * KS + sub * 4); o += vv * p; }
        o = o * inv;
        u32x2 w; w.x = pk2(o[0], o[1]); w.y = pk2(o[2], o[3]);
        *(u32x2*)(OC + (size_t)m * DM + head * 64 + sub * 4) = w;
        __syncthreads();
    }
}

template <int MODE>
__device__ __forceinline__ void prompt_attn_unit(Frame& F, int unit, int ldsoff) {
    constexpr int KST = 144, VST = 528;
    LAS unsigned char* Kl = F.lds + ldsoff; LAS unsigned char* Vl = Kl + 256 * KST;
    const bf16_t* Q = (const bf16_t*)(F.ws + WS_Q); const bf16_t* Kb = (const bf16_t*)(F.ws + WS_K); const bf16_t* VT = (const bf16_t*)(F.ws + WS_VT);
    bf16_t* OC = (bf16_t*)(F.ws + WS_OCAT);
    const int kvh = unit & 1, qb = (unit >> 1) & 63, b = unit >> 7;
    const int key0 = (qb - 1) * 128;
    if (MODE != 2) {
    for (int e = F.tid; e < 256 * 8; e += NT) {
        const int key = e >> 3, ch = e & 7; const int pos = key0 + key;
        u32x4 v = {0u, 0u, 0u, 0u};
        if (pos >= 0) v = *(const u32x4*)(Kb + (size_t)(b * T + pos) * 128 + kvh * 64 + ch * 8);
        *(LAS u32x4*)(Kl + key * KST + ch * 16) = v;
    }
    for (int e = F.tid; e < 64 * 32; e += NT) {
        const int d = e >> 5, ch = e & 31; const int pos = key0 + ch * 8;
        u32x4 v = {0u, 0u, 0u, 0u};
        if (pos >= 0) v = *(const u32x4*)(VT + ((size_t)(b * 2 + kvh) * 64 + d) * T + pos);
        *(LAS u32x4*)(Vl + d * VST + ch * 16) = v;
    }
    }
    if (MODE == 1) return;
    if (MODE == 0) __syncthreads();
    const int fr = F.lane & 15, fq = F.lane >> 4;
    const int head = kvh * 4 + (F.wave >> 1);
    const float sink = F.in[9][head] * 1.4426950408889634f;
#pragma unroll 1
    for (int sb = 0; sb < 4; ++sb) {
        const int qi0 = (F.wave & 1) * 64 + sb * 16;
        const int qi = qi0 + fr;
        const size_t mrow = (size_t)b * T + qb * 128 + qi;
        const bf16x8 q0 = *(const bf16x8*)(Q + mrow * 512 + head * 64 + fq * 8);
        const bf16x8 q1 = *(const bf16x8*)(Q + mrow * 512 + head * 64 + 32 + fq * 8);
        const int ktlo = (F.wave & 1) * 4 + sb;
        f32x4 s[9];
#pragma unroll
        for (int kr = 0; kr < 9; ++kr) {
            const int kt = ktlo + kr;
            const bf16x8 k0 = *(const LAS bf16x8*)(Kl + (kt * 16 + fr) * KST + fq * 16);
            const bf16x8 k1 = *(const LAS bf16x8*)(Kl + (kt * 16 + fr) * KST + 64 + fq * 16);
            f32x4 a = {0.f, 0.f, 0.f, 0.f};
            a = __builtin_amdgcn_mfma_f32_16x16x32_bf16(k0, q0, a, 0, 0, 0);
            a = __builtin_amdgcn_mfma_f32_16x16x32_bf16(k1, q1, a, 0, 0, 0);
            s[kr] = a;
        }
        float mx = sink;
#pragma unroll
        for (int kr = 0; kr < 9; ++kr)
#pragma unroll
            for (int j = 0; j < 4; ++j) { const int sj = (ktlo + kr) * 16 + fq * 4 + j; const int dist = qi + 128 - sj; const bool ok = dist >= 0 && dist <= WIN && (key0 + sj) >= 0; const float v = ok ? s[kr][j] : -1e30f; s[kr][j] = v; mx = fmaxf(mx, v); }
        mx = fmaxf(mx, __shfl_xor(mx, 16)); mx = fmaxf(mx, __shfl_xor(mx, 32));
        float sum = 0.f;
        u32x2 pw[10];
#pragma unroll
        for (int kr = 0; kr < 9; ++kr) {
            f32x4 p;
#pragma unroll
            for (int j = 0; j < 4; ++j) { p[j] = s[kr][j] > -1e29f ? __builtin_amdgcn_exp2f(s[kr][j] - mx) : 0.f; sum += p[j]; }
            pw[kr].x = cvt_pk_bf16(p[0], p[1]); pw[kr].y = cvt_pk_bf16(p[2], p[3]);
        }
        pw[9].x = 0u; pw[9].y = 0u;
        sum += __shfl_xor(sum, 16); sum += __shfl_xor(sum, 32);
        const float inv = __builtin_amdgcn_rcpf(sum + __builtin_amdgcn_exp2f(sink - mx));
        f32x4 o[4];
#pragma unroll
        for (int dt = 0; dt < 4; ++dt) o[dt] = (f32x4){0.f, 0.f, 0.f, 0.f};
#pragma unroll
        for (int u = 0; u < 5; ++u) {
            u32x4 pb; pb.x = pw[2 * u].x; pb.y = pw[2 * u].y; pb.z = pw[2 * u + 1].x; pb.w = pw[2 * u + 1].y;
            const bf16x8 pf = __builtin_bit_cast(bf16x8, pb);
            const int kta = ktlo + 2 * u, ktb = u < 4 ? kta + 1 : kta;
#pragma unroll
            for (int dt = 0; dt < 4; ++dt) {
                const LAS unsigned char* vr = Vl + (dt * 16 + fr) * VST + (fq * 4) * 2;
                const u32x2 va = *(const LAS u32x2*)(vr + kta * 32), vb = *(const LAS u32x2*)(vr + ktb * 32);
                u32x4 vv; vv.x = va.x; vv.y = va.y; vv.z = vb.x; vv.w = vb.y;
                o[dt] = __builtin_amdgcn_mfma_f32_16x16x32_bf16(__builtin_bit_cast(bf16x8, vv), pf, o[dt], 0, 0, 0);
            }
        }
#pragma unroll
        for (int dt = 0; dt < 4; ++dt) { const f32x4 v = o[dt] * inv; u32x2 w; w.x = cvt_pk_bf16(v[0], v[1]); w.y = cvt_pk_bf16(v[2], v[3]); *(u32x2*)(OC + mrow * DM + head * 64 + dt * 16 + fq * 4) = w; }
    }
    if (MODE == 0) __syncthreads();
}

struct StepOps { f32x4 w, nbe, kk, k, r; float v; };
template <int STRIDE_F> __device__ __forceinline__ StepOps load_ops(const LAS float* img, int s, int cgi, int vrow) {
    const LAS float* p = img + s * STRIDE_F + cgi * 4; StepOps o;
    o.w = *(const LAS f32x4*)(p); o.nbe = *(const LAS f32x4*)(p + 64); o.kk = *(const LAS f32x4*)(p + 128); o.k = *(const LAS f32x4*)(p + 192); o.r = *(const LAS f32x4*)(p + 256);
    o.v = img[s * STRIDE_F + 320 + vrow]; return o;
}
template <int J> __device__ __forceinline__ float sel_lane16(float oldv, float newv) {
    float r; const unsigned long long m = 0x0001000100010001ull << J;
    asm("v_cndmask_b32_e64 %0, %1, %2, %3" : "=v"(r) : "v"(oldv), "v"(newv), "s"(m));
    return r;
}
struct ScanState { f32x2 s01, s23; float ykeep, ypart; StepOps c0, c1; };
template <int STRIDE_F, int J>
__device__ __forceinline__ void scan_step(const LAS float* img, int s0, int vrow, int cgi, ScanState& Z) {
    const StepOps nx = load_ops<STRIDE_F>(img, s0 + J + 2, cgi, vrow);
    const StepOps& c = Z.c0;
    const f32x2 kk01 = {c.kk[0], c.kk[1]}, kk23 = {c.kk[2], c.kk[3]}, w01 = {c.w[0], c.w[1]}, w23 = {c.w[2], c.w[3]}, k01 = {c.k[0], c.k[1]}, k23 = {c.k[2], c.k[3]};
    const f32x2 b01 = {c.nbe[0], c.nbe[1]}, b23 = {c.nbe[2], c.nbe[3]}, r01 = {c.r[0], c.r[1]}, r23 = {c.r[2], c.r[3]};
    f32x2 t = Z.s01 * kk01; t = Z.s23 * kk23 + t;
    float sa = t.x + t.y;
    const f32x2 u01 = Z.s01 * w01 + k01 * c.v, u23 = Z.s23 * w23 + k23 * c.v;
    if (J > 0) { allsum16_2(sa, Z.ypart); Z.ykeep = sel_lane16<(J > 0 ? J - 1 : 0)>(Z.ykeep, Z.ypart); } else sa = allsum16(sa);
    Z.s01 = b01 * sa + u01; Z.s23 = b23 * sa + u23;
    f32x2 y2 = Z.s01 * r01; y2 = Z.s23 * r23 + y2;
    Z.ypart = y2.x + y2.y;
    Z.c0 = Z.c1; Z.c1 = nx;
}
template <int STRIDE_F, int GS, int... Js>
__device__ __forceinline__ void scan_group_impl(const LAS float* img, int s0, int vrow, int cgi, ScanState& Z, float* yout, std::integer_sequence<int, Js...>) {
    (scan_step<STRIDE_F, Js>(img, s0, vrow, cgi, Z), ...);
    Z.ypart = allsum16(Z.ypart); Z.ykeep = sel_lane16<GS - 1>(Z.ykeep, Z.ypart);
    if (cgi < GS) yout[(size_t)(s0 + cgi) * 512] = Z.ykeep;
}
template <int STRIDE_F, int J>
__device__ __forceinline__ void scan_step_yp(const LAS float* img, int s0, int vrow, int cgi, ScanState& Z, LAS float* ypb) {
    const StepOps nx = load_ops<STRIDE_F>(img, s0 + J + 2, cgi, vrow);
    const StepOps& c = Z.c0;
    const f32x2 kk01 = {c.kk[0], c.kk[1]}, kk23 = {c.kk[2], c.kk[3]}, w01 = {c.w[0], c.w[1]}, w23 = {c.w[2], c.w[3]}, k01 = {c.k[0], c.k[1]}, k23 = {c.k[2], c.k[3]};
    const f32x2 b01 = {c.nbe[0], c.nbe[1]}, b23 = {c.nbe[2], c.nbe[3]}, r01 = {c.r[0], c.r[1]}, r23 = {c.r[2], c.r[3]};
    f32x2 t = Z.s01 * kk01; t = Z.s23 * kk23 + t;
    float sa = t.x + t.y;
    const f32x2 u01 = Z.s01 * w01 + k01 * c.v, u23 = Z.s23 * w23 + k23 * c.v;
    sa = allsum16(sa);
    Z.s01 = b01 * sa + u01; Z.s23 = b23 * sa + u23;
    f32x2 y2 = Z.s01 * r01; y2 = Z.s23 * r23 + y2;
    ypb[(s0 + J) * 64] = y2.x + y2.y;
    Z.c0 = Z.c1; Z.c1 = nx;
}
struct StepOpsS { f32x4 nbe, kk, k, r; };
template <int STRIDE_F> __device__ __forceinline__ StepOpsS load_ops_s(const LAS float* img, int s, int cgi) {
    const LAS float* p = img + s * STRIDE_F + cgi * 4; StepOpsS o;
    o.nbe = *(const LAS f32x4*)(p + 64); o.kk = *(const LAS f32x4*)(p + 128); o.k = *(const LAS f32x4*)(p + 192); o.r = *(const LAS f32x4*)(p + 256);
    return o;
}
struct ScanT { f32x2 t01, t23; StepOpsS c0, c1; f32x4 v4[4]; };
template <int STRIDE_F, int J>
__device__ __forceinline__ void scan_step_s(const LAS float* img, int cgi, ScanT& Z, LAS float* ypb) {
    const StepOpsS nx = load_ops_s<STRIDE_F>(img, J + 2, cgi);
    const StepOpsS& c = Z.c0;
    const float v = Z.v4[J >> 2][J & 3];
    f32x2 t = Z.t01 * (f32x2){c.kk[0], c.kk[1]}; t = Z.t23 * (f32x2){c.kk[2], c.kk[3]} + t;
    float sa = t.x + t.y;
    const f32x2 a01 = (f32x2){c.k[0], c.k[1]} * v + Z.t01, a23 = (f32x2){c.k[2], c.k[3]} * v + Z.t23;
    sa = allsum16(sa);
    Z.t01 = (f32x2){c.nbe[0], c.nbe[1]} * sa + a01; Z.t23 = (f32x2){c.nbe[2], c.nbe[3]} * sa + a23;
    f32x2 y2 = Z.t01 * (f32x2){c.r[0], c.r[1]}; y2 = Z.t23 * (f32x2){c.r[2], c.r[3]} + y2;
    ypb[J * 64] = y2.x + y2.y;
    Z.c0 = Z.c1; Z.c1 = nx;
}
template <int STRIDE_F, int... Js>
__device__ __forceinline__ void scan_chunk_s_impl(const LAS float* img, int cgi, ScanT& Z, LAS float* ypb, std::integer_sequence<int, Js...>) {
    (scan_step_s<STRIDE_F, Js>(img, cgi, Z, ypb), ...);
}
template <int STRIDE_F, int NS>
__device__ __forceinline__ void scan_transform(LAS float* img, int lane) {
    LAS float* p = img + lane; float Wc = 1.f;
#pragma unroll
    for (int t = 0; t < NS; ++t, p += STRIDE_F) {
        const float w = p[0], nb = p[64], kk = p[128], k = p[192], r = p[256];
        p[128] = Wc * kk;
        Wc *= w; const float inv = __builtin_amdgcn_rcpf(Wc);
        p[64] = nb * inv; p[192] = k * inv; p[256] = Wc * r;
    }
    img[(NS - 1) * STRIDE_F + lane] = Wc;
}
template <int STRIDE_F, int... Js>
__device__ __forceinline__ void scan_group_yp_impl(const LAS float* img, int s0, int vrow, int cgi, ScanState& Z, LAS float* ypb, std::integer_sequence<int, Js...>) {
    (scan_step_yp<STRIDE_F, Js>(img, s0, vrow, cgi, Z, ypb), ...);
}
template <int... Js>
__device__ __forceinline__ void yp_reduce_impl(const LAS float* ypb, int cgi, float* yout, int s0, std::integer_sequence<int, Js...>) {
    float ykeep = 0.f;
    ((ykeep = sel_lane16<Js>(ykeep, allsum16(ypb[(s0 + Js) * 64]))), ...);
    yout[(size_t)(s0 + cgi) * 512] = ykeep;
}
template <int STRIDE_F, int GS>
__device__ __forceinline__ void scan_group(const LAS float* img, int s0, int vrow, int cgi, ScanState& Z, float* yout) {
    scan_group_impl<STRIDE_F, GS>(img, s0, vrow, cgi, Z, yout, std::make_integer_sequence<int, GS>());
}
constexpr int SC = 32;
constexpr int PSTR = 328;
constexpr int SSTR = 384;
struct ScanRegs { f32x4 w[2]; u32x4 b0[2], b1[2]; u32x4 v; };
__device__ __forceinline__ void scan_load(const Frame& F, ScanRegs& R, int m0, int h, int v0) {
    if (F.wave < 4) return;
    const int vt = F.tid - 256;
#pragma unroll
    for (int i = 0; i < 2; ++i) {
        const int tid = vt + 256 * i;
        { const int row = tid >> 4, c4 = (tid & 15) * 4; R.w[i] = *(const f32x4*)((const float*)(F.ws + WS_SW) + (size_t)(m0 + row) * 512 + h * 64 + c4); }
        { const int st = tid >> 7, row = (tid & 127) >> 2, seg = tid & 3;
          const size_t base = st == 0 ? WS_SB : st == 1 ? WS_SKK : st == 2 ? WS_SK : WS_SR;
          const bf16_t* p = (const bf16_t*)(F.ws + base) + (size_t)(m0 + row) * 512 + h * 64 + seg * 16;
          R.b0[i] = *(const u32x4*)p; R.b1[i] = *(const u32x4*)(p + 8); }
    }
    { R.v = *(const u32x4*)((const bf16_t*)(F.ws + WS_SV) + (size_t)(m0 + (vt & 31)) * 512 + h * 64 + v0); }
}
__device__ __forceinline__ void scan_store(const Frame& F, const ScanRegs& R, LAS float* img) {
    if (F.wave < 4) return;
    const int vt = F.tid - 256;
#pragma unroll
    for (int i = 0; i < 2; ++i) {
        const int tid = vt + 256 * i;
        { const int row = tid >> 4, c4 = (tid & 15) * 4; *(LAS f32x4*)(img + row * PSTR + c4) = R.w[i]; }
        { const int st = tid >> 7, row = (tid & 127) >> 2, seg = tid & 3;
          LAS float* d = img + row * PSTR + 64 + st * 64 + seg * 16;
          const float sg = st == 0 ? -1.f : 1.f; const u32x4 b0 = R.b0[i], b1 = R.b1[i];
          *(LAS f32x4*)(d) = (f32x4){bflo(b0.x), bfhi(b0.x), bflo(b0.y), bfhi(b0.y)} * sg; *(LAS f32x4*)(d + 4) = (f32x4){bflo(b0.z), bfhi(b0.z), bflo(b0.w), bfhi(b0.w)} * sg;
          *(LAS f32x4*)(d + 8) = (f32x4){bflo(b1.x), bfhi(b1.x), bflo(b1.y), bfhi(b1.y)} * sg; *(LAS f32x4*)(d + 12) = (f32x4){bflo(b1.z), bfhi(b1.z), bflo(b1.w), bfhi(b1.w)} * sg; }
    }
    if (vt < 32) { LAS float* d = img + SC * PSTR + vt;
      d[0 * SC] = bflo(R.v.x); d[1 * SC] = bfhi(R.v.x); d[2 * SC] = bflo(R.v.y); d[3 * SC] = bfhi(R.v.y); d[4 * SC] = bflo(R.v.z); d[5 * SC] = bfhi(R.v.z); d[6 * SC] = bflo(R.v.w); d[7 * SC] = bfhi(R.v.w); }
}
constexpr int NSW = 2;
__device__ __forceinline__ void prompt_scan(Frame& F, int sblk) {
    const int xcd = sblk & 7, k = sblk >> 3;
    const int chain = xcd * 4 + (k >> 3), rg = k & 7;
    const int b = chain >> 3, h = chain & 7, v0 = rg * 8;
    LAS float* img = (LAS float*)F.lds;
    constexpr int IMG = SC * PSTR + 8 * SC;
    const int rl = F.lane >> 4, cgi = F.lane & 15;
    const int vrow = F.wave * 4 + rl;
    float* Y = F.out;
    ScanState Z; Z.s01 = (f32x2){0.f, 0.f}; Z.s23 = (f32x2){0.f, 0.f}; Z.ykeep = 0.f; Z.ypart = 0.f;
    ScanRegs R0, R1, R2, R3;
    const int mbase = b * T;
    constexpr int NCH = T / SC;
#ifndef SCAN_DUP
#define SCAN_DUP 1
#endif
    constexpr int NTOT = NCH * SCAN_DUP;
    scan_load(F, R0, mbase, h, v0); scan_store(F, R0, img);
    scan_load(F, R1, mbase + SC, h, v0); scan_store(F, R1, img + IMG);
    scan_load(F, R2, mbase + 2 * SC, h, v0); scan_load(F, R3, mbase + 3 * SC, h, v0);
    __syncthreads();
    if (F.wave == 4 || F.wave == 5) scan_transform<PSTR, 16>(img + (F.wave - 4) * 16 * PSTR, F.lane);
    __syncthreads();
    LAS float* ypr = (LAS float*)(F.lds + YP_OFF);
#define SCAN_CHUNK(cc_) do { const int c_ = (cc_) % NCH; \
        if (SCAN_DUP > 1 && c_ == 0) { Z.s01 = (f32x2){0.f, 0.f}; Z.s23 = (f32x2){0.f, 0.f}; } \
        if (F.wave < NSW) { const LAS float* im = img + ((cc_) % 3) * IMG; LAS float* ypb = ypr + (((cc_) & 1) * NSW + F.wave) * (SC * 64) + F.lane; \
            const LAS float* vtp = im + SC * PSTR + vrow * SC; \
            ScanT Tz; Tz.t01 = Z.s01; Tz.t23 = Z.s23; Tz.c0 = load_ops_s<PSTR>(im, 0, cgi); Tz.c1 = load_ops_s<PSTR>(im, 1, cgi); \
            _Pragma("unroll") for (int q_ = 0; q_ < 4; ++q_) Tz.v4[q_] = *(const LAS f32x4*)(vtp + 4 * q_); \
            scan_chunk_s_impl<PSTR>(im, cgi, Tz, ypb, std::make_integer_sequence<int, 16>()); \
            { const f32x4 wce = *(const LAS f32x4*)(im + 15 * PSTR + cgi * 4); Tz.t01 = Tz.t01 * (f32x2){wce[0], wce[1]}; Tz.t23 = Tz.t23 * (f32x2){wce[2], wce[3]}; } \
            _Pragma("unroll") for (int q_ = 0; q_ < 4; ++q_) Tz.v4[q_] = *(const LAS f32x4*)(vtp + 16 + 4 * q_); \
            scan_chunk_s_impl<PSTR>(im + 16 * PSTR, cgi, Tz, ypb + 16 * 64, std::make_integer_sequence<int, 16>()); \
            { const f32x4 wce = *(const LAS f32x4*)(im + 31 * PSTR + cgi * 4); Z.s01 = Tz.t01 * (f32x2){wce[0], wce[1]}; Z.s23 = Tz.t23 * (f32x2){wce[2], wce[3]}; } } \
        else if (F.wave < 2 * NSW && (cc_) > 0) { const int sw_ = F.wave - NSW, cp_ = ((cc_) - 1) % NCH; \
            const LAS float* ypb = ypr + ((((cc_) - 1) & 1) * NSW + sw_) * (SC * 64) + F.lane; float* yo = Y + (size_t)(mbase + cp_ * SC) * 512 + h * 64 + v0 + sw_ * 4 + rl; \
            yp_reduce_impl(ypb, cgi, yo, 0, std::make_integer_sequence<int, 16>()); yp_reduce_impl(ypb, cgi, yo, 16, std::make_integer_sequence<int, 16>()); } \
        else if ((F.wave == 4 || F.wave == 5) && (cc_) + 1 < NTOT) scan_transform<PSTR, 16>(img + (((cc_) + 1) % 3) * IMG + (F.wave - 4) * 16 * PSTR, F.lane); } while (0)
#define SCAN_ITER(j_, RL_, RS_) do { const int c4_ = cc + (j_); \
        scan_load(F, RL_, mbase + ((c4_ + 4 < NTOT ? c4_ + 4 : NTOT - 1) % NCH) * SC, h, v0);        \
        SCAN_CHUNK(c4_); \
        if (c4_ + 2 < NTOT) scan_store(F, RS_, img + ((c4_ + 2) % 3) * IMG);                         \
        asm volatile("s_waitcnt lgkmcnt(0)\n\ts_barrier" ::: "memory"); } while (0)
#pragma unroll 1
    for (int cc = 0; cc < NTOT; cc += 4) {
        SCAN_ITER(0, R0, R2); SCAN_ITER(1, R1, R3); SCAN_ITER(2, R2, R0); SCAN_ITER(3, R3, R1);
    }
#undef SCAN_ITER
#undef SCAN_CHUNK
    if (F.wave >= NSW && F.wave < 2 * NSW) { const int sw_ = F.wave - NSW, cp_ = (NTOT - 1) % NCH;
        const LAS float* ypb = ypr + (((NTOT - 1) & 1) * NSW + sw_) * (SC * 64) + F.lane; float* yo = Y + (size_t)(mbase + cp_ * SC) * 512 + h * 64 + v0 + sw_ * 4 + rl;
        yp_reduce_impl(ypb, cgi, yo, 0, std::make_integer_sequence<int, 16>()); yp_reduce_impl(ypb, cgi, yo, 16, std::make_integer_sequence<int, 16>()); }
    __syncthreads();
    if (F.wave < NSW) *(f32x4*)(F.out + O_WKVP + ((size_t)(b * 8 + h) * 64 + v0 + vrow) * 64 + cgi * 4) = (f32x4){Z.s01.x, Z.s01.y, Z.s23.x, Z.s23.y};
}
__device__ __forceinline__ void sample_scan(Frame& F, int sblk, int nsblk) {
    LAS float* img = (LAS float*)F.lds;
    float* Y = F.out;
    const int rl = F.lane >> 4, cgi = F.lane & 15;
    for (int chain = sblk; chain < DB * 8; chain += nsblk) {
        const int b = chain >> 3, h = chain & 7; const int m0 = MP + b * DT;
        for (int e = F.tid; e < 6 * DT * 64; e += NT) {
            const int st = e >> 9, row = (e >> 6) & 7, ch = e & 63; const size_t o = (size_t)(m0 + row) * 512 + h * 64 + ch;
            float val;
            if (st == 0) val = ((const float*)(F.ws + WS_SW))[o];
            else { const size_t base = st == 1 ? WS_SB : st == 2 ? WS_SKK : st == 3 ? WS_SK : st == 4 ? WS_SR : WS_SV; val = bf2f(((const bf16_t*)(F.ws + base))[o]); if (st == 1) val = -val; }
            img[row * SSTR + st * 64 + ch] = val;
        }
        __syncthreads();
#pragma unroll 1
        for (int rnd = 0; rnd < 2; ++rnd) {
            const int vrow = (rnd * 8 + F.wave) * 4 + rl;
            const float* s0 = F.in[5] + ((size_t)chain * 64 + vrow) * 64 + cgi * 4;
            const f32x4 S = *(const f32x4*)s0;
            ScanState Z; Z.s01 = (f32x2){S[0], S[1]}; Z.s23 = (f32x2){S[2], S[3]}; Z.ykeep = 0.f; Z.ypart = 0.f;
            Z.c0 = load_ops<SSTR>(img, 0, cgi, vrow); Z.c1 = load_ops<SSTR>(img, 1, cgi, vrow);
            scan_group<SSTR, DT>(img, 0, vrow, cgi, Z, Y + (size_t)m0 * 512 + h * 64 + vrow);
            *(f32x4*)(F.out + O_WKVS + ((size_t)chain * 64 + vrow) * 64 + cgi * 4) = (f32x4){Z.s01.x, Z.s01.y, Z.s23.x, Z.s23.y};
        }
        __syncthreads();
    }
}

__device__ __forceinline__ void post_phase(Frame& F) {
    const bf16_t* HRW = (const bf16_t*)(F.ws + WS_HRW);
    const bf16_t* SR = (const bf16_t*)(F.ws + WS_SR); const bf16_t* SK = (const bf16_t*)(F.ws + WS_SK); const bf16_t* SV = (const bf16_t*)(F.ws + WS_SV);
    const float* Y = F.out; bf16_t* OC = (bf16_t*)(F.ws + WS_OCAT);
    const int fr = F.lane & 15, fq = F.lane >> 4, h = F.wave;
    bf16x8 Ag[4][3];
#pragma unroll
    for (int nt = 0; nt < 4; ++nt)
#pragma unroll
        for (int s3 = 0; s3 < 3; ++s3) Ag[nt][s3] = wfrag(F.in[15], 32 * s3, fq, h * 64 + 16 * (fr >> 2) + 4 * nt + (fr & 3));
    constexpr int NTILE = M / 16;
    f32x4 prk[4], pgw[4], pgb[4], pmg[3][2];
#pragma unroll
    for (int i = 0; i < 4; ++i) { const int c4 = h * 64 + 16 * fq + 4 * i; prk[i] = *(const f32x4*)(F.in[18] + c4); pgw[i] = *(const f32x4*)(F.in[19] + c4); pgb[i] = *(const f32x4*)(F.in[20] + c4); }
#pragma unroll
    for (int s3 = 0; s3 < 3; ++s3) { pmg[s3][0] = *(const f32x4*)(F.in[10] + 1600 + 32 * s3 + 8 * fq); pmg[s3][1] = *(const f32x4*)(F.in[10] + 1604 + 32 * s3 + 8 * fq); }
    for (int tile_ = F.bid; tile_ < NTILE * POST_DUP; tile_ += F.G) {
        const int m = (tile_ % NTILE) * 16 + fr;
        const RowInfo ri = row_info(m);
        bf16x8 xg[3];
#pragma unroll
        for (int s3 = 0; s3 < 3; ++s3) {
            const F8 a = hs8m(F, HRW, m, ri, 1600 + 32 * s3 + 8 * fq, pmg[s3][0], pmg[s3][1]);
            f32x4 t0, t1;
#pragma unroll
            for (int i = 0; i < 4; ++i) { t0[i] = sigmoidf_(a.a[i]); t1[i] = sigmoidf_(a.b[i]); }
            xg[s3] = __builtin_bit_cast(bf16x8, pk8(t0, t1));
        }
        f32x4 y4[4], v4[4], g4[4]; float sy = 0.f, dot = 0.f;
#pragma unroll
        for (int np = 0; np < 2; ++np) {
            const int c8 = h * 64 + 16 * fq + 8 * np; const size_t o = (size_t)m * 512 + c8;
#pragma unroll
            for (int q = 0; q < 2; ++q) { f32x4 g = {0.f, 0.f, 0.f, 0.f};
#pragma unroll
                for (int s3 = 0; s3 < 3; ++s3) g = __builtin_amdgcn_mfma_f32_16x16x32_bf16(Ag[2 * np + q][s3], xg[s3], g, 0, 0, 0);
                g4[2 * np + q] = g; }
            const f32x4 ya = *(const f32x4*)(Y + o), yb = *(const f32x4*)(Y + o + 4);
            const F8 r8 = ld_bf8(SR + o), k8 = ld_bf8(SK + o), v8 = ld_bf8(SV + o);
            const f32x4 rka = prk[2 * np], rkb = prk[2 * np + 1];
            y4[2 * np] = ya; y4[2 * np + 1] = yb; v4[2 * np] = v8.a; v4[2 * np + 1] = v8.b;
            sy += ((ya[0] + ya[1]) + (ya[2] + ya[3])) + ((yb[0] + yb[1]) + (yb[2] + yb[3]));
            const f32x4 pa = r8.a * k8.a * rka, pb = r8.b * k8.b * rkb; dot += ((pa[0] + pa[1]) + (pa[2] + pa[3])) + ((pb[0] + pb[1]) + (pb[2] + pb[3]));
        }
        const float mean = xsum_fq(sy) * (1.f / 64.f); dot = xsum_fq(dot);
        float sq = 0.f;
#pragma unroll
        for (int nt = 0; nt < 4; ++nt) { y4[nt] = y4[nt] - mean; const f32x4 d = y4[nt]; sq += (d[0] * d[0] + d[1] * d[1]) + (d[2] * d[2] + d[3] * d[3]); }
        const float rstd = rsqrtf(xsum_fq(sq) * (1.f / 64.f) + GN_EPS);
#pragma unroll
        for (int np = 0; np < 2; ++np) {
            const int c8 = h * 64 + 16 * fq + 8 * np;
            f32x4 oo[2];
#pragma unroll
            for (int q = 0; q < 2; ++q) { const f32x4 gw = pgw[2 * np + q], gb = pgb[2 * np + q];
                oo[q] = (y4[2 * np + q] * rstd * gw + gb + v4[2 * np + q] * dot) * g4[2 * np + q]; }
            *(u32x4*)(OC + (size_t)m * DM + 512 + c8) = pk8(oo[0], oo[1]);
        }
    }
}

__device__ __forceinline__ f32x4 bf4_to_f(const u32x2 w) { return (f32x4){bflo(w.x), bfhi(w.x), bflo(w.y), bfhi(w.y)}; }
__device__ __forceinline__ float sumsq4(const f32x4 (&v)[4]) { float s = 0.f;
#pragma unroll
    for (int j = 0; j < 4; ++j) s += (v[j].x * v[j].x + v[j].y * v[j].y) + (v[j].z * v[j].z + v[j].w * v[j].w);
    return s; }
__device__ __forceinline__ void rows_mid(Frame& F) {
    const int gw = F.bid * NWAVES + F.wave, NGW = F.G * NWAVES;
    const f32x4* g1 = (const f32x4*)F.in[22]; const f32x4* g2 = (const f32x4*)F.in[23];
    bf16_t* XN = (bf16_t*)(F.ws + WS_XN); const bf16_t* MIXb = (const bf16_t*)(F.ws + WS_MIX);
    f32x4 ga[4], gb2[4];
#pragma unroll
    for (int j = 0; j < 4; ++j) { ga[j] = g1[64 * j + F.lane]; gb2[j] = g2[64 * j + F.lane]; }
    for (int m = gw; m < M; m += 2 * NGW) {
        const int m1 = m + NGW; const bool has1 = m1 < M; const int mm1 = has1 ? m1 : m;
        const f32x4* xr0 = (const f32x4*)xrow_ptr(F, m) + F.lane; const f32x4* xr1 = (const f32x4*)xrow_ptr(F, mm1) + F.lane;
        const u32x2* mb0 = (const u32x2*)(MIXb + (size_t)m * DM) + F.lane; const u32x2* mb1 = (const u32x2*)(MIXb + (size_t)mm1 * DM) + F.lane;
        f32x4 v0[4], v1[4], x0[4], x1[4];
#pragma unroll
        for (int j = 0; j < 4; ++j) { v0[j] = bf4_to_f(__builtin_nontemporal_load(mb0 + 64 * j)); x0[j] = __builtin_nontemporal_load(xr0 + 64 * j); }
#pragma unroll
        for (int j = 0; j < 4; ++j) { v1[j] = bf4_to_f(__builtin_nontemporal_load(mb1 + 64 * j)); x1[j] = __builtin_nontemporal_load(xr1 + 64 * j); }
        const float ra = 1.0f / sqrtf(wave_sum(sumsq4(v0)) * (1.f / DM) + RMS_EPS), rb = 1.0f / sqrtf(wave_sum(sumsq4(v1)) * (1.f / DM) + RMS_EPS);
#pragma unroll
        for (int j = 0; j < 4; ++j) { const f32x4 gg = ga[j]; v0[j] = x0[j] + v0[j] * ra * gg; v1[j] = x1[j] + v1[j] * rb * gg; }
        const float qa = 1.0f / sqrtf(wave_sum(sumsq4(v0)) * (1.f / DM) + RMS_EPS), qb = 1.0f / sqrtf(wave_sum(sumsq4(v1)) * (1.f / DM) + RMS_EPS);
        u32x2* o0 = (u32x2*)(XN + (size_t)m * DM) + F.lane; u32x2* o1 = (u32x2*)(XN + (size_t)mm1 * DM) + F.lane;
#pragma unroll
        for (int j = 0; j < 4; ++j) { const f32x4 gg = gb2[j];
            u32x2 w; w.x = pk2(v0[j].x * qa * gg.x, v0[j].y * qa * gg.y); w.y = pk2(v0[j].z * qa * gg.z, v0[j].w * qa * gg.w); o0[64 * j] = w;
            if (has1) { u32x2 q; q.x = pk2(v1[j].x * qb * gg.x, v1[j].y * qb * gg.y); q.y = pk2(v1[j].z * qb * gg.z, v1[j].w * qb * gg.w); o1[64 * j] = q; } }
    }
}
__device__ __forceinline__ void rows_final(Frame& F) {
    const int gw = F.bid * NWAVES + F.wave, NGW = F.G * NWAVES;
    const f32x4* g0 = (const f32x4*)F.in[22]; const f32x4* g1 = (const f32x4*)F.in[28];
    const bf16_t* Fb = (const bf16_t*)(F.ws + WS_F); const bf16_t* MIXb = (const bf16_t*)(F.ws + WS_MIX);
    f32x4 gA[4], gB[4];
#pragma unroll
    for (int j = 0; j < 4; ++j) { gA[j] = g0[64 * j + F.lane]; gB[j] = g1[64 * j + F.lane]; }
    for (int m = gw; m < M; m += 2 * NGW) {
        const int m1 = m + NGW; const bool has1 = m1 < M; const int mm1 = has1 ? m1 : m;
        f32x4 f0[4], f1[4], a0[4], a1[4], x0[4], x1[4];
        { const u32x2* fr = (const u32x2*)(Fb + (size_t)m * DM) + F.lane; const u32x2* mb = (const u32x2*)(MIXb + (size_t)m * DM) + F.lane; const f32x4* xr = (const f32x4*)xrow_ptr(F, m) + F.lane;
#pragma unroll
          for (int j = 0; j < 4; ++j) { f0[j] = bf4_to_f(__builtin_nontemporal_load(fr + 64 * j)); a0[j] = bf4_to_f(__builtin_nontemporal_load(mb + 64 * j)); x0[j] = __builtin_nontemporal_load(xr + 64 * j); } }
        { const u32x2* fr = (const u32x2*)(Fb + (size_t)mm1 * DM) + F.lane; const u32x2* mb = (const u32x2*)(MIXb + (size_t)mm1 * DM) + F.lane; const f32x4* xr = (const f32x4*)xrow_ptr(F, mm1) + F.lane;
#pragma unroll
          for (int j = 0; j < 4; ++j) { f1[j] = bf4_to_f(__builtin_nontemporal_load(fr + 64 * j)); a1[j] = bf4_to_f(__builtin_nontemporal_load(mb + 64 * j)); x1[j] = __builtin_nontemporal_load(xr + 64 * j); } }
        const float rf0 = 1.0f / sqrtf(wave_sum(sumsq4(f0)) * (1.f / DM) + RMS_EPS), rm0 = 1.0f / sqrtf(wave_sum(sumsq4(a0)) * (1.f / DM) + RMS_EPS);
        const float rf1 = 1.0f / sqrtf(wave_sum(sumsq4(f1)) * (1.f / DM) + RMS_EPS), rm1 = 1.0f / sqrtf(wave_sum(sumsq4(a1)) * (1.f / DM) + RMS_EPS);
        f32x4* y0 = (f32x4*)(F.out + (size_t)m * DM) + F.lane; f32x4* y1 = (f32x4*)(F.out + (size_t)mm1 * DM) + F.lane;
#pragma unroll
        for (int j = 0; j < 4; ++j) { const f32x4 ga = gA[j], gb = gB[j];
            __builtin_nontemporal_store((x0[j] + a0[j] * rm0 * ga) + f0[j] * rf0 * gb, y0 + 64 * j);
            if (has1) __builtin_nontemporal_store((x1[j] + a1[j] * rm1 * ga) + f1[j] * rf1 * gb, y1 + 64 * j); }
    }
}
__device__ __forceinline__ void conv_phase(Frame& F, int half) {
    const bf16_t* ZU = (const bf16_t*)(F.ws + WS_ZU); bf16_t* HID = (bf16_t*)(F.ws + WS_HID);
    const float* cw = F.in[25]; const float* cb = F.in[26]; const float* sc = F.in[6];
    const long total = (long)M * 176;
    for (long e = (long)F.bid * NT + F.tid; e < total; e += (long)F.G * NT) {
        const int m = (int)(e / 176), r = (int)(e - (long)m * 176); const int tile = r >> 4, c8 = (r & 15) * 8;
        const int ch = (half * 11 + tile) * 128 + c8;
        const RowInfo ri = row_info(m);
        const bf16_t* zp = ZU + (size_t)m * DFF + tile * 256 + c8;
        const u32x4 z0 = *(const u32x4*)zp, uu = *(const u32x4*)(zp + 128);
        float z[8], z1[8], z2[8], u8[8];
        z[0] = bflo(z0.x); z[1] = bfhi(z0.x); z[2] = bflo(z0.y); z[3] = bfhi(z0.y); z[4] = bflo(z0.z); z[5] = bfhi(z0.z); z[6] = bflo(z0.w); z[7] = bfhi(z0.w);
        u8[0] = bflo(uu.x); u8[1] = bfhi(uu.x); u8[2] = bflo(uu.y); u8[3] = bfhi(uu.y); u8[4] = bflo(uu.z); u8[5] = bfhi(uu.z); u8[6] = bflo(uu.w); u8[7] = bfhi(uu.w);
        if (ri.t >= 1) { const u32x4 w = *(const u32x4*)(zp - DFF); z1[0] = bflo(w.x); z1[1] = bfhi(w.x); z1[2] = bflo(w.y); z1[3] = bfhi(w.y); z1[4] = bflo(w.z); z1[5] = bfhi(w.z); z1[6] = bflo(w.w); z1[7] = bfhi(w.w); }
        else {
#pragma unroll
            for (int j = 0; j < 8; ++j) z1[j] = ri.samp ? sc[((size_t)ri.b * 2 + 1) * DFF + ch + j] : 0.f; }
        if (ri.t >= 2) { const u32x4 w = *(const u32x4*)(zp - 2 * DFF); z2[0] = bflo(w.x); z2[1] = bfhi(w.x); z2[2] = bflo(w.y); z2[3] = bfhi(w.y); z2[4] = bflo(w.z); z2[5] = bfhi(w.z); z2[6] = bflo(w.w); z2[7] = bfhi(w.w); }
        else {
#pragma unroll
            for (int j = 0; j < 8; ++j) z2[j] = ri.samp ? sc[((size_t)ri.b * 2 + ri.t) * DFF + ch + j] : 0.f; }
        float hd[8];
#pragma unroll
        for (int j = 0; j < 8; ++j) { const float zc = cb[ch + j] + cw[ch + j] * z2[j] + cw[DFF + ch + j] * z1[j] + cw[2 * DFF + ch + j] * z[j]; hd[j] = zc * sigmoidf_(zc) * u8[j]; }
        u32x4 w; w.x = pk2(hd[0], hd[1]); w.y = pk2(hd[2], hd[3]); w.z = pk2(hd[4], hd[5]); w.w = pk2(hd[6], hd[7]);
        *(u32x4*)(HID + (size_t)m * DFF + ch) = w;
    }
}

constexpr int NPHASE = 10;
__global__ void __launch_bounds__(NT, 2) fwd_megakernel(Args args) {
    extern __shared__ __attribute__((aligned(16))) unsigned char lds_raw[];
    Frame F;
    F.lds = (LAS unsigned char*)lds_raw; F.ws = args.ws; F.out = args.out; F.in = args.in;
    F.tid = threadIdx.x; F.lane = F.tid & 63; F.wave = __builtin_amdgcn_readfirstlane(F.tid >> 6); F.G = gridDim.x; F.bid = blockIdx.x;
    const int lo = args.ph_lo, hi = args.ph_hi;
#ifndef PH_MASK
#define PH_MASK 0x3ff
#endif
#ifndef DUP_MASK
#define DUP_MASK 0
#endif
#define IN(k) (((PH_MASK >> (k)) & 1) && lo <= (k) && (k) < hi)
#define REP(k) for (int rep_ = 0; rep_ < 1 + ((DUP_MASK >> (k)) & 1); ++rep_)
    unsigned* barw = (unsigned*)F.ws;
    volatile LAS unsigned* bst = (volatile LAS unsigned*)(F.lds + LDS_BYTES - 64);
    if (F.tid < 2) bst[F.tid] = 0u;
    XcdBarrier xbar; xbar.bar = barw; xbar.x = 0; xbar.st = bst;
    bool posted = false;
    if (lo + 1 < hi && F.bid == 0) { for (int i = F.tid; i < XCD_BAR_WORDS; i += NT) barw[i] = 0u; }
#define SEAM(k) do { if (IN(k) && IN((k) + 1)) { if (!posted) { cg::this_grid().sync(); xbar = xcd_barrier_post(barw, bst); posted = true; } else xcd_barrier(xbar); } } while (0)
    bf16_t* XN = (bf16_t*)(F.ws + WS_XN);
    if (IN(0)) REP(0) { p0_prologue(F); } SEAM(0);
    if (IN(1)) REP(1) {
        pg8::Gemm g{XN, (const bf16_t*)(F.ws + WS_WIN), M, DINP, DM, DM, DM, 0}; pg8::StaticOrder S; S.init(M, DINP, F.G, F.bid);
        Epi1 E{(const float*)(F.ws + WS_ROPE), (bf16_t*)(F.ws + WS_Q), (bf16_t*)(F.ws + WS_K), (bf16_t*)(F.ws + WS_VT), (bf16_t*)(F.ws + WS_HRW), F.out};
        pg8::gemm_phase<Epi1, true>(F.lds, g, S, E);
    } SEAM(1);
    if (IN(2)) REP(2) { prep_phase(F); sample_attn_phase(F); } SEAM(2);
    if (IN(3)) {
        if (F.G == 256) {
            constexpr int AOFF = 71680;
            prompt_attn_unit<1>(F, F.bid, 0); prompt_attn_unit<1>(F, F.bid + 256, AOFF);
            __syncthreads();
            prompt_attn_unit<2>(F, F.bid, 0); prompt_attn_unit<2>(F, F.bid + 256, AOFF);
            __syncthreads();
        } else for (int u = F.bid; u < NB * 64 * 2; u += F.G) prompt_attn_unit<0>(F, u, 0);
        sample_scan(F, F.bid, F.G);
        for (int sb = F.bid; sb < 256; sb += F.G) prompt_scan(F, sb);
    } SEAM(3);
    if (IN(4)) REP(4) { post_phase(F); } SEAM(4);
    if (IN(5)) REP(5) {
        pg8::Gemm g{(const bf16_t*)(F.ws + WS_OCAT), (const bf16_t*)(F.ws + WS_WOUT), M, DM, DM, DM, DM, 0}; pg8::StaticOrder S; S.init(M, DM, F.G, F.bid);
        EpiBf16 E{(bf16_t*)(F.ws + WS_MIX), DM};
        pg8::gemm_phase<EpiBf16, true>(F.lds, g, S, E);
    } SEAM(5);
    if (IN(6)) { rows_mid(F); } SEAM(6);
    if (IN(7)) REP(7) {
        pg8::Gemm g{XN, (const bf16_t*)(F.ws + WS_WFI), 136 * 256, 2 * DFF, DM, DM, DM, 1}; pg8::StaticOrder S; S.init(136 * 256, 2 * DFF, F.G, F.bid);
        EpiConv E{(bf16_t*)(F.ws + WS_HID), F.out, F.in[25], F.in[26], F.in[6], (LAS float*)(F.lds + 131072)};
        pg8::gemm_phase<EpiConv, true>(F.lds, g, S, E);
    } SEAM(7);
    if (IN(8)) REP(11) {
        pg8::Gemm g{(const bf16_t*)(F.ws + WS_HID), (const bf16_t*)(F.ws + WS_WFO), M, DM, DFF, DFF, DFF, 0}; pg8::StaticOrder S; S.init(M, DM, F.G, F.bid);
        EpiBf16 E{(bf16_t*)(F.ws + WS_F), DM};
        pg8::gemm_phase<EpiBf16, true>(F.lds, g, S, E);
    } SEAM(8);
    if (IN(9)) { rows_final(F); }
#undef IN
#undef SEAM
}

extern "C" void kernel_launch(void* const* d_in, const int* in_sizes, int n_in, void* d_out, int out_size, void* d_ws, size_t ws_size, hipStream_t stream) {
    static int grid = 0;
    if (grid == 0) {
        if (n_in != 29 || ws_size < WS_END) { fprintf(stderr, "kernel_launch: unexpected n_in %d / ws_size %zu\n", n_in, ws_size); grid = -1; return; }
        int dev = 0, cus = 0, per_cu = 0;
        hipGetDevice(&dev); hipDeviceGetAttribute(&cus, hipDeviceAttributeMultiprocessorCount, dev);
        if (hipFuncSetAttribute((const void*)fwd_megakernel, hipFuncAttributeMaxDynamicSharedMemorySize, LDS_BYTES) != hipSuccess) { fprintf(stderr, "kernel_launch: hipFuncSetAttribute failed\n"); grid = -1; return; }
        if (hipOccupancyMaxActiveBlocksPerMultiprocessor(&per_cu, (const void*)fwd_megakernel, NT, LDS_BYTES) != hipSuccess || per_cu < 1) { fprintf(stderr, "kernel_launch: occupancy query failed (%d)\n", per_cu); (void)hipGetLastError(); per_cu = 1; }
        grid = cus * (per_cu > 1 ? 1 : per_cu);
        fprintf(stderr, "kernel_launch: grid %d (cus %d, per_cu %d), ws %zu\n", grid, cus, per_cu, ws_size);
    }
    if (grid < 0) return;
    Args a{};
    for (int i = 0; i < 29; ++i) a.in[i] = (const float*)d_in[i];
    a.out = (float*)d_out; a.ws = (unsigned char*)d_ws;
#if MK_PER_PHASE
    for (int p = 0; p < NPHASE; ++p) { a.ph_lo = p; a.ph_hi = p + 1; hipLaunchKernelGGL(fwd_megakernel, dim3(grid), dim3(NT), LDS_BYTES, stream, a); }
#else
    a.ph_lo = 0; a.ph_hi = NPHASE;
    void* kargs[] = {&a};
    hipError_t e = hipLaunchCooperativeKernel((const void*)fwd_megakernel, dim3(grid), dim3(NT), kargs, LDS_BYTES, stream);
    if (e != hipSuccess) fprintf(stderr, "cooperative launch failed: %s (grid %d)\n", hipGetErrorString(e), grid);
#endif
}
```

```cpp
#include <hip/hip_runtime.h>
#include <hip/hip_cooperative_groups.h>
#include <cstdio>
#include <cstdint>
#include <utility>
namespace cg = cooperative_groups;

#ifndef MK_PER_PHASE
#define MK_PER_PHASE 0
#endif

#define LAS __attribute__((address_space(3)))
typedef unsigned short bf16_t;
typedef short bf16x8 __attribute__((ext_vector_type(8)));
typedef float f32x4 __attribute__((ext_vector_type(4)));
typedef float f32x2 __attribute__((ext_vector_type(2)));
typedef unsigned u32x4 __attribute__((ext_vector_type(4)));
typedef unsigned u32x2 __attribute__((ext_vector_type(2)));

constexpr int DM = 1024, NB = 4, T = 8192, MP = NB * T, DB = 128, DT = 8, MS = DB * DT, M = MP + MS;
constexpr int WIN = 128, DSH = 1696, DINP = 2560, DFF = 2816, DFFH = 1408;
constexpr float RMS_EPS = 1e-6f, GN_EPS = 64e-5f;
constexpr float QSCALE = 0.125f * 1.4426950408889634f;
constexpr size_t O_Y = 0, O_KWP = 34603008, O_VWP = 34668544, O_SHP = 34734080, O_WKVP = 34740864, O_CVP = 34871936,
                 O_KWS = 34894464, O_VWS = 36991616, O_SHS = 39088768, O_WKVS = 39305856, O_CVS = 43500160;
constexpr size_t MiB = 1u << 20;
constexpr size_t WS_WIN = 1 * MiB, WS_WOUT = 6 * MiB, WS_WFI = 8 * MiB, WS_WFO = 19 * MiB, WS_ROPE = 25 * MiB;
constexpr size_t WS_XN = 32 * MiB;
constexpr size_t WS_SR = 32 * MiB, WS_SK = 65 * MiB;
constexpr size_t WS_Q = 98 * MiB, WS_K = 131 * MiB, WS_VT = 140 * MiB;
constexpr size_t WS_HRW = 150 * MiB;
constexpr size_t WS_OCAT = 260 * MiB;
constexpr size_t WS_SW = 326 * MiB;
constexpr size_t WS_SV = 392 * MiB, WS_SKK = 425 * MiB, WS_SB = 458 * MiB;
constexpr size_t WS_ZU = 100 * MiB;
constexpr size_t WS_HID = 282 * MiB;
constexpr size_t WS_F = 216 * MiB;
constexpr size_t WS_MIX = 150 * MiB;
constexpr size_t WS_END = 491 * MiB;

__device__ __forceinline__ unsigned f2bf(float f) { unsigned u = __float_as_uint(f); return (u + 0x7fffu + ((u >> 16) & 1u)) >> 16; }

__device__ __forceinline__ float bf2f(unsigned short h) { return __uint_as_float(((unsigned)h) << 16); }
__device__ __forceinline__ float bflo(unsigned w) { return __uint_as_float(w << 16); }
__device__ __forceinline__ float bfhi(unsigned w) { return __uint_as_float(w & 0xffff0000u); }
__device__ __forceinline__ unsigned cvt_pk_bf16(float lo, float hi) { unsigned r; asm volatile("v_cvt_pk_bf16_f32 %0, %1, %2" : "=v"(r) : "v"(lo), "v"(hi)); return r; }
__device__ __forceinline__ unsigned pk2(float lo, float hi) { return cvt_pk_bf16(lo, hi); }
template <int CTRL> __device__ __forceinline__ float dppf(float x) { return __int_as_float(__builtin_amdgcn_update_dpp(0, __float_as_int(x), CTRL, 0xF, 0xF, false)); }
__device__ __forceinline__ float allsum16(float x) {
    x += dppf<0xB1>(x); x += dppf<0x4E>(x); x += dppf<0x141>(x); x += dppf<0x140>(x); return x;
}
__device__ __forceinline__ void allsum16_2(float& a, float& b) {
    a += dppf<0xB1>(a); b += dppf<0xB1>(b); a += dppf<0x4E>(a); b += dppf<0x4E>(b); a += dppf<0x141>(a); b += dppf<0x141>(b); a += dppf<0x140>(a); b += dppf<0x140>(b);
}
__device__ __forceinline__ float wave_sum(float v) {
    v = allsum16(v);
    { auto r = __builtin_amdgcn_permlane16_swap(__float_as_uint(v), __float_as_uint(v), false, false); v = __uint_as_float(r[0]) + __uint_as_float(r[1]); }
    { auto r = __builtin_amdgcn_permlane32_swap(__float_as_uint(v), __float_as_uint(v), false, false); v = __uint_as_float(r[0]) + __uint_as_float(r[1]); }
    return v;
}
__device__ __forceinline__ float sigmoidf_(float x) { return __builtin_amdgcn_rcpf(1.0f + __expf(-x)); }

namespace pg8 {
constexpr int BM = 256, BK = 64, HALF = 128, HTB = HALF * BK * 2, STAGE_BYTES = 8 * HTB, NXCD = 8, WGM = 8;
__host__ __device__ __forceinline__ int lds_byte(int r, int c) { const int st = (r >> 4) * 2 + (c >> 5), rr = r & 15, cc = c & 31, ob = rr * 64 + cc * 2; return st * 1024 + (ob ^ (((ob >> 9) & 1) << 5)); }
__host__ __device__ __forceinline__ void stage_rc(int b, int& R, int& C) { const int st = b / 1024, sb = b % 1024, swz = sb ^ (((sb >> 9) & 1) << 5); R = (st >> 1) * 16 + swz / 64; C = (st & 1) * 32 + (swz % 64) / 2; }
__host__ __device__ __forceinline__ int perm32(int rho) { const int n = rho >> 4, i = rho & 15; return 8 * (i >> 2) + 4 * n + (i & 3); }
struct Unit { int pm, pn; };
struct Gemm { const bf16_t* A; const bf16_t* Bt; int M, N, K, lda, ldb, conv; };
__device__ __forceinline__ long arow(const Gemm& g, int pm) {
    if (!g.conv) return (long)pm * 256;
    if (pm < 132) { const int b = pm / 33; return (long)b * 8192 + 254 * (pm - 33 * b) - 2; }
    return 32768 + (long)(pm - 132) * 256;
}
struct StaticOrder {
    int nM, nN, nwg, G, c;
    __device__ void init(int M_, int N_, int G_, int c_) { nM = M_ / BM; nN = N_ / BM; nwg = nM * nN; G = G_; c = c_; }
    __device__ bool next(int i, Unit& u) const {
        const long L = (long)i * G + c; if (L >= nwg) return false;
        int wgid = (int)L; { const int q = nwg / NXCD, r = nwg % NXCD, xcd = wgid % NXCD, off = wgid / NXCD; wgid = (xcd < r ? xcd * (q + 1) : r * (q + 1) + (xcd - r) * q) + off; }
        const int nig = WGM * nN, gid = wgid / nig, fm = gid * WGM, gsz = (nM - fm) < WGM ? (nM - fm) : WGM;
        u.pm = fm + ((wgid % nig) % gsz); u.pn = (wgid % nig) / gsz; return true;
    }
};
template <class Epi, bool ALIGN_EPI>
__device__ __forceinline__ void gemm_phase(LAS unsigned char* lds, const Gemm g, const StaticOrder& S, const Epi& E) {
    const int tid = threadIdx.x, wid = __builtin_amdgcn_readfirstlane(tid >> 6), lane = tid & 63, wr = wid >> 2, wc = wid & 3, fr = lane & 15, fq = lane >> 4;
    const int nt = g.K / BK;
    unsigned voffA[2], voffB[2];
#pragma unroll
    for (int i = 0; i < 2; ++i) { int R, C; stage_rc(tid * 16 + i * 8192, R, C); const int Rb = (R & ~31) + perm32(R & 31);
        voffA[i] = (unsigned)(R * g.lda + C) * 2u; voffB[i] = (unsigned)(Rb * g.ldb + C) * 2u; }
    const size_t kstep = (size_t)(BK * 2);
    const size_t hstepA = (size_t)HALF * g.lda * 2, hstepB = (size_t)HALF * g.ldb * 2;
    const size_t rowA = (size_t)g.lda * 2, tstepB = 2 * hstepB;
    const unsigned ldsw = (unsigned)wid * 1024u;
    const int aoff = lds_byte(wr * 64 + fr, fq * 8), boff = lds_byte(wc * 32 + fr, fq * 8);
#define PG8_SA(b, h) (((b) * 2 + (h)) * HTB)
#define PG8_SB(b, h) ((4 + (b) * 2 + (h)) * HTB)
#define PG8_STAGE(bufoff, gbase, voff) do { _Pragma("unroll") for (int _i = 0; _i < 2; ++_i) \
        __builtin_amdgcn_global_load_lds((const unsigned*)((const char*)(gbase) + (voff)[_i]), (LAS unsigned*)(lds + (bufoff) + ldsw + _i * 8192), 16, 0, 0); } while (0)
#define PG8_LDA(dst, b, h) do { _Pragma("unroll") for (int m = 0; m < 4; ++m) _Pragma("unroll") for (int k = 0; k < 2; ++k) dst[m][k] = *(const LAS bf16x8*)(lds + PG8_SA(b, h) + aoff + m * 2048 + k * 1024); } while (0)
#define PG8_LDB(dst, b, h) do { _Pragma("unroll") for (int n = 0; n < 2; ++n) _Pragma("unroll") for (int k = 0; k < 2; ++k) dst[n][k] = *(const LAS bf16x8*)(lds + PG8_SB(b, h) + boff + n * 2048 + k * 1024); } while (0)
#define PG8_MMA(ai, bj, At, Bt) do { __builtin_amdgcn_s_setprio(1); _Pragma("unroll") for (int m = 0; m < 4; ++m) _Pragma("unroll") for (int n = 0; n < 2; ++n) _Pragma("unroll") for (int k = 0; k < 2; ++k) \
        acc[ai][bj][m][n] = __builtin_amdgcn_mfma_f32_16x16x32_bf16(Bt[n][k], At[m][k], acc[ai][bj][m][n], 0, 0, 0); __builtin_amdgcn_s_setprio(0); } while (0)
#define PG8_WAIT_V(n) asm volatile("s_waitcnt vmcnt(" #n ")" ::: "memory")
#define PG8_WAIT_L(n) asm volatile("s_waitcnt lgkmcnt(" #n ")" ::: "memory")
#define PG8_BAR __builtin_amdgcn_s_barrier()
#define PG8_SCHED __builtin_amdgcn_sched_barrier(0)
    Unit cur, nxt; int ui = 0;
    if (!S.next(0, cur)) return;
    f32x4 acc[2][2][4][2];
#pragma unroll
    for (int a = 0; a < 2; ++a)
#pragma unroll
        for (int b = 0; b < 2; ++b)
#pragma unroll
            for (int m = 0; m < 4; ++m)
#pragma unroll
                for (int n = 0; n < 2; ++n) acc[a][b][m][n] = (f32x4){0.f, 0.f, 0.f, 0.f};
    bf16x8 At[4][2], B0[2][2], B1[2][2];
    const char* cA = (const char*)g.A + arow(g, cur.pm) * (long)rowA; const char* cB = (const char*)g.Bt + (size_t)cur.pn * tstepB;
    PG8_STAGE(PG8_SB(0, 0), cB, voffB); PG8_STAGE(PG8_SB(0, 1), cB + hstepB, voffB); PG8_STAGE(PG8_SA(0, 0), cA, voffA); PG8_STAGE(PG8_SA(0, 1), cA + hstepA, voffA);
    if (wr == 1) PG8_BAR;
    PG8_WAIT_V(2); PG8_BAR;
    PG8_STAGE(PG8_SB(1, 0), cB + kstep, voffB); PG8_STAGE(PG8_SA(1, 0), cA + kstep, voffA); PG8_STAGE(PG8_SB(1, 1), cB + hstepB + kstep, voffB);
    PG8_WAIT_V(6); PG8_BAR;
    for (;;) {
        const bool has_next = S.next(ui + 1, nxt);
        const char* nA = has_next ? (const char*)g.A + arow(g, nxt.pm) * (long)rowA : cA; const char* nB = has_next ? (const char*)g.Bt + (size_t)nxt.pn * tstepB : cB;
        for (int t = 0; t < nt; t += 2) {
            const bool last = (t == nt - 2);
            const char* a1 = cA + (size_t)(t + 1) * kstep;
            const char* a2 = last ? nA : cA + (size_t)(t + 2) * kstep; const char* b2 = last ? nB : cB + (size_t)(t + 2) * kstep;
            const char* a3 = a2 + kstep; const char* b3 = b2 + kstep;
            PG8_LDB(B0, 0, 0); PG8_LDB(B1, 0, 1); PG8_SCHED; PG8_LDA(At, 0, 0); PG8_STAGE(PG8_SA(1, 1), a1 + hstepA, voffA);
            PG8_WAIT_V(8); PG8_WAIT_L(0); PG8_BAR; PG8_MMA(0, 0, At, B0); PG8_MMA(0, 1, At, B1); PG8_BAR; PG8_SCHED;
            PG8_LDA(At, 0, 1); PG8_STAGE(PG8_SB(0, 0), b2, voffB); PG8_STAGE(PG8_SB(0, 1), b2 + hstepB, voffB); PG8_STAGE(PG8_SA(0, 0), a2, voffA);
            PG8_WAIT_V(8); PG8_WAIT_L(0); PG8_BAR; PG8_MMA(1, 0, At, B0); PG8_MMA(1, 1, At, B1); PG8_BAR; PG8_SCHED;
            PG8_LDB(B0, 1, 0); PG8_LDB(B1, 1, 1); PG8_SCHED; PG8_LDA(At, 1, 0); PG8_STAGE(PG8_SA(0, 1), a2 + hstepA, voffA);
            PG8_WAIT_V(8); PG8_WAIT_L(0); PG8_BAR; PG8_MMA(0, 0, At, B0); PG8_MMA(0, 1, At, B1); PG8_BAR; PG8_SCHED;
            PG8_LDA(At, 1, 1); PG8_STAGE(PG8_SB(1, 0), b3, voffB); PG8_STAGE(PG8_SB(1, 1), b3 + hstepB, voffB); PG8_STAGE(PG8_SA(1, 0), a3, voffA);
            PG8_WAIT_V(8); PG8_WAIT_L(0); PG8_BAR; PG8_MMA(1, 0, At, B0); PG8_MMA(1, 1, At, B1); PG8_BAR; PG8_SCHED;
        }
        if constexpr (ALIGN_EPI) { if (wr == 0) PG8_BAR; }
        asm volatile("s_nop 7\n\ts_nop 7" ::: "memory");
        E(acc, cur, wr, wc, fr, fq);
        if (!has_next) break;
#pragma unroll
        for (int a = 0; a < 2; ++a)
#pragma unroll
            for (int b = 0; b < 2; ++b)
#pragma unroll
                for (int m = 0; m < 4; ++m)
#pragma unroll
                    for (int n = 0; n < 2; ++n) acc[a][b][m][n] = (f32x4){0.f, 0.f, 0.f, 0.f};
        cur = nxt; cA = nA; cB = nB; ++ui;
        if constexpr (ALIGN_EPI) { if (wr == 1) PG8_BAR; }
    }
    PG8_WAIT_V(0);
    if constexpr (!ALIGN_EPI) { if (wr == 0) PG8_BAR; }
    PG8_BAR;
#undef PG8_SA
#undef PG8_SB
#undef PG8_STAGE
#undef PG8_LDA
#undef PG8_LDB
#undef PG8_MMA
#undef PG8_WAIT_V
#undef PG8_WAIT_L
#undef PG8_BAR
#undef PG8_SCHED
}
}

struct RowInfo { int b, t, samp; };
__device__ __forceinline__ RowInfo row_info(int row) { RowInfo r; if (row < MP) { r.samp = 0; r.b = row >> 13; r.t = row & (T - 1); } else { const int rs = row - MP; r.samp = 1; r.b = rs >> 3; r.t = rs & 7; } return r; }

struct Epi1 {
    const float* rope; bf16_t* Q; bf16_t* Kb; bf16_t* VT; bf16_t* HRW; float* out;
    __device__ __forceinline__ void operator()(const f32x4 (&acc)[2][2][4][2], const pg8::Unit& u, int wr, int wc, int fr, int fq) const {
#pragma unroll
        for (int ai = 0; ai < 2; ++ai)
#pragma unroll
            for (int m = 0; m < 4; ++m) {
                const int row = u.pm * 256 + ai * 128 + wr * 64 + m * 16 + fr;
                const RowInfo ri = row_info(row);
                const int pidx = ri.samp ? (T + ri.t) : ri.t;
#pragma unroll
                for (int bj = 0; bj < 2; ++bj) {
                    const int cb = u.pn * 256 + bj * 128;
                    const int c0 = cb + wc * 32 + fq * 8;
                    const f32x4 v0 = acc[ai][bj][m][0], v1 = acc[ai][bj][m][1];
                    if (cb < 640) {
                        const int d0 = ((c0 & 63) >> 3) * 4;
                        const f32x4* rp = (const f32x4*)(rope + ((size_t)pidx * 32 + d0) * 2);
                        const f32x4 cs0 = rp[0], cs1 = rp[1];
                        f32x4 o1, o2;
                        o1[0] = v0[0] * cs0[0] - v1[0] * cs0[1]; o2[0] = v1[0] * cs0[0] + v0[0] * cs0[1];
                        o1[1] = v0[1] * cs0[2] - v1[1] * cs0[3]; o2[1] = v1[1] * cs0[2] + v0[1] * cs0[3];
                        o1[2] = v0[2] * cs1[0] - v1[2] * cs1[1]; o2[2] = v1[2] * cs1[0] + v0[2] * cs1[1];
                        o1[3] = v0[3] * cs1[2] - v1[3] * cs1[3]; o2[3] = v1[3] * cs1[2] + v0[3] * cs1[3];
                        if (cb < 512) {
                            o1 = o1 * QSCALE; o2 = o2 * QSCALE;
                            bf16_t* qp = Q + (size_t)row * 512 + (c0 & ~63) + d0;
                            u32x2 w1, w2; w1.x = cvt_pk_bf16(o1[0], o1[1]); w1.y = cvt_pk_bf16(o1[2], o1[3]); w2.x = cvt_pk_bf16(o2[0], o2[1]); w2.y = cvt_pk_bf16(o2[2], o2[3]);
                            *(u32x2*)qp = w1; *(u32x2*)(qp + 32) = w2;
                        } else {
                            const int kvh = (c0 - 512) >> 6;
                            bf16_t* kp = Kb + (size_t)row * 128 + kvh * 64 + d0;
                            u32x2 w1, w2; w1.x = cvt_pk_bf16(o1[0], o1[1]); w1.y = cvt_pk_bf16(o1[2], o1[3]); w2.x = cvt_pk_bf16(o2[0], o2[1]); w2.y = cvt_pk_bf16(o2[2], o2[3]);
                            *(u32x2*)kp = w1; *(u32x2*)(kp + 32) = w2;
                            if (!ri.samp) { if (ri.t >= T - WIN) { float* o = out + O_KWP + ((size_t)(ri.b * WIN + (ri.t - (T - WIN))) * 2 + kvh) * 64 + d0; *(f32x4*)o = o1; *(f32x4*)(o + 32) = o2; } }
                            else { float* o = out + O_KWS + ((size_t)(ri.b * WIN + (WIN - DT) + ri.t) * 2 + kvh) * 64 + d0; *(f32x4*)o = o1; *(f32x4*)(o + 32) = o2; }
                        }
                    } else if (cb < 768) {
                        const int kvh = (c0 - 640) >> 6, d0 = (c0 - 640) & 63;
                        if (!ri.samp) {
                            bf16_t* vp = VT + ((size_t)(ri.b * 2 + kvh) * 64 + d0) * T + ri.t;
                            vp[0] = (bf16_t)f2bf(v0[0]); vp[(size_t)T] = (bf16_t)f2bf(v0[1]); vp[(size_t)2 * T] = (bf16_t)f2bf(v0[2]); vp[(size_t)3 * T] = (bf16_t)f2bf(v0[3]);
                            vp[(size_t)4 * T] = (bf16_t)f2bf(v1[0]); vp[(size_t)5 * T] = (bf16_t)f2bf(v1[1]); vp[(size_t)6 * T] = (bf16_t)f2bf(v1[2]); vp[(size_t)7 * T] = (bf16_t)f2bf(v1[3]);
                            if (ri.t >= T - WIN) { float* o = out + O_VWP + ((size_t)(ri.b * WIN + (ri.t - (T - WIN))) * 2 + kvh) * 64 + d0; *(f32x4*)o = v0; *(f32x4*)(o + 4) = v1; }
                        } else { float* o = out + O_VWS + ((size_t)(ri.b * WIN + (WIN - DT) + ri.t) * 2 + kvh) * 64 + d0; *(f32x4*)o = v0; *(f32x4*)(o + 4) = v1; }
                    } else if (c0 < 2464) {
                        const int col = c0 - 768;
                        u32x4 w; w.x = cvt_pk_bf16(v0[0], v0[1]); w.y = cvt_pk_bf16(v0[2], v0[3]); w.z = cvt_pk_bf16(v1[0], v1[1]); w.w = cvt_pk_bf16(v1[2], v1[3]);
                        *(u32x4*)(HRW + (size_t)row * DSH + col) = w;
                        if (!ri.samp) { if (ri.t == T - 1) { float* o = out + O_SHP + (size_t)ri.b * DSH + col; *(f32x4*)o = v0; *(f32x4*)(o + 4) = v1; } }
                        else if (ri.t == DT - 1) { float* o = out + O_SHS + (size_t)ri.b * DSH + col; *(f32x4*)o = v0; *(f32x4*)(o + 4) = v1; }
                    }
                }
            }
    }
};
struct EpiF32 {
    float* O; int ldc;
    __device__ __forceinline__ void operator()(const f32x4 (&acc)[2][2][4][2], const pg8::Unit& u, int wr, int wc, int fr, int fq) const {
#pragma unroll
        for (int ai = 0; ai < 2; ++ai)
#pragma unroll
            for (int m = 0; m < 4; ++m) {
                float* rowp = O + (size_t)(u.pm * 256 + ai * 128 + wr * 64 + m * 16 + fr) * ldc + u.pn * 256 + wc * 32 + fq * 8;
#pragma unroll
                for (int bj = 0; bj < 2; ++bj) { *(f32x4*)(rowp + bj * 128) = acc[ai][bj][m][0]; *(f32x4*)(rowp + bj * 128 + 4) = acc[ai][bj][m][1]; }
            }
    }
};
struct EpiBf16 {
    bf16_t* O; int ldc;
    __device__ __forceinline__ void operator()(const f32x4 (&acc)[2][2][4][2], const pg8::Unit& u, int wr, int wc, int fr, int fq) const {
#pragma unroll
        for (int ai = 0; ai < 2; ++ai)
#pragma unroll
            for (int m = 0; m < 4; ++m) {
                bf16_t* rowp = O + (size_t)(u.pm * 256 + ai * 128 + wr * 64 + m * 16 + fr) * ldc + u.pn * 256 + wc * 32 + fq * 8;
#pragma unroll
                for (int bj = 0; bj < 2; ++bj) { const f32x4 v0 = acc[ai][bj][m][0], v1 = acc[ai][bj][m][1];
                    u32x4 w; w.x = cvt_pk_bf16(v0[0], v0[1]); w.y = cvt_pk_bf16(v0[2], v0[3]); w.z = cvt_pk_bf16(v1[0], v1[1]); w.w = cvt_pk_bf16(v1[2], v1[3]);
                    *(u32x4*)(rowp + bj * 128) = w; }
            }
    }
};
template <int CTRL> __device__ __forceinline__ float dpp_old(float old, float src) { return __int_as_float(__builtin_amdgcn_update_dpp(__float_as_int(old), __float_as_int(src), CTRL, 0xF, 0xF, false)); }
struct EpiConv {
    bf16_t* HID; float* out; const float* cw; const float* cb; const float* sc; LAS float* exch;
    __device__ __forceinline__ void operator()(const f32x4 (&acc)[2][2][4][2], const pg8::Unit& u, int wr, int wc, int fr, int fq) const {
        const int cw8 = wc * 32 + fq * 8, ch0 = u.pn * 128 + cw8;
        if (fr >= 14) {
#pragma unroll
            for (int ai = 0; ai < 2; ++ai)
#pragma unroll
                for (int n = 0; n < 2; ++n) *(LAS f32x4*)(exch + ((ai * 2 + wr) * 2 + (fr - 14)) * 128 + cw8 + 4 * n) = acc[ai][0][3][n];
        }
        asm volatile("s_waitcnt lgkmcnt(0)\n\ts_barrier" ::: "memory");
        int row0, b0 = 0, i0 = 0; const bool samp = u.pm >= 132;
        if (!samp) { b0 = u.pm / 33; i0 = u.pm - 33 * b0; row0 = b0 * T + 254 * i0 - 2; } else row0 = MP + (u.pm - 132) * 256;
        f32x4 w0[2], w1[2], w2[2], bb[2];
#pragma unroll
        for (int n = 0; n < 2; ++n) { w0[n] = *(const f32x4*)(cw + ch0 + 4 * n); w1[n] = *(const f32x4*)(cw + DFF + ch0 + 4 * n); w2[n] = *(const f32x4*)(cw + 2 * DFF + ch0 + 4 * n); bb[n] = *(const f32x4*)(cb + ch0 + 4 * n); }
#pragma unroll
        for (int ai = 0; ai < 2; ++ai) {
            const int strip = ai * 2 + wr;
            f32x4 h1[2], h2[2];
#pragma unroll
            for (int n = 0; n < 2; ++n) {
                if (strip > 0) { h1[n] = *(const LAS f32x4*)(exch + ((strip - 1) * 2 + 1) * 128 + cw8 + 4 * n); h2[n] = *(const LAS f32x4*)(exch + ((strip - 1) * 2) * 128 + cw8 + 4 * n); }
                else { h1[n] = (f32x4){0.f, 0.f, 0.f, 0.f}; h2[n] = (f32x4){0.f, 0.f, 0.f, 0.f}; }
            }
#pragma unroll
            for (int m = 0; m < 4; ++m) {
                const int lr = ai * 128 + wr * 64 + m * 16 + fr;
                int t, b; bool valid;
                if (!samp) { t = 254 * i0 + lr - 2; b = b0; valid = lr >= 2 && t < T; } else { const int rs = row0 - MP + lr; b = rs >> 3; t = rs & 7; valid = true; }
                const size_t R = (size_t)((long)row0 + lr);
                f32x4 hd[2];
#pragma unroll
                for (int n = 0; n < 2; ++n) {
                    const f32x4 z = acc[ai][0][m][n], uu = acc[ai][1][m][n];
                    f32x4 o1, o2, zm1, zm2;
                    if (m == 0) { o1 = h1[n]; o2 = (fr == 0) ? h2[n] : h1[n]; }
                    else {
#pragma unroll
                        for (int e = 0; e < 4; ++e) { o1[e] = dppf<0x121>(acc[ai][0][m > 0 ? m - 1 : 0][n][e]); o2[e] = dppf<0x122>(acc[ai][0][m > 0 ? m - 1 : 0][n][e]); }
                    }
#pragma unroll
                    for (int e = 0; e < 4; ++e) { zm1[e] = dpp_old<0x111>(o1[e], z[e]); zm2[e] = dpp_old<0x112>(o2[e], z[e]); }
                    if (t == 0) {
                        if (samp) { zm1 = *(const f32x4*)(sc + ((size_t)b * 2 + 1) * DFF + ch0 + 4 * n); zm2 = *(const f32x4*)(sc + ((size_t)b * 2) * DFF + ch0 + 4 * n); }
                        else { zm1 = (f32x4){0.f, 0.f, 0.f, 0.f}; zm2 = (f32x4){0.f, 0.f, 0.f, 0.f}; }
                    } else if (t == 1) {
                        if (samp) zm2 = *(const f32x4*)(sc + ((size_t)b * 2 + 1) * DFF + ch0 + 4 * n); else zm2 = (f32x4){0.f, 0.f, 0.f, 0.f};
                    }
                    const f32x4 zc = bb[n] + w0[n] * zm2 + w1[n] * zm1 + w2[n] * z;
#pragma unroll
                    for (int e = 0; e < 4; ++e) hd[n][e] = zc[e] * sigmoidf_(zc[e]) * uu[e];
                }
                if (valid) {
                    u32x4 w; w.x = cvt_pk_bf16(hd[0][0], hd[0][1]); w.y = cvt_pk_bf16(hd[0][2], hd[0][3]); w.z = cvt_pk_bf16(hd[1][0], hd[1][1]); w.w = cvt_pk_bf16(hd[1][2], hd[1][3]);
                    *(u32x4*)(HID + R * DFF + ch0) = w;
                    if (!samp) { if (t >= T - 2) { float* o = out + O_CVP + (size_t)(b * 2 + (t - (T - 2))) * DFF + ch0; *(f32x4*)o = acc[ai][0][m][0]; *(f32x4*)(o + 4) = acc[ai][0][m][1]; } }
                    else if (t >= DT - 2) { float* o = out + O_CVS + (size_t)(b * 2 + (t - (DT - 2))) * DFF + ch0; *(f32x4*)o = acc[ai][0][m][0]; *(f32x4*)(o + 4) = acc[ai][0][m][1]; }
                }
            }
        }
    }
};

#define XB_TMO      128
#define XB_XCNT(j)  (256  + 64 * (j))
#define XB_XSUB(j)  (1280 + 64 * (j))
#define XB_XGEN(j)  (2304 + 64 * (j))
#define XB_TOP      3328
#define XB_TOPGEN   3392
#define XCD_BAR_WORDS 3456
#define XB_SPIN_CAP (1u << 20)
__device__ __forceinline__ unsigned xb_ld(unsigned* p)              { return __hip_atomic_load(p, __ATOMIC_RELAXED, __HIP_MEMORY_SCOPE_AGENT); }
__device__ __forceinline__ unsigned xb_add(unsigned* p, unsigned v) { return __hip_atomic_fetch_add(p, v, __ATOMIC_RELAXED, __HIP_MEMORY_SCOPE_AGENT); }
__device__ __forceinline__ unsigned xb_xcc_id() { return (unsigned)__builtin_amdgcn_s_getreg((3 << 11) | 20) & 0xFu; }
#define XB_SPIN(cond, bar) do { unsigned _sp = 0; while (cond) { __builtin_amdgcn_s_sleep(1); \
    if ((++_sp & 255u) == 0u) { if (xb_ld(&(bar)[XB_TMO])) break; if (_sp > XB_SPIN_CAP) { atomicAdd(&(bar)[XB_TMO], 1u); break; } } } } while (0)
struct XcdBarrier { unsigned* bar; unsigned x; volatile LAS unsigned* st; };
__device__ __forceinline__ XcdBarrier xcd_barrier_post(unsigned* bar, volatile LAS unsigned* st) {
    XcdBarrier b; b.bar = bar; b.x = xb_xcc_id(); b.st = st;
    if (threadIdx.x == 0) (void)xb_add(&bar[XB_XCNT(b.x)], 1u);
    return b;
}
__device__ __forceinline__ void xcd_barrier_complete(unsigned* bar, unsigned x, unsigned& nloc, unsigned& nx) {
    const unsigned G = gridDim.x * gridDim.y * gridDim.z;
    unsigned sum, cnt, mine, sp = 0u;
    for (;;) {
        sum = 0u; cnt = 0u; mine = 0u;
#pragma unroll
        for (unsigned j = 0; j < 16; ++j) { const unsigned c = xb_ld(&bar[XB_XCNT(j)]); sum += c; cnt += (c > 0u) ? 1u : 0u; mine = (j == x) ? c : mine; }
        if (sum == G) break;
        __builtin_amdgcn_s_sleep(1);
        if ((++sp & 255u) == 0u) { if (xb_ld(&bar[XB_TMO])) break; if (sp > XB_SPIN_CAP) { atomicAdd(&bar[XB_TMO], 1u); break; } }
    }
    nloc = mine > 0u ? mine : 1u; nx = cnt > 0u ? cnt : 1u;
}
__device__ __forceinline__ void xcd_barrier(const XcdBarrier& b) {
    asm volatile("s_waitcnt vmcnt(0)" ::: "memory");
    __syncthreads();
    if (threadIdx.x == 0) {
        unsigned* bar = b.bar;
        __builtin_amdgcn_s_waitcnt(0);
        unsigned nloc = b.st[0], nx = b.st[1];
        if (nloc == 0u) { xcd_barrier_complete(bar, b.x, nloc, nx); b.st[0] = nloc; b.st[1] = nx; }
        const unsigned old = xb_add(&bar[XB_XSUB(b.x)], 1u);
        const unsigned gen = old / nloc;
        if (old + 1u == (gen + 1u) * nloc) {
            __builtin_amdgcn_fence(__ATOMIC_RELEASE, "agent");
            asm volatile("s_waitcnt vmcnt(0)" ::: "memory");
            const unsigned og = xb_add(&bar[XB_TOP], 1u);
            const unsigned tg = og / nx;
            if (og + 1u == (tg + 1u) * nx) xb_add(&bar[XB_TOPGEN], 1u);
            else XB_SPIN(xb_ld(&bar[XB_TOPGEN]) == tg, bar);
            __builtin_amdgcn_fence(__ATOMIC_ACQUIRE, "agent");
            xb_add(&bar[XB_XGEN(b.x)], 1u);
            asm volatile("s_waitcnt vmcnt(0)" ::: "memory");
        } else {
            XB_SPIN(xb_ld(&bar[XB_XGEN(b.x)]) == gen, bar);
            __builtin_amdgcn_fence(__ATOMIC_ACQUIRE, "agent");
            asm volatile("s_waitcnt vmcnt(0)" ::: "memory");
        }
    }
    __syncthreads();
}

constexpr int NWAVES = 8, NT = 512;
constexpr int LDS_BYTES = 163840;
constexpr int YP_OFF = 129536;
struct Args { const float* in[29]; float* out; unsigned char* ws; int ph_lo, ph_hi; };
struct Frame {
    LAS unsigned char* lds; unsigned char* ws; float* out; const float* const* in;
    int tid, lane, wave, G, bid;
};
__device__ __forceinline__ const float* xrow_ptr(const Frame& F, int m) { return m < MP ? F.in[0] + (size_t)m * DM : F.in[1] + (size_t)(m - MP) * DM; }

template <class MAP>
__device__ __forceinline__ void p0_transpose_item(const float* W, int K, int N, int Nout, bf16_t* WT, LAS float* scr, int item, int lane, MAP map) {
    const int nblk = Nout / 32, kb = item / nblk, nb = item % nblk, k0 = 64 * kb, n0 = 32 * nb;
    const int src = map(n0 + (lane & 31));
    float tv[32];
#pragma unroll
    for (int i = 0; i < 32; ++i) { const int kk = 2 * i + (lane >> 5); tv[i] = src >= 0 ? W[(size_t)(k0 + kk) * N + src] : 0.f; }
#pragma unroll
    for (int i = 0; i < 32; ++i) { const int kk = 2 * i + (lane >> 5); scr[kk * 33 + (lane & 31)] = tv[i]; }
    asm volatile("s_waitcnt lgkmcnt(0)" ::: "memory");
    const int c = lane & 7;
#pragma unroll
    for (int j = 0; j < 4; ++j) { const int n = (lane >> 3) + 8 * j; const LAS float* s = scr + (8 * c) * 33 + n;
        u32x4 o; o.x = pk2(s[0 * 33], s[1 * 33]); o.y = pk2(s[2 * 33], s[3 * 33]); o.z = pk2(s[4 * 33], s[5 * 33]); o.w = pk2(s[6 * 33], s[7 * 33]);
        *(u32x4*)(WT + (size_t)(n0 + n) * K + k0 + 8 * c) = o; }
    asm volatile("s_waitcnt lgkmcnt(0)" ::: "memory");
}
struct MapIn { __device__ int operator()(int n) const { if (n < 640) { const int w = n & 63; return (n & ~63) + (w >> 3) * 4 + (w & 3) + 32 * ((w >> 2) & 1); } return n < 2464 ? n : -1; } };
struct MapId { __device__ int operator()(int n) const { return n; } };
struct MapFfn { __device__ int operator()(int n) const { const int tile = n >> 8, sub = n & 255, ch = tile * 128 + (sub & 127); return sub < 128 ? ch : DFF + ch; } };

__device__ __forceinline__ void p0_prologue(Frame& F) {
    LAS float* scr = (LAS float*)(F.lds + F.wave * 16384);
    const int gw = F.bid * NWAVES + F.wave, NGW = F.G * NWAVES;
    constexpr int I_IN = 16 * (DINP / 32), I_OUT = 16 * 32, I_FI = 16 * (2 * DFF / 32), I_FO = (DFF / 64) * 32;
    constexpr int NITEMS = I_IN + I_OUT + I_FI + I_FO;
#ifndef TR_DUP
#define TR_DUP 1
#endif
    for (int it_ = gw; it_ < NITEMS * TR_DUP; it_ += NGW) {
        const int it = it_ % NITEMS;
        int r = it;
        if (r < I_IN) { p0_transpose_item(F.in[8], DM, 2464, DINP, (bf16_t*)(F.ws + WS_WIN), scr, r, F.lane, MapIn()); continue; } r -= I_IN;
        if (r < I_OUT) { p0_transpose_item(F.in[21], DM, DM, DM, (bf16_t*)(F.ws + WS_WOUT), scr, r, F.lane, MapId()); continue; } r -= I_OUT;
        if (r < I_FI) { p0_transpose_item(F.in[24], DM, 2 * DFF, 2 * DFF, (bf16_t*)(F.ws + WS_WFI), scr, r, F.lane, MapFfn()); continue; } r -= I_FI;
        p0_transpose_item(F.in[27], DFF, DM, DM, (bf16_t*)(F.ws + WS_WFO), scr, r, F.lane, MapId());
    }
    float* rope = (float*)(F.ws + WS_ROPE);
    for (int e = F.bid * NT + F.tid; e < (T + DT) * 32; e += F.G * NT) {
        const int pidx = e >> 5, i = e & 31; const int pos = pidx < T ? pidx : 16384 + (pidx - T);
        const float inv = (float)exp2(-(double)i * (13.287712379549449 / 32.0));
        const float angf = (float)pos * inv;
        const double a = (double)angf;
        const double TWO_PI = 6.283185307179586476925286766559;
        const double n = rint(a / TWO_PI);
        const double r = a - n * TWO_PI;
        const double r2 = r * r;
        double c = 1.0, s = 1.0, tc = 1.0, ts = 1.0;
#pragma unroll
        for (int k = 1; k <= 14; ++k) { tc = -tc * r2 * (1.0 / (double)((2 * k - 1) * (2 * k))); ts = -ts * r2 * (1.0 / (double)((2 * k) * (2 * k + 1))); c += tc; s += ts; }
        s *= r;
        rope[(size_t)e * 2] = (float)c; rope[(size_t)e * 2 + 1] = (float)s;
    }
    const float* g = F.in[7];
    bf16_t* XN = (bf16_t*)(F.ws + WS_XN);
    f32x4 gq[4];
#pragma unroll
    for (int j = 0; j < 4; ++j) gq[j] = ((const f32x4*)g)[64 * j + F.lane];
    for (int m = gw; m < M; m += 2 * NGW) {
        const int m1 = m + NGW; const bool has1 = m1 < M;
        const f32x4* xr0 = (const f32x4*)xrow_ptr(F, m) + F.lane; const f32x4* xr1 = (const f32x4*)xrow_ptr(F, has1 ? m1 : m) + F.lane;
        f32x4 v0[4], v1[4];
#pragma unroll
        for (int j = 0; j < 4; ++j) v0[j] = __builtin_nontemporal_load(xr0 + 64 * j);
#pragma unroll
        for (int j = 0; j < 4; ++j) v1[j] = __builtin_nontemporal_load(xr1 + 64 * j);
        float s0 = 0.f, s1 = 0.f;
#pragma unroll
        for (int j = 0; j < 4; ++j) { s0 += (v0[j].x * v0[j].x + v0[j].y * v0[j].y) + (v0[j].z * v0[j].z + v0[j].w * v0[j].w); s1 += (v1[j].x * v1[j].x + v1[j].y * v1[j].y) + (v1[j].z * v1[j].z + v1[j].w * v1[j].w); }
        const float r0 = 1.0f / sqrtf(wave_sum(s0) * (1.f / DM) + RMS_EPS), r1 = 1.0f / sqrtf(wave_sum(s1) * (1.f / DM) + RMS_EPS);
        u32x2* o0 = (u32x2*)(XN + (size_t)m * DM) + F.lane; u32x2* o1 = (u32x2*)(XN + (size_t)m1 * DM) + F.lane;
#pragma unroll
        for (int j = 0; j < 4; ++j) { const f32x4 gg = gq[j];
            u32x2 w; w.x = pk2(v0[j].x * r0 * gg.x, v0[j].y * r0 * gg.y); w.y = pk2(v0[j].z * r0 * gg.z, v0[j].w * r0 * gg.w); o0[64 * j] = w;
            if (has1) { u32x2 q; q.x = pk2(v1[j].x * r1 * gg.x, v1[j].y * r1 * gg.y); q.y = pk2(v1[j].z * r1 * gg.z, v1[j].w * r1 * gg.w); o1[64 * j] = q; } }
    }
}

__device__ __forceinline__ float hprev_val(const Frame& F, const bf16_t* HRW, int m, int col) {
    const RowInfo ri = row_info(m);
    if (ri.t == 0) return ri.samp ? F.in[4][(size_t)ri.b * DSH + col] : 0.f;
    return bf2f(HRW[(size_t)(m - 1) * DSH + col]);
}
__device__ __forceinline__ f32x4 ld_bf4(const bf16_t* p) { const u32x2 w = *(const u32x2*)p; return (f32x4){bflo(w.x), bfhi(w.x), bflo(w.y), bfhi(w.y)}; }
__device__ __forceinline__ f32x4 hs4(const Frame& F, const bf16_t* HRW, int m, const RowInfo& ri, int col) {
    const f32x4 h = ld_bf4(HRW + (size_t)m * DSH + col);
    f32x4 hp;
    if (ri.t == 0) hp = ri.samp ? *(const f32x4*)(F.in[4] + (size_t)ri.b * DSH + col) : (f32x4){0.f, 0.f, 0.f, 0.f};
    else hp = ld_bf4(HRW + (size_t)(m - 1) * DSH + col);
    const f32x4 mu = *(const f32x4*)(F.in[10] + col);
    return h + (hp - h) * mu;
}
struct F8 { f32x4 a, b; };
__device__ __forceinline__ F8 ld_bf8(const bf16_t* p) { const u32x4 w = *(const u32x4*)p; F8 r; r.a = (f32x4){bflo(w.x), bfhi(w.x), bflo(w.y), bfhi(w.y)}; r.b = (f32x4){bflo(w.z), bfhi(w.z), bflo(w.w), bfhi(w.w)}; return r; }
__device__ __forceinline__ u32x4 pk8(const f32x4 a, const f32x4 b) { u32x4 w; w.x = cvt_pk_bf16(a[0], a[1]); w.y = cvt_pk_bf16(a[2], a[3]); w.z = cvt_pk_bf16(b[0], b[1]); w.w = cvt_pk_bf16(b[2], b[3]); return w; }
__device__ __forceinline__ F8 hs8m(const Frame& F, const bf16_t* HRW, int m, const RowInfo& ri, int col, const f32x4 mua, const f32x4 mub) {
    const F8 h = ld_bf8(HRW + (size_t)m * DSH + col);
    F8 hp;
    if (ri.t == 0) {
        if (ri.samp) { hp.a = *(const f32x4*)(F.in[4] + (size_t)ri.b * DSH + col); hp.b = *(const f32x4*)(F.in[4] + (size_t)ri.b * DSH + col + 4); }
        else { hp.a = (f32x4){0.f, 0.f, 0.f, 0.f}; hp.b = (f32x4){0.f, 0.f, 0.f, 0.f}; }
    } else hp = ld_bf8(HRW + (size_t)(m - 1) * DSH + col);
    F8 r; r.a = h.a + (hp.a - h.a) * mua; r.b = h.b + (hp.b - h.b) * mub; return r;
}
__device__ __forceinline__ F8 hs8(const Frame& F, const bf16_t* HRW, int m, const RowInfo& ri, int col) {
    const F8 h = ld_bf8(HRW + (size_t)m * DSH + col);
    F8 hp;
    if (ri.t == 0) {
        if (ri.samp) { hp.a = *(const f32x4*)(F.in[4] + (size_t)ri.b * DSH + col); hp.b = *(const f32x4*)(F.in[4] + (size_t)ri.b * DSH + col + 4); }
        else { hp.a = (f32x4){0.f, 0.f, 0.f, 0.f}; hp.b = (f32x4){0.f, 0.f, 0.f, 0.f}; }
    } else hp = ld_bf8(HRW + (size_t)(m - 1) * DSH + col);
    const f32x4 mua = *(const f32x4*)(F.in[10] + col), mub = *(const f32x4*)(F.in[10] + col + 4);
    F8 r; r.a = h.a + (hp.a - h.a) * mua; r.b = h.b + (hp.b - h.b) * mub; return r;
}
__device__ __forceinline__ float xsum_fq(float v) {
    { auto r = __builtin_amdgcn_permlane16_swap(__float_as_uint(v), __float_as_uint(v), false, false); v = __uint_as_float(r[0]) + __uint_as_float(r[1]); }
    { auto r = __builtin_amdgcn_permlane32_swap(__float_as_uint(v), __float_as_uint(v), false, false); v = __uint_as_float(r[0]) + __uint_as_float(r[1]); }
    return v;
}
__device__ __forceinline__ u32x2 pk4(const f32x4 v) { u32x2 w; w.x = cvt_pk_bf16(v[0], v[1]); w.y = cvt_pk_bf16(v[2], v[3]); return w; }
__device__ __forceinline__ bf16x8 wfrag(const float* W, int k0, int fq, int ch) {
    u32x4 w; const float* p = W + (size_t)(k0 + 8 * fq) * 512 + ch;
    w.x = cvt_pk_bf16(p[0], p[512]); w.y = cvt_pk_bf16(p[1024], p[1536]); w.z = cvt_pk_bf16(p[2048], p[2560]); w.w = cvt_pk_bf16(p[3072], p[3584]);
    return __builtin_bit_cast(bf16x8, w);
}
#ifndef PREP_DUP
#define PREP_DUP 1
#endif
#ifndef POST_DUP
#define POST_DUP 1
#endif
__device__ __forceinline__ void prep_phase(Frame& F) {
    const bf16_t* HRW = (const bf16_t*)(F.ws + WS_HRW);
    bf16_t* SR = (bf16_t*)(F.ws + WS_SR); bf16_t* SK = (bf16_t*)(F.ws + WS_SK); bf16_t* SV = (bf16_t*)(F.ws + WS_SV);
    bf16_t* SKK = (bf16_t*)(F.ws + WS_SKK); bf16_t* SB = (bf16_t*)(F.ws + WS_SB); float* SW = (float*)(F.ws + WS_SW);
    const int fr = F.lane & 15, fq = F.lane >> 4, h = F.wave;
    bf16x8 Aw[4], Aa[4];
#pragma unroll
    for (int nt = 0; nt < 4; ++nt) { const int ch = h * 64 + 16 * (fr >> 2) + 4 * nt + (fr & 3); Aw[nt] = wfrag(F.in[12], 0, fq, ch); Aa[nt] = wfrag(F.in[14], 0, fq, ch); }
    constexpr int NTILE = M / 16;
    f32x4 pw0[4], pa0[4], pkk[4], pka[4];
    f32x4 pmu[3][4];
#pragma unroll
    for (int st = 0; st < 3; ++st)
#pragma unroll
        for (int i = 0; i < 4; ++i) pmu[st][i] = *(const f32x4*)(F.in[10] + st * 512 + h * 64 + 16 * fq + 4 * i);
#pragma unroll
    for (int i = 0; i < 4; ++i) { const int c4 = h * 64 + 16 * fq + 4 * i; pw0[i] = *(const f32x4*)(F.in[11] + c4); pa0[i] = *(const f32x4*)(F.in[13] + c4); pkk[i] = *(const f32x4*)(F.in[16] + c4); pka[i] = *(const f32x4*)(F.in[17] + c4); }
    for (int tile_ = F.bid; tile_ < NTILE * PREP_DUP; tile_ += F.G) {
        const int m = (tile_ % NTILE) * 16 + fr;
        const RowInfo ri = row_info(m);
        bf16x8 xw, xa;
        { const F8 a = hs8(F, HRW, m, ri, 1536 + 8 * fq);
          f32x4 t0, t1;
#pragma unroll
          for (int i = 0; i < 4; ++i) { t0[i] = 1.f - 2.f * __builtin_amdgcn_rcpf(__expf(2.f * a.a[i]) + 1.f); t1[i] = 1.f - 2.f * __builtin_amdgcn_rcpf(__expf(2.f * a.b[i]) + 1.f); }
          xw = __builtin_bit_cast(bf16x8, pk8(t0, t1)); }
        { const F8 a = hs8(F, HRW, m, ri, 1568 + 8 * fq); xa = __builtin_bit_cast(bf16x8, pk8(a.a, a.b)); }
        f32x4 kkr[4], av[4]; float ss = 0.f;
#pragma unroll
        for (int np = 0; np < 2; ++np) {
            const int c8 = h * 64 + 16 * fq + 8 * np;
            const f32x4 z = {0.f, 0.f, 0.f, 0.f};
            f32x4 accw[2], acca[2];
#pragma unroll
            for (int q = 0; q < 2; ++q) { accw[q] = __builtin_amdgcn_mfma_f32_16x16x32_bf16(Aw[2 * np + q], xw, z, 0, 0, 0); acca[q] = __builtin_amdgcn_mfma_f32_16x16x32_bf16(Aa[2 * np + q], xa, z, 0, 0, 0); }
            const F8 r8 = hs8m(F, HRW, m, ri, c8, pmu[0][2 * np], pmu[0][2 * np + 1]), k8 = hs8m(F, HRW, m, ri, 512 + c8, pmu[1][2 * np], pmu[1][2 * np + 1]), v8 = hs8m(F, HRW, m, ri, 1024 + c8, pmu[2][2 * np], pmu[2][2 * np + 1]);
            f32x4 dec[2], k2[2];
#pragma unroll
            for (int q = 0; q < 2; ++q) {
                const f32x4 k = q ? k8.b : k8.a;
                const f32x4 w0 = pw0[2 * np + q], a0 = pa0[2 * np + q], kkc = pkk[2 * np + q], kac = pka[2 * np + q];
                f32x4 a;
#pragma unroll
                for (int j = 0; j < 4; ++j) {
                    const float x = -(w0[j] + accw[q][j]);
                    const float sp = fmaxf(x, 0.f) + __logf(1.f + __expf(-fabsf(x)));
                    dec[q][j] = __expf(-__expf(-sp - 0.5f));
                    a[j] = sigmoidf_(a0[j] + acca[q][j]);
                    k2[q][j] = k[j] * (1.f + (a[j] - 1.f) * kac[j]);
                }
                const f32x4 kk = k * kkc;
                ss += (kk[0] * kk[0] + kk[1] * kk[1]) + (kk[2] * kk[2] + kk[3] * kk[3]);
                kkr[2 * np + q] = kk; av[2 * np + q] = a;
            }
            const size_t o = (size_t)m * 512 + c8;
            *(f32x4*)(SW + o) = dec[0]; *(f32x4*)(SW + o + 4) = dec[1];
            *(u32x4*)(SR + o) = pk8(r8.a, r8.b); *(u32x4*)(SK + o) = pk8(k2[0], k2[1]); *(u32x4*)(SV + o) = pk8(v8.a, v8.b);
        }
        ss = xsum_fq(ss);
        const float rs = rsqrtf(fmaxf(ss, 1e-24f));
#pragma unroll
        for (int np = 0; np < 2; ++np) {
            const size_t o = (size_t)m * 512 + h * 64 + 16 * fq + 8 * np;
            const f32x4 ka = kkr[2 * np] * rs, kb = kkr[2 * np + 1] * rs;
            *(u32x4*)(SKK + o) = pk8(ka, kb); *(u32x4*)(SB + o) = pk8(ka * av[2 * np], kb * av[2 * np + 1]);
        }
    }
}

__device__ __forceinline__ void sample_attn_phase(Frame& F) {
    constexpr int NK = WIN + DT, KS = 68;
    LAS float* Kl = (LAS float*)F.lds;
    LAS float* Vl = Kl + NK * KS;
    LAS float* Pl = Vl + NK * KS;
    const bf16_t* Q = (const bf16_t*)(F.ws + WS_Q);
    bf16_t* OC = (bf16_t*)(F.ws + WS_OCAT);
    for (int unit = F.bid; unit < DB * 2; unit += F.G) {
        const int b = unit >> 1, kvh = unit & 1;
        for (int e = F.tid; e < NK * 16; e += NT) {
            const int key = e >> 4, d4 = (e & 15) * 4;
            f32x4 kv, vv;
            if (key < WIN) { kv = *(const f32x4*)(F.in[2] + ((size_t)(b * WIN + key) * 2 + kvh) * 64 + d4); vv = *(const f32x4*)(F.in[3] + ((size_t)(b * WIN + key) * 2 + kvh) * 64 + d4); }
            else { kv = *(const f32x4*)(F.out + O_KWS + ((size_t)(b * WIN + key - DT) * 2 + kvh) * 64 + d4); vv = *(const f32x4*)(F.out + O_VWS + ((size_t)(b * WIN + key - DT) * 2 + kvh) * 64 + d4); }
            *(LAS f32x4*)(Kl + key * KS + d4) = kv; *(LAS f32x4*)(Vl + key * KS + d4) = vv;
            if (key >= DT && key < WIN) { *(f32x4*)(F.out + O_KWS + ((size_t)(b * WIN + key - DT) * 2 + kvh) * 64 + d4) = kv; *(f32x4*)(F.out + O_VWS + ((size_t)(b * WIN + key - DT) * 2 + kvh) * 64 + d4) = vv; }
        }
        __syncthreads();
        const int qi = F.tid >> 4, sub = F.tid & 15;
        const int t = qi >> 2, g = qi & 3, head = kvh * 4 + g;
        const int m = MP + b * DT + t;
        float mx = F.in[9][head] * 1.4426950408889634f;
        {
            const bf16_t* qp = Q + (size_t)m * 512 + head * 64;
            float q[64];
#pragma unroll
            for (int i = 0; i < 8; ++i) { const u32x4 w = *(const u32x4*)(qp + 8 * i); q[8 * i] = bflo(w.x); q[8 * i + 1] = bfhi(w.x); q[8 * i + 2] = bflo(w.y); q[8 * i + 3] = bfhi(w.y); q[8 * i + 4] = bflo(w.z); q[8 * i + 5] = bfhi(w.z); q[8 * i + 6] = bflo(w.w); q[8 * i + 7] = bfhi(w.w); }
#pragma unroll 1
            for (int key = sub; key < NK; key += 16) {
                float a = 0.f; const LAS f32x4* kr = (const LAS f32x4*)(Kl + key * KS);
#pragma unroll
                for (int i = 0; i < 16; ++i) { const f32x4 kx = kr[i]; a += q[4 * i] * kx[0] + q[4 * i + 1] * kx[1] + q[4 * i + 2] * kx[2] + q[4 * i + 3] * kx[3]; }
                const int dist = t + WIN - key;
                const float s = (dist >= 0 && dist <= WIN) ? a : -1e30f;
                Pl[qi * NK + key] = s; mx = fmaxf(mx, s);
            }
        }
        mx = fmaxf(mx, __shfl_xor(mx, 1)); mx = fmaxf(mx, __shfl_xor(mx, 2)); mx = fmaxf(mx, __shfl_xor(mx, 4)); mx = fmaxf(mx, __shfl_xor(mx, 8));
        float sum = 0.f;
#pragma unroll 1
        for (int key = sub; key < NK; key += 16) { const float sv = Pl[qi * NK + key]; const float p = sv > -1e29f ? __builtin_amdgcn_exp2f(sv - mx) : 0.f; sum += p; Pl[qi * NK + key] = p; }
        sum += __shfl_xor(sum, 1); sum += __shfl_xor(sum, 2); sum += __shfl_xor(sum, 4); sum += __shfl_xor(sum, 8);
        const float inv = __builtin_amdgcn_rcpf(sum + __builtin_amdgcn_exp2f(F.in[9][head] * 1.4426950408889634f - mx));
        __syncthreads();
        f32x4 o = {0.f, 0.f, 0.f, 0.f};
        for (int key = 0; key < NK; ++key) { const float p = Pl[qi * NK + key]; const f32x4 vv = *(const LAS f32x4*)(Vl + key * KS + sub * 4); o += vv * p; }
        o = o * inv;
        u32x2 w; w.x = pk2(o[0], o[1]); w.y = pk2(o[2], o[3]);
        *(u32x2*)(OC + (size_t)m * DM + head * 64 + sub * 4) = w;
        __syncthreads();
    }
}

template <int MODE>
__device__ __forceinline__ void prompt_attn_unit(Frame& F, int unit, int ldsoff) {
    constexpr int KST = 144, VST = 528;
    LAS unsigned char* Kl = F.lds + ldsoff; LAS unsigned char* Vl = Kl + 256 * KST;
    const bf16_t* Q = (const bf16_t*)(F.ws + WS_Q); const bf16_t* Kb = (const bf16_t*)(F.ws + WS_K); const bf16_t* VT = (const bf16_t*)(F.ws + WS_VT);
    bf16_t* OC = (bf16_t*)(F.ws + WS_OCAT);
    const int kvh = unit & 1, qb = (unit >> 1) & 63, b = unit >> 7;
    const int key0 = (qb - 1) * 128;
    if (MODE != 2) {
    for (int e = F.tid; e < 256 * 8; e += NT) {
        const int key = e >> 3, ch = e & 7; const int pos = key0 + key;
        u32x4 v = {0u, 0u, 0u, 0u};
        if (pos >= 0) v = *(const u32x4*)(Kb + (size_t)(b * T + pos) * 128 + kvh * 64 + ch * 8);
        *(LAS u32x4*)(Kl + key * KST + ch * 16) = v;
    }
    for (int e = F.tid; e < 64 * 32; e += NT) {
        const int d = e >> 5, ch = e & 31; const int pos = key0 + ch * 8;
        u32x4 v = {0u, 0u, 0u, 0u};
        if (pos >= 0) v = *(const u32x4*)(VT + ((size_t)(b * 2 + kvh) * 64 + d) * T + pos);
        *(LAS u32x4*)(Vl + d * VST + ch * 16) = v;
    }
    }
    if (MODE == 1) return;
    if (MODE == 0) __syncthreads();
    const int fr = F.lane & 15, fq = F.lane >> 4;
    const int head = kvh * 4 + (F.wave >> 1);
    const float sink = F.in[9][head] * 1.4426950408889634f;
#pragma unroll 1
    for (int sb = 0; sb < 4; ++sb) {
        const int qi0 = (F.wave & 1) * 64 + sb * 16;
        const int qi = qi0 + fr;
        const size_t mrow = (size_t)b * T + qb * 128 + qi;
        const bf16x8 q0 = *(const bf16x8*)(Q + mrow * 512 + head * 64 + fq * 8);
        const bf16x8 q1 = *(const bf16x8*)(Q + mrow * 512 + head * 64 + 32 + fq * 8);
        const int ktlo = (F.wave & 1) * 4 + sb;
        f32x4 s[9];
#pragma unroll
        for (int kr = 0; kr < 9; ++kr) {
            const int kt = ktlo + kr;
            const bf16x8 k0 = *(const LAS bf16x8*)(Kl + (kt * 16 + fr) * KST + fq * 16);
            const bf16x8 k1 = *(const LAS bf16x8*)(Kl + (kt * 16 + fr) * KST + 64 + fq * 16);
            f32x4 a = {0.f, 0.f, 0.f, 0.f};
            a = __builtin_amdgcn_mfma_f32_16x16x32_bf16(k0, q0, a, 0, 0, 0);
            a = __builtin_amdgcn_mfma_f32_16x16x32_bf16(k1, q1, a, 0, 0, 0);
            s[kr] = a;
        }
        float mx = sink;
#pragma unroll
        for (int kr = 0; kr < 9; ++kr)
#pragma unroll
            for (int j = 0; j < 4; ++j) { const int sj = (ktlo + kr) * 16 + fq * 4 + j; const int dist = qi + 128 - sj; const bool ok = dist >= 0 && dist <= WIN && (key0 + sj) >= 0; const float v = ok ? s[kr][j] : -1e30f; s[kr][j] = v; mx = fmaxf(mx, v); }
        mx = fmaxf(mx, __shfl_xor(mx, 16)); mx = fmaxf(mx, __shfl_xor(mx, 32));
        float sum = 0.f;
        u32x2 pw[10];
#pragma unroll
        for (int kr = 0; kr < 9; ++kr) {
            f32x4 p;
#pragma unroll
            for (int j = 0; j < 4; ++j) { p[j] = s[kr][j] > -1e29f ? __builtin_amdgcn_exp2f(s[kr][j] - mx) : 0.f; sum += p[j]; }
            pw[kr].x = cvt_pk_bf16(p[0], p[1]); pw[kr].y = cvt_pk_bf16(p[2], p[3]);
        }
        pw[9].x = 0u; pw[9].y = 0u;
        sum += __shfl_xor(sum, 16); sum += __shfl_xor(sum, 32);
        const float inv = __builtin_amdgcn_rcpf(sum + __builtin_amdgcn_exp2f(sink - mx));
        f32x4 o[4];
#pragma unroll
        for (int dt = 0; dt < 4; ++dt) o[dt] = (f32x4){0.f, 0.f, 0.f, 0.f};
#pragma unroll
        for (int u = 0; u < 5; ++u) {
            u32x4 pb; pb.x = pw[2 * u].x; pb.y = pw[2 * u].y; pb.z = pw[2 * u + 1].x; pb.w = pw[2 * u + 1].y;
            const bf16x8 pf = __builtin_bit_cast(bf16x8, pb);
            const int kta = ktlo + 2 * u, ktb = u < 4 ? kta + 1 : kta;
#pragma unroll
            for (int dt = 0; dt < 4; ++dt) {
                const LAS unsigned char* vr = Vl + (dt * 16 + fr) * VST + (fq * 4) * 2;
                const u32x2 va = *(const LAS u32x2*)(vr + kta * 32), vb = *(const LAS u32x2*)(vr + ktb * 32);
                u32x4 vv; vv.x = va.x; vv.y = va.y; vv.z = vb.x; vv.w = vb.y;
                o[dt] = __builtin_amdgcn_mfma_f32_16x16x32_bf16(__builtin_bit_cast(bf16x8, vv), pf, o[dt], 0, 0, 0);
            }
        }
#pragma unroll
        for (int dt = 0; dt < 4; ++dt) { const f32x4 v = o[dt] * inv; u32x2 w; w.x = cvt_pk_bf16(v[0], v[1]); w.y = cvt_pk_bf16(v[2], v[3]); *(u32x2*)(OC + mrow * DM + head * 64 + dt * 16 + fq * 4) = w; }
    }
    if (MODE == 0) __syncthreads();
}

struct StepOps { f32x4 w, nbe, kk, k, r; float v; };
template <int STRIDE_F> __device__ __forceinline__ StepOps load_ops(const LAS float* img, int s, int cgi, int vrow) {
    const LAS float* p = img + s * STRIDE_F + cgi * 4; StepOps o;
    o.w = *(const LAS f32x4*)(p); o.nbe = *(const LAS f32x4*)(p + 64); o.kk = *(const LAS f32x4*)(p + 128); o.k = *(const LAS f32x4*)(p + 192); o.r = *(const LAS f32x4*)(p + 256);
    o.v = img[s * STRIDE_F + 320 + vrow]; return o;
}
template <int J> __device__ __forceinline__ float sel_lane16(float oldv, float newv) {
    float r; const unsigned long long m = 0x0001000100010001ull << J;
    asm("v_cndmask_b32_e64 %0, %1, %2, %3" : "=v"(r) : "v"(oldv), "v"(newv), "s"(m));
    return r;
}
struct ScanState { f32x2 s01, s23; float ykeep, ypart; StepOps c0, c1; };
template <int STRIDE_F, int J>
__device__ __forceinline__ void scan_step(const LAS float* img, int s0, int vrow, int cgi, ScanState& Z) {
    const StepOps nx = load_ops<STRIDE_F>(img, s0 + J + 2, cgi, vrow);
    const StepOps& c = Z.c0;
    const f32x2 kk01 = {c.kk[0], c.kk[1]}, kk23 = {c.kk[2], c.kk[3]}, w01 = {c.w[0], c.w[1]}, w23 = {c.w[2], c.w[3]}, k01 = {c.k[0], c.k[1]}, k23 = {c.k[2], c.k[3]};
    const f32x2 b01 = {c.nbe[0], c.nbe[1]}, b23 = {c.nbe[2], c.nbe[3]}, r01 = {c.r[0], c.r[1]}, r23 = {c.r[2], c.r[3]};
    f32x2 t = Z.s01 * kk01; t = Z.s23 * kk23 + t;
    float sa = t.x + t.y;
    const f32x2 u01 = Z.s01 * w01 + k01 * c.v, u23 = Z.s23 * w23 + k23 * c.v;
    if (J > 0) { allsum16_2(sa, Z.ypart); Z.ykeep = sel_lane16<(J > 0 ? J - 1 : 0)>(Z.ykeep, Z.ypart); } else sa = allsum16(sa);
    Z.s01 = b01 * sa + u01; Z.s23 = b23 * sa + u23;
    f32x2 y2 = Z.s01 * r01; y2 = Z.s23 * r23 + y2;
    Z.ypart = y2.x + y2.y;
    Z.c0 = Z.c1; Z.c1 = nx;
}
template <int STRIDE_F, int GS, int... Js>
__device__ __forceinline__ void scan_group_impl(const LAS float* img, int s0, int vrow, int cgi, ScanState& Z, float* yout, std::integer_sequence<int, Js...>) {
    (scan_step<STRIDE_F, Js>(img, s0, vrow, cgi, Z), ...);
    Z.ypart = allsum16(Z.ypart); Z.ykeep = sel_lane16<GS - 1>(Z.ykeep, Z.ypart);
    if (cgi < GS) yout[(size_t)(s0 + cgi) * 512] = Z.ykeep;
}
template <int STRIDE_F, int J>
__device__ __forceinline__ void scan_step_yp(const LAS float* img, int s0, int vrow, int cgi, ScanState& Z, LAS float* ypb) {
    const StepOps nx = load_ops<STRIDE_F>(img, s0 + J + 2, cgi, vrow);
    const StepOps& c = Z.c0;
    const f32x2 kk01 = {c.kk[0], c.kk[1]}, kk23 = {c.kk[2], c.kk[3]}, w01 = {c.w[0], c.w[1]}, w23 = {c.w[2], c.w[3]}, k01 = {c.k[0], c.k[1]}, k23 = {c.k[2], c.k[3]};
    const f32x2 b01 = {c.nbe[0], c.nbe[1]}, b23 = {c.nbe[2], c.nbe[3]}, r01 = {c.r[0], c.r[1]}, r23 = {c.r[2], c.r[3]};
    f32x2 t = Z.s01 * kk01; t = Z.s23 * kk23 + t;
    float sa = t.x + t.y;
    const f32x2 u01 = Z.s01 * w01 + k01 * c.v, u23 = Z.s23 * w23 + k23 * c.v;
    sa = allsum16(sa);
    Z.s01 = b01 * sa + u01; Z.s23 = b23 * sa + u23;
    f32x2 y2 = Z.s01 * r01; y2 = Z.s23 * r23 + y2;
    ypb[(s0 + J) * 64] = y2.x + y2.y;
    Z.c0 = Z.c1; Z.c1 = nx;
}
struct StepOpsS { f32x4 nbe, kk, k, r; };
template <int STRIDE_F> __device__ __forceinline__ StepOpsS load_ops_s(const LAS float* img, int s, int cgi) {
    const LAS float* p = img + s * STRIDE_F + cgi * 4; StepOpsS o;
    o.nbe = *(const LAS f32x4*)(p + 64); o.kk = *(const LAS f32x4*)(p + 128); o.k = *(const LAS f32x4*)(p + 192); o.r = *(const LAS f32x4*)(p + 256);
    return o;
}
struct ScanT { f32x2 t01, t23; StepOpsS c0, c1; f32x4 v4[4]; };
template <int STRIDE_F, int J>
__device__ __forceinline__ void scan_step_s(const LAS float* img, int cgi, ScanT& Z, LAS float* ypb) {
    const StepOpsS nx = load_ops_s<STRIDE_F>(img, J + 2, cgi);
    const StepOpsS& c = Z.c0;
    const float v = Z.v4[J >> 2][J & 3];
    f32x2 t = Z.t01 * (f32x2){c.kk[0], c.kk[1]}; t = Z.t23 * (f32x2){c.kk[2], c.kk[3]} + t;
    float sa = t.x + t.y;
    const f32x2 a01 = (f32x2){c.k[0], c.k[1]} * v + Z.t01, a23 = (f32x2){c.k[2], c.k[3]} * v + Z.t23;
    sa = allsum16(sa);
    Z.t01 = (f32x2){c.nbe[0], c.nbe[1]} * sa + a01; Z.t23 = (f32x2){c.nbe[2], c.nbe[3]} * sa + a23;
    f32x2 y2 = Z.t01 * (f32x2){c.r[0], c.r[1]}; y2 = Z.t23 * (f32x2){c.r[2], c.r[3]} + y2;
    ypb[J * 64] = y2.x + y2.y;
    Z.c0 = Z.c1; Z.c1 = nx;
}
template <int STRIDE_F, int... Js>
__device__ __forceinline__ void scan_chunk_s_impl(const LAS float* img, int cgi, ScanT& Z, LAS float* ypb, std::integer_sequence<int, Js...>) {
    (scan_step_s<STRIDE_F, Js>(img, cgi, Z, ypb), ...);
}
template <int STRIDE_F, int NS>
__device__ __forceinline__ void scan_transform(LAS float* img, int lane) {
    LAS float* p = img + lane; float Wc = 1.f;
#pragma unroll
    for (int t = 0; t < NS; ++t, p += STRIDE_F) {
        const float w = p[0], nb = p[64], kk = p[128], k = p[192], r = p[256];
        p[128] = Wc * kk;
        Wc *= w; const float inv = __builtin_amdgcn_rcpf(Wc);
        p[64] = nb * inv; p[192] = k * inv; p[256] = Wc * r;
    }
    img[(NS - 1) * STRIDE_F + lane] = Wc;
}
template <int STRIDE_F, int... Js>
__device__ __forceinline__ void scan_group_yp_impl(const LAS float* img, int s0, int vrow, int cgi, ScanState& Z, LAS float* ypb, std::integer_sequence<int, Js...>) {
    (scan_step_yp<STRIDE_F, Js>(img, s0, vrow, cgi, Z, ypb), ...);
}
template <int... Js>
__device__ __forceinline__ void yp_reduce_impl(const LAS float* ypb, int cgi, float* yout, int s0, std::integer_sequence<int, Js...>) {
    float ykeep = 0.f;
    ((ykeep = sel_lane16<Js>(ykeep, allsum16(ypb[(s0 + Js) * 64]))), ...);
    yout[(size_t)(s0 + cgi) * 512] = ykeep;
}
template <int STRIDE_F, int GS>
__device__ __forceinline__ void scan_group(const LAS float* img, int s0, int vrow, int cgi, ScanState& Z, float* yout) {
    scan_group_impl<STRIDE_F, GS>(img, s0, vrow, cgi, Z, yout, std::make_integer_sequence<int, GS>());
}
constexpr int SC = 32;
constexpr int PSTR = 328;
constexpr int SSTR = 384;
struct ScanRegs { f32x4 w[2]; u32x4 b0[2], b1[2]; u32x4 v; };
__device__ __forceinline__ void scan_load(const Frame& F, ScanRegs& R, int m0, int h, int v0) {
    if (F.wave < 4) return;
    const int vt = F.tid - 256;
#pragma unroll
    for (int i = 0; i < 2; ++i) {
        const int tid = vt + 256 * i;
        { const int row = tid >> 4, c4 = (tid & 15) * 4; R.w[i] = *(const f32x4*)((const float*)(F.ws + WS_SW) + (size_t)(m0 + row) * 512 + h * 64 + c4); }
        { const int st = tid >> 7, row = (tid & 127) >> 2, seg = tid & 3;
          const size_t base = st == 0 ? WS_SB : st == 1 ? WS_SKK : st == 2 ? WS_SK : WS_SR;
          const bf16_t* p = (const bf16_t*)(F.ws + base) + (size_t)(m0 + row) * 512 + h * 64 + seg * 16;
          R.b0[i] = *(const u32x4*)p; R.b1[i] = *(const u32x4*)(p + 8); }
    }
    { R.v = *(const u32x4*)((const bf16_t*)(F.ws + WS_SV) + (size_t)(m0 + (vt & 31)) * 512 + h * 64 + v0); }
}
__device__ __forceinline__ void scan_store(const Frame& F, const ScanRegs& R, LAS float* img) {
    if (F.wave < 4) return;
    const int vt = F.tid - 256;
#pragma unroll
    for (int i = 0; i < 2; ++i) {
        const int tid = vt + 256 * i;
        { const int row = tid >> 4, c4 = (tid & 15) * 4; *(LAS f32x4*)(img + row * PSTR + c4) = R.w[i]; }
        { const int st = tid >> 7, row = (tid & 127) >> 2, seg = tid & 3;
          LAS float* d = img + row * PSTR + 64 + st * 64 + seg * 16;
          const float sg = st == 0 ? -1.f : 1.f; const u32x4 b0 = R.b0[i], b1 = R.b1[i];
          *(LAS f32x4*)(d) = (f32x4){bflo(b0.x), bfhi(b0.x), bflo(b0.y), bfhi(b0.y)} * sg; *(LAS f32x4*)(d + 4) = (f32x4){bflo(b0.z), bfhi(b0.z), bflo(b0.w), bfhi(b0.w)} * sg;
          *(LAS f32x4*)(d + 8) = (f32x4){bflo(b1.x), bfhi(b1.x), bflo(b1.y), bfhi(b1.y)} * sg; *(LAS f32x4*)(d + 12) = (f32x4){bflo(b1.z), bfhi(b1.z), bflo(b1.w), bfhi(b1.w)} * sg; }
    }
    if (vt < 32) { LAS float* d = img + SC * PSTR + vt;
      d[0 * SC] = bflo(R.v.x); d[1 * SC] = bfhi(R.v.x); d[2 * SC] = bflo(R.v.y); d[3 * SC] = bfhi(R.v.y); d[4 * SC] = bflo(R.v.z); d[5 * SC] = bfhi(R.v.z); d[6 * SC] = bflo(R.v.w); d[7 * SC] = bfhi(R.v.w); }
}
constexpr int NSW = 2;
__device__ __forceinline__ void prompt_scan(Frame& F, int sblk) {
    const int xcd = sblk & 7, k = sblk >> 3;
    const int chain = xcd * 4 + (k >> 3), rg = k & 7;
    const int b = chain >> 3, h = chain & 7, v0 = rg * 8;
    LAS float* img = (LAS float*)F.lds;
    constexpr int IMG = SC * PSTR + 8 * SC;
    const int rl = F.lane >> 4, cgi = F.lane & 15;
    const int vrow = F.wave * 4 + rl;
    float* Y = F.out;
    ScanState Z; Z.s01 = (f32x2){0.f, 0.f}; Z.s23 = (f32x2){0.f, 0.f}; Z.ykeep = 0.f; Z.ypart = 0.f;
    ScanRegs R0, R1, R2, R3;
    const int mbase = b * T;
    constexpr int NCH = T / SC;
#ifndef SCAN_DUP
#define SCAN_DUP 1
#endif
    constexpr int NTOT = NCH * SCAN_DUP;
    scan_load(F, R0, mbase, h, v0); scan_store(F, R0, img);
    scan_load(F, R1, mbase + SC, h, v0); scan_store(F, R1, img + IMG);
    scan_load(F, R2, mbase + 2 * SC, h, v0); scan_load(F, R3, mbase + 3 * SC, h, v0);
    __syncthreads();
    if (F.wave == 4 || F.wave == 5) scan_transform<PSTR, 16>(img + (F.wave - 4) * 16 * PSTR, F.lane);
    __syncthreads();
    LAS float* ypr = (LAS float*)(F.lds + YP_OFF);
#define SCAN_CHUNK(cc_) do { const int c_ = (cc_) % NCH; \
        if (SCAN_DUP > 1 && c_ == 0) { Z.s01 = (f32x2){0.f, 0.f}; Z.s23 = (f32x2){0.f, 0.f}; } \
        if (F.wave < NSW) { const LAS float* im = img + ((cc_) % 3) * IMG; LAS float* ypb = ypr + (((cc_) & 1) * NSW + F.wave) * (SC * 64) + F.lane; \
            const LAS float* vtp = im + SC * PSTR + vrow * SC; \
            ScanT Tz; Tz.t01 = Z.s01; Tz.t23 = Z.s23; Tz.c0 = load_ops_s<PSTR>(im, 0, cgi); Tz.c1 = load_ops_s<PSTR>(im, 1, cgi); \
            _Pragma("unroll") for (int q_ = 0; q_ < 4; ++q_) Tz.v4[q_] = *(const LAS f32x4*)(vtp + 4 * q_); \
            scan_chunk_s_impl<PSTR>(im, cgi, Tz, ypb, std::make_integer_sequence<int, 16>()); \
            { const f32x4 wce = *(const LAS f32x4*)(im + 15 * PSTR + cgi * 4); Tz.t01 = Tz.t01 * (f32x2){wce[0], wce[1]}; Tz.t23 = Tz.t23 * (f32x2){wce[2], wce[3]}; } \
            _Pragma("unroll") for (int q_ = 0; q_ < 4; ++q_) Tz.v4[q_] = *(const LAS f32x4*)(vtp + 16 + 4 * q_); \
            scan_chunk_s_impl<PSTR>(im + 16 * PSTR, cgi, Tz, ypb + 16 * 64, std::make_integer_sequence<int, 16>()); \
            { const f32x4 wce = *(const LAS f32x4*)(im + 31 * PSTR + cgi * 4); Z.s01 = Tz.t01 * (f32x2){wce[0], wce[1]}; Z.s23 = Tz.t23 * (f32x2){wce[2], wce[3]}; } } \
        else if (F.wave < 2 * NSW && (cc_) > 0) { const int sw_ = F.wave - NSW, cp_ = ((cc_) - 1) % NCH; \
            const LAS float* ypb = ypr + ((((cc_) - 1) & 1) * NSW + sw_) * (SC * 64) + F.lane; float* yo = Y + (size_t)(mbase + cp_ * SC) * 512 + h * 64 + v0 + sw_ * 4 + rl; \
            yp_reduce_impl(ypb, cgi, yo, 0, std::make_integer_sequence<int, 16>()); yp_reduce_impl(ypb, cgi, yo, 16, std::make_integer_sequence<int, 16>()); } \
        else if ((F.wave == 4 || F.wave == 5) && (cc_) + 1 < NTOT) scan_transform<PSTR, 16>(img + (((cc_) + 1) % 3) * IMG + (F.wave - 4) * 16 * PSTR, F.lane); } while (0)
#define SCAN_ITER(j_, RL_, RS_) do { const int c4_ = cc + (j_); \
        scan_load(F, RL_, mbase + ((c4_ + 4 < NTOT ? c4_ + 4 : NTOT - 1) % NCH) * SC, h, v0);        \
        SCAN_CHUNK(c4_); \
        if (c4_ + 2 < NTOT) scan_store(F, RS_, img + ((c4_ + 2) % 3) * IMG);                         \
        asm volatile("s_waitcnt lgkmcnt(0)\n\ts_barrier" ::: "memory"); } while (0)
#pragma unroll 1
    for (int cc = 0; cc < NTOT; cc += 4) {
        SCAN_ITER(0, R0, R2); SCAN_ITER(1, R1, R3); SCAN_ITER(2, R2, R0); SCAN_ITER(3, R3, R1);
    }
#undef SCAN_ITER
#undef SCAN_CHUNK
    if (F.wave >= NSW && F.wave < 2 * NSW) { const int sw_ = F.wave - NSW, cp_ = (NTOT - 1) % NCH;
        const LAS float* ypb = ypr + (((NTOT - 1) & 1) * NSW + sw_) * (SC * 64) + F.lane; float* yo = Y + (size_t)(mbase + cp_ * SC) * 512 + h * 64 + v0 + sw_ * 4 + rl;
        yp_reduce_impl(ypb, cgi, yo, 0, std::make_integer_sequence<int, 16>()); yp_reduce_impl(ypb, cgi, yo, 16, std::make_integer_sequence<int, 16>()); }
    __syncthreads();
    if (F.wave < NSW) *(f32x4*)(F.out + O_WKVP + ((size_t)(b * 8 + h) * 64 + v0 + vrow) * 64 + cgi * 4) = (f32x4){Z.s01.x, Z.s01.y, Z.s23.x, Z.s23.y};
}
__device__ __forceinline__ void sample_scan(Frame& F, int sblk, int nsblk) {
    LAS float* img0 = (LAS float*)F.lds;
    float* Y = F.out;
    const int rl = F.lane >> 4, cgi = F.lane & 15;
    constexpr int IMGS = DT * SSTR, BATCH = 8;
    for (int base = sblk; base < DB * 8; base += nsblk * BATCH) {
#pragma unroll 1
        for (int ci = 0; ci < BATCH; ++ci) {
            const int chain = base + ci * nsblk; if (chain >= DB * 8) break;
            const int b = chain >> 3, h = chain & 7; const int m0 = MP + b * DT; LAS float* img = img0 + ci * IMGS;
            for (int e = F.tid; e < 6 * DT * 64; e += NT) {
                const int st = e >> 9, row = (e >> 6) & 7, ch = e & 63; const size_t o = (size_t)(m0 + row) * 512 + h * 64 + ch;
                float val;
                if (st == 0) val = ((const float*)(F.ws + WS_SW))[o];
                else { const size_t bs = st == 1 ? WS_SB : st == 2 ? WS_SKK : st == 3 ? WS_SK : st == 4 ? WS_SR : WS_SV; val = bf2f(((const bf16_t*)(F.ws + bs))[o]); if (st == 1) val = -val; }
                img[row * SSTR + st * 64 + ch] = val;
            }
        }
        __syncthreads();
#pragma unroll 1
        for (int ci = 0; ci < BATCH; ++ci) {
            const int chain = base + ci * nsblk; if (chain >= DB * 8) break;
            const int b = chain >> 3, h = chain & 7; const int m0 = MP + b * DT; const LAS float* img = img0 + ci * IMGS;
#pragma unroll 1
            for (int rnd = 0; rnd < 2; ++rnd) {
                const int vrow = (rnd * 8 + F.wave) * 4 + rl;
                const float* s0 = F.in[5] + ((size_t)chain * 64 + vrow) * 64 + cgi * 4;
                const f32x4 S = *(const f32x4*)s0;
                ScanState Z; Z.s01 = (f32x2){S[0], S[1]}; Z.s23 = (f32x2){S[2], S[3]}; Z.ykeep = 0.f; Z.ypart = 0.f;
                Z.c0 = load_ops<SSTR>(img, 0, cgi, vrow); Z.c1 = load_ops<SSTR>(img, 1, cgi, vrow);
                scan_group<SSTR, DT>(img, 0, vrow, cgi, Z, Y + (size_t)m0 * 512 + h * 64 + vrow);
                *(f32x4*)(F.out + O_WKVS + ((size_t)chain * 64 + vrow) * 64 + cgi * 4) = (f32x4){Z.s01.x, Z.s01.y, Z.s23.x, Z.s23.y};
            }
        }
        __syncthreads();
    }
}

__device__ __forceinline__ void post_phase(Frame& F) {
    const bf16_t* HRW = (const bf16_t*)(F.ws + WS_HRW);
    const bf16_t* SR = (const bf16_t*)(F.ws + WS_SR); const bf16_t* SK = (const bf16_t*)(F.ws + WS_SK); const bf16_t* SV = (const bf16_t*)(F.ws + WS_SV);
    const float* Y = F.out; bf16_t* OC = (bf16_t*)(F.ws + WS_OCAT);
    const int fr = F.lane & 15, fq = F.lane >> 4, h = F.wave;
    bf16x8 Ag[4][3];
#pragma unroll
    for (int nt = 0; nt < 4; ++nt)
#pragma unroll
        for (int s3 = 0; s3 < 3; ++s3) Ag[nt][s3] = wfrag(F.in[15], 32 * s3, fq, h * 64 + 16 * (fr >> 2) + 4 * nt + (fr & 3));
    constexpr int NTILE = M / 16;
    f32x4 prk[4], pgw[4], pgb[4], pmg[3][2];
#pragma unroll
    for (int i = 0; i < 4; ++i) { const int c4 = h * 64 + 16 * fq + 4 * i; prk[i] = *(const f32x4*)(F.in[18] + c4); pgw[i] = *(const f32x4*)(F.in[19] + c4); pgb[i] = *(const f32x4*)(F.in[20] + c4); }
#pragma unroll
    for (int s3 = 0; s3 < 3; ++s3) { pmg[s3][0] = *(const f32x4*)(F.in[10] + 1600 + 32 * s3 + 8 * fq); pmg[s3][1] = *(const f32x4*)(F.in[10] + 1604 + 32 * s3 + 8 * fq); }
    for (int tile_ = F.bid; tile_ < NTILE * POST_DUP; tile_ += F.G) {
        const int m = (tile_ % NTILE) * 16 + fr;
        const RowInfo ri = row_info(m);
        bf16x8 xg[3];
#pragma unroll
        for (int s3 = 0; s3 < 3; ++s3) {
            const F8 a = hs8m(F, HRW, m, ri, 1600 + 32 * s3 + 8 * fq, pmg[s3][0], pmg[s3][1]);
            f32x4 t0, t1;
#pragma unroll
            for (int i = 0; i < 4; ++i) { t0[i] = sigmoidf_(a.a[i]); t1[i] = sigmoidf_(a.b[i]); }
            xg[s3] = __builtin_bit_cast(bf16x8, pk8(t0, t1));
        }
        f32x4 y4[4], v4[4], g4[4]; float sy = 0.f, dot = 0.f;
#pragma unroll
        for (int np = 0; np < 2; ++np) {
            const int c8 = h * 64 + 16 * fq + 8 * np; const size_t o = (size_t)m * 512 + c8;
#pragma unroll
            for (int q = 0; q < 2; ++q) { f32x4 g = {0.f, 0.f, 0.f, 0.f};
#pragma unroll
                for (int s3 = 0; s3 < 3; ++s3) g = __builtin_amdgcn_mfma_f32_16x16x32_bf16(Ag[2 * np + q][s3], xg[s3], g, 0, 0, 0);
                g4[2 * np + q] = g; }
            const f32x4 ya = *(const f32x4*)(Y + o), yb = *(const f32x4*)(Y + o + 4);
            const F8 r8 = ld_bf8(SR + o), k8 = ld_bf8(SK + o), v8 = ld_bf8(SV + o);
            const f32x4 rka = prk[2 * np], rkb = prk[2 * np + 1];
            y4[2 * np] = ya; y4[2 * np + 1] = yb; v4[2 * np] = v8.a; v4[2 * np + 1] = v8.b;
            sy += ((ya[0] + ya[1]) + (ya[2] + ya[3])) + ((yb[0] + yb[1]) + (yb[2] + yb[3]));
            const f32x4 pa = r8.a * k8.a * rka, pb = r8.b * k8.b * rkb; dot += ((pa[0] + pa[1]) + (pa[2] + pa[3])) + ((pb[0] + pb[1]) + (pb[2] + pb[3]));
        }
        const float mean = xsum_fq(sy) * (1.f / 64.f); dot = xsum_fq(dot);
        float sq = 0.f;
#pragma unroll
        for (int nt = 0; nt < 4; ++nt) { y4[nt] = y4[nt] - mean; const f32x4 d = y4[nt]; sq += (d[0] * d[0] + d[1] * d[1]) + (d[2] * d[2] + d[3] * d[3]); }
        const float rstd = rsqrtf(xsum_fq(sq) * (1.f / 64.f) + GN_EPS);
#pragma unroll
        for (int np = 0; np < 2; ++np) {
            const int c8 = h * 64 + 16 * fq + 8 * np;
            f32x4 oo[2];
#pragma unroll
            for (int q = 0; q < 2; ++q) { const f32x4 gw = pgw[2 * np + q], gb = pgb[2 * np + q];
                oo[q] = (y4[2 * np + q] * rstd * gw + gb + v4[2 * np + q] * dot) * g4[2 * np + q]; }
            *(u32x4*)(OC + (size_t)m * DM + 512 + c8) = pk8(oo[0], oo[1]);
        }
    }
}

__device__ __forceinline__ f32x4 bf4_to_f(const u32x2 w) { return (f32x4){bflo(w.x), bfhi(w.x), bflo(w.y), bfhi(w.y)}; }
__device__ __forceinline__ float sumsq4(const f32x4 (&v)[4]) { float s = 0.f;
#pragma unroll
    for (int j = 0; j < 4; ++j) s += (v[j].x * v[j].x + v[j].y * v[j].y) + (v[j].z * v[j].z + v[j].w * v[j].w);
    return s; }
__device__ __forceinline__ void rows_mid(Frame& F) {
    const int gw = F.bid * NWAVES + F.wave, NGW = F.G * NWAVES;
    const f32x4* g1 = (const f32x4*)F.in[22]; const f32x4* g2 = (const f32x4*)F.in[23];
    bf16_t* XN = (bf16_t*)(F.ws + WS_XN); const bf16_t* MIXb = (const bf16_t*)(F.ws + WS_MIX);
    f32x4 ga[4], gb2[4];
#pragma unroll
    for (int j = 0; j < 4; ++j) { ga[j] = g1[64 * j + F.lane]; gb2[j] = g2[64 * j + F.lane]; }
    for (int m = gw; m < M; m += 2 * NGW) {
        const int m1 = m + NGW; const bool has1 = m1 < M; const int mm1 = has1 ? m1 : m;
        const f32x4* xr0 = (const f32x4*)xrow_ptr(F, m) + F.lane; const f32x4* xr1 = (const f32x4*)xrow_ptr(F, mm1) + F.lane;
        const u32x2* mb0 = (const u32x2*)(MIXb + (size_t)m * DM) + F.lane; const u32x2* mb1 = (const u32x2*)(MIXb + (size_t)mm1 * DM) + F.lane;
        f32x4 v0[4], v1[4], x0[4], x1[4];
#pragma unroll
        for (int j = 0; j < 4; ++j) { v0[j] = bf4_to_f(__builtin_nontemporal_load(mb0 + 64 * j)); x0[j] = __builtin_nontemporal_load(xr0 + 64 * j); }
#pragma unroll
        for (int j = 0; j < 4; ++j) { v1[j] = bf4_to_f(__builtin_nontemporal_load(mb1 + 64 * j)); x1[j] = __builtin_nontemporal_load(xr1 + 64 * j); }
        const float ra = 1.0f / sqrtf(wave_sum(sumsq4(v0)) * (1.f / DM) + RMS_EPS), rb = 1.0f / sqrtf(wave_sum(sumsq4(v1)) * (1.f / DM) + RMS_EPS);
#pragma unroll
        for (int j = 0; j < 4; ++j) { const f32x4 gg = ga[j]; v0[j] = x0[j] + v0[j] * ra * gg; v1[j] = x1[j] + v1[j] * rb * gg; }
        const float qa = 1.0f / sqrtf(wave_sum(sumsq4(v0)) * (1.f / DM) + RMS_EPS), qb = 1.0f / sqrtf(wave_sum(sumsq4(v1)) * (1.f / DM) + RMS_EPS);
        u32x2* o0 = (u32x2*)(XN + (size_t)m * DM) + F.lane; u32x2* o1 = (u32x2*)(XN + (size_t)mm1 * DM) + F.lane;
#pragma unroll
        for (int j = 0; j < 4; ++j) { const f32x4 gg = gb2[j];
            u32x2 w; w.x = pk2(v0[j].x * qa * gg.x, v0[j].y * qa * gg.y); w.y = pk2(v0[j].z * qa * gg.z, v0[j].w * qa * gg.w); o0[64 * j] = w;
            if (has1) { u32x2 q; q.x = pk2(v1[j].x * qb * gg.x, v1[j].y * qb * gg.y); q.y = pk2(v1[j].z * qb * gg.z, v1[j].w * qb * gg.w); o1[64 * j] = q; } }
    }
}
__device__ __forceinline__ void rows_final(Frame& F) {
    const int gw = F.bid * NWAVES + F.wave, NGW = F.G * NWAVES;
    const f32x4* g0 = (const f32x4*)F.in[22]; const f32x4* g1 = (const f32x4*)F.in[28];
    const bf16_t* Fb = (const bf16_t*)(F.ws + WS_F); const bf16_t* MIXb = (const bf16_t*)(F.ws + WS_MIX);
    f32x4 gA[4], gB[4];
#pragma unroll
    for (int j = 0; j < 4; ++j) { gA[j] = g0[64 * j + F.lane]; gB[j] = g1[64 * j + F.lane]; }
    for (int m = gw; m < M; m += 2 * NGW) {
        const int m1 = m + NGW; const bool has1 = m1 < M; const int mm1 = has1 ? m1 : m;
        f32x4 f0[4], f1[4], a0[4], a1[4], x0[4], x1[4];
        { const u32x2* fr = (const u32x2*)(Fb + (size_t)m * DM) + F.lane; const u32x2* mb = (const u32x2*)(MIXb + (size_t)m * DM) + F.lane; const f32x4* xr = (const f32x4*)xrow_ptr(F, m) + F.lane;
#pragma unroll
          for (int j = 0; j < 4; ++j) { f0[j] = bf4_to_f(__builtin_nontemporal_load(fr + 64 * j)); a0[j] = bf4_to_f(__builtin_nontemporal_load(mb + 64 * j)); x0[j] = __builtin_nontemporal_load(xr + 64 * j); } }
        { const u32x2* fr = (const u32x2*)(Fb + (size_t)mm1 * DM) + F.lane; const u32x2* mb = (const u32x2*)(MIXb + (size_t)mm1 * DM) + F.lane; const f32x4* xr = (const f32x4*)xrow_ptr(F, mm1) + F.lane;
#pragma unroll
          for (int j = 0; j < 4; ++j) { f1[j] = bf4_to_f(__builtin_nontemporal_load(fr + 64 * j)); a1[j] = bf4_to_f(__builtin_nontemporal_load(mb + 64 * j)); x1[j] = __builtin_nontemporal_load(xr + 64 * j); } }
        const float rf0 = 1.0f / sqrtf(wave_sum(sumsq4(f0)) * (1.f / DM) + RMS_EPS), rm0 = 1.0f / sqrtf(wave_sum(sumsq4(a0)) * (1.f / DM) + RMS_EPS);
        const float rf1 = 1.0f / sqrtf(wave_sum(sumsq4(f1)) * (1.f / DM) + RMS_EPS), rm1 = 1.0f / sqrtf(wave_sum(sumsq4(a1)) * (1.f / DM) + RMS_EPS);
        f32x4* y0 = (f32x4*)(F.out + (size_t)m * DM) + F.lane; f32x4* y1 = (f32x4*)(F.out + (size_t)mm1 * DM) + F.lane;
#pragma unroll
        for (int j = 0; j < 4; ++j) { const f32x4 ga = gA[j], gb = gB[j];
            __builtin_nontemporal_store((x0[j] + a0[j] * rm0 * ga) + f0[j] * rf0 * gb, y0 + 64 * j);
            if (has1) __builtin_nontemporal_store((x1[j] + a1[j] * rm1 * ga) + f1[j] * rf1 * gb, y1 + 64 * j); }
    }
}
__device__ __forceinline__ void conv_phase(Frame& F, int half) {
    const bf16_t* ZU = (const bf16_t*)(F.ws + WS_ZU); bf16_t* HID = (bf16_t*)(F.ws + WS_HID);
    const float* cw = F.in[25]; const float* cb = F.in[26]; const float* sc = F.in[6];
    const long total = (long)M * 176;
    for (long e = (long)F.bid * NT + F.tid; e < total; e += (long)F.G * NT) {
        const int m = (int)(e / 176), r = (int)(e - (long)m * 176); const int tile = r >> 4, c8 = (r & 15) * 8;
        const int ch = (half * 11 + tile) * 128 + c8;
        const RowInfo ri = row_info(m);
        const bf16_t* zp = ZU + (size_t)m * DFF + tile * 256 + c8;
        const u32x4 z0 = *(const u32x4*)zp, uu = *(const u32x4*)(zp + 128);
        float z[8], z1[8], z2[8], u8[8];
        z[0] = bflo(z0.x); z[1] = bfhi(z0.x); z[2] = bflo(z0.y); z[3] = bfhi(z0.y); z[4] = bflo(z0.z); z[5] = bfhi(z0.z); z[6] = bflo(z0.w); z[7] = bfhi(z0.w);
        u8[0] = bflo(uu.x); u8[1] = bfhi(uu.x); u8[2] = bflo(uu.y); u8[3] = bfhi(uu.y); u8[4] = bflo(uu.z); u8[5] = bfhi(uu.z); u8[6] = bflo(uu.w); u8[7] = bfhi(uu.w);
        if (ri.t >= 1) { const u32x4 w = *(const u32x4*)(zp - DFF); z1[0] = bflo(w.x); z1[1] = bfhi(w.x); z1[2] = bflo(w.y); z1[3] = bfhi(w.y); z1[4] = bflo(w.z); z1[5] = bfhi(w.z); z1[6] = bflo(w.w); z1[7] = bfhi(w.w); }
        else {
#pragma unroll
            for (int j = 0; j < 8; ++j) z1[j] = ri.samp ? sc[((size_t)ri.b * 2 + 1) * DFF + ch + j] : 0.f; }
        if (ri.t >= 2) { const u32x4 w = *(const u32x4*)(zp - 2 * DFF); z2[0] = bflo(w.x); z2[1] = bfhi(w.x); z2[2] = bflo(w.y); z2[3] = bfhi(w.y); z2[4] = bflo(w.z); z2[5] = bfhi(w.z); z2[6] = bflo(w.w); z2[7] = bfhi(w.w); }
        else {
#pragma unroll
            for (int j = 0; j < 8; ++j) z2[j] = ri.samp ? sc[((size_t)ri.b * 2 + ri.t) * DFF + ch + j] : 0.f; }
        float hd[8];
#pragma unroll
        for (int j = 0; j < 8; ++j) { const float zc = cb[ch + j] + cw[ch + j] * z2[j] + cw[DFF + ch + j] * z1[j] + cw[2 * DFF + ch + j] * z[j]; hd[j] = zc * sigmoidf_(zc) * u8[j]; }
        u32x4 w; w.x = pk2(hd[0], hd[1]); w.y = pk2(hd[2], hd[3]); w.z = pk2(hd[4], hd[5]); w.w = pk2(hd[6], hd[7]);
        *(u32x4*)(HID + (size_t)m * DFF + ch) = w;
    }
}

constexpr int NPHASE = 10;
__global__ void __launch_bounds__(NT, 2) fwd_megakernel(Args args) {
    extern __shared__ __attribute__((aligned(16))) unsigned char lds_raw[];
    Frame F;
    F.lds = (LAS unsigned char*)lds_raw; F.ws = args.ws; F.out = args.out; F.in = args.in;
    F.tid = threadIdx.x; F.lane = F.tid & 63; F.wave = __builtin_amdgcn_readfirstlane(F.tid >> 6); F.G = gridDim.x; F.bid = blockIdx.x;
    const int lo = args.ph_lo, hi = args.ph_hi;
#ifndef PH_MASK
#define PH_MASK 0x3ff
#endif
#ifndef DUP_MASK
#define DUP_MASK 0
#endif
#define IN(k) (((PH_MASK >> (k)) & 1) && lo <= (k) && (k) < hi)
#define REP(k) for (int rep_ = 0; rep_ < 1 + ((DUP_MASK >> (k)) & 1); ++rep_)
    unsigned* barw = (unsigned*)F.ws;
    volatile LAS unsigned* bst = (volatile LAS unsigned*)(F.lds + LDS_BYTES - 64);
    if (F.tid < 2) bst[F.tid] = 0u;
    XcdBarrier xbar; xbar.bar = barw; xbar.x = 0; xbar.st = bst;
    bool posted = false;
    if (lo + 1 < hi && F.bid == 0) { for (int i = F.tid; i < XCD_BAR_WORDS; i += NT) barw[i] = 0u; }
#define SEAM(k) do { if (IN(k) && IN((k) + 1)) { if (!posted) { cg::this_grid().sync(); xbar = xcd_barrier_post(barw, bst); posted = true; } else xcd_barrier(xbar); } } while (0)
    bf16_t* XN = (bf16_t*)(F.ws + WS_XN);
    if (IN(0)) REP(0) { p0_prologue(F); } SEAM(0);
    if (IN(1)) REP(1) {
        pg8::Gemm g{XN, (const bf16_t*)(F.ws + WS_WIN), M, DINP, DM, DM, DM, 0}; pg8::StaticOrder S; S.init(M, DINP, F.G, F.bid);
        Epi1 E{(const float*)(F.ws + WS_ROPE), (bf16_t*)(F.ws + WS_Q), (bf16_t*)(F.ws + WS_K), (bf16_t*)(F.ws + WS_VT), (bf16_t*)(F.ws + WS_HRW), F.out};
        pg8::gemm_phase<Epi1, true>(F.lds, g, S, E);
    } SEAM(1);
    if (IN(2)) REP(2) { prep_phase(F); sample_attn_phase(F); } SEAM(2);
    if (IN(3)) {
        if (F.G == 256) {
            constexpr int AOFF = 71680;
            prompt_attn_unit<1>(F, F.bid, 0); prompt_attn_unit<1>(F, F.bid + 256, AOFF);
            __syncthreads();
            prompt_attn_unit<2>(F, F.bid, 0); prompt_attn_unit<2>(F, F.bid + 256, AOFF);
            __syncthreads();
        } else for (int u = F.bid; u < NB * 64 * 2; u += F.G) prompt_attn_unit<0>(F, u, 0);
        sample_scan(F, F.bid, F.G);
        for (int sb = F.bid; sb < 256; sb += F.G) prompt_scan(F, sb);
    } SEAM(3);
    if (IN(4)) REP(4) { post_phase(F); } SEAM(4);
    if (IN(5)) REP(5) {
        pg8::Gemm g{(const bf16_t*)(F.ws + WS_OCAT), (const bf16_t*)(F.ws + WS_WOUT), M, DM, DM, DM, DM, 0}; pg8::StaticOrder S; S.init(M, DM, F.G, F.bid);
        EpiBf16 E{(bf16_t*)(F.ws + WS_MIX), DM};
        pg8::gemm_phase<EpiBf16, true>(F.lds, g, S, E);
    } SEAM(5);
    if (IN(6)) { rows_mid(F); } SEAM(6);
    if (IN(7)) REP(7) {
        pg8::Gemm g{XN, (const bf16_t*)(F.ws + WS_WFI), 136 * 256, 2 * DFF, DM, DM, DM, 1}; pg8::StaticOrder S; S.init(136 * 256, 2 * DFF, F.G, F.bid);
        EpiConv E{(bf16_t*)(F.ws + WS_HID), F.out, F.in[25], F.in[26], F.in[6], (LAS float*)(F.lds + 131072)};
        pg8::gemm_phase<EpiConv, true>(F.lds, g, S, E);
    } SEAM(7);
    if (IN(8)) REP(11) {
        pg8::Gemm g{(const bf16_t*)(F.ws + WS_HID), (const bf16_t*)(F.ws + WS_WFO), M, DM, DFF, DFF, DFF, 0}; pg8::StaticOrder S; S.init(M, DM, F.G, F.bid);
        EpiBf16 E{(bf16_t*)(F.ws + WS_F), DM};
        pg8::gemm_phase<EpiBf16, true>(F.lds, g, S, E);
    } SEAM(8);
    if (IN(9)) { rows_final(F); }
#undef IN
#undef SEAM
}

extern "C" void kernel_launch(void* const* d_in, const int* in_sizes, int n_in, void* d_out, int out_size, void* d_ws, size_t ws_size, hipStream_t stream) {
    static int grid = 0;
    if (grid == 0) {
        if (n_in != 29 || ws_size < WS_END) { fprintf(stderr, "kernel_launch: unexpected n_in %d / ws_size %zu\n", n_in, ws_size); grid = -1; return; }
        int dev = 0, cus = 0, per_cu = 0;
        hipGetDevice(&dev); hipDeviceGetAttribute(&cus, hipDeviceAttributeMultiprocessorCount, dev);
        if (hipFuncSetAttribute((const void*)fwd_megakernel, hipFuncAttributeMaxDynamicSharedMemorySize, LDS_BYTES) != hipSuccess) { fprintf(stderr, "kernel_launch: hipFuncSetAttribute failed\n"); grid = -1; return; }
        if (hipOccupancyMaxActiveBlocksPerMultiprocessor(&per_cu, (const void*)fwd_megakernel, NT, LDS_BYTES) != hipSuccess || per_cu < 1) { fprintf(stderr, "kernel_launch: occupancy query failed (%d)\n", per_cu); (void)hipGetLastError(); per_cu = 1; }
        grid = cus * (per_cu > 1 ? 1 : per_cu);
        fprintf(stderr, "kernel_launch: grid %d (cus %d, per_cu %d), ws %zu\n", grid, cus, per_cu, ws_size);
    }
    if (grid < 0) return;
    Args a{};
    for (int i = 0; i < 29; ++i) a.in[i] = (const float*)d_in[i];
    a.out = (float*)d_out; a.ws = (unsigned char*)d_ws;
#if MK_PER_PHASE
    for (int p = 0; p < NPHASE; ++p) { a.ph_lo = p; a.ph_hi = p + 1; hipLaunchKernelGGL(fwd_megakernel, dim3(grid), dim3(NT), LDS_BYTES, stream, a); }
#else
    a.ph_lo = 0; a.ph_hi = NPHASE;
    void* kargs[] = {&a};
    hipError_t e = hipLaunchCooperativeKernel((const void*)fwd_megakernel, dim3(grid), dim3(NT), kargs, LDS_BYTES, stream);
    if (e != hipSuccess) fprintf(stderr, "cooperative launch failed: %s (grid %d)\n", hipGetErrorString(e), grid);
#endif
}
```

```cpp
#include <hip/hip_runtime.h>
#include <hip/hip_cooperative_groups.h>
#include <cstdio>
#include <cstdint>
#include <utility>
namespace cg = cooperative_groups;

#ifndef MK_PER_PHASE
#define MK_PER_PHASE 0
#endif

#define LAS __attribute__((address_space(3)))
typedef unsigned short bf16_t;
typedef short bf16x8 __attribute__((ext_vector_type(8)));
typedef float f32x4 __attribute__((ext_vector_type(4)));
typedef float f32x2 __attribute__((ext_vector_type(2)));
typedef unsigned u32x4 __attribute__((ext_vector_type(4)));
typedef unsigned u32x2 __attribute__((ext_vector_type(2)));

constexpr int DM = 1024, NB = 4, T = 8192, MP = NB * T, DB = 128, DT = 8, MS = DB * DT, M = MP + MS;
constexpr int WIN = 128, DSH = 1696, DINP = 2560, DFF = 2816, DFFH = 1408;
constexpr float RMS_EPS = 1e-6f, GN_EPS = 64e-5f;
constexpr float QSCALE = 0.125f * 1.4426950408889634f;
constexpr size_t O_Y = 0, O_KWP = 34603008, O_VWP = 34668544, O_SHP = 34734080, O_WKVP = 34740864, O_CVP = 34871936,
                 O_KWS = 34894464, O_VWS = 36991616, O_SHS = 39088768, O_WKVS = 39305856, O_CVS = 43500160;
constexpr size_t MiB = 1u << 20;
constexpr size_t WS_WIN = 1 * MiB, WS_WOUT = 6 * MiB, WS_WFI = 8 * MiB, WS_WFO = 19 * MiB, WS_ROPE = 25 * MiB;
constexpr size_t WS_FRAG = 28 * MiB;
constexpr size_t WS_XN = 32 * MiB;
constexpr size_t WS_SR = 32 * MiB, WS_SK = 65 * MiB;
constexpr size_t WS_Q = 98 * MiB, WS_K = 131 * MiB, WS_VT = 140 * MiB;
constexpr size_t WS_HRW = 150 * MiB;
constexpr size_t WS_OCAT = 260 * MiB;
constexpr size_t WS_SW = 326 * MiB;
constexpr size_t WS_SV = 392 * MiB, WS_SKK = 425 * MiB, WS_SB = 458 * MiB;
constexpr size_t WS_ZU = 100 * MiB;
constexpr size_t WS_HID = 282 * MiB;
constexpr size_t WS_F = 216 * MiB;
constexpr size_t WS_MIX = 150 * MiB;
constexpr size_t WS_END = 491 * MiB;

__device__ __forceinline__ unsigned f2bf(float f) { unsigned u = __float_as_uint(f); return (u + 0x7fffu + ((u >> 16) & 1u)) >> 16; }

__device__ __forceinline__ float bf2f(unsigned short h) { return __uint_as_float(((unsigned)h) << 16); }
__device__ __forceinline__ float bflo(unsigned w) { return __uint_as_float(w << 16); }
__device__ __forceinline__ float bfhi(unsigned w) { return __uint_as_float(w & 0xffff0000u); }
__device__ __forceinline__ unsigned cvt_pk_bf16(float lo, float hi) { unsigned r; asm volatile("v_cvt_pk_bf16_f32 %0, %1, %2" : "=v"(r) : "v"(lo), "v"(hi)); return r; }
__device__ __forceinline__ unsigned pk2(float lo, float hi) { return cvt_pk_bf16(lo, hi); }
template <int CTRL> __device__ __forceinline__ float dppf(float x) { return __int_as_float(__builtin_amdgcn_update_dpp(0, __float_as_int(x), CTRL, 0xF, 0xF, false)); }
__device__ __forceinline__ float allsum16(float x) {
    x += dppf<0xB1>(x); x += dppf<0x4E>(x); x += dppf<0x141>(x); x += dppf<0x140>(x); return x;
}
__device__ __forceinline__ void allsum16_2(float& a, float& b) {
    a += dppf<0xB1>(a); b += dppf<0xB1>(b); a += dppf<0x4E>(a); b += dppf<0x4E>(b); a += dppf<0x141>(a); b += dppf<0x141>(b); a += dppf<0x140>(a); b += dppf<0x140>(b);
}
__device__ __forceinline__ float wave_sum(float v) {
    v = allsum16(v);
    { auto r = __builtin_amdgcn_permlane16_swap(__float_as_uint(v), __float_as_uint(v), false, false); v = __uint_as_float(r[0]) + __uint_as_float(r[1]); }
    { auto r = __builtin_amdgcn_permlane32_swap(__float_as_uint(v), __float_as_uint(v), false, false); v = __uint_as_float(r[0]) + __uint_as_float(r[1]); }
    return v;
}
__device__ __forceinline__ float sigmoidf_(float x) { return __builtin_amdgcn_rcpf(1.0f + __expf(-x)); }

namespace pg8 {
constexpr int BM = 256, BK = 64, HALF = 128, HTB = HALF * BK * 2, STAGE_BYTES = 8 * HTB, NXCD = 8, WGM = 8;
__host__ __device__ __forceinline__ int lds_byte(int r, int c) { const int st = (r >> 4) * 2 + (c >> 5), rr = r & 15, cc = c & 31, ob = rr * 64 + cc * 2; return st * 1024 + (ob ^ (((ob >> 9) & 1) << 5)); }
__host__ __device__ __forceinline__ void stage_rc(int b, int& R, int& C) { const int st = b / 1024, sb = b % 1024, swz = sb ^ (((sb >> 9) & 1) << 5); R = (st >> 1) * 16 + swz / 64; C = (st & 1) * 32 + (swz % 64) / 2; }
__host__ __device__ __forceinline__ int perm32(int rho) { const int n = rho >> 4, i = rho & 15; return 8 * (i >> 2) + 4 * n + (i & 3); }
struct Unit { int pm, pn; };
struct Gemm { const bf16_t* A; const bf16_t* Bt; int M, N, K, lda, ldb, conv; };
__device__ __forceinline__ long arow(const Gemm& g, int pm) {
    if (!g.conv) return (long)pm * 256;
    if (pm < 132) { const int b = pm / 33; return (long)b * 8192 + 254 * (pm - 33 * b) - 2; }
    return 32768 + (long)(pm - 132) * 256;
}
struct StaticOrder {
    int nM, nN, nwg, G, c;
    __device__ void init(int M_, int N_, int G_, int c_) { nM = M_ / BM; nN = N_ / BM; nwg = nM * nN; G = G_; c = c_; }
    __device__ bool next(int i, Unit& u) const {
        const long L = (long)i * G + c; if (L >= nwg) return false;
        int wgid = (int)L; { const int q = nwg / NXCD, r = nwg % NXCD, xcd = wgid % NXCD, off = wgid / NXCD; wgid = (xcd < r ? xcd * (q + 1) : r * (q + 1) + (xcd - r) * q) + off; }
        const int nig = WGM * nN, gid = wgid / nig, fm = gid * WGM, gsz = (nM - fm) < WGM ? (nM - fm) : WGM;
        u.pm = fm + ((wgid % nig) % gsz); u.pn = (wgid % nig) / gsz; return true;
    }
};
template <class Epi, bool ALIGN_EPI>
__device__ __forceinline__ void gemm_phase(LAS unsigned char* lds, const Gemm g, const StaticOrder& S, const Epi& E) {
    const int tid = threadIdx.x, wid = __builtin_amdgcn_readfirstlane(tid >> 6), lane = tid & 63, wr = wid >> 2, wc = wid & 3, fr = lane & 15, fq = lane >> 4;
    const int nt = g.K / BK;
    unsigned voffA[2], voffB[2];
#pragma unroll
    for (int i = 0; i < 2; ++i) { int R, C; stage_rc(tid * 16 + i * 8192, R, C); const int Rb = (R & ~31) + perm32(R & 31);
        voffA[i] = (unsigned)(R * g.lda + C) * 2u; voffB[i] = (unsigned)(Rb * g.ldb + C) * 2u; }
    const size_t kstep = (size_t)(BK * 2);
    const size_t hstepA = (size_t)HALF * g.lda * 2, hstepB = (size_t)HALF * g.ldb * 2;
    const size_t rowA = (size_t)g.lda * 2, tstepB = 2 * hstepB;
    const unsigned ldsw = (unsigned)wid * 1024u;
    const int aoff = lds_byte(wr * 64 + fr, fq * 8), boff = lds_byte(wc * 32 + fr, fq * 8);
#define PG8_SA(b, h) (((b) * 2 + (h)) * HTB)
#define PG8_SB(b, h) ((4 + (b) * 2 + (h)) * HTB)
#define PG8_STAGE(bufoff, gbase, voff) do { _Pragma("unroll") for (int _i = 0; _i < 2; ++_i) \
        __builtin_amdgcn_global_load_lds((const unsigned*)((const char*)(gbase) + (voff)[_i]), (LAS unsigned*)(lds + (bufoff) + ldsw + _i * 8192), 16, 0, 0); } while (0)
#define PG8_LDA(dst, b, h) do { _Pragma("unroll") for (int m = 0; m < 4; ++m) _Pragma("unroll") for (int k = 0; k < 2; ++k) dst[m][k] = *(const LAS bf16x8*)(lds + PG8_SA(b, h) + aoff + m * 2048 + k * 1024); } while (0)
#define PG8_LDB(dst, b, h) do { _Pragma("unroll") for (int n = 0; n < 2; ++n) _Pragma("unroll") for (int k = 0; k < 2; ++k) dst[n][k] = *(const LAS bf16x8*)(lds + PG8_SB(b, h) + boff + n * 2048 + k * 1024); } while (0)
#define PG8_MMA(ai, bj, At, Bt) do { __builtin_amdgcn_s_setprio(1); _Pragma("unroll") for (int m = 0; m < 4; ++m) _Pragma("unroll") for (int n = 0; n < 2; ++n) _Pragma("unroll") for (int k = 0; k < 2; ++k) \
        acc[ai][bj][m][n] = __builtin_amdgcn_mfma_f32_16x16x32_bf16(Bt[n][k], At[m][k], acc[ai][bj][m][n], 0, 0, 0); __builtin_amdgcn_s_setprio(0); } while (0)
#define PG8_WAIT_V(n) asm volatile("s_waitcnt vmcnt(" #n ")" ::: "memory")
#define PG8_WAIT_L(n) asm volatile("s_waitcnt lgkmcnt(" #n ")" ::: "memory")
#define PG8_BAR __builtin_amdgcn_s_barrier()
#define PG8_SCHED __builtin_amdgcn_sched_barrier(0)
    Unit cur, nxt; int ui = 0;
    if (!S.next(0, cur)) return;
    f32x4 acc[2][2][4][2];
#pragma unroll
    for (int a = 0; a < 2; ++a)
#pragma unroll
        for (int b = 0; b < 2; ++b)
#pragma unroll
            for (int m = 0; m < 4; ++m)
#pragma unroll
                for (int n = 0; n < 2; ++n) acc[a][b][m][n] = (f32x4){0.f, 0.f, 0.f, 0.f};
    bf16x8 At[4][2], B0[2][2], B1[2][2];
    const char* cA = (const char*)g.A + arow(g, cur.pm) * (long)rowA; const char* cB = (const char*)g.Bt + (size_t)cur.pn * tstepB;
    PG8_STAGE(PG8_SB(0, 0), cB, voffB); PG8_STAGE(PG8_SB(0, 1), cB + hstepB, voffB); PG8_STAGE(PG8_SA(0, 0), cA, voffA); PG8_STAGE(PG8_SA(0, 1), cA + hstepA, voffA);
    if (wr == 1) PG8_BAR;
    PG8_WAIT_V(2); PG8_BAR;
    PG8_STAGE(PG8_SB(1, 0), cB + kstep, voffB); PG8_STAGE(PG8_SA(1, 0), cA + kstep, voffA); PG8_STAGE(PG8_SB(1, 1), cB + hstepB + kstep, voffB);
    PG8_WAIT_V(6); PG8_BAR;
    for (;;) {
        const bool has_next = S.next(ui + 1, nxt);
        const char* nA = has_next ? (const char*)g.A + arow(g, nxt.pm) * (long)rowA : cA; const char* nB = has_next ? (const char*)g.Bt + (size_t)nxt.pn * tstepB : cB;
        for (int t = 0; t < nt; t += 2) {
            const bool last = (t == nt - 2);
            const char* a1 = cA + (size_t)(t + 1) * kstep;
            const char* a2 = last ? nA : cA + (size_t)(t + 2) * kstep; const char* b2 = last ? nB : cB + (size_t)(t + 2) * kstep;
            const char* a3 = a2 + kstep; const char* b3 = b2 + kstep;
            PG8_LDB(B0, 0, 0); PG8_LDB(B1, 0, 1); PG8_SCHED; PG8_LDA(At, 0, 0); PG8_STAGE(PG8_SA(1, 1), a1 + hstepA, voffA);
            PG8_WAIT_V(8); PG8_WAIT_L(0); PG8_BAR; PG8_MMA(0, 0, At, B0); PG8_MMA(0, 1, At, B1); PG8_BAR; PG8_SCHED;
            PG8_LDA(At, 0, 1); PG8_STAGE(PG8_SB(0, 0), b2, voffB); PG8_STAGE(PG8_SB(0, 1), b2 + hstepB, voffB); PG8_STAGE(PG8_SA(0, 0), a2, voffA);
            PG8_WAIT_V(8); PG8_WAIT_L(0); PG8_BAR; PG8_MMA(1, 0, At, B0); PG8_MMA(1, 1, At, B1); PG8_BAR; PG8_SCHED;
            PG8_LDB(B0, 1, 0); PG8_LDB(B1, 1, 1); PG8_SCHED; PG8_LDA(At, 1, 0); PG8_STAGE(PG8_SA(0, 1), a2 + hstepA, voffA);
            PG8_WAIT_V(8); PG8_WAIT_L(0); PG8_BAR; PG8_MMA(0, 0, At, B0); PG8_MMA(0, 1, At, B1); PG8_BAR; PG8_SCHED;
            PG8_LDA(At, 1, 1); PG8_STAGE(PG8_SB(1, 0), b3, voffB); PG8_STAGE(PG8_SB(1, 1), b3 + hstepB, voffB); PG8_STAGE(PG8_SA(1, 0), a3, voffA);
            PG8_WAIT_V(8); PG8_WAIT_L(0); PG8_BAR; PG8_MMA(1, 0, At, B0); PG8_MMA(1, 1, At, B1); PG8_BAR; PG8_SCHED;
        }
        if constexpr (ALIGN_EPI) { if (wr == 0) PG8_BAR; }
        asm volatile("s_nop 7\n\ts_nop 7" ::: "memory");
        E(acc, cur, wr, wc, fr, fq);
        if (!has_next) break;
#pragma unroll
        for (int a = 0; a < 2; ++a)
#pragma unroll
            for (int b = 0; b < 2; ++b)
#pragma unroll
                for (int m = 0; m < 4; ++m)
#pragma unroll
                    for (int n = 0; n < 2; ++n) acc[a][b][m][n] = (f32x4){0.f, 0.f, 0.f, 0.f};
        cur = nxt; cA = nA; cB = nB; ++ui;
        if constexpr (ALIGN_EPI) { if (wr == 1) PG8_BAR; }
    }
    PG8_WAIT_V(0);
    if constexpr (!ALIGN_EPI) { if (wr == 0) PG8_BAR; }
    PG8_BAR;
#undef PG8_SA
#undef PG8_SB
#undef PG8_STAGE
#undef PG8_LDA
#undef PG8_LDB
#undef PG8_MMA
#undef PG8_WAIT_V
#undef PG8_WAIT_L
#undef PG8_BAR
#undef PG8_SCHED
}
}

struct RowInfo { int b, t, samp; };
__device__ __forceinline__ RowInfo row_info(int row) { RowInfo r; if (row < MP) { r.samp = 0; r.b = row >> 13; r.t = row & (T - 1); } else { const int rs = row - MP; r.samp = 1; r.b = rs >> 3; r.t = rs & 7; } return r; }

struct Epi1 {
    const float* rope; bf16_t* Q; bf16_t* Kb; bf16_t* VT; bf16_t* HRW; float* out;
    __device__ __forceinline__ void operator()(const f32x4 (&acc)[2][2][4][2], const pg8::Unit& u, int wr, int wc, int fr, int fq) const {
#pragma unroll
        for (int ai = 0; ai < 2; ++ai)
#pragma unroll
            for (int m = 0; m < 4; ++m) {
                const int row = u.pm * 256 + ai * 128 + wr * 64 + m * 16 + fr;
                const RowInfo ri = row_info(row);
                const int pidx = ri.samp ? (T + ri.t) : ri.t;
#pragma unroll
                for (int bj = 0; bj < 2; ++bj) {
                    const int cb = u.pn * 256 + bj * 128;
                    const int c0 = cb + wc * 32 + fq * 8;
                    const f32x4 v0 = acc[ai][bj][m][0], v1 = acc[ai][bj][m][1];
                    if (cb < 640) {
                        const int d0 = ((c0 & 63) >> 3) * 4;
                        const f32x4* rp = (const f32x4*)(rope + ((size_t)pidx * 32 + d0) * 2);
                        const f32x4 cs0 = rp[0], cs1 = rp[1];
                        f32x4 o1, o2;
                        o1[0] = v0[0] * cs0[0] - v1[0] * cs0[1]; o2[0] = v1[0] * cs0[0] + v0[0] * cs0[1];
                        o1[1] = v0[1] * cs0[2] - v1[1] * cs0[3]; o2[1] = v1[1] * cs0[2] + v0[1] * cs0[3];
                        o1[2] = v0[2] * cs1[0] - v1[2] * cs1[1]; o2[2] = v1[2] * cs1[0] + v0[2] * cs1[1];
                        o1[3] = v0[3] * cs1[2] - v1[3] * cs1[3]; o2[3] = v1[3] * cs1[2] + v0[3] * cs1[3];
                        if (cb < 512) {
                            o1 = o1 * QSCALE; o2 = o2 * QSCALE;
                            bf16_t* qp = Q + (size_t)row * 512 + (c0 & ~63) + d0;
                            u32x2 w1, w2; w1.x = cvt_pk_bf16(o1[0], o1[1]); w1.y = cvt_pk_bf16(o1[2], o1[3]); w2.x = cvt_pk_bf16(o2[0], o2[1]); w2.y = cvt_pk_bf16(o2[2], o2[3]);
                            *(u32x2*)qp = w1; *(u32x2*)(qp + 32) = w2;
                        } else {
                            const int kvh = (c0 - 512) >> 6;
                            bf16_t* kp = Kb + (size_t)row * 128 + kvh * 64 + d0;
                            u32x2 w1, w2; w1.x = cvt_pk_bf16(o1[0], o1[1]); w1.y = cvt_pk_bf16(o1[2], o1[3]); w2.x = cvt_pk_bf16(o2[0], o2[1]); w2.y = cvt_pk_bf16(o2[2], o2[3]);
                            *(u32x2*)kp = w1; *(u32x2*)(kp + 32) = w2;
                            if (!ri.samp) { if (ri.t >= T - WIN) { float* o = out + O_KWP + ((size_t)(ri.b * WIN + (ri.t - (T - WIN))) * 2 + kvh) * 64 + d0; *(f32x4*)o = o1; *(f32x4*)(o + 32) = o2; } }
                            else { float* o = out + O_KWS + ((size_t)(ri.b * WIN + (WIN - DT) + ri.t) * 2 + kvh) * 64 + d0; *(f32x4*)o = o1; *(f32x4*)(o + 32) = o2; }
                        }
                    } else if (cb < 768) {
                        const int kvh = (c0 - 640) >> 6, d0 = (c0 - 640) & 63;
                        if (!ri.samp) {
                            bf16_t* vp = VT + ((size_t)(ri.b * 2 + kvh) * 64 + d0) * T + ri.t;
                            vp[0] = (bf16_t)f2bf(v0[0]); vp[(size_t)T] = (bf16_t)f2bf(v0[1]); vp[(size_t)2 * T] = (bf16_t)f2bf(v0[2]); vp[(size_t)3 * T] = (bf16_t)f2bf(v0[3]);
                            vp[(size_t)4 * T] = (bf16_t)f2bf(v1[0]); vp[(size_t)5 * T] = (bf16_t)f2bf(v1[1]); vp[(size_t)6 * T] = (bf16_t)f2bf(v1[2]); vp[(size_t)7 * T] = (bf16_t)f2bf(v1[3]);
                            if (ri.t >= T - WIN) { float* o = out + O_VWP + ((size_t)(ri.b * WIN + (ri.t - (T - WIN))) * 2 + kvh) * 64 + d0; *(f32x4*)o = v0; *(f32x4*)(o + 4) = v1; }
                        } else { float* o = out + O_VWS + ((size_t)(ri.b * WIN + (WIN - DT) + ri.t) * 2 + kvh) * 64 + d0; *(f32x4*)o = v0; *(f32x4*)(o + 4) = v1; }
                    } else if (c0 < 2464) {
                        const int col = c0 - 768;
                        u32x4 w; w.x = cvt_pk_bf16(v0[0], v0[1]); w.y = cvt_pk_bf16(v0[2], v0[3]); w.z = cvt_pk_bf16(v1[0], v1[1]); w.w = cvt_pk_bf16(v1[2], v1[3]);
                        *(u32x4*)(HRW + (size_t)row * DSH + col) = w;
                        if (!ri.samp) { if (ri.t == T - 1) { float* o = out + O_SHP + (size_t)ri.b * DSH + col; *(f32x4*)o = v0; *(f32x4*)(o + 4) = v1; } }
                        else if (ri.t == DT - 1) { float* o = out + O_SHS + (size_t)ri.b * DSH + col; *(f32x4*)o = v0; *(f32x4*)(o + 4) = v1; }
                    }
                }
            }
    }
};
struct EpiF32 {
    float* O; int ldc;
    __device__ __forceinline__ void operator()(const f32x4 (&acc)[2][2][4][2], const pg8::Unit& u, int wr, int wc, int fr, int fq) const {
#pragma unroll
        for (int ai = 0; ai < 2; ++ai)
#pragma unroll
            for (int m = 0; m < 4; ++m) {
                float* rowp = O + (size_t)(u.pm * 256 + ai * 128 + wr * 64 + m * 16 + fr) * ldc + u.pn * 256 + wc * 32 + fq * 8;
#pragma unroll
                for (int bj = 0; bj < 2; ++bj) { *(f32x4*)(rowp + bj * 128) = acc[ai][bj][m][0]; *(f32x4*)(rowp + bj * 128 + 4) = acc[ai][bj][m][1]; }
            }
    }
};
struct EpiBf16 {
    bf16_t* O; int ldc;
    __device__ __forceinline__ void operator()(const f32x4 (&acc)[2][2][4][2], const pg8::Unit& u, int wr, int wc, int fr, int fq) const {
#pragma unroll
        for (int ai = 0; ai < 2; ++ai)
#pragma unroll
            for (int m = 0; m < 4; ++m) {
                bf16_t* rowp = O + (size_t)(u.pm * 256 + ai * 128 + wr * 64 + m * 16 + fr) * ldc + u.pn * 256 + wc * 32 + fq * 8;
#pragma unroll
                for (int bj = 0; bj < 2; ++bj) { const f32x4 v0 = acc[ai][bj][m][0], v1 = acc[ai][bj][m][1];
                    u32x4 w; w.x = cvt_pk_bf16(v0[0], v0[1]); w.y = cvt_pk_bf16(v0[2], v0[3]); w.z = cvt_pk_bf16(v1[0], v1[1]); w.w = cvt_pk_bf16(v1[2], v1[3]);
                    *(u32x4*)(rowp + bj * 128) = w; }
            }
    }
};
template <int CTRL> __device__ __forceinline__ float dpp_old(float old, float src) { return __int_as_float(__builtin_amdgcn_update_dpp(__float_as_int(old), __float_as_int(src), CTRL, 0xF, 0xF, false)); }
struct EpiConv {
    bf16_t* HID; float* out; const float* cw; const float* cb; const float* sc; LAS float* exch;
    __device__ __forceinline__ void operator()(const f32x4 (&acc)[2][2][4][2], const pg8::Unit& u, int wr, int wc, int fr, int fq) const {
        const int cw8 = wc * 32 + fq * 8, ch0 = u.pn * 128 + cw8;
        if (fr >= 14) {
#pragma unroll
            for (int ai = 0; ai < 2; ++ai)
#pragma unroll
                for (int n = 0; n < 2; ++n) *(LAS f32x4*)(exch + ((ai * 2 + wr) * 2 + (fr - 14)) * 128 + cw8 + 4 * n) = acc[ai][0][3][n];
        }
        asm volatile("s_waitcnt lgkmcnt(0)\n\ts_barrier" ::: "memory");
        int row0, b0 = 0, i0 = 0; const bool samp = u.pm >= 132;
        if (!samp) { b0 = u.pm / 33; i0 = u.pm - 33 * b0; row0 = b0 * T + 254 * i0 - 2; } else row0 = MP + (u.pm - 132) * 256;
        f32x4 w0[2], w1[2], w2[2], bb[2];
#pragma unroll
        for (int n = 0; n < 2; ++n) { w0[n] = *(const f32x4*)(cw + ch0 + 4 * n); w1[n] = *(const f32x4*)(cw + DFF + ch0 + 4 * n); w2[n] = *(const f32x4*)(cw + 2 * DFF + ch0 + 4 * n); bb[n] = *(const f32x4*)(cb + ch0 + 4 * n); }
#pragma unroll
        for (int ai = 0; ai < 2; ++ai) {
            const int strip = ai * 2 + wr;
            f32x4 h1[2], h2[2];
#pragma unroll
            for (int n = 0; n < 2; ++n) {
                if (strip > 0) { h1[n] = *(const LAS f32x4*)(exch + ((strip - 1) * 2 + 1) * 128 + cw8 + 4 * n); h2[n] = *(const LAS f32x4*)(exch + ((strip - 1) * 2) * 128 + cw8 + 4 * n); }
                else { h1[n] = (f32x4){0.f, 0.f, 0.f, 0.f}; h2[n] = (f32x4){0.f, 0.f, 0.f, 0.f}; }
            }
#pragma unroll
            for (int m = 0; m < 4; ++m) {
                const int lr = ai * 128 + wr * 64 + m * 16 + fr;
                int t, b; bool valid;
                if (!samp) { t = 254 * i0 + lr - 2; b = b0; valid = lr >= 2 && t < T; } else { const int rs = row0 - MP + lr; b = rs >> 3; t = rs & 7; valid = true; }
                const size_t R = (size_t)((long)row0 + lr);
                f32x4 hd[2];
#pragma unroll
                for (int n = 0; n < 2; ++n) {
                    const f32x4 z = acc[ai][0][m][n], uu = acc[ai][1][m][n];
                    f32x4 o1, o2, zm1, zm2;
                    if (m == 0) { o1 = h1[n]; o2 = (fr == 0) ? h2[n] : h1[n]; }
                    else {
#pragma unroll
                        for (int e = 0; e < 4; ++e) { o1[e] = dppf<0x121>(acc[ai][0][m > 0 ? m - 1 : 0][n][e]); o2[e] = dppf<0x122>(acc[ai][0][m > 0 ? m - 1 : 0][n][e]); }
                    }
#pragma unroll
                    for (int e = 0; e < 4; ++e) { zm1[e] = dpp_old<0x111>(o1[e], z[e]); zm2[e] = dpp_old<0x112>(o2[e], z[e]); }
                    if (t == 0) {
                        if (samp) { zm1 = *(const f32x4*)(sc + ((size_t)b * 2 + 1) * DFF + ch0 + 4 * n); zm2 = *(const f32x4*)(sc + ((size_t)b * 2) * DFF + ch0 + 4 * n); }
                        else { zm1 = (f32x4){0.f, 0.f, 0.f, 0.f}; zm2 = (f32x4){0.f, 0.f, 0.f, 0.f}; }
                    } else if (t == 1) {
                        if (samp) zm2 = *(const f32x4*)(sc + ((size_t)b * 2 + 1) * DFF + ch0 + 4 * n); else zm2 = (f32x4){0.f, 0.f, 0.f, 0.f};
                    }
                    const f32x4 zc = bb[n] + w0[n] * zm2 + w1[n] * zm1 + w2[n] * z;
#pragma unroll
                    for (int e = 0; e < 4; ++e) hd[n][e] = zc[e] * sigmoidf_(zc[e]) * uu[e];
                }
                if (valid) {
                    u32x4 w; w.x = cvt_pk_bf16(hd[0][0], hd[0][1]); w.y = cvt_pk_bf16(hd[0][2], hd[0][3]); w.z = cvt_pk_bf16(hd[1][0], hd[1][1]); w.w = cvt_pk_bf16(hd[1][2], hd[1][3]);
                    *(u32x4*)(HID + R * DFF + ch0) = w;
                    if (!samp) { if (t >= T - 2) { float* o = out + O_CVP + (size_t)(b * 2 + (t - (T - 2))) * DFF + ch0; *(f32x4*)o = acc[ai][0][m][0]; *(f32x4*)(o + 4) = acc[ai][0][m][1]; } }
                    else if (t >= DT - 2) { float* o = out + O_CVS + (size_t)(b * 2 + (t - (DT - 2))) * DFF + ch0; *(f32x4*)o = acc[ai][0][m][0]; *(f32x4*)(o + 4) = acc[ai][0][m][1]; }
                }
            }
        }
    }
};

#define XB_TMO      128
#define XB_XCNT(j)  (256  + 64 * (j))
#define XB_XSUB(j)  (1280 + 64 * (j))
#define XB_XGEN(j)  (2304 + 64 * (j))
#define XB_TOP      3328
#define XB_TOPGEN   3392
#define XCD_BAR_WORDS 3456
#define XB_SPIN_CAP (1u << 20)
__device__ __forceinline__ unsigned xb_ld(unsigned* p)              { return __hip_atomic_load(p, __ATOMIC_RELAXED, __HIP_MEMORY_SCOPE_AGENT); }
__device__ __forceinline__ unsigned xb_add(unsigned* p, unsigned v) { return __hip_atomic_fetch_add(p, v, __ATOMIC_RELAXED, __HIP_MEMORY_SCOPE_AGENT); }
__device__ __forceinline__ unsigned xb_xcc_id() { return (unsigned)__builtin_amdgcn_s_getreg((3 << 11) | 20) & 0xFu; }
#define XB_SPIN(cond, bar) do { unsigned _sp = 0; while (cond) { __builtin_amdgcn_s_sleep(1); \
    if ((++_sp & 255u) == 0u) { if (xb_ld(&(bar)[XB_TMO])) break; if (_sp > XB_SPIN_CAP) { atomicAdd(&(bar)[XB_TMO], 1u); break; } } } } while (0)
struct XcdBarrier { unsigned* bar; unsigned x; volatile LAS unsigned* st; };
__device__ __forceinline__ XcdBarrier xcd_barrier_post(unsigned* bar, volatile LAS unsigned* st) {
    XcdBarrier b; b.bar = bar; b.x = xb_xcc_id(); b.st = st;
    if (threadIdx.x == 0) (void)xb_add(&bar[XB_XCNT(b.x)], 1u);
    return b;
}
__device__ __forceinline__ void xcd_barrier_complete(unsigned* bar, unsigned x, unsigned& nloc, unsigned& nx) {
    const unsigned G = gridDim.x * gridDim.y * gridDim.z;
    unsigned sum, cnt, mine, sp = 0u;
    for (;;) {
        sum = 0u; cnt = 0u; mine = 0u;
#pragma unroll
        for (unsigned j = 0; j < 16; ++j) { const unsigned c = xb_ld(&bar[XB_XCNT(j)]); sum += c; cnt += (c > 0u) ? 1u : 0u; mine = (j == x) ? c : mine; }
        if (sum == G) break;
        __builtin_amdgcn_s_sleep(1);
        if ((++sp & 255u) == 0u) { if (xb_ld(&bar[XB_TMO])) break; if (sp > XB_SPIN_CAP) { atomicAdd(&bar[XB_TMO], 1u); break; } }
    }
    nloc = mine > 0u ? mine : 1u; nx = cnt > 0u ? cnt : 1u;
}
__device__ __forceinline__ void xcd_barrier(const XcdBarrier& b) {
    asm volatile("s_waitcnt vmcnt(0)" ::: "memory");
    __syncthreads();
    if (threadIdx.x == 0) {
        unsigned* bar = b.bar;
        __builtin_amdgcn_s_waitcnt(0);
        unsigned nloc = b.st[0], nx = b.st[1];
        if (nloc == 0u) { xcd_barrier_complete(bar, b.x, nloc, nx); b.st[0] = nloc; b.st[1] = nx; }
        const unsigned old = xb_add(&bar[XB_XSUB(b.x)], 1u);
        const unsigned gen = old / nloc;
        if (old + 1u == (gen + 1u) * nloc) {
            __builtin_amdgcn_fence(__ATOMIC_RELEASE, "agent");
            asm volatile("s_waitcnt vmcnt(0)" ::: "memory");
            const unsigned og = xb_add(&bar[XB_TOP], 1u);
            const unsigned tg = og / nx;
            if (og + 1u == (tg + 1u) * nx) xb_add(&bar[XB_TOPGEN], 1u);
            else XB_SPIN(xb_ld(&bar[XB_TOPGEN]) == tg, bar);
            __builtin_amdgcn_fence(__ATOMIC_ACQUIRE, "agent");
            xb_add(&bar[XB_XGEN(b.x)], 1u);
            asm volatile("s_waitcnt vmcnt(0)" ::: "memory");
        } else {
            XB_SPIN(xb_ld(&bar[XB_XGEN(b.x)]) == gen, bar);
            __builtin_amdgcn_fence(__ATOMIC_ACQUIRE, "agent");
            asm volatile("s_waitcnt vmcnt(0)" ::: "memory");
        }
    }
    __syncthreads();
}

constexpr int NWAVES = 8, NT = 512;
constexpr int LDS_BYTES = 163840;
constexpr int YP_OFF = 129536;
struct Args { const float* in[29]; float* out; unsigned char* ws; int ph_lo, ph_hi; };
struct Frame {
    LAS unsigned char* lds; unsigned char* ws; float* out; const float* const* in;
    int tid, lane, wave, G, bid;
};
__device__ __forceinline__ const float* xrow_ptr(const Frame& F, int m) { return m < MP ? F.in[0] + (size_t)m * DM : F.in[1] + (size_t)(m - MP) * DM; }

template <class MAP>
__device__ __forceinline__ void p0_transpose_item(const float* W, int K, int N, int Nout, bf16_t* WT, LAS float* scr, int item, int lane, MAP map) {
    const int nblk = Nout / 32, kb = item / nblk, nb = item % nblk, k0 = 64 * kb, n0 = 32 * nb;
    const int src = map(n0 + (lane & 31));
    float tv[32];
#pragma unroll
    for (int i = 0; i < 32; ++i) { const int kk = 2 * i + (lane >> 5); tv[i] = src >= 0 ? W[(size_t)(k0 + kk) * N + src] : 0.f; }
#pragma unroll
    for (int i = 0; i < 32; ++i) { const int kk = 2 * i + (lane >> 5); scr[kk * 33 + (lane & 31)] = tv[i]; }
    asm volatile("s_waitcnt lgkmcnt(0)" ::: "memory");
    const int c = lane & 7;
#pragma unroll
    for (int j = 0; j < 4; ++j) { const int n = (lane >> 3) + 8 * j; const LAS float* s = scr + (8 * c) * 33 + n;
        u32x4 o; o.x = pk2(s[0 * 33], s[1 * 33]); o.y = pk2(s[2 * 33], s[3 * 33]); o.z = pk2(s[4 * 33], s[5 * 33]); o.w = pk2(s[6 * 33], s[7 * 33]);
        *(u32x4*)(WT + (size_t)(n0 + n) * K + k0 + 8 * c) = o; }
    asm volatile("s_waitcnt lgkmcnt(0)" ::: "memory");
}
struct MapIn { __device__ int operator()(int n) const { if (n < 640) { const int w = n & 63; return (n & ~63) + (w >> 3) * 4 + (w & 3) + 32 * ((w >> 2) & 1); } return n < 2464 ? n : -1; } };
struct MapId { __device__ int operator()(int n) const { return n; } };
struct MapFfn { __device__ int operator()(int n) const { const int tile = n >> 8, sub = n & 255, ch = tile * 128 + (sub & 127); return sub < 128 ? ch : DFF + ch; } };

__device__ __forceinline__ void p0_prologue(Frame& F) {
    LAS float* scr = (LAS float*)(F.lds + F.wave * 16384);
    const int gw = F.bid * NWAVES + F.wave, NGW = F.G * NWAVES;
    constexpr int I_IN = 16 * (DINP / 32), I_OUT = 16 * 32, I_FI = 16 * (2 * DFF / 32), I_FO = (DFF / 64) * 32;
    constexpr int NITEMS = I_IN + I_OUT + I_FI + I_FO;
#ifndef TR_DUP
#define TR_DUP 1
#endif
    for (int it_ = gw; it_ < NITEMS * TR_DUP; it_ += NGW) {
        const int it = it_ % NITEMS;
        int r = it;
        if (r < I_IN) { p0_transpose_item(F.in[8], DM, 2464, DINP, (bf16_t*)(F.ws + WS_WIN), scr, r, F.lane, MapIn()); continue; } r -= I_IN;
        if (r < I_OUT) { p0_transpose_item(F.in[21], DM, DM, DM, (bf16_t*)(F.ws + WS_WOUT), scr, r, F.lane, MapId()); continue; } r -= I_OUT;
        if (r < I_FI) { p0_transpose_item(F.in[24], DM, 2 * DFF, 2 * DFF, (bf16_t*)(F.ws + WS_WFI), scr, r, F.lane, MapFfn()); continue; } r -= I_FI;
        p0_transpose_item(F.in[27], DFF, DM, DM, (bf16_t*)(F.ws + WS_WFO), scr, r, F.lane, MapId());
    }
    float* rope = (float*)(F.ws + WS_ROPE);
    for (int e = F.bid * NT + F.tid; e < (T + DT) * 32; e += F.G * NT) {
        const int pidx = e >> 5, i = e & 31; const int pos = pidx < T ? pidx : 16384 + (pidx - T);
        const float inv = (float)exp2(-(double)i * (13.287712379549449 / 32.0));
        const float angf = (float)pos * inv;
        const double a = (double)angf;
        const double TWO_PI = 6.283185307179586476925286766559;
        const double n = rint(a / TWO_PI);
        const double r = a - n * TWO_PI;
        const double r2 = r * r;
        double c = 1.0, s = 1.0, tc = 1.0, ts = 1.0;
#pragma unroll
        for (int k = 1; k <= 14; ++k) { tc = -tc * r2 * (1.0 / (double)((2 * k - 1) * (2 * k))); ts = -ts * r2 * (1.0 / (double)((2 * k) * (2 * k + 1))); c += tc; s += ts; }
        s *= r;
        rope[(size_t)e * 2] = (float)c; rope[(size_t)e * 2 + 1] = (float)s;
    }
    const float* g = F.in[7];
    bf16_t* XN = (bf16_t*)(F.ws + WS_XN);
    f32x4 gq[4];
#pragma unroll
    for (int j = 0; j < 4; ++j) gq[j] = ((const f32x4*)g)[64 * j + F.lane];
    for (int m = gw; m < M; m += 2 * NGW) {
        const int m1 = m + NGW; const bool has1 = m1 < M;
        const f32x4* xr0 = (const f32x4*)xrow_ptr(F, m) + F.lane; const f32x4* xr1 = (const f32x4*)xrow_ptr(F, has1 ? m1 : m) + F.lane;
        f32x4 v0[4], v1[4];
#pragma unroll
        for (int j = 0; j < 4; ++j) v0[j] = __builtin_nontemporal_load(xr0 + 64 * j);
#pragma unroll
        for (int j = 0; j < 4; ++j) v1[j] = __builtin_nontemporal_load(xr1 + 64 * j);
        float s0 = 0.f, s1 = 0.f;
#pragma unroll
        for (int j = 0; j < 4; ++j) { s0 += (v0[j].x * v0[j].x + v0[j].y * v0[j].y) + (v0[j].z * v0[j].z + v0[j].w * v0[j].w); s1 += (v1[j].x * v1[j].x + v1[j].y * v1[j].y) + (v1[j].z * v1[j].z + v1[j].w * v1[j].w); }
        const float r0 = 1.0f / sqrtf(wave_sum(s0) * (1.f / DM) + RMS_EPS), r1 = 1.0f / sqrtf(wave_sum(s1) * (1.f / DM) + RMS_EPS);
        u32x2* o0 = (u32x2*)(XN + (size_t)m * DM) + F.lane; u32x2* o1 = (u32x2*)(XN + (size_t)m1 * DM) + F.lane;
#pragma unroll
        for (int j = 0; j < 4; ++j) { const f32x4 gg = gq[j];
            u32x2 w; w.x = pk2(v0[j].x * r0 * gg.x, v0[j].y * r0 * gg.y); w.y = pk2(v0[j].z * r0 * gg.z, v0[j].w * r0 * gg.w); o0[64 * j] = w;
            if (has1) { u32x2 q; q.x = pk2(v1[j].x * r1 * gg.x, v1[j].y * r1 * gg.y); q.y = pk2(v1[j].z * r1 * gg.z, v1[j].w * r1 * gg.w); o1[64 * j] = q; } }
    }
}

__device__ __forceinline__ float hprev_val(const Frame& F, const bf16_t* HRW, int m, int col) {
    const RowInfo ri = row_info(m);
    if (ri.t == 0) return ri.samp ? F.in[4][(size_t)ri.b * DSH + col] : 0.f;
    return bf2f(HRW[(size_t)(m - 1) * DSH + col]);
}
__device__ __forceinline__ f32x4 ld_bf4(const bf16_t* p) { const u32x2 w = *(const u32x2*)p; return (f32x4){bflo(w.x), bfhi(w.x), bflo(w.y), bfhi(w.y)}; }
__device__ __forceinline__ f32x4 hs4(const Frame& F, const bf16_t* HRW, int m, const RowInfo& ri, int col) {
    const f32x4 h = ld_bf4(HRW + (size_t)m * DSH + col);
    f32x4 hp;
    if (ri.t == 0) hp = ri.samp ? *(const f32x4*)(F.in[4] + (size_t)ri.b * DSH + col) : (f32x4){0.f, 0.f, 0.f, 0.f};
    else hp = ld_bf4(HRW + (size_t)(m - 1) * DSH + col);
    const f32x4 mu = *(const f32x4*)(F.in[10] + col);
    return h + (hp - h) * mu;
}
struct F8 { f32x4 a, b; };
__device__ __forceinline__ F8 ld_bf8(const bf16_t* p) { const u32x4 w = *(const u32x4*)p; F8 r; r.a = (f32x4){bflo(w.x), bfhi(w.x), bflo(w.y), bfhi(w.y)}; r.b = (f32x4){bflo(w.z), bfhi(w.z), bflo(w.w), bfhi(w.w)}; return r; }
__device__ __forceinline__ u32x4 pk8(const f32x4 a, const f32x4 b) { u32x4 w; w.x = cvt_pk_bf16(a[0], a[1]); w.y = cvt_pk_bf16(a[2], a[3]); w.z = cvt_pk_bf16(b[0], b[1]); w.w = cvt_pk_bf16(b[2], b[3]); return w; }
__device__ __forceinline__ F8 hs8m(const Frame& F, const bf16_t* HRW, int m, const RowInfo& ri, int col, const f32x4 mua, const f32x4 mub) {
    const F8 h = ld_bf8(HRW + (size_t)m * DSH + col);
    F8 hp;
    if (ri.t == 0) {
        if (ri.samp) { hp.a = *(const f32x4*)(F.in[4] + (size_t)ri.b * DSH + col); hp.b = *(const f32x4*)(F.in[4] + (size_t)ri.b * DSH + col + 4); }
        else { hp.a = (f32x4){0.f, 0.f, 0.f, 0.f}; hp.b = (f32x4){0.f, 0.f, 0.f, 0.f}; }
    } else hp = ld_bf8(HRW + (size_t)(m - 1) * DSH + col);
    F8 r; r.a = h.a + (hp.a - h.a) * mua; r.b = h.b + (hp.b - h.b) * mub; return r;
}
__device__ __forceinline__ F8 hs8(const Frame& F, const bf16_t* HRW, int m, const RowInfo& ri, int col) {
    const F8 h = ld_bf8(HRW + (size_t)m * DSH + col);
    F8 hp;
    if (ri.t == 0) {
        if (ri.samp) { hp.a = *(const f32x4*)(F.in[4] + (size_t)ri.b * DSH + col); hp.b = *(const f32x4*)(F.in[4] + (size_t)ri.b * DSH + col + 4); }
        else { hp.a = (f32x4){0.f, 0.f, 0.f, 0.f}; hp.b = (f32x4){0.f, 0.f, 0.f, 0.f}; }
    } else hp = ld_bf8(HRW + (size_t)(m - 1) * DSH + col);
    const f32x4 mua = *(const f32x4*)(F.in[10] + col), mub = *(const f32x4*)(F.in[10] + col + 4);
    F8 r; r.a = h.a + (hp.a - h.a) * mua; r.b = h.b + (hp.b - h.b) * mub; return r;
}
__device__ __forceinline__ float xsum_fq(float v) {
    { auto r = __builtin_amdgcn_permlane16_swap(__float_as_uint(v), __float_as_uint(v), false, false); v = __uint_as_float(r[0]) + __uint_as_float(r[1]); }
    { auto r = __builtin_amdgcn_permlane32_swap(__float_as_uint(v), __float_as_uint(v), false, false); v = __uint_as_float(r[0]) + __uint_as_float(r[1]); }
    return v;
}
__device__ __forceinline__ u32x2 pk4(const f32x4 v) { u32x2 w; w.x = cvt_pk_bf16(v[0], v[1]); w.y = cvt_pk_bf16(v[2], v[3]); return w; }
__device__ __forceinline__ bf16x8 wfrag(const float* W, int k0, int fq, int ch) {
    u32x4 w; const float* p = W + (size_t)(k0 + 8 * fq) * 512 + ch;
    w.x = cvt_pk_bf16(p[0], p[512]); w.y = cvt_pk_bf16(p[1024], p[1536]); w.z = cvt_pk_bf16(p[2048], p[2560]); w.w = cvt_pk_bf16(p[3072], p[3584]);
    return __builtin_bit_cast(bf16x8, w);
}
__device__ __forceinline__ int frag_idx(int mat, int h, int nt, int s3) { return ((mat * 8 + h) * 4 + nt) * 3 + s3; }
__device__ __forceinline__ void p0_frag_table(Frame& F) {
    const int gw = F.bid * NWAVES + F.wave, NGW = F.G * NWAVES;
    const int fr = F.lane & 15, fq = F.lane >> 4;
    u32x4* tab = (u32x4*)(F.ws + WS_FRAG);
    for (int t = gw; t < 3 * 8 * 4 * 3; t += NGW) {
        const int mat = t / 96, rem = t - mat * 96, h = rem / 12, nt = (rem - h * 12) / 3, s3 = rem % 3;
        if (mat < 2 && s3 > 0) continue;
        const float* W = mat == 0 ? F.in[12] : mat == 1 ? F.in[14] : F.in[15];
        const bf16x8 f = wfrag(W, 32 * s3, fq, h * 64 + 16 * (fr >> 2) + 4 * nt + (fr & 3));
        tab[(size_t)t * 64 + F.lane] = __builtin_bit_cast(u32x4, f);
    }
}
__device__ __forceinline__ bf16x8 ld_frag(const Frame& F, int mat, int h, int nt, int s3) { return __builtin_bit_cast(bf16x8, ((const u32x4*)(F.ws + WS_FRAG))[(size_t)frag_idx(mat, h, nt, s3) * 64 + F.lane]); }
#ifndef PREP_DUP
#define PREP_DUP 1
#endif
#ifndef POST_DUP
#define POST_DUP 1
#endif
__device__ __forceinline__ void prep_phase(Frame& F) {
    const bf16_t* HRW = (const bf16_t*)(F.ws + WS_HRW);
    bf16_t* SR = (bf16_t*)(F.ws + WS_SR); bf16_t* SK = (bf16_t*)(F.ws + WS_SK); bf16_t* SV = (bf16_t*)(F.ws + WS_SV);
    bf16_t* SKK = (bf16_t*)(F.ws + WS_SKK); bf16_t* SB = (bf16_t*)(F.ws + WS_SB); float* SW = (float*)(F.ws + WS_SW);
    const int fr = F.lane & 15, fq = F.lane >> 4, h = F.wave;
    bf16x8 Aw[4], Aa[4];
#pragma unroll
    for (int nt = 0; nt < 4; ++nt) { Aw[nt] = ld_frag(F, 0, h, nt, 0); Aa[nt] = ld_frag(F, 1, h, nt, 0); }
    constexpr int NTILE = M / 16;
    f32x4 pw0[4], pa0[4], pkk[4], pka[4];
    f32x4 pmu[3][4];
#pragma unroll
    for (int st = 0; st < 3; ++st)
#pragma unroll
        for (int i = 0; i < 4; ++i) pmu[st][i] = *(const f32x4*)(F.in[10] + st * 512 + h * 64 + 16 * fq + 4 * i);
#pragma unroll
    for (int i = 0; i < 4; ++i) { const int c4 = h * 64 + 16 * fq + 4 * i; pw0[i] = *(const f32x4*)(F.in[11] + c4); pa0[i] = *(const f32x4*)(F.in[13] + c4); pkk[i] = *(const f32x4*)(F.in[16] + c4); pka[i] = *(const f32x4*)(F.in[17] + c4); }
    for (int tile_ = F.bid; tile_ < NTILE * PREP_DUP; tile_ += F.G) {
        const int m = (tile_ % NTILE) * 16 + fr;
        const RowInfo ri = row_info(m);
        bf16x8 xw, xa;
        { const F8 a = hs8(F, HRW, m, ri, 1536 + 8 * fq);
          f32x4 t0, t1;
#pragma unroll
          for (int i = 0; i < 4; ++i) { t0[i] = 1.f - 2.f * __builtin_amdgcn_rcpf(__expf(2.f * a.a[i]) + 1.f); t1[i] = 1.f - 2.f * __builtin_amdgcn_rcpf(__expf(2.f * a.b[i]) + 1.f); }
          xw = __builtin_bit_cast(bf16x8, pk8(t0, t1)); }
        { const F8 a = hs8(F, HRW, m, ri, 1568 + 8 * fq); xa = __builtin_bit_cast(bf16x8, pk8(a.a, a.b)); }
        f32x4 kkr[4], av[4]; float ss = 0.f;
#pragma unroll
        for (int np = 0; np < 2; ++np) {
            const int c8 = h * 64 + 16 * fq + 8 * np;
            const f32x4 z = {0.f, 0.f, 0.f, 0.f};
            f32x4 accw[2], acca[2];
#pragma unroll
            for (int q = 0; q < 2; ++q) { accw[q] = __builtin_amdgcn_mfma_f32_16x16x32_bf16(Aw[2 * np + q], xw, z, 0, 0, 0); acca[q] = __builtin_amdgcn_mfma_f32_16x16x32_bf16(Aa[2 * np + q], xa, z, 0, 0, 0); }
            const F8 r8 = hs8m(F, HRW, m, ri, c8, pmu[0][2 * np], pmu[0][2 * np + 1]), k8 = hs8m(F, HRW, m, ri, 512 + c8, pmu[1][2 * np], pmu[1][2 * np + 1]), v8 = hs8m(F, HRW, m, ri, 1024 + c8, pmu[2][2 * np], pmu[2][2 * np + 1]);
            f32x4 dec[2], k2[2];
#pragma unroll
            for (int q = 0; q < 2; ++q) {
                const f32x4 k = q ? k8.b : k8.a;
                const f32x4 w0 = pw0[2 * np + q], a0 = pa0[2 * np + q], kkc = pkk[2 * np + q], kac = pka[2 * np + q];
                f32x4 a;
#pragma unroll
                for (int j = 0; j < 4; ++j) {
                    const float x = -(w0[j] + accw[q][j]);
                    const float sp = fmaxf(x, 0.f) + __logf(1.f + __expf(-fabsf(x)));
                    dec[q][j] = __expf(-__expf(-sp - 0.5f));
                    a[j] = sigmoidf_(a0[j] + acca[q][j]);
                    k2[q][j] = k[j] * (1.f + (a[j] - 1.f) * kac[j]);
                }
                const f32x4 kk = k * kkc;
                ss += (kk[0] * kk[0] + kk[1] * kk[1]) + (kk[2] * kk[2] + kk[3] * kk[3]);
                kkr[2 * np + q] = kk; av[2 * np + q] = a;
            }
            const size_t o = (size_t)m * 512 + c8;
            *(f32x4*)(SW + o) = dec[0]; *(f32x4*)(SW + o + 4) = dec[1];
            *(u32x4*)(SR + o) = pk8(r8.a, r8.b); *(u32x4*)(SK + o) = pk8(k2[0], k2[1]); *(u32x4*)(SV + o) = pk8(v8.a, v8.b);
        }
        ss = xsum_fq(ss);
        const float rs = rsqrtf(fmaxf(ss, 1e-24f));
#pragma unroll
        for (int np = 0; np < 2; ++np) {
            const size_t o = (size_t)m * 512 + h * 64 + 16 * fq + 8 * np;
            const f32x4 ka = kkr[2 * np] * rs, kb = kkr[2 * np + 1] * rs;
            *(u32x4*)(SKK + o) = pk8(ka, kb); *(u32x4*)(SB + o) = pk8(ka * av[2 * np], kb * av[2 * np + 1]);
        }
    }
}

__device__ __forceinline__ void sample_attn_phase(Frame& F) {
    constexpr int NK = WIN + DT, KS = 68;
    LAS float* Kl = (LAS float*)F.lds;
    LAS float* Vl = Kl + NK * KS;
    LAS float* Pl = Vl + NK * KS;
    const bf16_t* Q = (const bf16_t*)(F.ws + WS_Q);
    bf16_t* OC = (bf16_t*)(F.ws + WS_OCAT);
    for (int unit = F.bid; unit < DB * 2; unit += F.G) {
        const int b = unit >> 1, kvh = unit & 1;
        for (int e = F.tid; e < NK * 16; e += NT) {
            const int key = e >> 4, d4 = (e & 15) * 4;
            f32x4 kv, vv;
            if (key < WIN) { kv = *(const f32x4*)(F.in[2] + ((size_t)(b * WIN + key) * 2 + kvh) * 64 + d4); vv = *(const f32x4*)(F.in[3] + ((size_t)(b * WIN + key) * 2 + kvh) * 64 + d4); }
            else { kv = *(const f32x4*)(F.out + O_KWS + ((size_t)(b * WIN + key - DT) * 2 + kvh) * 64 + d4); vv = *(const f32x4*)(F.out + O_VWS + ((size_t)(b * WIN + key - DT) * 2 + kvh) * 64 + d4); }
            *(LAS f32x4*)(Kl + key * KS + d4) = kv; *(LAS f32x4*)(Vl + key * KS + d4) = vv;
            if (key >= DT && key < WIN) { *(f32x4*)(F.out + O_KWS + ((size_t)(b * WIN + key - DT) * 2 + kvh) * 64 + d4) = kv; *(f32x4*)(F.out + O_VWS + ((size_t)(b * WIN + key - DT) * 2 + kvh) * 64 + d4) = vv; }
        }
        __syncthreads();
        const int qi = F.tid >> 4, sub = F.tid & 15;
        const int t = qi >> 2, g = qi & 3, head = kvh * 4 + g;
        const int m = MP + b * DT + t;
        float mx = F.in[9][head] * 1.4426950408889634f;
        {
            const bf16_t* qp = Q + (size_t)m * 512 + head * 64;
            float q[64];
#pragma unroll
            for (int i = 0; i < 8; ++i) { const u32x4 w = *(const u32x4*)(qp + 8 * i); q[8 * i] = bflo(w.x); q[8 * i + 1] = bfhi(w.x); q[8 * i + 2] = bflo(w.y); q[8 * i + 3] = bfhi(w.y); q[8 * i + 4] = bflo(w.z); q[8 * i + 5] = bfhi(w.z); q[8 * i + 6] = bflo(w.w); q[8 * i + 7] = bfhi(w.w); }
#pragma unroll 1
            for (int key = sub; key < NK; key += 16) {
                float a = 0.f; const LAS f32x4* kr = (const LAS f32x4*)(Kl + key * KS);
#pragma unroll
                for (int i = 0; i < 16; ++i) { const f32x4 kx = kr[i]; a += q[4 * i] * kx[0] + q[4 * i + 1] * kx[1] + q[4 * i + 2] * kx[2] + q[4 * i + 3] * kx[3]; }
                const int dist = t + WIN - key;
                const float s = (dist >= 0 && dist <= WIN) ? a : -1e30f;
                Pl[qi * NK + key] = s; mx = fmaxf(mx, s);
            }
        }
        mx = fmaxf(mx, __shfl_xor(mx, 1)); mx = fmaxf(mx, __shfl_xor(mx, 2)); mx = fmaxf(mx, __shfl_xor(mx, 4)); mx = fmaxf(mx, __shfl_xor(mx, 8));
        float sum = 0.f;
#pragma unroll 1
        for (int key = sub; key < NK; key += 16) { const float sv = Pl[qi * NK + key]; const float p = sv > -1e29f ? __builtin_amdgcn_exp2f(sv - mx) : 0.f; sum += p; Pl[qi * NK + key] = p; }
        sum += __shfl_xor(sum, 1); sum += __shfl_xor(sum, 2); sum += __shfl_xor(sum, 4); sum += __shfl_xor(sum, 8);
        const float inv = __builtin_amdgcn_rcpf(sum + __builtin_amdgcn_exp2f(F.in[9][head] * 1.4426950408889634f - mx));
        __syncthreads();
        f32x4 o = {0.f, 0.f, 0.f, 0.f};
        for (int key = 0; key < NK; ++key) { const float p = Pl[qi * NK + key]; const f32x4 vv = *(const LAS f32x4*)(Vl + key * KS + sub * 4); o += vv * p; }
        o = o * inv;
        u32x2 w; w.x = pk2(o[0], o[1]); w.y = pk2(o[2], o[3]);
        *(u32x2*)(OC + (size_t)m * DM + head * 64 + sub * 4) = w;
        __syncthreads();
    }
}

template <int MODE>
__device__ __forceinline__ void prompt_attn_unit(Frame& F, int unit, int ldsoff) {
    constexpr int KST = 144, VST = 528;
    LAS unsigned char* Kl = F.lds + ldsoff; LAS unsigned char* Vl = Kl + 256 * KST;
    const bf16_t* Q = (const bf16_t*)(F.ws + WS_Q); const bf16_t* Kb = (const bf16_t*)(F.ws + WS_K); const bf16_t* VT = (const bf16_t*)(F.ws + WS_VT);
    bf16_t* OC = (bf16_t*)(F.ws + WS_OCAT);
    const int kvh = unit & 1, qb = (unit >> 1) & 63, b = unit >> 7;
    const int key0 = (qb - 1) * 128;
    if (MODE != 2) {
    for (int e = F.tid; e < 256 * 8; e += NT) {
        const int key = e >> 3, ch = e & 7; const int pos = key0 + key;
        u32x4 v = {0u, 0u, 0u, 0u};
        if (pos >= 0) v = *(const u32x4*)(Kb + (size_t)(b * T + pos) * 128 + kvh * 64 + ch * 8);
        *(LAS u32x4*)(Kl + key * KST + ch * 16) = v;
    }
    for (int e = F.tid; e < 64 * 32; e += NT) {
        const int d = e >> 5, ch = e & 31; const int pos = key0 + ch * 8;
        u32x4 v = {0u, 0u, 0u, 0u};
        if (pos >= 0) v = *(const u32x4*)(VT + ((size_t)(b * 2 + kvh) * 64 + d) * T + pos);
        *(LAS u32x4*)(Vl + d * VST + ch * 16) = v;
    }
    }
    if (MODE == 1) return;
    if (MODE == 0) __syncthreads();
    const int fr = F.lane & 15, fq = F.lane >> 4;
    const int head = kvh * 4 + (F.wave >> 1);
    const float sink = F.in[9][head] * 1.4426950408889634f;
#pragma unroll 1
    for (int sb = 0; sb < 4; ++sb) {
        const int qi0 = (F.wave & 1) * 64 + sb * 16;
        const int qi = qi0 + fr;
        const size_t mrow = (size_t)b * T + qb * 128 + qi;
        const bf16x8 q0 = *(const bf16x8*)(Q + mrow * 512 + head * 64 + fq * 8);
        const bf16x8 q1 = *(const bf16x8*)(Q + mrow * 512 + head * 64 + 32 + fq * 8);
        const int ktlo = (F.wave & 1) * 4 + sb;
        f32x4 s[9];
#pragma unroll
        for (int kr = 0; kr < 9; ++kr) {
            const int kt = ktlo + kr;
            const bf16x8 k0 = *(const LAS bf16x8*)(Kl + (kt * 16 + fr) * KST + fq * 16);
            const bf16x8 k1 = *(const LAS bf16x8*)(Kl + (kt * 16 + fr) * KST + 64 + fq * 16);
            f32x4 a = {0.f, 0.f, 0.f, 0.f};
            a = __builtin_amdgcn_mfma_f32_16x16x32_bf16(k0, q0, a, 0, 0, 0);
            a = __builtin_amdgcn_mfma_f32_16x16x32_bf16(k1, q1, a, 0, 0, 0);
            s[kr] = a;
        }
        float mx = sink;
#pragma unroll
        for (int kr = 0; kr < 9; ++kr)
#pragma unroll
            for (int j = 0; j < 4; ++j) { const int sj = (ktlo + kr) * 16 + fq * 4 + j; const int dist = qi + 128 - sj; const bool ok = dist >= 0 && dist <= WIN && (key0 + sj) >= 0; const float v = ok ? s[kr][j] : -1e30f; s[kr][j] = v; mx = fmaxf(mx, v); }
        mx = fmaxf(mx, __shfl_xor(mx, 16)); mx = fmaxf(mx, __shfl_xor(mx, 32));
        float sum = 0.f;
        u32x2 pw[10];
#pragma unroll
        for (int kr = 0; kr < 9; ++kr) {
            f32x4 p;
#pragma unroll
            for (int j = 0; j < 4; ++j) { p[j] = s[kr][j] > -1e29f ? __builtin_amdgcn_exp2f(s[kr][j] - mx) : 0.f; sum += p[j]; }
            pw[kr].x = cvt_pk_bf16(p[0], p[1]); pw[kr].y = cvt_pk_bf16(p[2], p[3]);
        }
        pw[9].x = 0u; pw[9].y = 0u;
        sum += __shfl_xor(sum, 16); sum += __shfl_xor(sum, 32);
        const float inv = __builtin_amdgcn_rcpf(sum + __builtin_amdgcn_exp2f(sink - mx));
        f32x4 o[4];
#pragma unroll
        for (int dt = 0; dt < 4; ++dt) o[dt] = (f32x4){0.f, 0.f, 0.f, 0.f};
#pragma unroll
        for (int u = 0; u < 5; ++u) {
            u32x4 pb; pb.x = pw[2 * u].x; pb.y = pw[2 * u].y; pb.z = pw[2 * u + 1].x; pb.w = pw[2 * u + 1].y;
            const bf16x8 pf = __builtin_bit_cast(bf16x8, pb);
            const int kta = ktlo + 2 * u, ktb = u < 4 ? kta + 1 : kta;
#pragma unroll
            for (int dt = 0; dt < 4; ++dt) {
                const LAS unsigned char* vr = Vl + (dt * 16 + fr) * VST + (fq * 4) * 2;
                const u32x2 va = *(const LAS u32x2*)(vr + kta * 32), vb = *(const LAS u32x2*)(vr + ktb * 32);
                u32x4 vv; vv.x = va.x; vv.y = va.y; vv.z = vb.x; vv.w = vb.y;
                o[dt] = __builtin_amdgcn_mfma_f32_16x16x32_bf16(__builtin_bit_cast(bf16x8, vv), pf, o[dt], 0, 0, 0);
            }
        }
#pragma unroll
        for (int dt = 0; dt < 4; ++dt) { const f32x4 v = o[dt] * inv; u32x2 w; w.x = cvt_pk_bf16(v[0], v[1]); w.y = cvt_pk_bf16(v[2], v[3]); *(u32x2*)(OC + mrow * DM + head * 64 + dt * 16 + fq * 4) = w; }
    }
    if (MODE == 0) __syncthreads();
}

struct StepOps { f32x4 w, nbe, kk, k, r; float v; };
template <int STRIDE_F> __device__ __forceinline__ StepOps load_ops(const LAS float* img, int s, int cgi, int vrow) {
    const LAS float* p = img + s * STRIDE_F + cgi * 4; StepOps o;
    o.w = *(const LAS f32x4*)(p); o.nbe = *(const LAS f32x4*)(p + 64); o.kk = *(const LAS f32x4*)(p + 128); o.k = *(const LAS f32x4*)(p + 192); o.r = *(const LAS f32x4*)(p + 256);
    o.v = img[s * STRIDE_F + 320 + vrow]; return o;
}
template <int J> __device__ __forceinline__ float sel_lane16(float oldv, float newv) {
    float r; const unsigned long long m = 0x0001000100010001ull << J;
    asm("v_cndmask_b32_e64 %0, %1, %2, %3" : "=v"(r) : "v"(oldv), "v"(newv), "s"(m));
    return r;
}
struct ScanState { f32x2 s01, s23; float ykeep, ypart; StepOps c0, c1; };
template <int STRIDE_F, int J>
__device__ __forceinline__ void scan_step(const LAS float* img, int s0, int vrow, int cgi, ScanState& Z) {
    const StepOps nx = load_ops<STRIDE_F>(img, s0 + J + 2, cgi, vrow);
    const StepOps& c = Z.c0;
    const f32x2 kk01 = {c.kk[0], c.kk[1]}, kk23 = {c.kk[2], c.kk[3]}, w01 = {c.w[0], c.w[1]}, w23 = {c.w[2], c.w[3]}, k01 = {c.k[0], c.k[1]}, k23 = {c.k[2], c.k[3]};
    const f32x2 b01 = {c.nbe[0], c.nbe[1]}, b23 = {c.nbe[2], c.nbe[3]}, r01 = {c.r[0], c.r[1]}, r23 = {c.r[2], c.r[3]};
    f32x2 t = Z.s01 * kk01; t = Z.s23 * kk23 + t;
    float sa = t.x + t.y;
    const f32x2 u01 = Z.s01 * w01 + k01 * c.v, u23 = Z.s23 * w23 + k23 * c.v;
    if (J > 0) { allsum16_2(sa, Z.ypart); Z.ykeep = sel_lane16<(J > 0 ? J - 1 : 0)>(Z.ykeep, Z.ypart); } else sa = allsum16(sa);
    Z.s01 = b01 * sa + u01; Z.s23 = b23 * sa + u23;
    f32x2 y2 = Z.s01 * r01; y2 = Z.s23 * r23 + y2;
    Z.ypart = y2.x + y2.y;
    Z.c0 = Z.c1; Z.c1 = nx;
}
template <int STRIDE_F, int GS, int... Js>
__device__ __forceinline__ void scan_group_impl(const LAS float* img, int s0, int vrow, int cgi, ScanState& Z, float* yout, std::integer_sequence<int, Js...>) {
    (scan_step<STRIDE_F, Js>(img, s0, vrow, cgi, Z), ...);
    Z.ypart = allsum16(Z.ypart); Z.ykeep = sel_lane16<GS - 1>(Z.ykeep, Z.ypart);
    if (cgi < GS) yout[(size_t)(s0 + cgi) * 512] = Z.ykeep;
}
template <int STRIDE_F, int J>
__device__ __forceinline__ void scan_step_yp(const LAS float* img, int s0, int vrow, int cgi, ScanState& Z, LAS float* ypb) {
    const StepOps nx = load_ops<STRIDE_F>(img, s0 + J + 2, cgi, vrow);
    const StepOps& c = Z.c0;
    const f32x2 kk01 = {c.kk[0], c.kk[1]}, kk23 = {c.kk[2], c.kk[3]}, w01 = {c.w[0], c.w[1]}, w23 = {c.w[2], c.w[3]}, k01 = {c.k[0], c.k[1]}, k23 = {c.k[2], c.k[3]};
    const f32x2 b01 = {c.nbe[0], c.nbe[1]}, b23 = {c.nbe[2], c.nbe[3]}, r01 = {c.r[0], c.r[1]}, r23 = {c.r[2], c.r[3]};
    f32x2 t = Z.s01 * kk01; t = Z.s23 * kk23 + t;
    float sa = t.x + t.y;
    const f32x2 u01 = Z.s01 * w01 + k01 * c.v, u23 = Z.s23 * w23 + k23 * c.v;
    sa = allsum16(sa);
    Z.s01 = b01 * sa + u01; Z.s23 = b23 * sa + u23;
    f32x2 y2 = Z.s01 * r01; y2 = Z.s23 * r23 + y2;
    ypb[(s0 + J) * 64] = y2.x + y2.y;
    Z.c0 = Z.c1; Z.c1 = nx;
}
struct StepOpsS { f32x4 nbe, kk, k, r; };
template <int STRIDE_F> __device__ __forceinline__ StepOpsS load_ops_s(const LAS float* img, int s, int cgi) {
    const LAS float* p = img + s * STRIDE_F + cgi * 4; StepOpsS o;
    o.nbe = *(const LAS f32x4*)(p + 64); o.kk = *(const LAS f32x4*)(p + 128); o.k = *(const LAS f32x4*)(p + 192); o.r = *(const LAS f32x4*)(p + 256);
    return o;
}
struct ScanT { f32x2 t01, t23; StepOpsS c0, c1; f32x4 v4[4]; };
template <int STRIDE_F, int J>
__device__ __forceinline__ void scan_step_s(const LAS float* img, int cgi, ScanT& Z, LAS float* ypb) {
    const StepOpsS nx = load_ops_s<STRIDE_F>(img, J + 2, cgi);
    const StepOpsS& c = Z.c0;
    const float v = Z.v4[J >> 2][J & 3];
    f32x2 t = Z.t01 * (f32x2){c.kk[0], c.kk[1]}; t = Z.t23 * (f32x2){c.kk[2], c.kk[3]} + t;
    float sa = t.x + t.y;
    const f32x2 a01 = (f32x2){c.k[0], c.k[1]} * v + Z.t01, a23 = (f32x2){c.k[2], c.k[3]} * v + Z.t23;
    sa = allsum16(sa);
    Z.t01 = (f32x2){c.nbe[0], c.nbe[1]} * sa + a01; Z.t23 = (f32x2){c.nbe[2], c.nbe[3]} * sa + a23;
    f32x2 y2 = Z.t01 * (f32x2){c.r[0], c.r[1]}; y2 = Z.t23 * (f32x2){c.r[2], c.r[3]} + y2;
    ypb[J * 64] = y2.x + y2.y;
    Z.c0 = Z.c1; Z.c1 = nx;
}
template <int STRIDE_F, int... Js>
__device__ __forceinline__ void scan_chunk_s_impl(const LAS float* img, int cgi, ScanT& Z, LAS float* ypb, std::integer_sequence<int, Js...>) {
    (scan_step_s<STRIDE_F, Js>(img, cgi, Z, ypb), ...);
}
template <int STRIDE_F, int NS>
__device__ __forceinline__ void scan_transform(LAS float* img, int lane) {
    LAS float* p = img + lane; float Wc = 1.f;
#pragma unroll
    for (int t = 0; t < NS; ++t, p += STRIDE_F) {
        const float w = p[0], nb = p[64], kk = p[128], k = p[192], r = p[256];
        p[128] = Wc * kk;
        Wc *= w; const float inv = __builtin_amdgcn_rcpf(Wc);
        p[64] = nb * inv; p[192] = k * inv; p[256] = Wc * r;
    }
    img[(NS - 1) * STRIDE_F + lane] = Wc;
}
template <int STRIDE_F, int... Js>
__device__ __forceinline__ void scan_group_yp_impl(const LAS float* img, int s0, int vrow, int cgi, ScanState& Z, LAS float* ypb, std::integer_sequence<int, Js...>) {
    (scan_step_yp<STRIDE_F, Js>(img, s0, vrow, cgi, Z, ypb), ...);
}
template <int... Js>
__device__ __forceinline__ void yp_reduce_impl(const LAS float* ypb, int cgi, float* yout, int s0, std::integer_sequence<int, Js...>) {
    float ykeep = 0.f;
    ((ykeep = sel_lane16<Js>(ykeep, allsum16(ypb[(s0 + Js) * 64]))), ...);
    yout[(size_t)(s0 + cgi) * 512] = ykeep;
}
template <int STRIDE_F, int GS>
__device__ __forceinline__ void scan_group(const LAS float* img, int s0, int vrow, int cgi, ScanState& Z, float* yout) {
    scan_group_impl<STRIDE_F, GS>(img, s0, vrow, cgi, Z, yout, std::make_integer_sequence<int, GS>());
}
constexpr int SC = 32;
constexpr int PSTR = 328;
constexpr int SSTR = 384;
struct ScanRegs { f32x4 w[2]; u32x4 b0[2], b1[2]; u32x4 v; };
__device__ __forceinline__ void scan_load(const Frame& F, ScanRegs& R, int m0, int h, int v0) {
    if (F.wave < 4) return;
    const int vt = F.tid - 256;
#pragma unroll
    for (int i = 0; i < 2; ++i) {
        const int tid = vt + 256 * i;
        { const int row = tid >> 4, c4 = (tid & 15) * 4; R.w[i] = *(const f32x4*)((const float*)(F.ws + WS_SW) + (size_t)(m0 + row) * 512 + h * 64 + c4); }
        { const int st = tid >> 7, row = (tid & 127) >> 2, seg = tid & 3;
          const size_t base = st == 0 ? WS_SB : st == 1 ? WS_SKK : st == 2 ? WS_SK : WS_SR;
          const bf16_t* p = (const bf16_t*)(F.ws + base) + (size_t)(m0 + row) * 512 + h * 64 + seg * 16;
          R.b0[i] = *(const u32x4*)p; R.b1[i] = *(const u32x4*)(p + 8); }
    }
    { R.v = *(const u32x4*)((const bf16_t*)(F.ws + WS_SV) + (size_t)(m0 + (vt & 31)) * 512 + h * 64 + v0); }
}
__device__ __forceinline__ void scan_store(const Frame& F, const ScanRegs& R, LAS float* img) {
    if (F.wave < 4) return;
    const int vt = F.tid - 256;
#pragma unroll
    for (int i = 0; i < 2; ++i) {
        const int tid = vt + 256 * i;
        { const int row = tid >> 4, c4 = (tid & 15) * 4; *(LAS f32x4*)(img + row * PSTR + c4) = R.w[i]; }
        { const int st = tid >> 7, row = (tid & 127) >> 2, seg = tid & 3;
          LAS float* d = img + row * PSTR + 64 + st * 64 + seg * 16;
          const float sg = st == 0 ? -1.f : 1.f; const u32x4 b0 = R.b0[i], b1 = R.b1[i];
          *(LAS f32x4*)(d) = (f32x4){bflo(b0.x), bfhi(b0.x), bflo(b0.y), bfhi(b0.y)} * sg; *(LAS f32x4*)(d + 4) = (f32x4){bflo(b0.z), bfhi(b0.z), bflo(b0.w), bfhi(b0.w)} * sg;
          *(LAS f32x4*)(d + 8) = (f32x4){bflo(b1.x), bfhi(b1.x), bflo(b1.y), bfhi(b1.y)} * sg; *(LAS f32x4*)(d + 12) = (f32x4){bflo(b1.z), bfhi(b1.z), bflo(b1.w), bfhi(b1.w)} * sg; }
    }
    if (vt < 32) { LAS float* d = img + SC * PSTR + vt;
      d[0 * SC] = bflo(R.v.x); d[1 * SC] = bfhi(R.v.x); d[2 * SC] = bflo(R.v.y); d[3 * SC] = bfhi(R.v.y); d[4 * SC] = bflo(R.v.z); d[5 * SC] = bfhi(R.v.z); d[6 * SC] = bflo(R.v.w); d[7 * SC] = bfhi(R.v.w); }
}
constexpr int NSW = 2;
__device__ __forceinline__ void prompt_scan(Frame& F, int sblk) {
    const int xcd = sblk & 7, k = sblk >> 3;
    const int chain = xcd * 4 + (k >> 3), rg = k & 7;
    const int b = chain >> 3, h = chain & 7, v0 = rg * 8;
    LAS float* img = (LAS float*)F.lds;
    constexpr int IMG = SC * PSTR + 8 * SC;
    const int rl = F.lane >> 4, cgi = F.lane & 15;
    const int vrow = F.wave * 4 + rl;
    float* Y = F.out;
    ScanState Z; Z.s01 = (f32x2){0.f, 0.f}; Z.s23 = (f32x2){0.f, 0.f}; Z.ykeep = 0.f; Z.ypart = 0.f;
    ScanRegs R0, R1, R2, R3;
    const int mbase = b * T;
    constexpr int NCH = T / SC;
#ifndef SCAN_DUP
#define SCAN_DUP 1
#endif
    constexpr int NTOT = NCH * SCAN_DUP;
    scan_load(F, R0, mbase, h, v0); scan_store(F, R0, img);
    scan_load(F, R1, mbase + SC, h, v0); scan_store(F, R1, img + IMG);
    scan_load(F, R2, mbase + 2 * SC, h, v0); scan_load(F, R3, mbase + 3 * SC, h, v0);
    __syncthreads();
    if (F.wave == 4 || F.wave == 5) scan_transform<PSTR, 16>(img + (F.wave - 4) * 16 * PSTR, F.lane);
    __syncthreads();
    LAS float* ypr = (LAS float*)(F.lds + YP_OFF);
#define SCAN_CHUNK(cc_) do { const int c_ = (cc_) % NCH; \
        if (SCAN_DUP > 1 && c_ == 0) { Z.s01 = (f32x2){0.f, 0.f}; Z.s23 = (f32x2){0.f, 0.f}; } \
        if (F.wave < NSW) { const LAS float* im = img + ((cc_) % 3) * IMG; LAS float* ypb = ypr + (((cc_) & 1) * NSW + F.wave) * (SC * 64) + F.lane; \
            const LAS float* vtp = im + SC * PSTR + vrow * SC; \
            ScanT Tz; Tz.t01 = Z.s01; Tz.t23 = Z.s23; Tz.c0 = load_ops_s<PSTR>(im, 0, cgi); Tz.c1 = load_ops_s<PSTR>(im, 1, cgi); \
            _Pragma("unroll") for (int q_ = 0; q_ < 4; ++q_) Tz.v4[q_] = *(const LAS f32x4*)(vtp + 4 * q_); \
            scan_chunk_s_impl<PSTR>(im, cgi, Tz, ypb, std::make_integer_sequence<int, 16>()); \
            { const f32x4 wce = *(const LAS f32x4*)(im + 15 * PSTR + cgi * 4); Tz.t01 = Tz.t01 * (f32x2){wce[0], wce[1]}; Tz.t23 = Tz.t23 * (f32x2){wce[2], wce[3]}; } \
            _Pragma("unroll") for (int q_ = 0; q_ < 4; ++q_) Tz.v4[q_] = *(const LAS f32x4*)(vtp + 16 + 4 * q_); \
            scan_chunk_s_impl<PSTR>(im + 16 * PSTR, cgi, Tz, ypb + 16 * 64, std::make_integer_sequence<int, 16>()); \
            { const f32x4 wce = *(const LAS f32x4*)(im + 31 * PSTR + cgi * 4); Z.s01 = Tz.t01 * (f32x2){wce[0], wce[1]}; Z.s23 = Tz.t23 * (f32x2){wce[2], wce[3]}; } } \
        else if (F.wave < 2 * NSW && (cc_) > 0) { const int sw_ = F.wave - NSW, cp_ = ((cc_) - 1) % NCH; \
            const LAS float* ypb = ypr + ((((cc_) - 1) & 1) * NSW + sw_) * (SC * 64) + F.lane; float* yo = Y + (size_t)(mbase + cp_ * SC) * 512 + h * 64 + v0 + sw_ * 4 + rl; \
            yp_reduce_impl(ypb, cgi, yo, 0, std::make_integer_sequence<int, 16>()); yp_reduce_impl(ypb, cgi, yo, 16, std::make_integer_sequence<int, 16>()); } \
        else if ((F.wave == 4 || F.wave == 5) && (cc_) + 1 < NTOT) scan_transform<PSTR, 16>(img + (((cc_) + 1) % 3) * IMG + (F.wave - 4) * 16 * PSTR, F.lane); } while (0)
#define SCAN_ITER(j_, RL_, RS_) do { const int c4_ = cc + (j_); \
        scan_load(F, RL_, mbase + ((c4_ + 4 < NTOT ? c4_ + 4 : NTOT - 1) % NCH) * SC, h, v0);        \
        SCAN_CHUNK(c4_); \
        if (c4_ + 2 < NTOT) scan_store(F, RS_, img + ((c4_ + 2) % 3) * IMG);                         \
        asm volatile("s_waitcnt lgkmcnt(0)\n\ts_barrier" ::: "memory"); } while (0)
#pragma unroll 1
    for (int cc = 0; cc < NTOT; cc += 4) {
        SCAN_ITER(0, R0, R2); SCAN_ITER(1, R1, R3); SCAN_ITER(2, R2, R0); SCAN_ITER(3, R3, R1);
    }
#undef SCAN_ITER
#undef SCAN_CHUNK
    if (F.wave >= NSW && F.wave < 2 * NSW) { const int sw_ = F.wave - NSW, cp_ = (NTOT - 1) % NCH;
        const LAS float* ypb = ypr + (((NTOT - 1) & 1) * NSW + sw_) * (SC * 64) + F.lane; float* yo = Y + (size_t)(mbase + cp_ * SC) * 512 + h * 64 + v0 + sw_ * 4 + rl;
        yp_reduce_impl(ypb, cgi, yo, 0, std::make_integer_sequence<int, 16>()); yp_reduce_impl(ypb, cgi, yo, 16, std::make_integer_sequence<int, 16>()); }
    __syncthreads();
    if (F.wave < NSW) *(f32x4*)(F.out + O_WKVP + ((size_t)(b * 8 + h) * 64 + v0 + vrow) * 64 + cgi * 4) = (f32x4){Z.s01.x, Z.s01.y, Z.s23.x, Z.s23.y};
}
__device__ __forceinline__ void sample_scan(Frame& F, int sblk, int nsblk) {
    LAS float* img0 = (LAS float*)F.lds;
    float* Y = F.out;
    const int rl = F.lane >> 4, cgi = F.lane & 15;
    constexpr int IMGS = DT * SSTR, BATCH = 8;
    for (int base = sblk; base < DB * 8; base += nsblk * BATCH) {
#pragma unroll 1
        for (int ci = 0; ci < BATCH; ++ci) {
            const int chain = base + ci * nsblk; if (chain >= DB * 8) break;
            const int b = chain >> 3, h = chain & 7; const int m0 = MP + b * DT; LAS float* img = img0 + ci * IMGS;
            for (int e = F.tid; e < 6 * DT * 64; e += NT) {
                const int st = e >> 9, row = (e >> 6) & 7, ch = e & 63; const size_t o = (size_t)(m0 + row) * 512 + h * 64 + ch;
                float val;
                if (st == 0) val = ((const float*)(F.ws + WS_SW))[o];
                else { const size_t bs = st == 1 ? WS_SB : st == 2 ? WS_SKK : st == 3 ? WS_SK : st == 4 ? WS_SR : WS_SV; val = bf2f(((const bf16_t*)(F.ws + bs))[o]); if (st == 1) val = -val; }
                img[row * SSTR + st * 64 + ch] = val;
            }
        }
        __syncthreads();
#pragma unroll 1
        for (int ci = 0; ci < BATCH; ++ci) {
            const int chain = base + ci * nsblk; if (chain >= DB * 8) break;
            const int b = chain >> 3, h = chain & 7; const int m0 = MP + b * DT; const LAS float* img = img0 + ci * IMGS;
#pragma unroll 1
            for (int rnd = 0; rnd < 2; ++rnd) {
                const int vrow = (rnd * 8 + F.wave) * 4 + rl;
                const float* s0 = F.in[5] + ((size_t)chain * 64 + vrow) * 64 + cgi * 4;
                const f32x4 S = *(const f32x4*)s0;
                ScanState Z; Z.s01 = (f32x2){S[0], S[1]}; Z.s23 = (f32x2){S[2], S[3]}; Z.ykeep = 0.f; Z.ypart = 0.f;
                Z.c0 = load_ops<SSTR>(img, 0, cgi, vrow); Z.c1 = load_ops<SSTR>(img, 1, cgi, vrow);
                scan_group<SSTR, DT>(img, 0, vrow, cgi, Z, Y + (size_t)m0 * 512 + h * 64 + vrow);
                *(f32x4*)(F.out + O_WKVS + ((size_t)chain * 64 + vrow) * 64 + cgi * 4) = (f32x4){Z.s01.x, Z.s01.y, Z.s23.x, Z.s23.y};
            }
        }
        __syncthreads();
    }
}

__device__ __forceinline__ void post_phase(Frame& F) {
    const bf16_t* HRW = (const bf16_t*)(F.ws + WS_HRW);
    const bf16_t* SR = (const bf16_t*)(F.ws + WS_SR); const bf16_t* SK = (const bf16_t*)(F.ws + WS_SK); const bf16_t* SV = (const bf16_t*)(F.ws + WS_SV);
    const float* Y = F.out; bf16_t* OC = (bf16_t*)(F.ws + WS_OCAT);
    const int fr = F.lane & 15, fq = F.lane >> 4, h = F.wave;
    bf16x8 Ag[4][3];
#pragma unroll
    for (int nt = 0; nt < 4; ++nt)
#pragma unroll
        for (int s3 = 0; s3 < 3; ++s3) Ag[nt][s3] = ld_frag(F, 2, h, nt, s3);
    constexpr int NTILE = M / 16;
    f32x4 prk[4], pgw[4], pgb[4], pmg[3][2];
#pragma unroll
    for (int i = 0; i < 4; ++i) { const int c4 = h * 64 + 16 * fq + 4 * i; prk[i] = *(const f32x4*)(F.in[18] + c4); pgw[i] = *(const f32x4*)(F.in[19] + c4); pgb[i] = *(const f32x4*)(F.in[20] + c4); }
#pragma unroll
    for (int s3 = 0; s3 < 3; ++s3) { pmg[s3][0] = *(const f32x4*)(F.in[10] + 1600 + 32 * s3 + 8 * fq); pmg[s3][1] = *(const f32x4*)(F.in[10] + 1604 + 32 * s3 + 8 * fq); }
    for (int tile_ = F.bid; tile_ < NTILE * POST_DUP; tile_ += F.G) {
        const int m = (tile_ % NTILE) * 16 + fr;
        const RowInfo ri = row_info(m);
        bf16x8 xg[3];
#pragma unroll
        for (int s3 = 0; s3 < 3; ++s3) {
            const F8 a = hs8m(F, HRW, m, ri, 1600 + 32 * s3 + 8 * fq, pmg[s3][0], pmg[s3][1]);
            f32x4 t0, t1;
#pragma unroll
            for (int i = 0; i < 4; ++i) { t0[i] = sigmoidf_(a.a[i]); t1[i] = sigmoidf_(a.b[i]); }
            xg[s3] = __builtin_bit_cast(bf16x8, pk8(t0, t1));
        }
        f32x4 y4[4], v4[4], g4[4]; float sy = 0.f, dot = 0.f;
#pragma unroll
        for (int np = 0; np < 2; ++np) {
            const int c8 = h * 64 + 16 * fq + 8 * np; const size_t o = (size_t)m * 512 + c8;
#pragma unroll
            for (int q = 0; q < 2; ++q) { f32x4 g = {0.f, 0.f, 0.f, 0.f};
#pragma unroll
                for (int s3 = 0; s3 < 3; ++s3) g = __builtin_amdgcn_mfma_f32_16x16x32_bf16(Ag[2 * np + q][s3], xg[s3], g, 0, 0, 0);
                g4[2 * np + q] = g; }
            const f32x4 ya = *(const f32x4*)(Y + o), yb = *(const f32x4*)(Y + o + 4);
            const F8 r8 = ld_bf8(SR + o), k8 = ld_bf8(SK + o), v8 = ld_bf8(SV + o);
            const f32x4 rka = prk[2 * np], rkb = prk[2 * np + 1];
            y4[2 * np] = ya; y4[2 * np + 1] = yb; v4[2 * np] = v8.a; v4[2 * np + 1] = v8.b;
            sy += ((ya[0] + ya[1]) + (ya[2] + ya[3])) + ((yb[0] + yb[1]) + (yb[2] + yb[3]));
            const f32x4 pa = r8.a * k8.a * rka, pb = r8.b * k8.b * rkb; dot += ((pa[0] + pa[1]) + (pa[2] + pa[3])) + ((pb[0] + pb[1]) + (pb[2] + pb[3]));
        }
        const float mean = xsum_fq(sy) * (1.f / 64.f); dot = xsum_fq(dot);
        float sq = 0.f;
#pragma unroll
        for (int nt = 0; nt < 4; ++nt) { y4[nt] = y4[nt] - mean; const f32x4 d = y4[nt]; sq += (d[0] * d[0] + d[1] * d[1]) + (d[2] * d[2] + d[3] * d[3]); }
        const float rstd = rsqrtf(xsum_fq(sq) * (1.f / 64.f) + GN_EPS);
#pragma unroll
        for (int np = 0; np < 2; ++np) {
            const int c8 = h * 64 + 16 * fq + 8 * np;
            f32x4 oo[2];
#pragma unroll
            for (int q = 0; q < 2; ++q) { const f32x4 gw = pgw[2 * np + q], gb = pgb[2 * np + q];
                oo[q] = (y4[2 * np + q] * rstd * gw + gb + v4[2 * np + q] * dot) * g4[2 * np + q]; }
            *(u32x4*)(OC + (size_t)m * DM + 512 + c8) = pk8(oo[0], oo[1]);
        }
    }
}

__device__ __forceinline__ f32x4 bf4_to_f(const u32x2 w) { return (f32x4){bflo(w.x), bfhi(w.x), bflo(w.y), bfhi(w.y)}; }
__device__ __forceinline__ float sumsq4(const f32x4 (&v)[4]) { float s = 0.f;
#pragma unroll
    for (int j = 0; j < 4; ++j) s += (v[j].x * v[j].x + v[j].y * v[j].y) + (v[j].z * v[j].z + v[j].w * v[j].w);
    return s; }
__device__ __forceinline__ void rows_mid(Frame& F) {
    const int gw = F.bid * NWAVES + F.wave, NGW = F.G * NWAVES;
    const f32x4* g1 = (const f32x4*)F.in[22]; const f32x4* g2 = (const f32x4*)F.in[23];
    bf16_t* XN = (bf16_t*)(F.ws + WS_XN); const bf16_t* MIXb = (const bf16_t*)(F.ws + WS_MIX);
    f32x4 ga[4], gb2[4];
#pragma unroll
    for (int j = 0; j < 4; ++j) { ga[j] = g1[64 * j + F.lane]; gb2[j] = g2[64 * j + F.lane]; }
    for (int m = gw; m < M; m += 2 * NGW) {
        const int m1 = m + NGW; const bool has1 = m1 < M; const int mm1 = has1 ? m1 : m;
        const f32x4* xr0 = (const f32x4*)xrow_ptr(F, m) + F.lane; const f32x4* xr1 = (const f32x4*)xrow_ptr(F, mm1) + F.lane;
        const u32x2* mb0 = (const u32x2*)(MIXb + (size_t)m * DM) + F.lane; const u32x2* mb1 = (const u32x2*)(MIXb + (size_t)mm1 * DM) + F.lane;
        f32x4 v0[4], v1[4], x0[4], x1[4];
#pragma unroll
        for (int j = 0; j < 4; ++j) { v0[j] = bf4_to_f(__builtin_nontemporal_load(mb0 + 64 * j)); x0[j] = __builtin_nontemporal_load(xr0 + 64 * j); }
#pragma unroll
        for (int j = 0; j < 4; ++j) { v1[j] = bf4_to_f(__builtin_nontemporal_load(mb1 + 64 * j)); x1[j] = __builtin_nontemporal_load(xr1 + 64 * j); }
        const float ra = 1.0f / sqrtf(wave_sum(sumsq4(v0)) * (1.f / DM) + RMS_EPS), rb = 1.0f / sqrtf(wave_sum(sumsq4(v1)) * (1.f / DM) + RMS_EPS);
#pragma unroll
        for (int j = 0; j < 4; ++j) { const f32x4 gg = ga[j]; v0[j] = x0[j] + v0[j] * ra * gg; v1[j] = x1[j] + v1[j] * rb * gg; }
        const float qa = 1.0f / sqrtf(wave_sum(sumsq4(v0)) * (1.f / DM) + RMS_EPS), qb = 1.0f / sqrtf(wave_sum(sumsq4(v1)) * (1.f / DM) + RMS_EPS);
        u32x2* o0 = (u32x2*)(XN + (size_t)m * DM) + F.lane; u32x2* o1 = (u32x2*)(XN + (size_t)mm1 * DM) + F.lane;
#pragma unroll
        for (int j = 0; j < 4; ++j) { const f32x4 gg = gb2[j];
            u32x2 w; w.x = pk2(v0[j].x * qa * gg.x, v0[j].y * qa * gg.y); w.y = pk2(v0[j].z * qa * gg.z, v0[j].w * qa * gg.w); o0[64 * j] = w;
            if (has1) { u32x2 q; q.x = pk2(v1[j].x * qb * gg.x, v1[j].y * qb * gg.y); q.y = pk2(v1[j].z * qb * gg.z, v1[j].w * qb * gg.w); o1[64 * j] = q; } }
    }
}
__device__ __forceinline__ void rows_final(Frame& F) {
    const int gw = F.bid * NWAVES + F.wave, NGW = F.G * NWAVES;
    const f32x4* g0 = (const f32x4*)F.in[22]; const f32x4* g1 = (const f32x4*)F.in[28];
    const bf16_t* Fb = (const bf16_t*)(F.ws + WS_F); const bf16_t* MIXb = (const bf16_t*)(F.ws + WS_MIX);
    f32x4 gA[4], gB[4];
#pragma unroll
    for (int j = 0; j < 4; ++j) { gA[j] = g0[64 * j + F.lane]; gB[j] = g1[64 * j + F.lane]; }
    for (int m = gw; m < M; m += 2 * NGW) {
        const int m1 = m + NGW; const bool has1 = m1 < M; const int mm1 = has1 ? m1 : m;
        f32x4 f0[4], f1[4], a0[4], a1[4], x0[4], x1[4];
        { const u32x2* fr = (const u32x2*)(Fb + (size_t)m * DM) + F.lane; const u32x2* mb = (const u32x2*)(MIXb + (size_t)m * DM) + F.lane; const f32x4* xr = (const f32x4*)xrow_ptr(F, m) + F.lane;
#pragma unroll
          for (int j = 0; j < 4; ++j) { f0[j] = bf4_to_f(__builtin_nontemporal_load(fr + 64 * j)); a0[j] = bf4_to_f(__builtin_nontemporal_load(mb + 64 * j)); x0[j] = __builtin_nontemporal_load(xr + 64 * j); } }
        { const u32x2* fr = (const u32x2*)(Fb + (size_t)mm1 * DM) + F.lane; const u32x2* mb = (const u32x2*)(MIXb + (size_t)mm1 * DM) + F.lane; const f32x4* xr = (const f32x4*)xrow_ptr(F, mm1) + F.lane;
#pragma unroll
          for (int j = 0; j < 4; ++j) { f1[j] = bf4_to_f(__builtin_nontemporal_load(fr + 64 * j)); a1[j] = bf4_to_f(__builtin_nontemporal_load(mb + 64 * j)); x1[j] = __builtin_nontemporal_load(xr + 64 * j); } }
        const float rf0 = 1.0f / sqrtf(wave_sum(sumsq4(f0)) * (1.f / DM) + RMS_EPS), rm0 = 1.0f / sqrtf(wave_sum(sumsq4(a0)) * (1.f / DM) + RMS_EPS);
        const float rf1 = 1.0f / sqrtf(wave_sum(sumsq4(f1)) * (1.f / DM) + RMS_EPS), rm1 = 1.0f / sqrtf(wave_sum(sumsq4(a1)) * (1.f / DM) + RMS_EPS);
        f32x4* y0 = (f32x4*)(F.out + (size_t)m * DM) + F.lane; f32x4* y1 = (f32x4*)(F.out + (size_t)mm1 * DM) + F.lane;
#pragma unroll
        for (int j = 0; j < 4; ++j) { const f32x4 ga = gA[j], gb = gB[j];
            __builtin_nontemporal_store((x0[j] + a0[j] * rm0 * ga) + f0[j] * rf0 * gb, y0 + 64 * j);
            if (has1) __builtin_nontemporal_store((x1[j] + a1[j] * rm1 * ga) + f1[j] * rf1 * gb, y1 + 64 * j); }
    }
}
__device__ __forceinline__ void conv_phase(Frame& F, int half) {
    const bf16_t* ZU = (const bf16_t*)(F.ws + WS_ZU); bf16_t* HID = (bf16_t*)(F.ws + WS_HID);
    const float* cw = F.in[25]; const float* cb = F.in[26]; const float* sc = F.in[6];
    const long total = (long)M * 176;
    for (long e = (long)F.bid * NT + F.tid; e < total; e += (long)F.G * NT) {
        const int m = (int)(e / 176), r = (int)(e - (long)m * 176); const int tile = r >> 4, c8 = (r & 15) * 8;
        const int ch = (half * 11 + tile) * 128 + c8;
        const RowInfo ri = row_info(m);
        const bf16_t* zp = ZU + (size_t)m * DFF + tile * 256 + c8;
        const u32x4 z0 = *(const u32x4*)zp, uu = *(const u32x4*)(zp + 128);
        float z[8], z1[8], z2[8], u8[8];
        z[0] = bflo(z0.x); z[1] = bfhi(z0.x); z[2] = bflo(z0.y); z[3] = bfhi(z0.y); z[4] = bflo(z0.z); z[5] = bfhi(z0.z); z[6] = bflo(z0.w); z[7] = bfhi(z0.w);
        u8[0] = bflo(uu.x); u8[1] = bfhi(uu.x); u8[2] = bflo(uu.y); u8[3] = bfhi(uu.y); u8[4] = bflo(uu.z); u8[5] = bfhi(uu.z); u8[6] = bflo(uu.w); u8[7] = bfhi(uu.w);
        if (ri.t >= 1) { const u32x4 w = *(const u32x4*)(zp - DFF); z1[0] = bflo(w.x); z1[1] = bfhi(w.x); z1[2] = bflo(w.y); z1[3] = bfhi(w.y); z1[4] = bflo(w.z); z1[5] = bfhi(w.z); z1[6] = bflo(w.w); z1[7] = bfhi(w.w); }
        else {
#pragma unroll
            for (int j = 0; j < 8; ++j) z1[j] = ri.samp ? sc[((size_t)ri.b * 2 + 1) * DFF + ch + j] : 0.f; }
        if (ri.t >= 2) { const u32x4 w = *(const u32x4*)(zp - 2 * DFF); z2[0] = bflo(w.x); z2[1] = bfhi(w.x); z2[2] = bflo(w.y); z2[3] = bfhi(w.y); z2[4] = bflo(w.z); z2[5] = bfhi(w.z); z2[6] = bflo(w.w); z2[7] = bfhi(w.w); }
        else {
#pragma unroll
            for (int j = 0; j < 8; ++j) z2[j] = ri.samp ? sc[((size_t)ri.b * 2 + ri.t) * DFF + ch + j] : 0.f; }
        float hd[8];
#pragma unroll
        for (int j = 0; j < 8; ++j) { const float zc = cb[ch + j] + cw[ch + j] * z2[j] + cw[DFF + ch + j] * z1[j] + cw[2 * DFF + ch + j] * z[j]; hd[j] = zc * sigmoidf_(zc) * u8[j]; }
        u32x4 w; w.x = pk2(hd[0], hd[1]); w.y = pk2(hd[2], hd[3]); w.z = pk2(hd[4], hd[5]); w.w = pk2(hd[6], hd[7]);
        *(u32x4*)(HID + (size_t)m * DFF + ch) = w;
    }
}

constexpr int NPHASE = 10;
__global__ void __launch_bounds__(NT, 2) fwd_megakernel(Args args) {
    extern __shared__ __attribute__((aligned(16))) unsigned char lds_raw[];
    Frame F;
    F.lds = (LAS unsigned char*)lds_raw; F.ws = args.ws; F.out = args.out; F.in = args.in;
    F.tid = threadIdx.x; F.lane = F.tid & 63; F.wave = __builtin_amdgcn_readfirstlane(F.tid >> 6); F.G = gridDim.x; F.bid = blockIdx.x;
    const int lo = args.ph_lo, hi = args.ph_hi;
#ifndef PH_MASK
#define PH_MASK 0x3ff
#endif
#ifndef DUP_MASK
#define DUP_MASK 0
#endif
#define IN(k) (((PH_MASK >> (k)) & 1) && lo <= (k) && (k) < hi)
#define REP(k) for (int rep_ = 0; rep_ < 1 + ((DUP_MASK >> (k)) & 1); ++rep_)
    unsigned* barw = (unsigned*)F.ws;
    volatile LAS unsigned* bst = (volatile LAS unsigned*)(F.lds + LDS_BYTES - 64);
    if (F.tid < 2) bst[F.tid] = 0u;
    XcdBarrier xbar; xbar.bar = barw; xbar.x = 0; xbar.st = bst;
    bool posted = false;
    if (lo + 1 < hi && F.bid == 0) { for (int i = F.tid; i < XCD_BAR_WORDS; i += NT) barw[i] = 0u; }
#define SEAM(k) do { if (IN(k) && IN((k) + 1)) { if (!posted) { cg::this_grid().sync(); xbar = xcd_barrier_post(barw, bst); posted = true; } else xcd_barrier(xbar); } } while (0)
    bf16_t* XN = (bf16_t*)(F.ws + WS_XN);
    if (IN(0)) REP(0) { p0_prologue(F); p0_frag_table(F); } SEAM(0);
    if (IN(1)) REP(1) {
        pg8::Gemm g{XN, (const bf16_t*)(F.ws + WS_WIN), M, DINP, DM, DM, DM, 0}; pg8::StaticOrder S; S.init(M, DINP, F.G, F.bid);
        Epi1 E{(const float*)(F.ws + WS_ROPE), (bf16_t*)(F.ws + WS_Q), (bf16_t*)(F.ws + WS_K), (bf16_t*)(F.ws + WS_VT), (bf16_t*)(F.ws + WS_HRW), F.out};
        pg8::gemm_phase<Epi1, true>(F.lds, g, S, E);
    } SEAM(1);
    if (IN(2)) REP(2) { prep_phase(F); sample_attn_phase(F); } SEAM(2);
    if (IN(3)) {
        if (F.G == 256) {
            constexpr int AOFF = 71680;
            prompt_attn_unit<1>(F, F.bid, 0); prompt_attn_unit<1>(F, F.bid + 256, AOFF);
            __syncthreads();
            prompt_attn_unit<2>(F, F.bid, 0); prompt_attn_unit<2>(F, F.bid + 256, AOFF);
            __syncthreads();
        } else for (int u = F.bid; u < NB * 64 * 2; u += F.G) prompt_attn_unit<0>(F, u, 0);
        sample_scan(F, F.bid, F.G);
        for (int sb = F.bid; sb < 256; sb += F.G) prompt_scan(F, sb);
    } SEAM(3);
    if (IN(4)) REP(4) { post_phase(F); } SEAM(4);
    if (IN(5)) REP(5) {
        pg8::Gemm g{(const bf16_t*)(F.ws + WS_OCAT), (const bf16_t*)(F.ws + WS_WOUT), M, DM, DM, DM, DM, 0}; pg8::StaticOrder S; S.init(M, DM, F.G, F.bid);
        EpiBf16 E{(bf16_t*)(F.ws + WS_MIX), DM};
        pg8::gemm_phase<EpiBf16, true>(F.lds, g, S, E);
    } SEAM(5);
    if (IN(6)) { rows_mid(F); } SEAM(6);
    if (IN(7)) REP(7) {
        pg8::Gemm g{XN, (const bf16_t*)(F.ws + WS_WFI), 136 * 256, 2 * DFF, DM, DM, DM, 1}; pg8::StaticOrder S; S.init(136 * 256, 2 * DFF, F.G, F.bid);
        EpiConv E{(bf16_t*)(F.ws + WS_HID), F.out, F.in[25], F.in[26], F.in[6], (LAS float*)(F.lds + 131072)};
        pg8::gemm_phase<EpiConv, true>(F.lds, g, S, E);
    } SEAM(7);
    if (IN(8)) REP(11) {
        pg8::Gemm g{(const bf16_t*)(F.ws + WS_HID), (const bf16_t*)(F.ws + WS_WFO), M, DM, DFF, DFF, DFF, 0}; pg8::StaticOrder S; S.init(M, DM, F.G, F.bid);
        EpiBf16 E{(bf16_t*)(F.ws + WS_F), DM};
        pg8::gemm_phase<EpiBf16, true>(F.lds, g, S, E);
    } SEAM(8);
    if (IN(9)) { rows_final(F); }
#undef IN
#undef SEAM
}

extern "C" void kernel_launch(void* const* d_in, const int* in_sizes, int n_in, void* d_out, int out_size, void* d_ws, size_t ws_size, hipStream_t stream) {
    static int grid = 0;
    if (grid == 0) {
        if (n_in != 29 || ws_size < WS_END) { fprintf(stderr, "kernel_launch: unexpected n_in %d / ws_size %zu\n", n_in, ws_size); grid = -1; return; }
        int dev = 0, cus = 0, per_cu = 0;
        hipGetDevice(&dev); hipDeviceGetAttribute(&cus, hipDeviceAttributeMultiprocessorCount, dev);
        if (hipFuncSetAttribute((const void*)fwd_megakernel, hipFuncAttributeMaxDynamicSharedMemorySize, LDS_BYTES) != hipSuccess) { fprintf(stderr, "kernel_launch: hipFuncSetAttribute failed\n"); grid = -1; return; }
        if (hipOccupancyMaxActiveBlocksPerMultiprocessor(&per_cu, (const void*)fwd_megakernel, NT, LDS_BYTES) != hipSuccess || per_cu < 1) { fprintf(stderr, "kernel_launch: occupancy query failed (%d)\n", per_cu); (void)hipGetLastError(); per_cu = 1; }
        grid = cus * (per_cu > 1 ? 1 : per_cu);
        fprintf(stderr, "kernel_launch: grid %d (cus %d, per_cu %d), ws %zu\n", grid, cus, per_cu, ws_size);
    }
    if (grid < 0) return;
    Args a{};
    for (int i = 0; i < 29; ++i) a.in[i] = (const float*)d_in[i];
    a.out = (float*)d_out; a.ws = (unsigned char*)d_ws;
#if MK_PER_PHASE
    for (int p = 0; p < NPHASE; ++p) { a.ph_lo = p; a.ph_hi = p + 1; hipLaunchKernelGGL(fwd_megakernel, dim3(grid), dim3(NT), LDS_BYTES, stream, a); }
#else
    a.ph_lo = 0; a.ph_hi = NPHASE;
    void* kargs[] = {&a};
    hipError_t e = hipLaunchCooperativeKernel((const void*)fwd_megakernel, dim3(grid), dim3(NT), kargs, LDS_BYTES, stream);
    if (e != hipSuccess) fprintf(stderr, "cooperative launch failed: %s (grid %d)\n", hipGetErrorString(e), grid);
#endif
}
```
